# Optimizing an MI355X kernel written in HIP

```python
import math
import jax, jax.numpy as jnp
from jax import lax
import numpy as np

D_MODEL = 1024
BATCH = 32
SEQ = 256
DEPTH = 2
DEC_BATCH = 8
DEC_SEQ = 1024
PAST_LEN = 256

GRID_W = 64
HEAD_DIM = 64
N_Q_HEADS = 8
N_KV_HEADS = 2
Q_PER_KV = N_Q_HEADS // N_KV_HEADS
ATTN_WIDTH = N_Q_HEADS * HEAD_DIM
KV_WIDTH = N_KV_HEADS * HEAD_DIM
FOURIER_WIDTH = D_MODEL // 4
FOURIER_GROUPS = 4
FOURIER_GROUP_DIM = FOURIER_WIDTH // FOURIER_GROUPS
HYENA_WIDTH = D_MODEL // 4
HYENA_ORDER = 2
HYENA_PROJ = (HYENA_ORDER + 1) * HYENA_WIDTH
SHORT_CONV = 3
HYENA_EMB_DIM = 33
HYENA_BANDS = (HYENA_EMB_DIM - 1) // 2
HYENA_FILTER_WIDTH = 64
HYENA_MIN_DECAY = 3.07
HYENA_MAX_DECAY = 15.35
MIX_WIDTH = FOURIER_WIDTH + HYENA_WIDTH + ATTN_WIDTH
IN_WIDTH = FOURIER_WIDTH + HYENA_PROJ + ATTN_WIDTH + 2 * KV_WIDTH
WINDOW = 128
BLOCK = 128
ROPE_BASE = 10000.0
D_FF = 2816
N_SUB = 3
RMS_EPS = 1e-6

kernel_name = 'hybrid_prefix_dit_step'

F32 = jnp.float32


def rmsnorm(x, g):
    xf = x.astype(F32)
    y = xf * lax.rsqrt(jnp.mean(xf * xf, axis=-1, keepdims=True) + RMS_EPS)
    return (y * g.astype(F32)).astype(x.dtype)


def modulation(cvec, w, b):
    m = jax.nn.silu(cvec) @ w + b
    return m.reshape(m.shape[0], 1, N_SUB, 3, D_MODEL)


def swiglu(h, wg, wu, wd):
    return (jax.nn.silu(h @ wg) * (h @ wu)) @ wd


def fourier_mix(u):
    b, n, _ = u.shape
    uf = u.astype(F32).reshape(b, n, FOURIER_GROUPS, FOURIER_GROUP_DIM)
    y = jnp.fft.fft2(uf, axes=(1, 3), norm='ortho').real
    return y.reshape(b, n, FOURIER_WIDTH).astype(u.dtype)


def short_conv(x, w):
    n = x.shape[1]
    pad = SHORT_CONV // 2
    xp = jnp.pad(x, ((0, 0), (pad, pad), (0, 0)))
    return sum(xp[:, i:i + n] * w[i] for i in range(SHORT_CONV))


def hyena_filters(n, w1, b1, w2, b2, w3, freq, decay):
    d = jnp.arange(n, dtype=F32)
    t = jnp.linspace(0.0, 1.0, n, dtype=F32)[:, None]
    f = jnp.linspace(1e-4, HYENA_BANDS - 1, HYENA_BANDS, dtype=F32)
    ang = (2.0 * math.pi / n) * d[:, None] * f[None, :]
    feats = jnp.concatenate([t, jnp.cos(ang), -jnp.sin(ang)], axis=-1)
    fr = freq.astype(F32)
    h = jnp.sin(fr * (feats @ w1.astype(F32) + b1.astype(F32)))
    h = jnp.sin(fr * (h @ w2.astype(F32) + b2.astype(F32)))
    h = (h @ w3.astype(F32)).reshape(n, 2, HYENA_ORDER, HYENA_WIDTH)
    window = jnp.exp(-t[:, :, None] * jnp.abs(decay.astype(F32))[None])
    h = h * window[:, None]
    fwd, bwd = h[:, 0], h[:, 1]
    return jnp.concatenate([fwd, jnp.zeros_like(fwd[:1]), bwd[:0:-1]], axis=0)


def fft_long_conv(u, k, bias):
    n = u.shape[1]
    uf = jnp.fft.rfft(u.astype(F32), n=2 * n, axis=1)
    kf = jnp.fft.rfft(k, n=2 * n, axis=0)
    y = jnp.fft.irfft(uf * kf[None], n=2 * n, axis=1)[:, :n] / (2 * n)
    return (y + u.astype(F32) * bias.astype(F32)).astype(u.dtype)


def hyena_mix(u, conv_w, w1, b1, w2, b2, w3, freq, decay, bias):
    z = short_conv(u, conv_w)
    v, g1, g2 = jnp.split(z, HYENA_ORDER + 1, axis=-1)
    k = hyena_filters(u.shape[1], w1, b1, w2, b2, w3, freq, decay)
    z = g1 * fft_long_conv(v, k[:, 0], bias[0])
    return g2 * fft_long_conv(z, k[:, 1], bias[1])


def rope_half(x, ang):
    c = jnp.cos(ang)[None, :, None, :]
    s = jnp.sin(ang)[None, :, None, :]
    x1, x2 = jnp.split(x.astype(F32), 2, axis=-1)
    return jnp.concatenate([x1 * c - x2 * s, x2 * c + x1 * s], axis=-1)


def axial_rope(x):
    n = x.shape[1]
    rows = n // GRID_W
    row = jnp.repeat(jnp.arange(rows, dtype=F32), GRID_W)
    col = jnp.tile(jnp.arange(GRID_W, dtype=F32), rows)
    half = HEAD_DIM // 2
    inv = ROPE_BASE ** (-jnp.arange(0, half, 2, dtype=F32) / half)
    xr, xc = jnp.split(x, 2, axis=-1)
    out = jnp.concatenate([rope_half(xr, row[:, None] * inv[None]),
                           rope_half(xc, col[:, None] * inv[None])], axis=-1)
    return out.astype(x.dtype)


def latent_attention(q, k, v, ck, cv, sink):
    b, n = q.shape[:2]
    nb = n // BLOCK
    c_len = ck.shape[1]
    scale = HEAD_DIM ** -0.5
    qb = q.reshape(b, nb, BLOCK, N_KV_HEADS, Q_PER_KV, HEAD_DIM)
    pad = ((0, 0), (BLOCK, BLOCK), (0, 0), (0, 0))
    kb = jnp.pad(k, pad).reshape(b, nb + 2, BLOCK, N_KV_HEADS, HEAD_DIM)
    vb = jnp.pad(v, pad).reshape(b, nb + 2, BLOCK, N_KV_HEADS, HEAD_DIM)
    band = lambda t: jnp.concatenate([t[:, :-2], t[:, 1:-1], t[:, 2:]], axis=2)
    kband, vband = band(kb), band(vb)
    qi = jnp.arange(BLOCK)
    kj = jnp.arange(3 * BLOCK)
    blk = jnp.arange(nb)
    rel = kj[None, :] - BLOCK - qi[:, None]
    kpos = (blk[:, None] - 1) * BLOCK + kj[None, :]
    valid = (jnp.abs(rel) <= WINDOW)[None] & ((kpos >= 0) & (kpos < n))[:, None, :]
    s_loc = jnp.einsum('bnqhgd,bnshd->bnhgqs', qb, kband, preferred_element_type=F32) * scale
    s_loc = jnp.where(valid[None, :, None, None], s_loc, -jnp.inf)
    s_ctx = jnp.einsum('bnqhgd,bchd->bnhgqc', qb, ck, preferred_element_type=F32) * scale
    s_sink = jnp.broadcast_to(sink.astype(F32).reshape(N_KV_HEADS, Q_PER_KV)[None, None, :, :, None, None],
                              s_loc.shape[:-1] + (1,))
    p = jax.nn.softmax(jnp.concatenate([s_loc, s_ctx, s_sink], axis=-1), axis=-1)
    s_w = 3 * BLOCK
    o = (jnp.einsum('bnhgqs,bnshd->bnqhgd', p[..., :s_w].astype(v.dtype), vband)
         + jnp.einsum('bnhgqc,bchd->bnqhgd', p[..., s_w:s_w + c_len].astype(cv.dtype), cv))
    return o.reshape(b, n, ATTN_WIDTH)


def context_attention(q, k, v, sink):
    b, c_len = q.shape[:2]
    nq = c_len // BLOCK
    scale = HEAD_DIM ** -0.5
    qb = q.reshape(b, nq, BLOCK, N_KV_HEADS, Q_PER_KV, HEAD_DIM).transpose(1, 0, 2, 3, 4, 5)
    sink_col = sink.astype(F32).reshape(N_KV_HEADS, Q_PER_KV)

    def one_block(qblk):
        s = jnp.einsum('bqhgd,bchd->bhgqc', qblk, k, preferred_element_type=F32) * scale
        s_sink = jnp.broadcast_to(sink_col[None, :, :, None, None], s.shape[:-1] + (1,))
        p = jax.nn.softmax(jnp.concatenate([s, s_sink], axis=-1), axis=-1)[..., :c_len]
        return jnp.einsum('bhgqc,bchd->bqhgd', p.astype(v.dtype), v)

    o = lax.map(one_block, qb)
    return o.transpose(1, 0, 2, 3, 4, 5).reshape(b, c_len, ATTN_WIDTH)


def trunk_layer(x, m, latent, ctx_k, ctx_v, g, wg, wu, wd, w_in, w_out, conv_w,
                f_w1, f_b1, f_w2, f_b2, f_w3, f_freq, decay, hbias, sink):
    b, n, _ = x.shape
    h = rmsnorm(x, g[0]) * (1 + m[:, :, 0, 1]) + m[:, :, 0, 0]
    x = x + 0.5 * m[:, :, 0, 2] * rmsnorm(swiglu(h, wg[0], wu[0], wd[0]), g[1])
    h = rmsnorm(x, g[2]) * (1 + m[:, :, 1, 1]) + m[:, :, 1, 0]
    p = h @ w_in
    o1 = FOURIER_WIDTH
    o2 = o1 + HYENA_PROJ
    o3 = o2 + ATTN_WIDTH
    o4 = o3 + KV_WIDTH
    y_f = fourier_mix(p[..., :o1])
    y_h = hyena_mix(p[..., o1:o2], conv_w, f_w1, f_b1, f_w2, f_b2, f_w3, f_freq, decay, hbias)
    q = p[..., o2:o3].reshape(b, n, N_Q_HEADS, HEAD_DIM)
    k = p[..., o3:o4].reshape(b, n, N_KV_HEADS, HEAD_DIM)
    v = p[..., o4:].reshape(b, n, N_KV_HEADS, HEAD_DIM)
    if latent:
        y_a = latent_attention(axial_rope(q), axial_rope(k), v, ctx_k, ctx_v, sink)
    else:
        y_a = context_attention(q, k, v, sink)
    y = jnp.concatenate([y_f, y_h, y_a], axis=-1) @ w_out
    x = x + m[:, :, 1, 2] * rmsnorm(y, g[3])
    h = rmsnorm(x, g[4]) * (1 + m[:, :, 2, 1]) + m[:, :, 2, 0]
    x = x + 0.5 * m[:, :, 2, 2] * rmsnorm(swiglu(h, wg[1], wu[1], wd[1]), g[5])
    return x, k, v


def setup_inputs(seed: int = 0) -> dict:
    key = jax.random.key(seed)
    ks = jax.random.split(key, 24)
    nrm = lambda k, shape, s: jax.random.normal(k, shape, F32) * s
    kv_cache_shape = (DEC_BATCH, DEPTH, PAST_LEN, N_KV_HEADS, HEAD_DIM)
    return {
        'x_prompt': nrm(ks[0], (BATCH, SEQ, D_MODEL), 1.0),
        'x_sample': nrm(ks[1], (DEC_BATCH, DEC_SEQ, D_MODEL), 1.0),
        'cache_k': nrm(ks[2], kv_cache_shape, 1.0),
        'cache_v': nrm(ks[3], kv_cache_shape, 1.0),
        'c': nrm(ks[4], (DEC_BATCH, D_MODEL), 1.0),
        'c_ctx': nrm(ks[5], (D_MODEL,), 1.0),
        'w_mod': nrm(ks[6], (DEPTH, D_MODEL, 3 * N_SUB * D_MODEL), 0.5 * D_MODEL ** -0.5),
        'b_mod': nrm(ks[7], (DEPTH, 3 * N_SUB * D_MODEL), 0.02),
        'norm_g': 1.0 + nrm(ks[8], (DEPTH, 2 * N_SUB, D_MODEL), 0.05),
        'ffn_w_gate': nrm(ks[9], (DEPTH, 2, D_MODEL, D_FF), D_MODEL ** -0.5),
        'ffn_w_up': nrm(ks[10], (DEPTH, 2, D_MODEL, D_FF), D_MODEL ** -0.5),
        'ffn_w_down': nrm(ks[11], (DEPTH, 2, D_FF, D_MODEL), D_FF ** -0.5),
        'w_in': nrm(ks[12], (DEPTH, D_MODEL, IN_WIDTH), D_MODEL ** -0.5),
        'w_out': nrm(ks[13], (DEPTH, MIX_WIDTH, D_MODEL), MIX_WIDTH ** -0.5),
        'hyena_conv_w': nrm(ks[14], (DEPTH, SHORT_CONV, HYENA_PROJ), SHORT_CONV ** -0.5),
        'hyena_f_w1': nrm(ks[15], (DEPTH, HYENA_EMB_DIM, HYENA_FILTER_WIDTH), HYENA_EMB_DIM ** -0.5),
        'hyena_f_b1': nrm(ks[16], (DEPTH, HYENA_FILTER_WIDTH), 0.02),
        'hyena_f_w2': nrm(ks[17], (DEPTH, HYENA_FILTER_WIDTH, HYENA_FILTER_WIDTH), HYENA_FILTER_WIDTH ** -0.5),
        'hyena_f_b2': nrm(ks[18], (DEPTH, HYENA_FILTER_WIDTH), 0.02),
        'hyena_f_w3': nrm(ks[19], (DEPTH, HYENA_FILTER_WIDTH, 2 * HYENA_ORDER * HYENA_WIDTH), HYENA_FILTER_WIDTH ** -0.5),
        'hyena_f_freq': 1.0 + nrm(ks[20], (DEPTH, HYENA_FILTER_WIDTH), 0.05),
        'hyena_decay': jnp.linspace(HYENA_MIN_DECAY, HYENA_MAX_DECAY, HYENA_WIDTH, dtype=F32)[None, None, :]
                       + nrm(ks[21], (DEPTH, HYENA_ORDER, HYENA_WIDTH), 0.1),
        'hyena_bias': nrm(ks[22], (DEPTH, HYENA_ORDER, HYENA_WIDTH), 1.0),
        'attn_sink': nrm(ks[23], (DEPTH, N_Q_HEADS), 0.5),
    }


def reference(x_prompt, x_sample, cache_k, cache_v, c, c_ctx, w_mod, b_mod, norm_g,
              ffn_w_gate, ffn_w_up, ffn_w_down, w_in, w_out, hyena_conv_w,
              hyena_f_w1, hyena_f_b1, hyena_f_w2, hyena_f_b2, hyena_f_w3, hyena_f_freq,
              hyena_decay, hyena_bias, attn_sink):
    def layer_params(l):
        return (norm_g[l], ffn_w_gate[l], ffn_w_up[l], ffn_w_down[l], w_in[l], w_out[l],
                hyena_conv_w[l], hyena_f_w1[l], hyena_f_b1[l], hyena_f_w2[l], hyena_f_b2[l],
                hyena_f_w3[l], hyena_f_freq[l], hyena_decay[l], hyena_bias[l], attn_sink[l])

    xp = x_prompt
    new_k, new_v = [], []
    for l in range(DEPTH):
        m_ctx = modulation(c_ctx[None], w_mod[l], b_mod[l])
        xp, k_l, v_l = trunk_layer(xp, m_ctx, False, None, None, *layer_params(l))
        new_k.append(k_l)
        new_v.append(v_l)

    xs = x_sample
    for l in range(DEPTH):
        m_lat = modulation(c, w_mod[l], b_mod[l])
        xs, _, _ = trunk_layer(xs, m_lat, True, cache_k[:, l], cache_v[:, l], *layer_params(l))

    return (xp, xs, jnp.stack(new_k, axis=1), jnp.stack(new_v, axis=1))
```

```cpp
#include <hip/hip_runtime.h>
#include <hip/hip_cooperative_groups.h>
#include <cstdio>
namespace cg = cooperative_groups;

#define LAS __attribute__((address_space(3)))
typedef unsigned short bf16_t;
typedef short bf16x8 __attribute__((ext_vector_type(8)));
typedef float f32x4 __attribute__((ext_vector_type(4)));
typedef unsigned u32x4 __attribute__((ext_vector_type(4)));
typedef unsigned u32x2 __attribute__((ext_vector_type(2)));

constexpr int D = 1024, NTOK = 16384, NCTX = 8192, DFF = 2816, INW = 1792;
constexpr int NTHREADS = 512;
constexpr float EPS = 1e-6f;
constexpr float PI2 = 6.283185307179586f;

constexpr size_t AL(size_t x) { return (x + 255) & ~(size_t)255; }
constexpr size_t SZ_WGU = (size_t)5632 * 1024 * 2, SZ_WD = (size_t)1024 * 2816 * 2, SZ_WIN = (size_t)2048 * 1024 * 2, SZ_WOUT = (size_t)1024 * 1024 * 2;
constexpr size_t OFF_WGU = 0;
constexpr size_t OFF_WD = OFF_WGU + 4 * SZ_WGU;
constexpr size_t OFF_WIN = OFF_WD + 4 * SZ_WD;
constexpr size_t OFF_WOUT = OFF_WIN + 2 * SZ_WIN;
constexpr size_t OFF_H = OFF_WOUT + 2 * SZ_WOUT;
constexpr size_t OFF_Y = OFF_H + (size_t)NTOK * D * 2;
constexpr size_t OFF_SSQ = OFF_Y + (size_t)NTOK * D * 2;
constexpr size_t OFF_MOD = OFF_SSQ + (size_t)NTOK * 16 * 4;
constexpr size_t OFF_FILT = AL(OFF_MOD + (size_t)2 * 9 * 9216 * 4);
constexpr size_t FILT_CTX = (size_t)4 * 256 * 256, FILT_LAT = (size_t)4 * 256 * 1024, FILT_L = FILT_CTX + FILT_LAT;
constexpr size_t OFF_FC = AL(OFF_FILT + 2 * FILT_L * 4);
constexpr size_t OFF_FL = OFF_FC + (size_t)256 * 512 * 2;
constexpr size_t OFF_ROPE = OFF_FL + (size_t)1024 * 2048 * 2;
constexpr size_t OFF_UNION = AL(OFF_ROPE + 64 * 16 * 8);
constexpr size_t OFF_ACT = OFF_UNION;
constexpr size_t OFF_ZT = OFF_UNION;
constexpr size_t ZT_LAT = (size_t)NCTX * 512;
constexpr size_t OFF_HT = OFF_ZT + (size_t)NTOK * 512 * 2;
constexpr size_t HT_LAT = (size_t)NCTX * 768;
constexpr size_t OFF_QB = OFF_HT + (size_t)NTOK * 768 * 2;
constexpr size_t OFF_KB = OFF_QB + (size_t)NTOK * 512 * 2;
constexpr size_t OFF_VB = OFF_KB + (size_t)NTOK * 128 * 2;
constexpr size_t OFF_YCAT = OFF_VB + (size_t)NTOK * 128 * 2;
constexpr size_t UNION_END = OFF_YCAT + (size_t)NTOK * 1024 * 2;
constexpr size_t ACT_END = OFF_ACT + (size_t)NTOK * DFF * 2;
constexpr size_t WS_END = (UNION_END > ACT_END ? UNION_END : ACT_END);

struct Params {
    const float* in[24];
    float* out;
    unsigned char* ws;
};

__device__ __forceinline__ unsigned short f2bf(float f) { unsigned u = __float_as_uint(f); u += 0x7FFFu + ((u >> 16) & 1u); return (unsigned short)(u >> 16); }
__device__ __forceinline__ float bf2f(unsigned short b) { return __uint_as_float(((unsigned)b) << 16); }
__device__ __forceinline__ unsigned cvt_pk_bf16(float lo, float hi) { unsigned r; asm volatile("v_cvt_pk_bf16_f32 %0, %1, %2" : "=v"(r) : "v"(lo), "v"(hi)); return r; }
__device__ __forceinline__ float silu_f(float x) { return x * __builtin_amdgcn_rcpf(1.0f + __expf(-x)); }
__device__ __forceinline__ int perm32(int rho) { const int n = rho >> 4, i = rho & 15; return 8 * (i >> 2) + 4 * n + (i & 3); }

__device__ __forceinline__ int opaque_tid() { int t = threadIdx.x; asm volatile("" : "+v"(t)); return t; }

namespace pg8 {
constexpr int BM = 256, BK = 64, HALF = 128, HTB = HALF * BK * 2, STAGE_BYTES = 8 * HTB, NXCD = 8, WGM = 8;
__device__ __forceinline__ int lds_byte(int r, int c) { const int st = (r >> 4) * 2 + (c >> 5), rr = r & 15, cc = c & 31, ob = rr * 64 + cc * 2; return st * 1024 + (ob ^ (((ob >> 9) & 1) << 5)); }
__device__ __forceinline__ void stage_rc(int b, int& R, int& C) { const int st = b / 1024, sb = b % 1024, swz = sb ^ (((sb >> 9) & 1) << 5); R = (st >> 1) * 16 + swz / 64; C = (st & 1) * 32 + (swz % 64) / 2; }
struct Unit { int pm, pn; };
struct Gemm { const bf16_t* A; const bf16_t* Bt; int M, N, K, lda, ldb; };
struct StaticOrder {
    int nM, nN, nwg, G, c;
    __device__ void init(int M, int N, int G_, int c_) { nM = M / BM; nN = N / BM; nwg = nM * nN; G = G_; c = c_; }
    __device__ bool next(int i, Unit& u) const {
        if (c < 0) return false;
        const long L = (long)i * G + c; if (L >= nwg) return false;
        int wgid = (int)L; { const int q = nwg / NXCD, r = nwg % NXCD, xcd = wgid % NXCD, off = wgid / NXCD; wgid = (xcd < r ? xcd * (q + 1) : r * (q + 1) + (xcd - r) * q) + off; }
        const int nig = WGM * nN, gid = wgid / nig, fm = gid * WGM, gsz = (nM - fm) < WGM ? (nM - fm) : WGM;
        u.pm = fm + ((wgid % nig) % gsz); u.pn = (wgid % nig) / gsz; return true;
    }
    __device__ __forceinline__ void a_ready(const Unit&) const {}
    __device__ __forceinline__ void done(const Unit&) const {}
};

template <class Epi, class Sched>
__device__ __forceinline__ void gemm_phase(LAS unsigned char* lds, Gemm g, const Sched& S, const Epi& E) {
    asm volatile("" : "+s"(g.A), "+s"(g.Bt), "+s"(g.K), "+s"(g.lda), "+s"(g.ldb));
    int tid = threadIdx.x; asm volatile("" : "+v"(tid));
    const int wid = __builtin_amdgcn_readfirstlane(tid >> 6), lane = tid & 63, wr = wid >> 2, wc = wid & 3, fr = lane & 15, fq = lane >> 4;
    const int K = g.K, nt = K / BK;
    unsigned voffA[2], voffB[2];
#pragma unroll
    for (int i = 0; i < 2; ++i) { int R, C; stage_rc(tid * 16 + i * 8192, R, C);
        voffA[i] = (unsigned)(R * g.lda + C) * 2u; voffB[i] = (unsigned)(R * g.ldb + C) * 2u; }
    const size_t kstep = (size_t)(BK * 2);
    const size_t hstepA = (size_t)HALF * g.lda * 2, hstepB = (size_t)HALF * g.ldb * 2;
    const size_t tstepA = 2 * hstepA, tstepB = 2 * hstepB;
    const unsigned ldsw = (unsigned)wid * 1024u;
    const int aoff = lds_byte(wr * 64 + fr, fq * 8), boff = lds_byte(wc * 32 + fr, fq * 8);
#define PG8_SA(b, h) (((b) * 2 + (h)) * HTB)
#define PG8_SB(b, h) ((4 + (b) * 2 + (h)) * HTB)
#define PG8_STAGE(bufoff, gbase, voff) do { _Pragma("unroll") for (int _i = 0; _i < 2; ++_i) \
        __builtin_amdgcn_global_load_lds((const unsigned*)((const char*)(gbase) + (voff)[_i]), (LAS unsigned*)(lds + (bufoff) + ldsw + _i * 8192), 16, 0, 0); } while (0)
#define PG8_LDA(dst, b, h) do { _Pragma("unroll") for (int m = 0; m < 4; ++m) _Pragma("unroll") for (int k = 0; k < 2; ++k) dst[m][k] = *(const LAS bf16x8*)(lds + PG8_SA(b, h) + aoff + m * 2048 + k * 1024); } while (0)
#define PG8_LDB(dst, b, h) do { _Pragma("unroll") for (int n = 0; n < 2; ++n) _Pragma("unroll") for (int k = 0; k < 2; ++k) dst[n][k] = *(const LAS bf16x8*)(lds + PG8_SB(b, h) + boff + n * 2048 + k * 1024); } while (0)
#define PG8_MMA(ai, bj, At, Bt) do { __builtin_amdgcn_s_setprio(1); _Pragma("unroll") for (int m = 0; m < 4; ++m) _Pragma("unroll") for (int n = 0; n < 2; ++n) _Pragma("unroll") for (int k = 0; k < 2; ++k) \
        acc[ai][bj][m][n] = __builtin_amdgcn_mfma_f32_16x16x32_bf16(Bt[n][k], At[m][k], acc[ai][bj][m][n], 0, 0, 0); __builtin_amdgcn_s_setprio(0); } while (0)
#define PG8_WAIT_V(n) asm volatile("s_waitcnt vmcnt(" #n ")" ::: "memory")
#define PG8_WAIT_L(n) asm volatile("s_waitcnt lgkmcnt(" #n ")" ::: "memory")
#define PG8_BAR __builtin_amdgcn_s_barrier()
#define PG8_SCHED __builtin_amdgcn_sched_barrier(0)
    Unit cur, nxt; int ui = 0;
    if (!S.next(0, cur)) return;
    f32x4 acc[2][2][4][2];
#pragma unroll
    for (int a = 0; a < 2; ++a)
#pragma unroll
        for (int b = 0; b < 2; ++b)
#pragma unroll
            for (int m = 0; m < 4; ++m)
#pragma unroll
                for (int n = 0; n < 2; ++n) acc[a][b][m][n] = (f32x4){0.f, 0.f, 0.f, 0.f};
    bf16x8 At[4][2], B0[2][2], B1[2][2];
    const char* cA = (const char*)g.A + (size_t)cur.pm * tstepA; const char* cB = (const char*)g.Bt + (size_t)cur.pn * tstepB;
    S.a_ready(cur);
    PG8_STAGE(PG8_SB(0, 0), cB, voffB); PG8_STAGE(PG8_SA(0, 0), cA, voffA); PG8_STAGE(PG8_SB(0, 1), cB + hstepB, voffB); PG8_STAGE(PG8_SA(0, 1), cA + hstepA, voffA);
    if (wr == 1) PG8_BAR;
    PG8_WAIT_V(4); PG8_BAR;
    PG8_STAGE(PG8_SB(1, 0), cB + kstep, voffB); PG8_STAGE(PG8_SA(1, 0), cA + kstep, voffA); PG8_STAGE(PG8_SB(1, 1), cB + hstepB + kstep, voffB);
    PG8_WAIT_V(6); PG8_BAR;
    for (;;) {
        const bool has_next = S.next(ui + 1, nxt);
        const char* nA = has_next ? (const char*)g.A + (size_t)nxt.pm * tstepA : cA; const char* nB = has_next ? (const char*)g.Bt + (size_t)nxt.pn * tstepB : cB;
        for (int t = 0; t < nt; t += 2) {
            const bool last = (t == nt - 2);
            const char* a1 = cA + (size_t)(t + 1) * kstep;
            const char* a2 = last ? nA : cA + (size_t)(t + 2) * kstep; const char* b2 = last ? nB : cB + (size_t)(t + 2) * kstep;
            const char* a3 = a2 + kstep; const char* b3 = b2 + kstep;
            if (last && has_next) S.a_ready(nxt);
            PG8_LDB(B0, 0, 0); PG8_SCHED; PG8_LDA(At, 0, 0); PG8_STAGE(PG8_SA(1, 1), a1 + hstepA, voffA);
            PG8_WAIT_L(8); PG8_BAR; PG8_WAIT_L(0); PG8_MMA(0, 0, At, B0); PG8_BAR; PG8_SCHED;
            PG8_LDB(B1, 0, 1); PG8_STAGE(PG8_SB(0, 0), b2, voffB);
            PG8_BAR; PG8_WAIT_L(0); PG8_MMA(0, 1, At, B1); PG8_BAR;
            PG8_LDA(At, 0, 1); PG8_STAGE(PG8_SA(0, 0), a2, voffA);
            PG8_BAR; PG8_WAIT_L(0); PG8_MMA(1, 0, At, B0); PG8_BAR; PG8_SCHED;
            PG8_STAGE(PG8_SB(0, 1), b2 + hstepB, voffB);
            PG8_WAIT_V(6); PG8_BAR; PG8_MMA(1, 1, At, B1); PG8_BAR;
            PG8_LDB(B0, 1, 0); PG8_SCHED; PG8_LDA(At, 1, 0); PG8_STAGE(PG8_SA(0, 1), a2 + hstepA, voffA);
            PG8_WAIT_L(8); PG8_BAR; PG8_WAIT_L(0); PG8_MMA(0, 0, At, B0); PG8_BAR; PG8_SCHED;
            PG8_LDB(B1, 1, 1); PG8_STAGE(PG8_SB(1, 0), b3, voffB);
            PG8_BAR; PG8_WAIT_L(0); PG8_MMA(0, 1, At, B1); PG8_BAR;
            PG8_LDA(At, 1, 1); PG8_STAGE(PG8_SA(1, 0), a3, voffA);
            PG8_BAR; PG8_WAIT_L(0); PG8_MMA(1, 0, At, B0); PG8_BAR; PG8_SCHED;
            PG8_STAGE(PG8_SB(1, 1), b3 + hstepB, voffB);
            PG8_WAIT_V(6); PG8_BAR; PG8_MMA(1, 1, At, B1); PG8_BAR;
        }
        E(acc, cur, wr, wc, fr, fq); S.done(cur);
        if (!has_next) break;
#pragma unroll
        for (int a = 0; a < 2; ++a)
#pragma unroll
            for (int b = 0; b < 2; ++b)
#pragma unroll
                for (int m = 0; m < 4; ++m)
#pragma unroll
                    for (int n = 0; n < 2; ++n) acc[a][b][m][n] = (f32x4){0.f, 0.f, 0.f, 0.f};
        cur = nxt; cA = nA; cB = nB; ++ui;
    }
    PG8_WAIT_V(0);
    if (wr == 0) PG8_BAR;
    PG8_BAR;
#undef PG8_SA
#undef PG8_SB
#undef PG8_STAGE
#undef PG8_LDA
#undef PG8_LDB
#undef PG8_MMA
#undef PG8_WAIT_V
#undef PG8_WAIT_L
#undef PG8_BAR
#undef PG8_SCHED
}
}

struct EpiSwiglu {
    bf16_t* O;
    __device__ __forceinline__ void operator()(const f32x4 (&acc)[2][2][4][2], const pg8::Unit& u, int wr, int wc, int fr, int fq) const {
        const int row0 = u.pm * 256 + wr * 64 + fr, col0 = u.pn * 128 + wc * 32 + 8 * fq;
#pragma unroll
        for (int ai = 0; ai < 2; ++ai)
#pragma unroll
            for (int m = 0; m < 4; ++m) {
                bf16_t* rowp = O + (size_t)(row0 + ai * 128 + m * 16) * DFF + col0;
                const f32x4 g0 = acc[ai][0][m][0], g1 = acc[ai][0][m][1], u0 = acc[ai][1][m][0], u1 = acc[ai][1][m][1];
                u32x4 w;
                w.x = cvt_pk_bf16(silu_f(g0[0]) * u0[0], silu_f(g0[1]) * u0[1]); w.y = cvt_pk_bf16(silu_f(g0[2]) * u0[2], silu_f(g0[3]) * u0[3]);
                w.z = cvt_pk_bf16(silu_f(g1[0]) * u1[0], silu_f(g1[1]) * u1[1]); w.w = cvt_pk_bf16(silu_f(g1[2]) * u1[2], silu_f(g1[3]) * u1[3]);
                *(u32x4*)rowp = w;
            }
    }
};
struct EpiYssq {
    bf16_t* Y; float* ssq;
    __device__ __forceinline__ void operator()(const f32x4 (&acc)[2][2][4][2], const pg8::Unit& u, int wr, int wc, int fr, int fq) const {
        const int row0 = u.pm * 256 + wr * 64 + fr, col0 = u.pn * 256 + wc * 32 + 8 * fq;
#pragma unroll
        for (int ai = 0; ai < 2; ++ai)
#pragma unroll
            for (int m = 0; m < 4; ++m) {
                const int row = row0 + ai * 128 + m * 16;
                bf16_t* rowp = Y + (size_t)row * D + col0;
                float s = 0.f;
#pragma unroll
                for (int bj = 0; bj < 2; ++bj) {
                    const f32x4 v0 = acc[ai][bj][m][0], v1 = acc[ai][bj][m][1];
                    s += v0[0] * v0[0] + v0[1] * v0[1] + v0[2] * v0[2] + v0[3] * v0[3] + v1[0] * v1[0] + v1[1] * v1[1] + v1[2] * v1[2] + v1[3] * v1[3];
                    u32x4 w; w.x = cvt_pk_bf16(v0[0], v0[1]); w.y = cvt_pk_bf16(v0[2], v0[3]); w.z = cvt_pk_bf16(v1[0], v1[1]); w.w = cvt_pk_bf16(v1[2], v1[3]);
                    *(u32x4*)(rowp + bj * 128) = w;
                }
                s += __shfl_xor(s, 16); s += __shfl_xor(s, 32);
                if (fq == 0) ssq[(size_t)row * 16 + u.pn * 4 + wc] = s;
            }
    }
};
struct EpiWin {
    bf16_t* ZT; bf16_t* HT; bf16_t* QB; bf16_t* KB; bf16_t* VB; const float* rope; float* newk; float* newv; int layer;
    __device__ __forceinline__ void operator()(const f32x4 (&acc)[2][2][4][2], const pg8::Unit& u, int wr, int wc, int fr, int fq) const {
        const int r0 = u.pm * 256 + wr * 64 + fr;
        const bool lat = u.pm >= 32;
        const int pn = u.pn;
        if (pn < 5) {
            bf16_t* base; int t0; size_t sch;
            if (pn < 2) {
                if (!lat) { const int b = u.pm; base = ZT + ((size_t)b * 256 * 2 + pn) * 256; sch = 512; t0 = r0 - u.pm * 256; }
                else { const int b = (u.pm - 32) >> 2; base = ZT + ZT_LAT + ((size_t)b * 256 * 2 + pn) * 1024; sch = 2048; t0 = r0 - NCTX - b * 1024; }
            } else {
                const int c0 = (pn - 2) * 256;
                if (!lat) { const int b = u.pm; base = HT + ((size_t)b * 768 + c0) * 256; sch = 256; t0 = r0 - u.pm * 256; }
                else { const int b = (u.pm - 32) >> 2; base = HT + HT_LAT + ((size_t)b * 768 + c0) * 1024; sch = 1024; t0 = r0 - NCTX - b * 1024; }
            }
#pragma unroll
            for (int ai = 0; ai < 2; ++ai)
#pragma unroll
                for (int m = 0; m < 4; ++m) {
                    const int t = t0 + ai * 128 + m * 16;
#pragma unroll
                    for (int bj = 0; bj < 2; ++bj)
#pragma unroll
                        for (int n = 0; n < 2; ++n) {
                            const int ch = bj * 128 + wc * 32 + n * 16 + 4 * fq;
                            const f32x4 v = acc[ai][bj][m][n];
#pragma unroll
                            for (int e = 0; e < 4; ++e) base[(size_t)(ch + e) * sch + t] = f2bf(v[e]);
                        }
                }
        } else {
            const int blk = wc & 1;
#pragma unroll
            for (int ai = 0; ai < 2; ++ai)
#pragma unroll
                for (int m = 0; m < 4; ++m) {
                    const int row = r0 + ai * 128 + m * 16;
                    f32x4 cs0 = {1.f, 0.f, 1.f, 0.f}, cs1 = {1.f, 0.f, 1.f, 0.f};
                    if (lat) { const int t = row & 1023; const int pos = blk ? (t & 63) : (t >> 6);
                        const f32x4* rp = (const f32x4*)(rope + (size_t)(pos * 16 + 4 * fq) * 2); cs0 = rp[0]; cs1 = rp[1]; }
#pragma unroll
                    for (int bj = 0; bj < 2; ++bj) {
                        f32x4 x1 = acc[ai][bj][m][0], x2 = acc[ai][bj][m][1];
                        const bool isv = (pn == 7 && bj == 1);
                        const bool isk = (pn == 7 && bj == 0);
                        const int cc = bj * 128 + wc * 32 + 4 * fq;
                        if ((isk || isv) && !lat) {
                            const int b = row >> 8, t = row & 255;
                            float* dst = (isk ? newk : newv) + (((size_t)b * 2 + layer) * 256 + t) * 128 + (cc & 127);
                            *(f32x4*)dst = x1; *(f32x4*)(dst + 16) = x2;
                        }
                        if (!isv) {
                            f32x4 o1, o2;
                            o1[0] = x1[0] * cs0[0] - x2[0] * cs0[1]; o2[0] = x2[0] * cs0[0] + x1[0] * cs0[1];
                            o1[1] = x1[1] * cs0[2] - x2[1] * cs0[3]; o2[1] = x2[1] * cs0[2] + x1[1] * cs0[3];
                            o1[2] = x1[2] * cs1[0] - x2[2] * cs1[1]; o2[2] = x2[2] * cs1[0] + x1[2] * cs1[1];
                            o1[3] = x1[3] * cs1[2] - x2[3] * cs1[3]; o2[3] = x2[3] * cs1[2] + x1[3] * cs1[3];
                            x1 = o1; x2 = o2;
                        }
                        bf16_t* dst;
                        if (pn < 7) { x1 *= 0.125f; x2 *= 0.125f; dst = QB + (size_t)row * 512 + (pn - 5) * 256 + cc; }
                        else if (isk) dst = KB + (size_t)row * 128 + cc;
                        else dst = VB + (size_t)row * 128 + (cc - 128);
                        u32x2 w1, w2; w1.x = cvt_pk_bf16(x1[0], x1[1]); w1.y = cvt_pk_bf16(x1[2], x1[3]); w2.x = cvt_pk_bf16(x2[0], x2[1]); w2.y = cvt_pk_bf16(x2[2], x2[3]);
                        *(u32x2*)dst = w1; *(u32x2*)(dst + 16) = w2;
                    }
                }
        }
    }
};
struct EpiFourier {
    bf16_t* YC; int rowbase, n;
    __device__ __forceinline__ void operator()(const f32x4 (&acc)[2][2][4][2], const pg8::Unit& u, int wr, int wc, int fr, int fq) const {
        const int kp0 = u.pm * 256 + wr * 64 + fr; const int b = u.pn;
#pragma unroll
        for (int ai = 0; ai < 2; ++ai)
#pragma unroll
            for (int m = 0; m < 4; ++m) {
                bf16_t* rowp = YC + (size_t)(rowbase + b * n + kp0 + ai * 128 + m * 16) * 1024 + wc * 32 + 4 * fq;
#pragma unroll
                for (int bj = 0; bj < 2; ++bj)
#pragma unroll
                    for (int nn = 0; nn < 2; ++nn) { const f32x4 v = acc[ai][bj][m][nn]; u32x2 w; w.x = cvt_pk_bf16(v[0], v[1]); w.y = cvt_pk_bf16(v[2], v[3]);
                        *(u32x2*)(rowp + bj * 128 + nn * 16) = w; }
            }
    }
};

template <bool PERM>
__device__ __forceinline__ void transpose_unit(const float* __restrict__ src, int ld, int k0, int cbase, bf16_t* __restrict__ dst, int Kd, int r0, float* tile) {
    const int tid = opaque_tid();
#pragma unroll
    for (int i = 0; i < 2; ++i) { const int idx = tid + 512 * i, kk = idx >> 4, c4 = idx & 15;
        const f32x4 v = *(const f32x4*)(src + (size_t)(k0 + kk) * ld + cbase + c4 * 4);
        float* tp = tile + kk * 65 + c4 * 4; tp[0] = v[0]; tp[1] = v[1]; tp[2] = v[2]; tp[3] = v[3]; }
    __syncthreads();
    { const int rr = tid >> 3, kc = tid & 7; const int cc = PERM ? ((rr & ~31) + perm32(rr & 31)) : rr;
        float v[8];
#pragma unroll
        for (int j = 0; j < 8; ++j) v[j] = tile[(kc * 8 + j) * 65 + cc];
        u32x4 w; w.x = cvt_pk_bf16(v[0], v[1]); w.y = cvt_pk_bf16(v[2], v[3]); w.z = cvt_pk_bf16(v[4], v[5]); w.w = cvt_pk_bf16(v[6], v[7]);
        *(u32x4*)(dst + (size_t)(r0 + rr) * Kd + k0 + kc * 8) = w; }
    __syncthreads();
}

__device__ void phase_prep(const Params& p, float* lds) {
    const int tid = opaque_tid(), nb = gridDim.x, bid = blockIdx.x;
    unsigned char* ws = p.ws;
    constexpr int U_GU = 4 * 88 * 16, U_D = 4 * 16 * 44, U_OUT = 2 * 16 * 16, U_IN = 2 * 24 * 16;
    for (int u = bid; u < U_GU + U_D + U_OUT + U_IN; u += nb) {
        if (u < U_GU) {
            const int ls = u / (88 * 16), rem = u % (88 * 16), rg = rem / 16, kb = rem % 16;
            const int r0 = rg * 64, pn = r0 >> 8, inner = r0 & 255, half = inner >> 7, q0 = inner & 127;
            const float* src = (half ? p.in[10] : p.in[9]) + (size_t)ls * 1024 * DFF;
            transpose_unit<true>(src, DFF, kb * 64, pn * 128 + q0, (bf16_t*)(ws + OFF_WGU + ls * SZ_WGU), 1024, r0, lds);
        } else if (u < U_GU + U_D) {
            const int v = u - U_GU; const int ls = v / (16 * 44), rem = v % (16 * 44), rg = rem / 44, kb = rem % 44;
            transpose_unit<true>(p.in[11] + (size_t)ls * DFF * 1024, 1024, kb * 64, rg * 64, (bf16_t*)(ws + OFF_WD + ls * SZ_WD), DFF, rg * 64, lds);
        } else if (u < U_GU + U_D + U_OUT) {
            const int v = u - U_GU - U_D; const int l = v / 256, rem = v % 256, rg = rem / 16, kb = rem % 16;
            transpose_unit<true>(p.in[13] + (size_t)l * 1024 * 1024, 1024, kb * 64, rg * 64, (bf16_t*)(ws + OFF_WOUT + l * SZ_WOUT), 1024, rg * 64, lds);
        } else {
            const int v = u - U_GU - U_D - U_OUT; const int l = v / (24 * 16), rem = v % (24 * 16), rg = rem / 16, kb = rem % 16;
            transpose_unit<false>(p.in[12] + (size_t)l * 1024 * INW, INW, kb * 64, 256 + rg * 64, (bf16_t*)(ws + OFF_WIN + l * SZ_WIN), 1024, 512 + rg * 64, lds);
        }
    }
    {
        float* tab = lds;
        if (tid < 64) { float sv, cv; sincosf(PI2 * (float)tid / 64.f, &sv, &cv); tab[tid] = cv; tab[64 + tid] = sv; }
        __syncthreads();
        const int lane = tid & 63, wv = tid >> 6;
        for (int u = bid * 8 + wv; u < 8192; u += nb * 8) {
            const int l = u >> 12, k = (u >> 2) & 1023, g = u & 3;
            const float* wrow = p.in[12] + ((size_t)l * 1024 + k) * INW + g * 64;
            const float wv_ = wrow[lane];
            float ac = 0.f, as = 0.f;
#pragma unroll 16
            for (int c = 0; c < 64; ++c) { const float w = __shfl(wv_, c); const int idx = (c * lane) & 63; ac += w * tab[idx]; as += w * tab[64 + idx]; }
            bf16_t* bt = (bf16_t*)(ws + OFF_WIN + l * SZ_WIN);
            bt[(size_t)(g * 64 + lane) * 1024 + k] = f2bf(ac);
            bt[(size_t)(256 + g * 64 + lane) * 1024 + k] = f2bf(as);
        }
        __syncthreads();
    }
    {
        float* sc = lds;
        float* part = lds + 9 * 1024;
        for (int i = tid; i < 9 * 1024; i += NTHREADS) { const int bc = i >> 10, k = i & 1023; const float cv = bc == 0 ? p.in[5][k] : p.in[4][(bc - 1) * 1024 + k]; sc[i] = cv / (1.0f + expf(-cv)); }
        __syncthreads();
        for (int cb = bid; cb < 256; cb += nb) {
            const int gc0 = cb * 72, l = gc0 / 9216, j0 = gc0 % 9216;
            const int col = tid % 72, kg = tid / 72;
            if (kg < 7) {
                float a[9];
#pragma unroll
                for (int i = 0; i < 9; ++i) a[i] = 0.f;
                const float* wp = p.in[6] + (size_t)l * 1024 * 9216 + j0 + col;
#pragma unroll 4
                for (int k = kg; k < 1024; k += 7) { const float w = wp[(size_t)k * 9216];
#pragma unroll
                    for (int i = 0; i < 9; ++i) a[i] += sc[i * 1024 + k] * w; }
#pragma unroll
                for (int i = 0; i < 9; ++i) part[(kg * 72 + col) * 9 + i] = a[i];
            }
            __syncthreads();
            for (int i = tid; i < 72 * 9; i += NTHREADS) { const int c2 = i / 9, bc = i % 9; float s = 0.f;
#pragma unroll
                for (int g = 0; g < 7; ++g) s += part[(g * 72 + c2) * 9 + bc];
                ((float*)(ws + OFF_MOD))[((size_t)l * 9 + bc) * 9216 + j0 + c2] = s + p.in[7][l * 9216 + j0 + c2]; }
            __syncthreads();
        }
    }
    {
        const int lane = tid & 63, wv = tid >> 6;
        for (int u = bid * 8 + wv; u < 2 * 320; u += nb * 8) {
            const int l = u / 320, gq = u % 320; const int pass = gq >= 64; const int n = pass ? 1024 : 256; const int d0 = (pass ? gq - 64 : gq) * 4;
            const float* w1 = p.in[15] + l * 33 * 64; const float* b1 = p.in[16] + l * 64; const float* w2 = p.in[17] + l * 64 * 64; const float* b2 = p.in[18] + l * 64;
            const float* w3 = p.in[19] + (size_t)l * 64 * 1024; const float fr = p.in[20][l * 64 + lane];
            float h2[4];
#pragma unroll
            for (int q = 0; q < 4; ++q) {
                const int d = d0 + q; const float tt = (float)d / (float)(n - 1);
                float feat = 0.f;
                if (lane == 0) feat = tt;
                else if (lane < 33) { const int j = (lane - 1) & 15; const float fj = 1e-4f + (float)j * ((15.0f - 1e-4f) / 15.0f); const float ang = (PI2 / (float)n) * (float)d * fj;
                    feat = lane < 17 ? cosf(ang) : -sinf(ang); }
                float a1 = b1[lane];
                for (int i = 0; i < 33; ++i) a1 += __shfl(feat, i) * w1[i * 64 + lane];
                const float h1 = sinf(fr * a1);
                float a2 = b2[lane];
                for (int i = 0; i < 64; ++i) a2 += __shfl(h1, i) * w2[i * 64 + lane];
                h2[q] = sinf(fr * a2);
            }
            float* fbase = (float*)(ws + OFF_FILT) + (size_t)l * FILT_L + (pass ? FILT_CTX : 0);
            for (int oc = 0; oc < 16; ++oc) {
                const int o = oc * 64 + lane;
                float a[4] = {0.f, 0.f, 0.f, 0.f};
                for (int i = 0; i < 64; ++i) { const float w = w3[i * 1024 + o];
#pragma unroll
                    for (int q = 0; q < 4; ++q) a[q] += __shfl(h2[q], i) * w; }
                const int ord = (o >> 8) & 1, c = o & 255;
                const float dec = fabsf(p.in[21][(l * 2 + ord) * 256 + c]);
#pragma unroll
                for (int q = 0; q < 4; ++q) { const int d = d0 + q; const float tt = (float)d / (float)(n - 1);
                    fbase[(size_t)o * n + d] = a[q] * expf(-tt * dec); }
            }
        }
    }
    {
        bf16_t* FC = (bf16_t*)(ws + OFF_FC); bf16_t* FL = (bf16_t*)(ws + OFF_FL);
        const int gt = bid * NTHREADS + tid, gn = nb * NTHREADS;
        for (int i = gt; i < 256 * 512 + 1024 * 2048; i += gn) {
            int n, k, col; bf16_t* dst;
            if (i < 256 * 512) { n = 256; k = i >> 9; col = i & 511; dst = FC + i; } else { const int j = i - 256 * 512; n = 1024; k = j >> 11; col = j & 2047; dst = FL + j; }
            const int s = col >= n, t = col - s * n; const int ph = (k * t) & (n - 1);
            float sv, cv; sincosf(PI2 * (float)ph / (float)n, &sv, &cv);
            const float sc = rsqrtf(64.0f * (float)n);
            *dst = f2bf((s ? -sv : cv) * sc);
        }
        if (bid == 0) for (int i = tid; i < 64 * 16; i += NTHREADS) { const int pos = i >> 4, j = i & 15; const float inv = powf(10000.0f, -(float)(2 * j) / 32.0f);
            float sv, cv; sincosf((float)pos * inv, &sv, &cv); float* rp = (float*)(ws + OFF_ROPE); rp[2 * i] = cv; rp[2 * i + 1] = sv; }
    }
}

template <int MODE>
__device__ void phase_row(const Params& p, int lpost, int spost, int lpre, int spre) {
    const int tid_ = opaque_tid(); const int lane = tid_ & 63, wv = tid_ >> 6;
    const float* mod = (const float*)(p.ws + OFF_MOD);
    const bf16_t* Y = (const bf16_t*)(p.ws + OFF_Y); const float* ssq = (const float*)(p.ws + OFF_SSQ);
    bf16_t* H = (bf16_t*)(p.ws + OFF_H);
    const float factor = (spost == 1) ? 1.0f : 0.5f;
    for (int row = blockIdx.x * 8 + wv; row < NTOK; row += gridDim.x * 8) {
        const int bc = row < NCTX ? 0 : 1 + ((row - NCTX) >> 10);
        float* xr = p.out + (size_t)row * D;
        f32x4 x[4];
        if (MODE == 0) { const float* src = row < NCTX ? p.in[0] + (size_t)row * D : p.in[1] + (size_t)(row - NCTX) * D;
#pragma unroll
            for (int j = 0; j < 4; ++j) x[j] = *(const f32x4*)(src + j * 256 + lane * 4); }
        else {
#pragma unroll
            for (int j = 0; j < 4; ++j) x[j] = *(const f32x4*)(xr + j * 256 + lane * 4);
            const f32x4* sp = (const f32x4*)(ssq + (size_t)row * 16);
            const f32x4 s0 = sp[0], s1 = sp[1], s2 = sp[2], s3 = sp[3];
            const float tot = (s0[0] + s0[1] + s0[2] + s0[3]) + (s1[0] + s1[1] + s1[2] + s1[3]) + (s2[0] + s2[1] + s2[2] + s2[3]) + (s3[0] + s3[1] + s3[2] + s3[3]);
            const float rstd = rsqrtf(tot * (1.0f / 1024.0f) + EPS) * factor;
            const float* gate = mod + ((size_t)lpost * 9 + bc) * 9216 + spost * 3072 + 2048;
            const float* gp = p.in[8] + (lpost * 6 + 2 * spost + 1) * 1024;
#pragma unroll
            for (int j = 0; j < 4; ++j) { const int c = j * 256 + lane * 4;
                const u32x2 yv = *(const u32x2*)(Y + (size_t)row * D + c);
                const f32x4 gt = *(const f32x4*)(gate + c), gg = *(const f32x4*)(gp + c);
                x[j][0] += gt[0] * gg[0] * rstd * __uint_as_float(yv.x << 16);
                x[j][1] += gt[1] * gg[1] * rstd * __uint_as_float(yv.x & 0xFFFF0000u);
                x[j][2] += gt[2] * gg[2] * rstd * __uint_as_float(yv.y << 16);
                x[j][3] += gt[3] * gg[3] * rstd * __uint_as_float(yv.y & 0xFFFF0000u); }
        }
#pragma unroll
        for (int j = 0; j < 4; ++j) *(f32x4*)(xr + j * 256 + lane * 4) = x[j];
        if (MODE != 2) {
            float s = 0.f;
#pragma unroll
            for (int j = 0; j < 4; ++j) s += x[j][0] * x[j][0] + x[j][1] * x[j][1] + x[j][2] * x[j][2] + x[j][3] * x[j][3];
#pragma unroll
            for (int o = 32; o >= 1; o >>= 1) s += __shfl_xor(s, o);
            const float rs = rsqrtf(s * (1.0f / 1024.0f) + EPS);
            const float* mb = mod + ((size_t)lpre * 9 + bc) * 9216 + spre * 3072;
            const float* gp = p.in[8] + (lpre * 6 + 2 * spre) * 1024;
#pragma unroll
            for (int j = 0; j < 4; ++j) { const int c = j * 256 + lane * 4;
                const f32x4 sh = *(const f32x4*)(mb + c), scl = *(const f32x4*)(mb + 1024 + c), gg = *(const f32x4*)(gp + c);
                f32x4 h;
#pragma unroll
                for (int e = 0; e < 4; ++e) h[e] = x[j][e] * rs * gg[e] * (1.0f + scl[e]) + sh[e];
                u32x2 w; w.x = cvt_pk_bf16(h[0], h[1]); w.y = cvt_pk_bf16(h[2], h[3]);
                *(u32x2*)(H + (size_t)row * D + c) = w; }
        }
    }
}

__device__ void hyena_naive(const Params& p, int l, float* lds) {
    const int tid = opaque_tid();
    const bf16_t* HT = (const bf16_t*)(p.ws + OFF_HT);
    bf16_t* YC = (bf16_t*)(p.ws + OFF_YCAT);
    const float* cw = p.in[14] + l * 3 * 768;
    for (int u = blockIdx.x; u < 2048 + 8192; u += gridDim.x) {
        const int pass = u < 2048; const int v = pass ? u : u - 2048; const int b = v >> 8, c = v & 255; const int n = pass ? 1024 : 256;
        const bf16_t* hb = HT + (pass ? HT_LAT + (size_t)b * 768 * 1024 : (size_t)b * 768 * 256);
        const int rowbase = pass ? NCTX + b * 1024 : b * 256;
        const float* fb = (const float*)(p.ws + OFF_FILT) + (size_t)l * FILT_L + (pass ? FILT_CTX : 0);
        float* sv = lds; float* sg1 = lds + n; float* sg2 = lds + 2 * n; float* sz = lds + 3 * n; float* k0 = lds + 4 * n; float* k1 = lds + 6 * n;
        for (int t = tid; t < n; t += NTHREADS) {
#pragma unroll
            for (int w = 0; w < 3; ++w) { const int ch = w * 256 + c; const bf16_t* r = hb + (size_t)ch * n;
                const float a = t > 0 ? bf2f(r[t - 1]) : 0.f, bb = bf2f(r[t]), cc = t < n - 1 ? bf2f(r[t + 1]) : 0.f;
                const float z = a * cw[ch] + bb * cw[768 + ch] + cc * cw[1536 + ch];
                (w == 0 ? sv : (w == 1 ? sg1 : sg2))[t] = z; }
            k0[n + t] = fb[((size_t)(0 * 2 + 0) * 256 + c) * n + t]; k1[n + t] = fb[((size_t)(0 * 2 + 1) * 256 + c) * n + t];
            if (t > 0) { k0[n - t] = fb[((size_t)(1 * 2 + 0) * 256 + c) * n + t]; k1[n - t] = fb[((size_t)(1 * 2 + 1) * 256 + c) * n + t]; }
            else { k0[0] = 0.f; k1[0] = 0.f; }
        }
        __syncthreads();
        const float inv2n = 1.0f / (float)(2 * n);
        const float bias0 = p.in[22][(l * 2 + 0) * 256 + c], bias1 = p.in[22][(l * 2 + 1) * 256 + c];
        for (int t = tid; t < n; t += NTHREADS) { float a = 0.f; const float* kp = k0 + n + t;
#pragma unroll 8
            for (int s = 0; s < n; ++s) a += sv[s] * kp[-s];
            const float y1 = a * inv2n + sv[t] * bias0; sz[t] = sg1[t] * y1; }
        __syncthreads();
        for (int t = tid; t < n; t += NTHREADS) { float a = 0.f; const float* kp = k1 + n + t;
#pragma unroll 8
            for (int s = 0; s < n; ++s) a += sz[s] * kp[-s];
            const float y2 = a * inv2n + sz[t] * bias1;
            YC[(size_t)(rowbase + t) * 1024 + 256 + c] = f2bf(sg2[t] * y2); }
        __syncthreads();
    }
}

__device__ void attn_naive(const Params& p, int l, float* lds) {
    const int tid = opaque_tid();
    const bf16_t* QB = (const bf16_t*)(p.ws + OFF_QB); const bf16_t* KB = (const bf16_t*)(p.ws + OFF_KB); const bf16_t* VB = (const bf16_t*)(p.ws + OFF_VB);
    bf16_t* YC = (bf16_t*)(p.ws + OFF_YCAT);
    float* Ks = lds; float* Vs = lds + 64 * 64;
    for (int u = blockIdx.x; u < 256; u += gridDim.x) {
        const int pass = u < 128; const int v = u & 127;
        int b, kvh, qb, n, rowbase;
        if (!pass) { b = v >> 2; kvh = (v >> 1) & 1; qb = v & 1; n = 256; rowbase = b * 256; }
        else { b = v >> 4; kvh = (v >> 3) & 1; qb = v & 7; n = 1024; rowbase = NCTX + b * 1024; }
        const int qi = tid & 127, g = tid >> 7, head = kvh * 4 + g, qpos = qb * 128 + qi, row = rowbase + qpos;
        float q[64], o[64];
        { const u32x4* qp = (const u32x4*)(QB + (size_t)row * 512 + head * 64);
#pragma unroll
            for (int i = 0; i < 8; ++i) { const u32x4 w = qp[i];
                q[8 * i + 0] = __uint_as_float(w.x << 16); q[8 * i + 1] = __uint_as_float(w.x & 0xFFFF0000u); q[8 * i + 2] = __uint_as_float(w.y << 16); q[8 * i + 3] = __uint_as_float(w.y & 0xFFFF0000u);
                q[8 * i + 4] = __uint_as_float(w.z << 16); q[8 * i + 5] = __uint_as_float(w.z & 0xFFFF0000u); q[8 * i + 6] = __uint_as_float(w.w << 16); q[8 * i + 7] = __uint_as_float(w.w & 0xFFFF0000u); } }
#pragma unroll
        for (int i = 0; i < 64; ++i) o[i] = 0.f;
        float m = p.in[23][l * 8 + head], lsum = 1.0f;
        int klo, khi;
        if (!pass) { klo = 0; khi = 256; } else { klo = qb * 128 - 128; if (klo < 0) klo = 0; khi = qb * 128 + 256; if (khi > n) khi = n; }
        const int nloc = (khi - klo) / 64, nchunks = nloc + (pass ? 4 : 0);
        for (int ch = 0; ch < nchunks; ++ch) {
            __syncthreads();
            { const int key = tid >> 3, d0 = (tid & 7) * 8;
                if (ch < nloc) {
                    const int krow = rowbase + klo + ch * 64 + key;
                    const u32x4 kw = *(const u32x4*)(KB + (size_t)krow * 128 + kvh * 64 + d0), vw = *(const u32x4*)(VB + (size_t)krow * 128 + kvh * 64 + d0);
                    float* kd = Ks + key * 64 + d0; float* vd = Vs + key * 64 + d0;
                    kd[0] = __uint_as_float(kw.x << 16); kd[1] = __uint_as_float(kw.x & 0xFFFF0000u); kd[2] = __uint_as_float(kw.y << 16); kd[3] = __uint_as_float(kw.y & 0xFFFF0000u);
                    kd[4] = __uint_as_float(kw.z << 16); kd[5] = __uint_as_float(kw.z & 0xFFFF0000u); kd[6] = __uint_as_float(kw.w << 16); kd[7] = __uint_as_float(kw.w & 0xFFFF0000u);
                    vd[0] = __uint_as_float(vw.x << 16); vd[1] = __uint_as_float(vw.x & 0xFFFF0000u); vd[2] = __uint_as_float(vw.y << 16); vd[3] = __uint_as_float(vw.y & 0xFFFF0000u);
                    vd[4] = __uint_as_float(vw.z << 16); vd[5] = __uint_as_float(vw.z & 0xFFFF0000u); vd[6] = __uint_as_float(vw.w << 16); vd[7] = __uint_as_float(vw.w & 0xFFFF0000u);
                } else {
                    const int ck = (ch - nloc) * 64 + key;
                    const size_t off = (((size_t)b * 2 + l) * 256 + ck) * 128 + kvh * 64 + d0;
                    const f32x4 k0 = *(const f32x4*)(p.in[2] + off), k1 = *(const f32x4*)(p.in[2] + off + 4), v0 = *(const f32x4*)(p.in[3] + off), v1 = *(const f32x4*)(p.in[3] + off + 4);
                    *(f32x4*)(Ks + key * 64 + d0) = k0; *(f32x4*)(Ks + key * 64 + d0 + 4) = k1; *(f32x4*)(Vs + key * 64 + d0) = v0; *(f32x4*)(Vs + key * 64 + d0 + 4) = v1;
                } }
            __syncthreads();
            for (int key = 0; key < 64; ++key) {
                const f32x4* kr = (const f32x4*)(Ks + key * 64);
                float s = 0.f;
#pragma unroll
                for (int i = 0; i < 16; ++i) { const f32x4 kv = kr[i]; s += q[4 * i] * kv[0] + q[4 * i + 1] * kv[1] + q[4 * i + 2] * kv[2] + q[4 * i + 3] * kv[3]; }
                bool valid = true;
                if (pass && ch < nloc) { const int kpos = klo + ch * 64 + key; int dd = kpos - qpos; if (dd < 0) dd = -dd; valid = dd <= 128; }
                if (valid) {
                    if (s > m) { const float corr = __expf(m - s); lsum *= corr;
#pragma unroll
                        for (int i = 0; i < 64; ++i) o[i] *= corr;
                        m = s; }
                    const float pe = __expf(s - m); lsum += pe;
                    const f32x4* vr = (const f32x4*)(Vs + key * 64);
#pragma unroll
                    for (int i = 0; i < 16; ++i) { const f32x4 vv = vr[i]; o[4 * i] += pe * vv[0]; o[4 * i + 1] += pe * vv[1]; o[4 * i + 2] += pe * vv[2]; o[4 * i + 3] += pe * vv[3]; }
                }
            }
        }
        const float inv = 1.0f / lsum;
        u32x4* op = (u32x4*)(YC + (size_t)row * 1024 + 512 + head * 64);
#pragma unroll
        for (int i = 0; i < 8; ++i) { u32x4 w; w.x = cvt_pk_bf16(o[8 * i] * inv, o[8 * i + 1] * inv); w.y = cvt_pk_bf16(o[8 * i + 2] * inv, o[8 * i + 3] * inv);
            w.z = cvt_pk_bf16(o[8 * i + 4] * inv, o[8 * i + 5] * inv); w.w = cvt_pk_bf16(o[8 * i + 6] * inv, o[8 * i + 7] * inv); op[i] = w; }
        __syncthreads();
    }
}

__global__ void __launch_bounds__(NTHREADS, 2) fwd_megakernel(Params p) {
    extern __shared__ __attribute__((aligned(16))) unsigned char shm[];
    cg::grid_group grid = cg::this_grid();
    LAS unsigned char* lds = (LAS unsigned char*)shm;
    float* ldsf = (float*)shm;
    unsigned char* ws = p.ws;
    const int G = gridDim.x, c = blockIdx.x;

    phase_prep(p, ldsf);
    grid.sync();
    phase_row<0>(p, 0, 0, 0, 0);
    grid.sync();
    for (int l = 0; l < 2; ++l) {
        for (int s = 0; s < 3; ++s) {
            if (s != 1) {
                const int fs = s >> 1;
                { pg8::Gemm g{(const bf16_t*)(ws + OFF_H), (const bf16_t*)(ws + OFF_WGU + (l * 2 + fs) * SZ_WGU), NTOK, 5632, 1024, 1024, 1024};
                    pg8::StaticOrder S; S.init(g.M, g.N, G, c); EpiSwiglu E{(bf16_t*)(ws + OFF_ACT)};
                    pg8::gemm_phase(lds, g, S, E); }
                grid.sync();
                { pg8::Gemm g{(const bf16_t*)(ws + OFF_ACT), (const bf16_t*)(ws + OFF_WD + (l * 2 + fs) * SZ_WD), NTOK, 1024, DFF, DFF, DFF};
                    pg8::StaticOrder S; S.init(g.M, g.N, G, c); EpiYssq E{(bf16_t*)(ws + OFF_Y), (float*)(ws + OFF_SSQ)};
                    pg8::gemm_phase(lds, g, S, E); }
                grid.sync();
            } else {
                { pg8::Gemm g{(const bf16_t*)(ws + OFF_H), (const bf16_t*)(ws + OFF_WIN + l * SZ_WIN), NTOK, 2048, 1024, 1024, 1024};
                    pg8::StaticOrder S; S.init(g.M, g.N, G, c);
                    EpiWin E{(bf16_t*)(ws + OFF_ZT), (bf16_t*)(ws + OFF_HT), (bf16_t*)(ws + OFF_QB), (bf16_t*)(ws + OFF_KB), (bf16_t*)(ws + OFF_VB), (const float*)(ws + OFF_ROPE),
                             p.out + (size_t)NTOK * D, p.out + (size_t)NTOK * D + (size_t)32 * 2 * 256 * 128, l};
                    pg8::gemm_phase(lds, g, S, E); }
                grid.sync();
                { pg8::Gemm g{(const bf16_t*)(ws + OFF_FL), (const bf16_t*)(ws + OFF_ZT) + ZT_LAT, 1024, 2048, 2048, 2048, 2048};
                    pg8::StaticOrder S; S.init(g.M, g.N, G, c); EpiFourier E{(bf16_t*)(ws + OFF_YCAT), NCTX, 1024};
                    pg8::gemm_phase(lds, g, S, E); }
                { pg8::Gemm g{(const bf16_t*)(ws + OFF_FC), (const bf16_t*)(ws + OFF_ZT), 256, 8192, 512, 512, 512};
                    pg8::StaticOrder S; S.init(g.M, g.N, G, c - 32); EpiFourier E{(bf16_t*)(ws + OFF_YCAT), 0, 256};
                    pg8::gemm_phase(lds, g, S, E); }
                __syncthreads();
                hyena_naive(p, l, ldsf);
                attn_naive(p, l, ldsf);
                grid.sync();
                { pg8::Gemm g{(const bf16_t*)(ws + OFF_YCAT), (const bf16_t*)(ws + OFF_WOUT + l * SZ_WOUT), NTOK, 1024, 1024, 1024, 1024};
                    pg8::StaticOrder S; S.init(g.M, g.N, G, c); EpiYssq E{(bf16_t*)(ws + OFF_Y), (float*)(ws + OFF_SSQ)};
                    pg8::gemm_phase(lds, g, S, E); }
                grid.sync();
            }
            if (l == 1 && s == 2) phase_row<2>(p, l, s, 0, 0);
            else { const int ln = s == 2 ? l + 1 : l, sn = s == 2 ? 0 : s + 1; phase_row<1>(p, l, s, ln, sn); }
            if (!(l == 1 && s == 2)) grid.sync();
        }
    }
}

extern "C" void kernel_launch(void* const* d_in, const int* in_sizes, int n_in, void* d_out, int out_size, void* d_ws, size_t ws_size, hipStream_t stream) {
    constexpr int LDS_BYTES = pg8::STAGE_BYTES;
    static int grid_blocks = 0;
    if (!grid_blocks) {
        if (n_in != 24 || ws_size < WS_END) { fprintf(stderr, "kernel_launch: bad inputs (n_in %d) or workspace too small (%zu < %zu)\n", n_in, ws_size, (size_t)WS_END); grid_blocks = -1; return; }
        int dev = 0, cus = 0, per_cu = 0;
        hipGetDevice(&dev);
        hipDeviceGetAttribute(&cus, hipDeviceAttributeMultiprocessorCount, dev);
        if (hipFuncSetAttribute((const void*)fwd_megakernel, hipFuncAttributeMaxDynamicSharedMemorySize, LDS_BYTES) != hipSuccess) fprintf(stderr, "kernel_launch: hipFuncSetAttribute failed\n");
        hipOccupancyMaxActiveBlocksPerMultiprocessor(&per_cu, (const void*)fwd_megakernel, NTHREADS, LDS_BYTES);
        if (per_cu < 1) { fprintf(stderr, "kernel_launch: occupancy query says %d blocks per CU\n", per_cu); per_cu = 1; }
        (void)hipGetLastError();
        grid_blocks = cus * per_cu;
        if (grid_blocks > 256) grid_blocks = 256;
    }
    if (grid_blocks < 0) return;
    Params p{};
    for (int i = 0; i < 24; ++i) p.in[i] = (const float*)d_in[i];
    p.out = (float*)d_out; p.ws = (unsigned char*)d_ws;
    void* args[] = {&p};
    hipError_t e = hipLaunchCooperativeKernel((const void*)fwd_megakernel, dim3(grid_blocks), dim3(NTHREADS), args, LDS_BYTES, stream);
    if (e != hipSuccess) fprintf(stderr, "cooperative launch failed: %s (grid %d)\n", hipGetErrorString(e), grid_blocks);
}
```

```cpp
#include <hip/hip_runtime.h>
#include <hip/hip_cooperative_groups.h>
#include <cstdio>
namespace cg = cooperative_groups;

#define LAS __attribute__((address_space(3)))
typedef unsigned short bf16_t;
typedef short bf16x8 __attribute__((ext_vector_type(8)));
typedef float f32x4 __attribute__((ext_vector_type(4)));
typedef unsigned u32x4 __attribute__((ext_vector_type(4)));
typedef unsigned u32x2 __attribute__((ext_vector_type(2)));

constexpr int D = 1024, NTOK = 16384, NCTX = 8192, DFF = 2816, INW = 1792;
constexpr int NTHREADS = 512;
constexpr float EPS = 1e-6f;
constexpr float PI2 = 6.283185307179586f;

constexpr size_t AL(size_t x) { return (x + 255) & ~(size_t)255; }
constexpr size_t SZ_WGU = (size_t)5632 * 1024 * 2, SZ_WD = (size_t)1024 * 2816 * 2, SZ_WIN = (size_t)2048 * 1024 * 2, SZ_WOUT = (size_t)1024 * 1024 * 2;
constexpr size_t OFF_WGU = 0;
constexpr size_t OFF_WD = OFF_WGU + 4 * SZ_WGU;
constexpr size_t OFF_WIN = OFF_WD + 4 * SZ_WD;
constexpr size_t OFF_WOUT = OFF_WIN + 2 * SZ_WIN;
constexpr size_t OFF_H = OFF_WOUT + 2 * SZ_WOUT;
constexpr size_t OFF_Y = OFF_H + (size_t)NTOK * D * 2;
constexpr size_t OFF_SSQ = OFF_Y + (size_t)NTOK * D * 2;
constexpr size_t OFF_MOD = OFF_SSQ + (size_t)NTOK * 16 * 4;
constexpr size_t OFF_FILT = AL(OFF_MOD + (size_t)2 * 9 * 9216 * 4);
constexpr size_t FILT_CTX = (size_t)4 * 256 * 256, FILT_LAT = (size_t)4 * 256 * 1024, FILT_L = FILT_CTX + FILT_LAT;
constexpr size_t OFF_FC = AL(OFF_FILT + 2 * FILT_L * 4);
constexpr size_t OFF_FL = OFF_FC + (size_t)256 * 512 * 2;
constexpr size_t OFF_ROPE = OFF_FL + (size_t)1024 * 2048 * 2;
constexpr size_t OFF_CKB = AL(OFF_ROPE + 64 * 16 * 8);
constexpr size_t OFF_CVT = OFF_CKB + (size_t)2 * 8 * 256 * 128 * 2;
constexpr size_t OFF_UNION = AL(OFF_CVT + (size_t)2 * 8 * 256 * 128 * 2);
constexpr size_t OFF_ACT = OFF_UNION;
constexpr size_t OFF_ZT = OFF_UNION;
constexpr size_t ZT_LAT = (size_t)NCTX * 512;
constexpr size_t OFF_HT = OFF_ZT + (size_t)NTOK * 512 * 2;
constexpr size_t HT_LAT = (size_t)NCTX * 768;
constexpr size_t OFF_QB = OFF_HT + (size_t)NTOK * 768 * 2;
constexpr size_t OFF_KB = OFF_QB + (size_t)NTOK * 512 * 2;
constexpr size_t OFF_VB = OFF_KB + (size_t)NTOK * 128 * 2;
constexpr size_t VT_LAT = (size_t)NCTX * 128;
constexpr size_t OFF_YCAT = OFF_VB + (size_t)NTOK * 128 * 2;
constexpr size_t UNION_END = OFF_YCAT + (size_t)NTOK * 1024 * 2;
constexpr size_t ACT_END = OFF_ACT + (size_t)NTOK * DFF * 2;
constexpr size_t WS_END = (UNION_END > ACT_END ? UNION_END : ACT_END);

struct Params {
    const float* in[24];
    float* out;
    unsigned char* ws;
};

__device__ __forceinline__ unsigned short f2bf(float f) { unsigned u = __float_as_uint(f); u += 0x7FFFu + ((u >> 16) & 1u); return (unsigned short)(u >> 16); }
__device__ __forceinline__ float bf2f(unsigned short b) { return __uint_as_float(((unsigned)b) << 16); }
__device__ __forceinline__ unsigned cvt_pk_bf16(float lo, float hi) { unsigned r; asm volatile("v_cvt_pk_bf16_f32 %0, %1, %2" : "=v"(r) : "v"(lo), "v"(hi)); return r; }
typedef __bf16 bf16x2_t __attribute__((ext_vector_type(2)));
typedef float f32x2_t __attribute__((ext_vector_type(2)));
typedef float f32x16 __attribute__((ext_vector_type(16)));
__device__ __forceinline__ unsigned pk_bf16(float lo, float hi) { f32x2_t v = {lo, hi}; return __builtin_bit_cast(unsigned, __builtin_convertvector(v, bf16x2_t)); }
__device__ __forceinline__ float silu_f(float x) { return x * __builtin_amdgcn_rcpf(1.0f + __expf(-x)); }
__device__ __forceinline__ int perm32(int rho) { const int n = rho >> 4, i = rho & 15; return 8 * (i >> 2) + 4 * n + (i & 3); }

__device__ __forceinline__ int opaque_tid() { int t = threadIdx.x; asm volatile("" : "+v"(t)); return t; }

namespace pg8 {
constexpr int BM = 256, BK = 64, HALF = 128, HTB = HALF * BK * 2, STAGE_BYTES = 8 * HTB, NXCD = 8, WGM = 8;
__device__ __forceinline__ int lds_byte(int r, int c) { const int st = (r >> 4) * 2 + (c >> 5), rr = r & 15, cc = c & 31, ob = rr * 64 + cc * 2; return st * 1024 + (ob ^ (((ob >> 9) & 1) << 5)); }
__device__ __forceinline__ void stage_rc(int b, int& R, int& C) { const int st = b / 1024, sb = b % 1024, swz = sb ^ (((sb >> 9) & 1) << 5); R = (st >> 1) * 16 + swz / 64; C = (st & 1) * 32 + (swz % 64) / 2; }
struct Unit { int pm, pn; };
struct Gemm { const bf16_t* A; const bf16_t* Bt; int M, N, K, lda, ldb; };
struct StaticOrder {
    int nM, nN, nwg, G, c;
    __device__ void init(int M, int N, int G_, int c_) { nM = M / BM; nN = N / BM; nwg = nM * nN; G = G_; c = c_; }
    __device__ bool next(int i, Unit& u) const {
        if (c < 0) return false;
        const long L = (long)i * G + c; if (L >= nwg) return false;
        int wgid = (int)L; { const int q = nwg / NXCD, r = nwg % NXCD, xcd = wgid % NXCD, off = wgid / NXCD; wgid = (xcd < r ? xcd * (q + 1) : r * (q + 1) + (xcd - r) * q) + off; }
        const int nig = WGM * nN, gid = wgid / nig, fm = gid * WGM, gsz = (nM - fm) < WGM ? (nM - fm) : WGM;
        u.pm = fm + ((wgid % nig) % gsz); u.pn = (wgid % nig) / gsz; return true;
    }
    __device__ __forceinline__ void a_ready(const Unit&) const {}
    __device__ __forceinline__ void done(const Unit&) const {}
};

template <class Epi, class Sched>
__device__ __forceinline__ void gemm_phase(LAS unsigned char* lds, Gemm g, const Sched& S, const Epi& E) {
    asm volatile("" : "+s"(g.A), "+s"(g.Bt), "+s"(g.K), "+s"(g.lda), "+s"(g.ldb));
    int tid = threadIdx.x; asm volatile("" : "+v"(tid));
    const int wid = __builtin_amdgcn_readfirstlane(tid >> 6), lane = tid & 63, wr = wid >> 2, wc = wid & 3, fr = lane & 15, fq = lane >> 4;
    const int K = g.K, nt = K / BK;
    unsigned voffA[2], voffB[2];
#pragma unroll
    for (int i = 0; i < 2; ++i) { int R, C; stage_rc(tid * 16 + i * 8192, R, C);
        voffA[i] = (unsigned)(R * g.lda + C) * 2u; voffB[i] = (unsigned)(R * g.ldb + C) * 2u; }
    const size_t kstep = (size_t)(BK * 2);
    const size_t hstepA = (size_t)HALF * g.lda * 2, hstepB = (size_t)HALF * g.ldb * 2;
    const size_t tstepA = 2 * hstepA, tstepB = 2 * hstepB;
    const unsigned ldsw = (unsigned)wid * 1024u;
    const int aoff = lds_byte(wr * 64 + fr, fq * 8), boff = lds_byte(wc * 32 + fr, fq * 8);
#define PG8_SA(b, h) (((b) * 2 + (h)) * HTB)
#define PG8_SB(b, h) ((4 + (b) * 2 + (h)) * HTB)
#define PG8_STAGE(bufoff, gbase, voff) do { _Pragma("unroll") for (int _i = 0; _i < 2; ++_i) \
        __builtin_amdgcn_global_load_lds((const unsigned*)((const char*)(gbase) + (voff)[_i]), (LAS unsigned*)(lds + (bufoff) + ldsw + _i * 8192), 16, 0, 0); } while (0)
#define PG8_LDA(dst, b, h) do { _Pragma("unroll") for (int m = 0; m < 4; ++m) _Pragma("unroll") for (int k = 0; k < 2; ++k) dst[m][k] = *(const LAS bf16x8*)(lds + PG8_SA(b, h) + aoff + m * 2048 + k * 1024); } while (0)
#define PG8_LDB(dst, b, h) do { _Pragma("unroll") for (int n = 0; n < 2; ++n) _Pragma("unroll") for (int k = 0; k < 2; ++k) dst[n][k] = *(const LAS bf16x8*)(lds + PG8_SB(b, h) + boff + n * 2048 + k * 1024); } while (0)
#define PG8_MMA(ai, bj, At, Bt) do { __builtin_amdgcn_s_setprio(1); _Pragma("unroll") for (int m = 0; m < 4; ++m) _Pragma("unroll") for (int n = 0; n < 2; ++n) _Pragma("unroll") for (int k = 0; k < 2; ++k) \
        acc[ai][bj][m][n] = __builtin_amdgcn_mfma_f32_16x16x32_bf16(Bt[n][k], At[m][k], acc[ai][bj][m][n], 0, 0, 0); __builtin_amdgcn_s_setprio(0); } while (0)
#define PG8_WAIT_V(n) asm volatile("s_waitcnt vmcnt(" #n ")" ::: "memory")
#define PG8_WAIT_L(n) asm volatile("s_waitcnt lgkmcnt(" #n ")" ::: "memory")
#define PG8_BAR __builtin_amdgcn_s_barrier()
#define PG8_SCHED __builtin_amdgcn_sched_barrier(0)
    Unit cur, nxt; int ui = 0;
    if (!S.next(0, cur)) return;
    f32x4 acc[2][2][4][2];
#pragma unroll
    for (int a = 0; a < 2; ++a)
#pragma unroll
        for (int b = 0; b < 2; ++b)
#pragma unroll
            for (int m = 0; m < 4; ++m)
#pragma unroll
                for (int n = 0; n < 2; ++n) acc[a][b][m][n] = (f32x4){0.f, 0.f, 0.f, 0.f};
    bf16x8 At[4][2], B0[2][2], B1[2][2];
    const char* cA = (const char*)g.A + (size_t)cur.pm * tstepA; const char* cB = (const char*)g.Bt + (size_t)cur.pn * tstepB;
    S.a_ready(cur);
    PG8_STAGE(PG8_SB(0, 0), cB, voffB); PG8_STAGE(PG8_SA(0, 0), cA, voffA); PG8_STAGE(PG8_SB(0, 1), cB + hstepB, voffB); PG8_STAGE(PG8_SA(0, 1), cA + hstepA, voffA);
    if (wr == 1) PG8_BAR;
    PG8_WAIT_V(4); PG8_BAR;
    PG8_STAGE(PG8_SB(1, 0), cB + kstep, voffB); PG8_STAGE(PG8_SA(1, 0), cA + kstep, voffA); PG8_STAGE(PG8_SB(1, 1), cB + hstepB + kstep, voffB);
    PG8_WAIT_V(6); PG8_BAR;
    for (;;) {
        const bool has_next = S.next(ui + 1, nxt);
        const char* nA = has_next ? (const char*)g.A + (size_t)nxt.pm * tstepA : cA; const char* nB = has_next ? (const char*)g.Bt + (size_t)nxt.pn * tstepB : cB;
        for (int t = 0; t < nt; t += 2) {
            const bool last = (t == nt - 2);
            const char* a1 = cA + (size_t)(t + 1) * kstep;
            const char* a2 = last ? nA : cA + (size_t)(t + 2) * kstep; const char* b2 = last ? nB : cB + (size_t)(t + 2) * kstep;
            const char* a3 = a2 + kstep; const char* b3 = b2 + kstep;
            if (last && has_next) S.a_ready(nxt);
            PG8_LDB(B0, 0, 0); PG8_SCHED; PG8_LDA(At, 0, 0); PG8_STAGE(PG8_SA(1, 1), a1 + hstepA, voffA);
            PG8_WAIT_L(8); PG8_BAR; PG8_WAIT_L(0); PG8_MMA(0, 0, At, B0); PG8_BAR; PG8_SCHED;
            PG8_LDB(B1, 0, 1); PG8_STAGE(PG8_SB(0, 0), b2, voffB);
            PG8_BAR; PG8_WAIT_L(0); PG8_MMA(0, 1, At, B1); PG8_BAR;
            PG8_LDA(At, 0, 1); PG8_STAGE(PG8_SA(0, 0), a2, voffA);
            PG8_BAR; PG8_WAIT_L(0); PG8_MMA(1, 0, At, B0); PG8_BAR; PG8_SCHED;
            PG8_STAGE(PG8_SB(0, 1), b2 + hstepB, voffB);
            PG8_WAIT_V(6); PG8_BAR; PG8_MMA(1, 1, At, B1); PG8_BAR;
            PG8_LDB(B0, 1, 0); PG8_SCHED; PG8_LDA(At, 1, 0); PG8_STAGE(PG8_SA(0, 1), a2 + hstepA, voffA);
            PG8_WAIT_L(8); PG8_BAR; PG8_WAIT_L(0); PG8_MMA(0, 0, At, B0); PG8_BAR; PG8_SCHED;
            PG8_LDB(B1, 1, 1); PG8_STAGE(PG8_SB(1, 0), b3, voffB);
            PG8_BAR; PG8_WAIT_L(0); PG8_MMA(0, 1, At, B1); PG8_BAR;
            PG8_LDA(At, 1, 1); PG8_STAGE(PG8_SA(1, 0), a3, voffA);
            PG8_BAR; PG8_WAIT_L(0); PG8_MMA(1, 0, At, B0); PG8_BAR; PG8_SCHED;
            PG8_STAGE(PG8_SB(1, 1), b3 + hstepB, voffB);
            PG8_WAIT_V(6); PG8_BAR; PG8_MMA(1, 1, At, B1); PG8_BAR;
        }
        { int fr2 = fr, fq2 = fq, wr2 = wr, wc2 = wc; asm volatile("" : "+v"(fr2), "+v"(fq2), "+s"(wr2), "+s"(wc2));
            E(acc, cur, wr2, wc2, fr2, fq2); } S.done(cur);
        if (!has_next) break;
#pragma unroll
        for (int a = 0; a < 2; ++a)
#pragma unroll
            for (int b = 0; b < 2; ++b)
#pragma unroll
                for (int m = 0; m < 4; ++m)
#pragma unroll
                    for (int n = 0; n < 2; ++n) acc[a][b][m][n] = (f32x4){0.f, 0.f, 0.f, 0.f};
        cur = nxt; cA = nA; cB = nB; ++ui;
    }
    PG8_WAIT_V(0);
    if (wr == 0) PG8_BAR;
    PG8_BAR;
#undef PG8_SA
#undef PG8_SB
#undef PG8_STAGE
#undef PG8_LDA
#undef PG8_LDB
#undef PG8_MMA
#undef PG8_WAIT_V
#undef PG8_WAIT_L
#undef PG8_BAR
#undef PG8_SCHED
}
}

struct EpiSwiglu {
    bf16_t* O;
    __device__ __forceinline__ void operator()(const f32x4 (&acc)[2][2][4][2], const pg8::Unit& u, int wr, int wc, int fr, int fq) const {
        const int row0 = u.pm * 256 + wr * 64 + fr, col0 = u.pn * 128 + wc * 32 + 8 * fq;
#pragma unroll
        for (int ai = 0; ai < 2; ++ai)
#pragma unroll
            for (int m = 0; m < 4; ++m) {
                bf16_t* rowp = O + (size_t)(row0 + ai * 128 + m * 16) * DFF + col0;
                const f32x4 g0 = acc[ai][0][m][0], g1 = acc[ai][0][m][1], u0 = acc[ai][1][m][0], u1 = acc[ai][1][m][1];
                u32x4 w;
                w.x = cvt_pk_bf16(silu_f(g0[0]) * u0[0], silu_f(g0[1]) * u0[1]); w.y = cvt_pk_bf16(silu_f(g0[2]) * u0[2], silu_f(g0[3]) * u0[3]);
                w.z = cvt_pk_bf16(silu_f(g1[0]) * u1[0], silu_f(g1[1]) * u1[1]); w.w = cvt_pk_bf16(silu_f(g1[2]) * u1[2], silu_f(g1[3]) * u1[3]);
                *(u32x4*)rowp = w;
            }
    }
};
struct EpiYssq {
    bf16_t* Y; float* ssq;
    __device__ __forceinline__ void operator()(const f32x4 (&acc)[2][2][4][2], const pg8::Unit& u, int wr, int wc, int fr, int fq) const {
        const int row0 = u.pm * 256 + wr * 64 + fr, col0 = u.pn * 256 + wc * 32 + 8 * fq;
#pragma unroll
        for (int ai = 0; ai < 2; ++ai)
#pragma unroll
            for (int m = 0; m < 4; ++m) {
                const int row = row0 + ai * 128 + m * 16;
                bf16_t* rowp = Y + (size_t)row * D + col0;
                float s = 0.f;
#pragma unroll
                for (int bj = 0; bj < 2; ++bj) {
                    const f32x4 v0 = acc[ai][bj][m][0], v1 = acc[ai][bj][m][1];
                    s += v0[0] * v0[0] + v0[1] * v0[1] + v0[2] * v0[2] + v0[3] * v0[3] + v1[0] * v1[0] + v1[1] * v1[1] + v1[2] * v1[2] + v1[3] * v1[3];
                    u32x4 w; w.x = cvt_pk_bf16(v0[0], v0[1]); w.y = cvt_pk_bf16(v0[2], v0[3]); w.z = cvt_pk_bf16(v1[0], v1[1]); w.w = cvt_pk_bf16(v1[2], v1[3]);
                    *(u32x4*)(rowp + bj * 128) = w;
                }
                s += __shfl_xor(s, 16); s += __shfl_xor(s, 32);
                if (fq == 0) ssq[(size_t)row * 16 + u.pn * 4 + wc] = s;
            }
    }
};
struct EpiWin {
    bf16_t* ZT; bf16_t* HT; bf16_t* QB; bf16_t* KB; bf16_t* VB; const float* rope; float* newk; float* newv; int layer;
    __device__ __forceinline__ void operator()(const f32x4 (&acc)[2][2][4][2], const pg8::Unit& u, int wr, int wc, int fr, int fq) const {
        const int r0 = u.pm * 256 + wr * 64 + fr;
        const bool lat = u.pm >= 32;
        const int pn = u.pn;
        if (pn < 5) {
            bf16_t* base; int t0; size_t sch;
            if (pn < 2) {
                if (!lat) { const int b = u.pm; base = ZT + ((size_t)b * 256 * 2 + pn) * 256; sch = 512; t0 = r0 - u.pm * 256; }
                else { const int b = (u.pm - 32) >> 2; base = ZT + ZT_LAT + ((size_t)b * 256 * 2 + pn) * 1024; sch = 2048; t0 = r0 - NCTX - b * 1024; }
            } else {
                const int c0 = (pn - 2) * 256;
                if (!lat) { const int b = u.pm; base = HT + ((size_t)b * 768 + c0) * 256; sch = 256; t0 = r0 - u.pm * 256; }
                else { const int b = (u.pm - 32) >> 2; base = HT + HT_LAT + ((size_t)b * 768 + c0) * 1024; sch = 1024; t0 = r0 - NCTX - b * 1024; }
            }
#pragma unroll
            for (int ai = 0; ai < 2; ++ai)
#pragma unroll
                for (int m = 0; m < 4; ++m) {
                    const int t = t0 + ai * 128 + m * 16;
#pragma unroll
                    for (int bj = 0; bj < 2; ++bj)
#pragma unroll
                        for (int n = 0; n < 2; ++n) {
                            const int ch = bj * 128 + wc * 32 + n * 16 + 4 * fq;
                            const f32x4 v = acc[ai][bj][m][n];
#pragma unroll
                            for (int e = 0; e < 4; ++e) base[(size_t)(ch + e) * sch + t] = f2bf(v[e]);
                        }
                }
        } else {
            const int blk = wc & 1;
#pragma unroll
            for (int ai = 0; ai < 2; ++ai)
#pragma unroll
                for (int m = 0; m < 4; ++m) {
                    const int row = r0 + ai * 128 + m * 16;
                    f32x4 cs0 = {1.f, 0.f, 1.f, 0.f}, cs1 = {1.f, 0.f, 1.f, 0.f};
                    if (lat) { const int t = row & 1023; const int pos = blk ? (t & 63) : (t >> 6);
                        const f32x4* rp = (const f32x4*)(rope + (size_t)(pos * 16 + 4 * fq) * 2); cs0 = rp[0]; cs1 = rp[1]; }
#pragma unroll
                    for (int bj = 0; bj < 2; ++bj) {
                        f32x4 x1 = acc[ai][bj][m][0], x2 = acc[ai][bj][m][1];
                        const bool isv = (pn == 7 && bj == 1);
                        const bool isk = (pn == 7 && bj == 0);
                        const int cc = bj * 128 + wc * 32 + 4 * fq;
                        if ((isk || isv) && !lat) {
                            const int b = row >> 8, t = row & 255;
                            float* dst = (isk ? newk : newv) + (((size_t)b * 2 + layer) * 256 + t) * 128 + (cc & 127);
                            *(f32x4*)dst = x1; *(f32x4*)(dst + 16) = x2;
                        }
                        if (!isv) {
                            f32x4 o1, o2;
                            o1[0] = x1[0] * cs0[0] - x2[0] * cs0[1]; o2[0] = x2[0] * cs0[0] + x1[0] * cs0[1];
                            o1[1] = x1[1] * cs0[2] - x2[1] * cs0[3]; o2[1] = x2[1] * cs0[2] + x1[1] * cs0[3];
                            o1[2] = x1[2] * cs1[0] - x2[2] * cs1[1]; o2[2] = x2[2] * cs1[0] + x1[2] * cs1[1];
                            o1[3] = x1[3] * cs1[2] - x2[3] * cs1[3]; o2[3] = x2[3] * cs1[2] + x1[3] * cs1[3];
                            x1 = o1; x2 = o2;
                        }
                        bf16_t* dst;
                        if (pn < 7) { x1 *= 0.125f; x2 *= 0.125f; dst = QB + (size_t)row * 512 + (pn - 5) * 256 + cc; }
                        else if (isk) dst = KB + (size_t)row * 128 + cc;
                        else {
                            bf16_t* vb; size_t n_;
                            if (!lat) { vb = VB + (size_t)(row >> 8) * 128 * 256 + (row & 255); n_ = 256; } else { vb = VB + VT_LAT + (size_t)((row - NCTX) >> 10) * 128 * 1024 + (row & 1023); n_ = 1024; }
                            const int c0 = cc - 128;
#pragma unroll
                            for (int e = 0; e < 4; ++e) { vb[(size_t)(c0 + e) * n_] = f2bf(x1[e]); vb[(size_t)(c0 + 16 + e) * n_] = f2bf(x2[e]); }
                            continue;
                        }
                        u32x2 w1, w2; w1.x = cvt_pk_bf16(x1[0], x1[1]); w1.y = cvt_pk_bf16(x1[2], x1[3]); w2.x = cvt_pk_bf16(x2[0], x2[1]); w2.y = cvt_pk_bf16(x2[2], x2[3]);
                        *(u32x2*)dst = w1; *(u32x2*)(dst + 16) = w2;
                    }
                }
        }
    }
};
struct EpiFourier {
    bf16_t* YC; int rowbase, n;
    __device__ __forceinline__ void operator()(const f32x4 (&acc)[2][2][4][2], const pg8::Unit& u, int wr, int wc, int fr, int fq) const {
        const int kp0 = u.pm * 256 + wr * 64 + fr; const int b = u.pn;
#pragma unroll
        for (int ai = 0; ai < 2; ++ai)
#pragma unroll
            for (int m = 0; m < 4; ++m) {
                bf16_t* rowp = YC + (size_t)(rowbase + b * n + kp0 + ai * 128 + m * 16) * 1024 + wc * 32 + 4 * fq;
#pragma unroll
                for (int bj = 0; bj < 2; ++bj)
#pragma unroll
                    for (int nn = 0; nn < 2; ++nn) { const f32x4 v = acc[ai][bj][m][nn]; u32x2 w; w.x = cvt_pk_bf16(v[0], v[1]); w.y = cvt_pk_bf16(v[2], v[3]);
                        *(u32x2*)(rowp + bj * 128 + nn * 16) = w; }
            }
    }
};

template <bool PERM>
__device__ __forceinline__ void transpose_unit(const float* __restrict__ src, int ld, int k0, int cbase, bf16_t* __restrict__ dst, int Kd, int r0, float* tile) {
    const int tid = opaque_tid();
#pragma unroll
    for (int i = 0; i < 2; ++i) { const int idx = tid + 512 * i, kk = idx >> 4, c4 = idx & 15;
        const f32x4 v = *(const f32x4*)(src + (size_t)(k0 + kk) * ld + cbase + c4 * 4);
        float* tp = tile + kk * 65 + c4 * 4; tp[0] = v[0]; tp[1] = v[1]; tp[2] = v[2]; tp[3] = v[3]; }
    __syncthreads();
    { const int rr = tid >> 3, kc = tid & 7; const int cc = PERM ? ((rr & ~31) + perm32(rr & 31)) : rr;
        float v[8];
#pragma unroll
        for (int j = 0; j < 8; ++j) v[j] = tile[(kc * 8 + j) * 65 + cc];
        u32x4 w; w.x = cvt_pk_bf16(v[0], v[1]); w.y = cvt_pk_bf16(v[2], v[3]); w.z = cvt_pk_bf16(v[4], v[5]); w.w = cvt_pk_bf16(v[6], v[7]);
        *(u32x4*)(dst + (size_t)(r0 + rr) * Kd + k0 + kc * 8) = w; }
    __syncthreads();
}

__device__ void phase_prep(const Params& p, float* lds) {
    const int tid = opaque_tid(), nb = gridDim.x, bid = blockIdx.x;
    unsigned char* ws = p.ws;
    constexpr int U_GU = 4 * 88 * 16, U_D = 4 * 16 * 44, U_OUT = 2 * 16 * 16, U_IN = 2 * 24 * 16;
    for (int u = bid; u < U_GU + U_D + U_OUT + U_IN; u += nb) {
        if (u < U_GU) {
            const int ls = u / (88 * 16), rem = u % (88 * 16), rg = rem / 16, kb = rem % 16;
            const int r0 = rg * 64, pn = r0 >> 8, inner = r0 & 255, half = inner >> 7, q0 = inner & 127;
            const float* src = (half ? p.in[10] : p.in[9]) + (size_t)ls * 1024 * DFF;
            transpose_unit<true>(src, DFF, kb * 64, pn * 128 + q0, (bf16_t*)(ws + OFF_WGU + ls * SZ_WGU), 1024, r0, lds);
        } else if (u < U_GU + U_D) {
            const int v = u - U_GU; const int ls = v / (16 * 44), rem = v % (16 * 44), rg = rem / 44, kb = rem % 44;
            transpose_unit<true>(p.in[11] + (size_t)ls * DFF * 1024, 1024, kb * 64, rg * 64, (bf16_t*)(ws + OFF_WD + ls * SZ_WD), DFF, rg * 64, lds);
        } else if (u < U_GU + U_D + U_OUT) {
            const int v = u - U_GU - U_D; const int l = v / 256, rem = v % 256, rg = rem / 16, kb = rem % 16;
            transpose_unit<true>(p.in[13] + (size_t)l * 1024 * 1024, 1024, kb * 64, rg * 64, (bf16_t*)(ws + OFF_WOUT + l * SZ_WOUT), 1024, rg * 64, lds);
        } else {
            const int v = u - U_GU - U_D - U_OUT; const int l = v / (24 * 16), rem = v % (24 * 16), rg = rem / 16, kb = rem % 16;
            transpose_unit<false>(p.in[12] + (size_t)l * 1024 * INW, INW, kb * 64, 256 + rg * 64, (bf16_t*)(ws + OFF_WIN + l * SZ_WIN), 1024, 512 + rg * 64, lds);
        }
    }
    {
        float* tab = lds;
        if (tid < 64) { float sv, cv; sincosf(PI2 * (float)tid / 64.f, &sv, &cv); tab[tid] = cv; tab[64 + tid] = sv; }
        __syncthreads();
        const int lane = tid & 63, wv = tid >> 6;
        for (int u = bid * 8 + wv; u < 8192; u += nb * 8) {
            const int l = u >> 12, k = (u >> 2) & 1023, g = u & 3;
            const float* wrow = p.in[12] + ((size_t)l * 1024 + k) * INW + g * 64;
            const float wv_ = wrow[lane];
            float ac = 0.f, as = 0.f;
#pragma unroll 16
            for (int c = 0; c < 64; ++c) { const float w = __shfl(wv_, c); const int idx = (c * lane) & 63; ac += w * tab[idx]; as += w * tab[64 + idx]; }
            bf16_t* bt = (bf16_t*)(ws + OFF_WIN + l * SZ_WIN);
            bt[(size_t)(g * 64 + lane) * 1024 + k] = f2bf(ac);
            bt[(size_t)(256 + g * 64 + lane) * 1024 + k] = f2bf(as);
        }
        __syncthreads();
    }
    {
        float* sc = lds;
        float* part = lds + 9 * 1024;
        for (int i = tid; i < 9 * 1024; i += NTHREADS) { const int bc = i >> 10, k = i & 1023; const float cv = bc == 0 ? p.in[5][k] : p.in[4][(bc - 1) * 1024 + k]; sc[i] = cv / (1.0f + expf(-cv)); }
        __syncthreads();
        for (int cb = bid; cb < 256; cb += nb) {
            const int gc0 = cb * 72, l = gc0 / 9216, j0 = gc0 % 9216;
            const int col = tid % 72, kg = tid / 72;
            if (kg < 7) {
                float a[9];
#pragma unroll
                for (int i = 0; i < 9; ++i) a[i] = 0.f;
                const float* wp = p.in[6] + (size_t)l * 1024 * 9216 + j0 + col;
#pragma unroll 4
                for (int k = kg; k < 1024; k += 7) { const float w = wp[(size_t)k * 9216];
#pragma unroll
                    for (int i = 0; i < 9; ++i) a[i] += sc[i * 1024 + k] * w; }
#pragma unroll
                for (int i = 0; i < 9; ++i) part[(kg * 72 + col) * 9 + i] = a[i];
            }
            __syncthreads();
            for (int i = tid; i < 72 * 9; i += NTHREADS) { const int c2 = i / 9, bc = i % 9; float s = 0.f;
#pragma unroll
                for (int g = 0; g < 7; ++g) s += part[(g * 72 + c2) * 9 + bc];
                ((float*)(ws + OFF_MOD))[((size_t)l * 9 + bc) * 9216 + j0 + c2] = s + p.in[7][l * 9216 + j0 + c2]; }
            __syncthreads();
        }
    }
    {
        const int lane = tid & 63, wv = tid >> 6;
        for (int u = bid * 8 + wv; u < 2 * 320; u += nb * 8) {
            const int l = u / 320, gq = u % 320; const int pass = gq >= 64; const int n = pass ? 1024 : 256; const int d0 = (pass ? gq - 64 : gq) * 4;
            const float* w1 = p.in[15] + l * 33 * 64; const float* b1 = p.in[16] + l * 64; const float* w2 = p.in[17] + l * 64 * 64; const float* b2 = p.in[18] + l * 64;
            const float* w3 = p.in[19] + (size_t)l * 64 * 1024; const float fr = p.in[20][l * 64 + lane];
            float h2[4];
#pragma unroll
            for (int q = 0; q < 4; ++q) {
                const int d = d0 + q; const float tt = (float)d / (float)(n - 1);
                float feat = 0.f;
                if (lane == 0) feat = tt;
                else if (lane < 33) { const int j = (lane - 1) & 15; const float fj = 1e-4f + (float)j * ((15.0f - 1e-4f) / 15.0f); const float ang = (PI2 / (float)n) * (float)d * fj;
                    feat = lane < 17 ? cosf(ang) : -sinf(ang); }
                float a1 = b1[lane];
                for (int i = 0; i < 33; ++i) a1 += __shfl(feat, i) * w1[i * 64 + lane];
                const float h1 = sinf(fr * a1);
                float a2 = b2[lane];
                for (int i = 0; i < 64; ++i) a2 += __shfl(h1, i) * w2[i * 64 + lane];
                h2[q] = sinf(fr * a2);
            }
            float* fbase = (float*)(ws + OFF_FILT) + (size_t)l * FILT_L + (pass ? FILT_CTX : 0);
            for (int oc = 0; oc < 16; ++oc) {
                const int o = oc * 64 + lane;
                float a[4] = {0.f, 0.f, 0.f, 0.f};
                for (int i = 0; i < 64; ++i) { const float w = w3[i * 1024 + o];
#pragma unroll
                    for (int q = 0; q < 4; ++q) a[q] += __shfl(h2[q], i) * w; }
                const int ord = (o >> 8) & 1, c = o & 255;
                const float dec = fabsf(p.in[21][(l * 2 + ord) * 256 + c]);
#pragma unroll
                for (int q = 0; q < 4; ++q) { const int d = d0 + q; const float tt = (float)d / (float)(n - 1);
                    fbase[(size_t)o * n + d] = a[q] * expf(-tt * dec); }
            }
        }
    }
    {
        bf16_t* FC = (bf16_t*)(ws + OFF_FC); bf16_t* FL = (bf16_t*)(ws + OFF_FL);
        const int gt = bid * NTHREADS + tid, gn = nb * NTHREADS;
        for (int i = gt; i < 256 * 512 + 1024 * 2048; i += gn) {
            int n, k, col; bf16_t* dst;
            if (i < 256 * 512) { n = 256; k = i >> 9; col = i & 511; dst = FC + i; } else { const int j = i - 256 * 512; n = 1024; k = j >> 11; col = j & 2047; dst = FL + j; }
            const int s = col >= n, t = col - s * n; const int ph = (k * t) & (n - 1);
            float sv, cv; sincosf(PI2 * (float)ph / (float)n, &sv, &cv);
            const float sc = rsqrtf(64.0f * (float)n);
            *dst = f2bf((s ? -sv : cv) * sc);
        }
        { bf16_t* CK = (bf16_t*)(ws + OFF_CKB); bf16_t* CV = (bf16_t*)(ws + OFF_CVT);
            for (int i = gt; i < 2 * 8 * 256 * 128; i += gn) {
                { const int c = i & 127, key = (i >> 7) & 255, b = (i >> 15) & 7, l = i >> 18;
                    CK[i] = f2bf(p.in[2][(((size_t)b * 2 + l) * 256 + key) * 128 + c]); }
                { const int key = i & 255, c = (i >> 8) & 127, b = (i >> 15) & 7, l = i >> 18;
                    CV[i] = f2bf(p.in[3][(((size_t)b * 2 + l) * 256 + key) * 128 + c]); }
            } }
        if (bid == 0) for (int i = tid; i < 64 * 16; i += NTHREADS) { const int pos = i >> 4, j = i & 15; const float inv = powf(10000.0f, -(float)(2 * j) / 32.0f);
            float sv, cv; sincosf((float)pos * inv, &sv, &cv); float* rp = (float*)(ws + OFF_ROPE); rp[2 * i] = cv; rp[2 * i + 1] = sv; }
    }
}

template <int MODE>
__device__ void phase_row(const Params& p, int lpost, int spost, int lpre, int spre) {
    const int tid_ = opaque_tid(); const int lane = tid_ & 63, wv = tid_ >> 6;
    const float* mod = (const float*)(p.ws + OFF_MOD);
    const bf16_t* Y = (const bf16_t*)(p.ws + OFF_Y); const float* ssq = (const float*)(p.ws + OFF_SSQ);
    bf16_t* H = (bf16_t*)(p.ws + OFF_H);
    const float factor = (spost == 1) ? 1.0f : 0.5f;
    for (int row = blockIdx.x * 8 + wv; row < NTOK; row += gridDim.x * 8) {
        const int bc = row < NCTX ? 0 : 1 + ((row - NCTX) >> 10);
        float* xr = p.out + (size_t)row * D;
        f32x4 x[4];
        if (MODE == 0) { const float* src = row < NCTX ? p.in[0] + (size_t)row * D : p.in[1] + (size_t)(row - NCTX) * D;
#pragma unroll
            for (int j = 0; j < 4; ++j) x[j] = *(const f32x4*)(src + j * 256 + lane * 4); }
        else {
#pragma unroll
            for (int j = 0; j < 4; ++j) x[j] = *(const f32x4*)(xr + j * 256 + lane * 4);
            const f32x4* sp = (const f32x4*)(ssq + (size_t)row * 16);
            const f32x4 s0 = sp[0], s1 = sp[1], s2 = sp[2], s3 = sp[3];
            const float tot = (s0[0] + s0[1] + s0[2] + s0[3]) + (s1[0] + s1[1] + s1[2] + s1[3]) + (s2[0] + s2[1] + s2[2] + s2[3]) + (s3[0] + s3[1] + s3[2] + s3[3]);
            const float rstd = rsqrtf(tot * (1.0f / 1024.0f) + EPS) * factor;
            const float* gate = mod + ((size_t)lpost * 9 + bc) * 9216 + spost * 3072 + 2048;
            const float* gp = p.in[8] + (lpost * 6 + 2 * spost + 1) * 1024;
#pragma unroll
            for (int j = 0; j < 4; ++j) { const int c = j * 256 + lane * 4;
                const u32x2 yv = *(const u32x2*)(Y + (size_t)row * D + c);
                const f32x4 gt = *(const f32x4*)(gate + c), gg = *(const f32x4*)(gp + c);
                x[j][0] += gt[0] * gg[0] * rstd * __uint_as_float(yv.x << 16);
                x[j][1] += gt[1] * gg[1] * rstd * __uint_as_float(yv.x & 0xFFFF0000u);
                x[j][2] += gt[2] * gg[2] * rstd * __uint_as_float(yv.y << 16);
                x[j][3] += gt[3] * gg[3] * rstd * __uint_as_float(yv.y & 0xFFFF0000u); }
        }
#pragma unroll
        for (int j = 0; j < 4; ++j) *(f32x4*)(xr + j * 256 + lane * 4) = x[j];
        if (MODE != 2) {
            float s = 0.f;
#pragma unroll
            for (int j = 0; j < 4; ++j) s += x[j][0] * x[j][0] + x[j][1] * x[j][1] + x[j][2] * x[j][2] + x[j][3] * x[j][3];
#pragma unroll
            for (int o = 32; o >= 1; o >>= 1) s += __shfl_xor(s, o);
            const float rs = rsqrtf(s * (1.0f / 1024.0f) + EPS);
            const float* mb = mod + ((size_t)lpre * 9 + bc) * 9216 + spre * 3072;
            const float* gp = p.in[8] + (lpre * 6 + 2 * spre) * 1024;
#pragma unroll
            for (int j = 0; j < 4; ++j) { const int c = j * 256 + lane * 4;
                const f32x4 sh = *(const f32x4*)(mb + c), scl = *(const f32x4*)(mb + 1024 + c), gg = *(const f32x4*)(gp + c);
                f32x4 h;
#pragma unroll
                for (int e = 0; e < 4; ++e) h[e] = x[j][e] * rs * gg[e] * (1.0f + scl[e]) + sh[e];
                u32x2 w; w.x = cvt_pk_bf16(h[0], h[1]); w.y = cvt_pk_bf16(h[2], h[3]);
                *(u32x2*)(H + (size_t)row * D + c) = w; }
        }
    }
}

__device__ void hyena_naive(const Params& p, int l, float* lds) {
    const int tid = opaque_tid();
    const bf16_t* HT = (const bf16_t*)(p.ws + OFF_HT);
    bf16_t* YC = (bf16_t*)(p.ws + OFF_YCAT);
    const float* cw = p.in[14] + l * 3 * 768;
    for (int u = blockIdx.x; u < 2048 + 8192; u += gridDim.x) {
        const int pass = u < 2048; const int v = pass ? u : u - 2048; const int b = v >> 8, c = v & 255; const int n = pass ? 1024 : 256;
        const bf16_t* hb = HT + (pass ? HT_LAT + (size_t)b * 768 * 1024 : (size_t)b * 768 * 256);
        const int rowbase = pass ? NCTX + b * 1024 : b * 256;
        const float* fb = (const float*)(p.ws + OFF_FILT) + (size_t)l * FILT_L + (pass ? FILT_CTX : 0);
        float* sv = lds; float* sg1 = lds + n; float* sg2 = lds + 2 * n; float* sz = lds + 3 * n; float* k0 = lds + 4 * n; float* k1 = lds + 6 * n;
        for (int t = tid; t < n; t += NTHREADS) {
#pragma unroll
            for (int w = 0; w < 3; ++w) { const int ch = w * 256 + c; const bf16_t* r = hb + (size_t)ch * n;
                const float a = t > 0 ? bf2f(r[t - 1]) : 0.f, bb = bf2f(r[t]), cc = t < n - 1 ? bf2f(r[t + 1]) : 0.f;
                const float z = a * cw[ch] + bb * cw[768 + ch] + cc * cw[1536 + ch];
                (w == 0 ? sv : (w == 1 ? sg1 : sg2))[t] = z; }
            k0[n + t] = fb[((size_t)(0 * 2 + 0) * 256 + c) * n + t]; k1[n + t] = fb[((size_t)(0 * 2 + 1) * 256 + c) * n + t];
            if (t > 0) { k0[n - t] = fb[((size_t)(1 * 2 + 0) * 256 + c) * n + t]; k1[n - t] = fb[((size_t)(1 * 2 + 1) * 256 + c) * n + t]; }
            else { k0[0] = 0.f; k1[0] = 0.f; }
        }
        __syncthreads();
        const float inv2n = 1.0f / (float)(2 * n);
        const float bias0 = p.in[22][(l * 2 + 0) * 256 + c], bias1 = p.in[22][(l * 2 + 1) * 256 + c];
        for (int t = tid; t < n; t += NTHREADS) { float a = 0.f; const float* kp = k0 + n + t;
#pragma unroll 8
            for (int s = 0; s < n; ++s) a += sv[s] * kp[-s];
            const float y1 = a * inv2n + sv[t] * bias0; sz[t] = sg1[t] * y1; }
        __syncthreads();
        for (int t = tid; t < n; t += NTHREADS) { float a = 0.f; const float* kp = k1 + n + t;
#pragma unroll 8
            for (int s = 0; s < n; ++s) a += sz[s] * kp[-s];
            const float y2 = a * inv2n + sz[t] * bias1;
            YC[(size_t)(rowbase + t) * 1024 + 256 + c] = f2bf(sg2[t] * y2); }
        __syncthreads();
    }
}

__device__ void attn_naive(const Params& p, int l, float* lds) {
    const int tid = opaque_tid();
    const bf16_t* QB = (const bf16_t*)(p.ws + OFF_QB); const bf16_t* KB = (const bf16_t*)(p.ws + OFF_KB); const bf16_t* VB = (const bf16_t*)(p.ws + OFF_VB);
    bf16_t* YC = (bf16_t*)(p.ws + OFF_YCAT);
    float* Ks = lds; float* Vs = lds + 64 * 64;
    for (int u = blockIdx.x; u < 256; u += gridDim.x) {
        const int pass = u < 128; const int v = u & 127;
        int b, kvh, qb, n, rowbase;
        if (!pass) { b = v >> 2; kvh = (v >> 1) & 1; qb = v & 1; n = 256; rowbase = b * 256; }
        else { b = v >> 4; kvh = (v >> 3) & 1; qb = v & 7; n = 1024; rowbase = NCTX + b * 1024; }
        const int qi = tid & 127, g = tid >> 7, head = kvh * 4 + g, qpos = qb * 128 + qi, row = rowbase + qpos;
        float q[64], o[64];
        { const u32x4* qp = (const u32x4*)(QB + (size_t)row * 512 + head * 64);
#pragma unroll
            for (int i = 0; i < 8; ++i) { const u32x4 w = qp[i];
                q[8 * i + 0] = __uint_as_float(w.x << 16); q[8 * i + 1] = __uint_as_float(w.x & 0xFFFF0000u); q[8 * i + 2] = __uint_as_float(w.y << 16); q[8 * i + 3] = __uint_as_float(w.y & 0xFFFF0000u);
                q[8 * i + 4] = __uint_as_float(w.z << 16); q[8 * i + 5] = __uint_as_float(w.z & 0xFFFF0000u); q[8 * i + 6] = __uint_as_float(w.w << 16); q[8 * i + 7] = __uint_as_float(w.w & 0xFFFF0000u); } }
#pragma unroll
        for (int i = 0; i < 64; ++i) o[i] = 0.f;
        float m = p.in[23][l * 8 + head], lsum = 1.0f;
        int klo, khi;
        if (!pass) { klo = 0; khi = 256; } else { klo = qb * 128 - 128; if (klo < 0) klo = 0; khi = qb * 128 + 256; if (khi > n) khi = n; }
        const int nloc = (khi - klo) / 64, nchunks = nloc + (pass ? 4 : 0);
        for (int ch = 0; ch < nchunks; ++ch) {
            __syncthreads();
            { const int key = tid >> 3, d0 = (tid & 7) * 8;
                if (ch < nloc) {
                    const int krow = rowbase + klo + ch * 64 + key;
                    const u32x4 kw = *(const u32x4*)(KB + (size_t)krow * 128 + kvh * 64 + d0), vw = *(const u32x4*)(VB + (size_t)krow * 128 + kvh * 64 + d0);
                    float* kd = Ks + key * 64 + d0; float* vd = Vs + key * 64 + d0;
                    kd[0] = __uint_as_float(kw.x << 16); kd[1] = __uint_as_float(kw.x & 0xFFFF0000u); kd[2] = __uint_as_float(kw.y << 16); kd[3] = __uint_as_float(kw.y & 0xFFFF0000u);
                    kd[4] = __uint_as_float(kw.z << 16); kd[5] = __uint_as_float(kw.z & 0xFFFF0000u); kd[6] = __uint_as_float(kw.w << 16); kd[7] = __uint_as_float(kw.w & 0xFFFF0000u);
                    vd[0] = __uint_as_float(vw.x << 16); vd[1] = __uint_as_float(vw.x & 0xFFFF0000u); vd[2] = __uint_as_float(vw.y << 16); vd[3] = __uint_as_float(vw.y & 0xFFFF0000u);
                    vd[4] = __uint_as_float(vw.z << 16); vd[5] = __uint_as_float(vw.z & 0xFFFF0000u); vd[6] = __uint_as_float(vw.w << 16); vd[7] = __uint_as_float(vw.w & 0xFFFF0000u);
                } else {
                    const int ck = (ch - nloc) * 64 + key;
                    const size_t off = (((size_t)b * 2 + l) * 256 + ck) * 128 + kvh * 64 + d0;
                    const f32x4 k0 = *(const f32x4*)(p.in[2] + off), k1 = *(const f32x4*)(p.in[2] + off + 4), v0 = *(const f32x4*)(p.in[3] + off), v1 = *(const f32x4*)(p.in[3] + off + 4);
                    *(f32x4*)(Ks + key * 64 + d0) = k0; *(f32x4*)(Ks + key * 64 + d0 + 4) = k1; *(f32x4*)(Vs + key * 64 + d0) = v0; *(f32x4*)(Vs + key * 64 + d0 + 4) = v1;
                } }
            __syncthreads();
            for (int key = 0; key < 64; ++key) {
                const f32x4* kr = (const f32x4*)(Ks + key * 64);
                float s = 0.f;
#pragma unroll
                for (int i = 0; i < 16; ++i) { const f32x4 kv = kr[i]; s += q[4 * i] * kv[0] + q[4 * i + 1] * kv[1] + q[4 * i + 2] * kv[2] + q[4 * i + 3] * kv[3]; }
                bool valid = true;
                if (pass && ch < nloc) { const int kpos = klo + ch * 64 + key; int dd = kpos - qpos; if (dd < 0) dd = -dd; valid = dd <= 128; }
                if (valid) {
                    if (s > m) { const float corr = __expf(m - s); lsum *= corr;
#pragma unroll
                        for (int i = 0; i < 64; ++i) o[i] *= corr;
                        m = s; }
                    const float pe = __expf(s - m); lsum += pe;
                    const f32x4* vr = (const f32x4*)(Vs + key * 64);
#pragma unroll
                    for (int i = 0; i < 16; ++i) { const f32x4 vv = vr[i]; o[4 * i] += pe * vv[0]; o[4 * i + 1] += pe * vv[1]; o[4 * i + 2] += pe * vv[2]; o[4 * i + 3] += pe * vv[3]; }
                }
            }
        }
        const float inv = 1.0f / lsum;
        u32x4* op = (u32x4*)(YC + (size_t)row * 1024 + 512 + head * 64);
#pragma unroll
        for (int i = 0; i < 8; ++i) { u32x4 w; w.x = cvt_pk_bf16(o[8 * i] * inv, o[8 * i + 1] * inv); w.y = cvt_pk_bf16(o[8 * i + 2] * inv, o[8 * i + 3] * inv);
            w.z = cvt_pk_bf16(o[8 * i + 4] * inv, o[8 * i + 5] * inv); w.w = cvt_pk_bf16(o[8 * i + 6] * inv, o[8 * i + 7] * inv); op[i] = w; }
        __syncthreads();
    }
}


__device__ void attn_mfma(const Params& p, int l) {
    const int tid = opaque_tid(); const int lane = tid & 63, wv = tid >> 6, r = lane & 31, h = lane >> 5;
    const bf16_t* QB = (const bf16_t*)(p.ws + OFF_QB); const bf16_t* KB = (const bf16_t*)(p.ws + OFF_KB); const bf16_t* VT = (const bf16_t*)(p.ws + OFF_VB);
    const bf16_t* CK = (const bf16_t*)(p.ws + OFF_CKB); const bf16_t* CV = (const bf16_t*)(p.ws + OFF_CVT);
    bf16_t* YC = (bf16_t*)(p.ws + OFF_YCAT);
    const int g = wv & 3, qh = wv >> 2;
    for (int u = blockIdx.x; u < 512; u += gridDim.x) {
        const int pass = u < 256; const int v = u & 255;
        int b, kvh, qb, n, rowbase;
        if (!pass) { b = v >> 3; kvh = (v >> 2) & 1; qb = v & 3; n = 256; rowbase = b * 256; }
        else { b = v >> 5; kvh = (v >> 4) & 1; qb = v & 15; n = 1024; rowbase = NCTX + b * 1024; }
        const int head = kvh * 4 + g, q0w = qb * 64 + qh * 32;
        int klo = 0, khi = 256;
        if (pass) { klo = q0w - 128; if (klo < 0) klo = 0; khi = q0w + 160; if (khi > n) khi = n; }
        const int nA = (khi - klo) >> 5, nT = nA + (pass ? 8 : 0);
        const bf16_t* kA = KB + (size_t)(rowbase + klo) * 128 + kvh * 64;
        const bf16_t* vA = VT + (pass ? VT_LAT + (size_t)b * 128 * 1024 : (size_t)b * 128 * 256) + (size_t)kvh * 64 * n + klo;
        const bf16_t* kB = CK + ((size_t)(l * 8 + b) * 256) * 128 + kvh * 64;
        const bf16_t* vB = CV + ((size_t)(l * 8 + b) * 128 + kvh * 64) * 256;
        bf16x8 qf[4];
        { const bf16_t* qp = QB + (size_t)(rowbase + q0w + r) * 512 + head * 64 + 8 * h;
#pragma unroll
            for (int kk = 0; kk < 4; ++kk) qf[kk] = *(const bf16x8*)(qp + 16 * kk); }
        float m = p.in[23][l * 8 + head], lsum = 1.0f;
        f32x16 O0, O1;
#pragma unroll
        for (int i = 0; i < 16; ++i) { O0[i] = 0.f; O1[i] = 0.f; }
        bf16x8 kf[4];
        {
            const bf16_t* kp = (nA > 0 ? kA : kB) + (size_t)r * 128 + 8 * h;
#pragma unroll
            for (int kk = 0; kk < 4; ++kk) kf[kk] = *(const bf16x8*)(kp + 16 * kk);
        }
        for (int t = 0; t < nT; ++t) {
            const bool inA = t < nA;
            const bf16_t* vp = inA ? vA + (size_t)r * n + t * 32 + 4 * h : vB + (size_t)r * 256 + (t - nA) * 32 + 4 * h;
            const size_t vld = inA ? (size_t)n : (size_t)256;
            u32x2 vraw[2][2][2];
#pragma unroll
            for (int dt = 0; dt < 2; ++dt)
#pragma unroll
                for (int s = 0; s < 2; ++s)
#pragma unroll
                    for (int q = 0; q < 2; ++q) vraw[dt][s][q] = *(const u32x2*)(vp + (size_t)dt * 32 * vld + 16 * s + 8 * q);
            bf16x8 kn[4];
            { const int tn = (t + 1 < nT) ? t + 1 : t; const bool nInA = tn < nA;
                const bf16_t* kp = (nInA ? kA + (size_t)tn * 32 * 128 : kB + (size_t)(tn - nA) * 32 * 128) + (size_t)r * 128 + 8 * h;
#pragma unroll
                for (int kk = 0; kk < 4; ++kk) kn[kk] = *(const bf16x8*)(kp + 16 * kk); }
            f32x16 S;
#pragma unroll
            for (int i = 0; i < 16; ++i) S[i] = 0.f;
#pragma unroll
            for (int kk = 0; kk < 4; ++kk) S = __builtin_amdgcn_mfma_f32_32x32x16_bf16(kf[kk], qf[kk], S, 0, 0, 0);
            if (pass && inA) {
                const int dk = klo + t * 32 - q0w;
                if (dk <= -128 || dk >= 128) {
#pragma unroll
                    for (int i = 0; i < 16; ++i) { const int j = (i & 3) + 8 * (i >> 2) + 4 * h; int dd = dk + j - r; if (dd < 0) dd = -dd; if (dd > 128) S[i] = -1e30f; }
                }
            }
            float mx = S[0];
#pragma unroll
            for (int i = 1; i < 16; ++i) mx = fmaxf(mx, S[i]);
            mx = fmaxf(mx, __shfl_xor(mx, 32));
            const float mn = fmaxf(m, mx), corr = __expf(m - mn);
            m = mn;
            float rs = 0.f;
#pragma unroll
            for (int i = 0; i < 16; ++i) { S[i] = __expf(S[i] - mn); rs += S[i]; }
            rs += __shfl_xor(rs, 32);
            lsum = lsum * corr + rs;
#pragma unroll
            for (int i = 0; i < 16; ++i) { O0[i] *= corr; O1[i] *= corr; }
            bf16x8 pf[2];
#pragma unroll
            for (int s = 0; s < 2; ++s) { u32x4 w; w.x = pk_bf16(S[8 * s], S[8 * s + 1]); w.y = pk_bf16(S[8 * s + 2], S[8 * s + 3]); w.z = pk_bf16(S[8 * s + 4], S[8 * s + 5]); w.w = pk_bf16(S[8 * s + 6], S[8 * s + 7]);
                pf[s] = __builtin_bit_cast(bf16x8, w); }
#pragma unroll
            for (int s = 0; s < 2; ++s) {
                u32x4 a0; a0.x = vraw[0][s][0].x; a0.y = vraw[0][s][0].y; a0.z = vraw[0][s][1].x; a0.w = vraw[0][s][1].y;
                u32x4 a1; a1.x = vraw[1][s][0].x; a1.y = vraw[1][s][0].y; a1.z = vraw[1][s][1].x; a1.w = vraw[1][s][1].y;
                O0 = __builtin_amdgcn_mfma_f32_32x32x16_bf16(__builtin_bit_cast(bf16x8, a0), pf[s], O0, 0, 0, 0);
                O1 = __builtin_amdgcn_mfma_f32_32x32x16_bf16(__builtin_bit_cast(bf16x8, a1), pf[s], O1, 0, 0, 0);
            }
#pragma unroll
            for (int kk = 0; kk < 4; ++kk) kf[kk] = kn[kk];
        }
        const float inv = 1.0f / lsum;
        bf16_t* op = YC + (size_t)(rowbase + q0w + r) * 1024 + 512 + head * 64 + 4 * h;
#pragma unroll
        for (int gq = 0; gq < 4; ++gq) {
            u32x2 w0; w0.x = pk_bf16(O0[4 * gq] * inv, O0[4 * gq + 1] * inv); w0.y = pk_bf16(O0[4 * gq + 2] * inv, O0[4 * gq + 3] * inv);
            u32x2 w1; w1.x = pk_bf16(O1[4 * gq] * inv, O1[4 * gq + 1] * inv); w1.y = pk_bf16(O1[4 * gq + 2] * inv, O1[4 * gq + 3] * inv);
            *(u32x2*)(op + 8 * gq) = w0; *(u32x2*)(op + 32 + 8 * gq) = w1;
        }
    }
}

__global__ void __launch_bounds__(NTHREADS, 2) fwd_megakernel(Params p) {
    extern __shared__ __attribute__((aligned(16))) unsigned char shm[];
    cg::grid_group grid = cg::this_grid();
    LAS unsigned char* lds = (LAS unsigned char*)shm;
    float* ldsf = (float*)shm;
    unsigned char* ws = p.ws;
    const int G = gridDim.x, c = blockIdx.x;

    phase_prep(p, ldsf);
    grid.sync();
    phase_row<0>(p, 0, 0, 0, 0);
    grid.sync();
    for (int l = 0; l < 2; ++l) {
        for (int s = 0; s < 3; ++s) {
            if (s != 1) {
                const int fs = s >> 1;
                { pg8::Gemm g{(const bf16_t*)(ws + OFF_H), (const bf16_t*)(ws + OFF_WGU + (l * 2 + fs) * SZ_WGU), NTOK, 5632, 1024, 1024, 1024};
                    pg8::StaticOrder S; S.init(g.M, g.N, G, c); EpiSwiglu E{(bf16_t*)(ws + OFF_ACT)};
                    pg8::gemm_phase(lds, g, S, E); }
                grid.sync();
                { pg8::Gemm g{(const bf16_t*)(ws + OFF_ACT), (const bf16_t*)(ws + OFF_WD + (l * 2 + fs) * SZ_WD), NTOK, 1024, DFF, DFF, DFF};
                    pg8::StaticOrder S; S.init(g.M, g.N, G, c); EpiYssq E{(bf16_t*)(ws + OFF_Y), (float*)(ws + OFF_SSQ)};
                    pg8::gemm_phase(lds, g, S, E); }
                grid.sync();
            } else {
                { pg8::Gemm g{(const bf16_t*)(ws + OFF_H), (const bf16_t*)(ws + OFF_WIN + l * SZ_WIN), NTOK, 2048, 1024, 1024, 1024};
                    pg8::StaticOrder S; S.init(g.M, g.N, G, c);
                    EpiWin E{(bf16_t*)(ws + OFF_ZT), (bf16_t*)(ws + OFF_HT), (bf16_t*)(ws + OFF_QB), (bf16_t*)(ws + OFF_KB), (bf16_t*)(ws + OFF_VB), (const float*)(ws + OFF_ROPE),
                             p.out + (size_t)NTOK * D, p.out + (size_t)NTOK * D + (size_t)32 * 2 * 256 * 128, l};
                    pg8::gemm_phase(lds, g, S, E); }
                grid.sync();
                { pg8::Gemm g{(const bf16_t*)(ws + OFF_FL), (const bf16_t*)(ws + OFF_ZT) + ZT_LAT, 1024, 2048, 2048, 2048, 2048};
                    pg8::StaticOrder S; S.init(g.M, g.N, G, c); EpiFourier E{(bf16_t*)(ws + OFF_YCAT), NCTX, 1024};
                    pg8::gemm_phase(lds, g, S, E); }
                { pg8::Gemm g{(const bf16_t*)(ws + OFF_FC), (const bf16_t*)(ws + OFF_ZT), 256, 8192, 512, 512, 512};
                    pg8::StaticOrder S; S.init(g.M, g.N, G, c - 32); EpiFourier E{(bf16_t*)(ws + OFF_YCAT), 0, 256};
                    pg8::gemm_phase(lds, g, S, E); }
                __syncthreads();
                hyena_naive(p, l, ldsf);
                attn_mfma(p, l);
                grid.sync();
                { pg8::Gemm g{(const bf16_t*)(ws + OFF_YCAT), (const bf16_t*)(ws + OFF_WOUT + l * SZ_WOUT), NTOK, 1024, 1024, 1024, 1024};
                    pg8::StaticOrder S; S.init(g.M, g.N, G, c); EpiYssq E{(bf16_t*)(ws + OFF_Y), (float*)(ws + OFF_SSQ)};
                    pg8::gemm_phase(lds, g, S, E); }
                grid.sync();
            }
            if (l == 1 && s == 2) phase_row<2>(p, l, s, 0, 0);
            else { const int ln = s == 2 ? l + 1 : l, sn = s == 2 ? 0 : s + 1; phase_row<1>(p, l, s, ln, sn); }
            if (!(l == 1 && s == 2)) grid.sync();
        }
    }
}

extern "C" void kernel_launch(void* const* d_in, const int* in_sizes, int n_in, void* d_out, int out_size, void* d_ws, size_t ws_size, hipStream_t stream) {
    constexpr int LDS_BYTES = pg8::STAGE_BYTES;
    static int grid_blocks = 0;
    if (!grid_blocks) {
        if (n_in != 24 || ws_size < WS_END) { fprintf(stderr, "kernel_launch: bad inputs (n_in %d) or workspace too small (%zu < %zu)\n", n_in, ws_size, (size_t)WS_END); grid_blocks = -1; return; }
        int dev = 0, cus = 0, per_cu = 0;
        hipGetDevice(&dev);
        hipDeviceGetAttribute(&cus, hipDeviceAttributeMultiprocessorCount, dev);
        if (hipFuncSetAttribute((const void*)fwd_megakernel, hipFuncAttributeMaxDynamicSharedMemorySize, LDS_BYTES) != hipSuccess) fprintf(stderr, "kernel_launch: hipFuncSetAttribute failed\n");
        hipOccupancyMaxActiveBlocksPerMultiprocessor(&per_cu, (const void*)fwd_megakernel, NTHREADS, LDS_BYTES);
        if (per_cu < 1) { fprintf(stderr, "kernel_launch: occupancy query says %d blocks per CU\n", per_cu); per_cu = 1; }
        (void)hipGetLastError();
        grid_blocks = cus * per_cu;
        if (grid_blocks > 256) grid_blocks = 256;
    }
    if (grid_blocks < 0) return;
    Params p{};
    for (int i = 0; i < 24; ++i) p.in[i] = (const float*)d_in[i];
    p.out = (float*)d_out; p.ws = (unsigned char*)d_ws;
    void* args[] = {&p};
    hipError_t e = hipLaunchCooperativeKernel((const void*)fwd_megakernel, dim3(grid_blocks), dim3(NTHREADS), args, LDS_BYTES, stream);
    if (e != hipSuccess) fprintf(stderr, "cooperative launch failed: %s (grid %d)\n", hipGetErrorString(e), grid_blocks);
}
```

```cpp
#include <hip/hip_runtime.h>
#include <hip/hip_cooperative_groups.h>
#include <cstdio>
namespace cg = cooperative_groups;

#define LAS __attribute__((address_space(3)))
typedef unsigned short bf16_t;
typedef short bf16x8 __attribute__((ext_vector_type(8)));
typedef float f32x4 __attribute__((ext_vector_type(4)));
typedef unsigned u32x4 __attribute__((ext_vector_type(4)));
typedef unsigned u32x2 __attribute__((ext_vector_type(2)));

constexpr int D = 1024, NTOK = 16384, NCTX = 8192, DFF = 2816, INW = 1792;
constexpr int NTHREADS = 512;
constexpr float EPS = 1e-6f;
constexpr float PI2 = 6.283185307179586f;

constexpr size_t AL(size_t x) { return (x + 255) & ~(size_t)255; }
constexpr size_t SZ_WGU = (size_t)5632 * 1024 * 2, SZ_WD = (size_t)1024 * 2816 * 2, SZ_WIN = (size_t)2048 * 1024 * 2, SZ_WOUT = (size_t)1024 * 1024 * 2;
constexpr size_t OFF_WGU = 0;
constexpr size_t OFF_WD = OFF_WGU + 4 * SZ_WGU;
constexpr size_t OFF_WIN = OFF_WD + 4 * SZ_WD;
constexpr size_t OFF_WOUT = OFF_WIN + 2 * SZ_WIN;
constexpr size_t OFF_H = OFF_WOUT + 2 * SZ_WOUT;
constexpr size_t OFF_Y = OFF_H + (size_t)NTOK * D * 2;
constexpr size_t OFF_SSQ = OFF_Y + (size_t)NTOK * D * 2;
constexpr size_t OFF_MOD = OFF_SSQ + (size_t)NTOK * 16 * 4;
constexpr size_t OFF_FILT = AL(OFF_MOD + (size_t)2 * 9 * 9216 * 4);
constexpr size_t FILT_CTX = (size_t)4 * 256 * 256, FILT_LAT = (size_t)4 * 256 * 1024, FILT_L = FILT_CTX + FILT_LAT;
constexpr size_t OFF_FC = AL(OFF_FILT + 2 * FILT_L * 4);
constexpr size_t OFF_FL = OFF_FC + (size_t)256 * 512 * 2;
constexpr size_t OFF_ROPE = OFF_FL + (size_t)1024 * 2048 * 2;
constexpr size_t OFF_CKB = AL(OFF_ROPE + 64 * 16 * 8);
constexpr size_t OFF_CVT = OFF_CKB + (size_t)2 * 8 * 256 * 128 * 2;
constexpr size_t OFF_UNION = AL(OFF_CVT + (size_t)2 * 8 * 256 * 128 * 2);
constexpr size_t OFF_ACT = OFF_UNION;
constexpr size_t OFF_ZT = OFF_UNION;
constexpr size_t ZT_LAT = (size_t)NCTX * 512;
constexpr size_t OFF_HT = OFF_ZT + (size_t)NTOK * 512 * 2;
constexpr size_t HT_LAT = (size_t)NCTX * 768;
constexpr size_t OFF_QB = OFF_HT + (size_t)NTOK * 768 * 2;
constexpr size_t OFF_KB = OFF_QB + (size_t)NTOK * 512 * 2;
constexpr size_t OFF_VB = OFF_KB + (size_t)NTOK * 128 * 2;
constexpr size_t VT_LAT = (size_t)NCTX * 128;
constexpr size_t OFF_YCAT = OFF_VB + (size_t)NTOK * 128 * 2;
constexpr size_t UNION_END = OFF_YCAT + (size_t)NTOK * 1024 * 2;
constexpr size_t ACT_END = OFF_ACT + (size_t)NTOK * DFF * 2;
constexpr size_t WS_END = (UNION_END > ACT_END ? UNION_END : ACT_END);

struct Params {
    const float* in[24];
    float* out;
    unsigned char* ws;
};

__device__ __forceinline__ unsigned short f2bf(float f) { unsigned u = __float_as_uint(f); u += 0x7FFFu + ((u >> 16) & 1u); return (unsigned short)(u >> 16); }
__device__ __forceinline__ float bf2f(unsigned short b) { return __uint_as_float(((unsigned)b) << 16); }
__device__ __forceinline__ unsigned cvt_pk_bf16(float lo, float hi) { unsigned r; asm volatile("v_cvt_pk_bf16_f32 %0, %1, %2" : "=v"(r) : "v"(lo), "v"(hi)); return r; }
typedef __bf16 bf16x2_t __attribute__((ext_vector_type(2)));
typedef float f32x2_t __attribute__((ext_vector_type(2)));
typedef float f32x16 __attribute__((ext_vector_type(16)));
__device__ __forceinline__ unsigned pk_bf16(float lo, float hi) { f32x2_t v = {lo, hi}; return __builtin_bit_cast(unsigned, __builtin_convertvector(v, bf16x2_t)); }
__device__ __forceinline__ float silu_f(float x) { return x * __builtin_amdgcn_rcpf(1.0f + __expf(-x)); }
__device__ __forceinline__ int perm32(int rho) { const int n = rho >> 4, i = rho & 15; return 8 * (i >> 2) + 4 * n + (i & 3); }

__device__ __forceinline__ int opaque_tid() { int t = threadIdx.x; asm volatile("" : "+v"(t)); return t; }

namespace pg8 {
constexpr int BM = 256, BK = 64, HALF = 128, HTB = HALF * BK * 2, STAGE_BYTES = 8 * HTB, NXCD = 8, WGM = 8;
__device__ __forceinline__ int lds_byte(int r, int c) { const int st = (r >> 4) * 2 + (c >> 5), rr = r & 15, cc = c & 31, ob = rr * 64 + cc * 2; return st * 1024 + (ob ^ (((ob >> 9) & 1) << 5)); }
__device__ __forceinline__ void stage_rc(int b, int& R, int& C) { const int st = b / 1024, sb = b % 1024, swz = sb ^ (((sb >> 9) & 1) << 5); R = (st >> 1) * 16 + swz / 64; C = (st & 1) * 32 + (swz % 64) / 2; }
struct Unit { int pm, pn; };
struct Gemm { const bf16_t* A; const bf16_t* Bt; int M, N, K, lda, ldb; };
struct StaticOrder {
    int nM, nN, nwg, G, c;
    __device__ void init(int M, int N, int G_, int c_) { nM = M / BM; nN = N / BM; nwg = nM * nN; G = G_; c = c_; }
    __device__ bool next(int i, Unit& u) const {
        if (c < 0) return false;
        const long L = (long)i * G + c; if (L >= nwg) return false;
        int wgid = (int)L; { const int q = nwg / NXCD, r = nwg % NXCD, xcd = wgid % NXCD, off = wgid / NXCD; wgid = (xcd < r ? xcd * (q + 1) : r * (q + 1) + (xcd - r) * q) + off; }
        const int nig = WGM * nN, gid = wgid / nig, fm = gid * WGM, gsz = (nM - fm) < WGM ? (nM - fm) : WGM;
        u.pm = fm + ((wgid % nig) % gsz); u.pn = (wgid % nig) / gsz; return true;
    }
    __device__ __forceinline__ void a_ready(const Unit&) const {}
    __device__ __forceinline__ void done(const Unit&) const {}
};

template <class Epi, class Sched>
__device__ __forceinline__ void gemm_phase(LAS unsigned char* lds, Gemm g, const Sched& S, const Epi& E) {
    asm volatile("" : "+s"(g.A), "+s"(g.Bt), "+s"(g.K), "+s"(g.lda), "+s"(g.ldb));
    int tid = threadIdx.x; asm volatile("" : "+v"(tid));
    const int wid = __builtin_amdgcn_readfirstlane(tid >> 6), lane = tid & 63, wr = wid >> 2, wc = wid & 3, fr = lane & 15, fq = lane >> 4;
    const int K = g.K, nt = K / BK;
    unsigned voffA[2], voffB[2];
#pragma unroll
    for (int i = 0; i < 2; ++i) { int R, C; stage_rc(tid * 16 + i * 8192, R, C);
        voffA[i] = (unsigned)(R * g.lda + C) * 2u; voffB[i] = (unsigned)(R * g.ldb + C) * 2u; }
    const size_t kstep = (size_t)(BK * 2);
    const size_t hstepA = (size_t)HALF * g.lda * 2, hstepB = (size_t)HALF * g.ldb * 2;
    const size_t tstepA = 2 * hstepA, tstepB = 2 * hstepB;
    const unsigned ldsw = (unsigned)wid * 1024u;
    const int aoff = lds_byte(wr * 64 + fr, fq * 8), boff = lds_byte(wc * 32 + fr, fq * 8);
#define PG8_SA(b, h) (((b) * 2 + (h)) * HTB)
#define PG8_SB(b, h) ((4 + (b) * 2 + (h)) * HTB)
#define PG8_STAGE(bufoff, gbase, voff) do { _Pragma("unroll") for (int _i = 0; _i < 2; ++_i) \
        __builtin_amdgcn_global_load_lds((const unsigned*)((const char*)(gbase) + (voff)[_i]), (LAS unsigned*)(lds + (bufoff) + ldsw + _i * 8192), 16, 0, 0); } while (0)
#define PG8_LDA(dst, b, h) do { _Pragma("unroll") for (int m = 0; m < 4; ++m) _Pragma("unroll") for (int k = 0; k < 2; ++k) dst[m][k] = *(const LAS bf16x8*)(lds + PG8_SA(b, h) + aoff + m * 2048 + k * 1024); } while (0)
#define PG8_LDB(dst, b, h) do { _Pragma("unroll") for (int n = 0; n < 2; ++n) _Pragma("unroll") for (int k = 0; k < 2; ++k) dst[n][k] = *(const LAS bf16x8*)(lds + PG8_SB(b, h) + boff + n * 2048 + k * 1024); } while (0)
#define PG8_MMA(ai, bj, At, Bt) do { __builtin_amdgcn_s_setprio(1); _Pragma("unroll") for (int m = 0; m < 4; ++m) _Pragma("unroll") for (int n = 0; n < 2; ++n) _Pragma("unroll") for (int k = 0; k < 2; ++k) \
        acc[ai][bj][m][n] = __builtin_amdgcn_mfma_f32_16x16x32_bf16(Bt[n][k], At[m][k], acc[ai][bj][m][n], 0, 0, 0); __builtin_amdgcn_s_setprio(0); } while (0)
#define PG8_WAIT_V(n) asm volatile("s_waitcnt vmcnt(" #n ")" ::: "memory")
#define PG8_WAIT_L(n) asm volatile("s_waitcnt lgkmcnt(" #n ")" ::: "memory")
#define PG8_BAR __builtin_amdgcn_s_barrier()
#define PG8_SCHED __builtin_amdgcn_sched_barrier(0)
    Unit cur, nxt; int ui = 0;
    if (!S.next(0, cur)) return;
    f32x4 acc[2][2][4][2];
#pragma unroll
    for (int a = 0; a < 2; ++a)
#pragma unroll
        for (int b = 0; b < 2; ++b)
#pragma unroll
            for (int m = 0; m < 4; ++m)
#pragma unroll
                for (int n = 0; n < 2; ++n) acc[a][b][m][n] = (f32x4){0.f, 0.f, 0.f, 0.f};
    bf16x8 At[4][2], B0[2][2], B1[2][2];
    const char* cA = (const char*)g.A + (size_t)cur.pm * tstepA; const char* cB = (const char*)g.Bt + (size_t)cur.pn * tstepB;
    S.a_ready(cur);
    PG8_STAGE(PG8_SB(0, 0), cB, voffB); PG8_STAGE(PG8_SA(0, 0), cA, voffA); PG8_STAGE(PG8_SB(0, 1), cB + hstepB, voffB); PG8_STAGE(PG8_SA(0, 1), cA + hstepA, voffA);
    if (wr == 1) PG8_BAR;
    PG8_WAIT_V(4); PG8_BAR;
    PG8_STAGE(PG8_SB(1, 0), cB + kstep, voffB); PG8_STAGE(PG8_SA(1, 0), cA + kstep, voffA); PG8_STAGE(PG8_SB(1, 1), cB + hstepB + kstep, voffB);
    PG8_WAIT_V(6); PG8_BAR;
    for (;;) {
        const bool has_next = S.next(ui + 1, nxt);
        const char* nA = has_next ? (const char*)g.A + (size_t)nxt.pm * tstepA : cA; const char* nB = has_next ? (const char*)g.Bt + (size_t)nxt.pn * tstepB : cB;
        for (int t = 0; t < nt; t += 2) {
            const bool last = (t == nt - 2);
            const char* a1 = cA + (size_t)(t + 1) * kstep;
            const char* a2 = last ? nA : cA + (size_t)(t + 2) * kstep; const char* b2 = last ? nB : cB + (size_t)(t + 2) * kstep;
            const char* a3 = a2 + kstep; const char* b3 = b2 + kstep;
            if (last && has_next) S.a_ready(nxt);
            PG8_LDB(B0, 0, 0); PG8_SCHED; PG8_LDA(At, 0, 0); PG8_STAGE(PG8_SA(1, 1), a1 + hstepA, voffA);
            PG8_WAIT_L(8); PG8_BAR; PG8_WAIT_L(0); PG8_MMA(0, 0, At, B0); PG8_BAR; PG8_SCHED;
            PG8_LDB(B1, 0, 1); PG8_STAGE(PG8_SB(0, 0), b2, voffB);
            PG8_BAR; PG8_WAIT_L(0); PG8_MMA(0, 1, At, B1); PG8_BAR;
            PG8_LDA(At, 0, 1); PG8_STAGE(PG8_SA(0, 0), a2, voffA);
            PG8_BAR; PG8_WAIT_L(0); PG8_MMA(1, 0, At, B0); PG8_BAR; PG8_SCHED;
            PG8_STAGE(PG8_SB(0, 1), b2 + hstepB, voffB);
            PG8_WAIT_V(6); PG8_BAR; PG8_MMA(1, 1, At, B1); PG8_BAR;
            PG8_LDB(B0, 1, 0); PG8_SCHED; PG8_LDA(At, 1, 0); PG8_STAGE(PG8_SA(0, 1), a2 + hstepA, voffA);
            PG8_WAIT_L(8); PG8_BAR; PG8_WAIT_L(0); PG8_MMA(0, 0, At, B0); PG8_BAR; PG8_SCHED;
            PG8_LDB(B1, 1, 1); PG8_STAGE(PG8_SB(1, 0), b3, voffB);
            PG8_BAR; PG8_WAIT_L(0); PG8_MMA(0, 1, At, B1); PG8_BAR;
            PG8_LDA(At, 1, 1); PG8_STAGE(PG8_SA(1, 0), a3, voffA);
            PG8_BAR; PG8_WAIT_L(0); PG8_MMA(1, 0, At, B0); PG8_BAR; PG8_SCHED;
            PG8_STAGE(PG8_SB(1, 1), b3 + hstepB, voffB);
            PG8_WAIT_V(6); PG8_BAR; PG8_MMA(1, 1, At, B1); PG8_BAR;
        }
        { int fr2 = fr, fq2 = fq, wr2 = wr, wc2 = wc; asm volatile("" : "+v"(fr2), "+v"(fq2), "+s"(wr2), "+s"(wc2));
            E(acc, cur, wr2, wc2, fr2, fq2); } S.done(cur);
        if (!has_next) break;
#pragma unroll
        for (int a = 0; a < 2; ++a)
#pragma unroll
            for (int b = 0; b < 2; ++b)
#pragma unroll
                for (int m = 0; m < 4; ++m)
#pragma unroll
                    for (int n = 0; n < 2; ++n) acc[a][b][m][n] = (f32x4){0.f, 0.f, 0.f, 0.f};
        cur = nxt; cA = nA; cB = nB; ++ui;
    }
    PG8_WAIT_V(0);
    if (wr == 0) PG8_BAR;
    PG8_BAR;
#undef PG8_SA
#undef PG8_SB
#undef PG8_STAGE
#undef PG8_LDA
#undef PG8_LDB
#undef PG8_MMA
#undef PG8_WAIT_V
#undef PG8_WAIT_L
#undef PG8_BAR
#undef PG8_SCHED
}
}

struct EpiSwiglu {
    bf16_t* O;
    __device__ __forceinline__ void operator()(const f32x4 (&acc)[2][2][4][2], const pg8::Unit& u, int wr, int wc, int fr, int fq) const {
        const int row0 = u.pm * 256 + wr * 64 + fr, col0 = u.pn * 128 + wc * 32 + 8 * fq;
#pragma unroll
        for (int ai = 0; ai < 2; ++ai)
#pragma unroll
            for (int m = 0; m < 4; ++m) {
                bf16_t* rowp = O + (size_t)(row0 + ai * 128 + m * 16) * DFF + col0;
                const f32x4 g0 = acc[ai][0][m][0], g1 = acc[ai][0][m][1], u0 = acc[ai][1][m][0], u1 = acc[ai][1][m][1];
                u32x4 w;
                w.x = cvt_pk_bf16(silu_f(g0[0]) * u0[0], silu_f(g0[1]) * u0[1]); w.y = cvt_pk_bf16(silu_f(g0[2]) * u0[2], silu_f(g0[3]) * u0[3]);
                w.z = cvt_pk_bf16(silu_f(g1[0]) * u1[0], silu_f(g1[1]) * u1[1]); w.w = cvt_pk_bf16(silu_f(g1[2]) * u1[2], silu_f(g1[3]) * u1[3]);
                *(u32x4*)rowp = w;
            }
    }
};
struct EpiYssq {
    bf16_t* Y; float* ssq;
    __device__ __forceinline__ void operator()(const f32x4 (&acc)[2][2][4][2], const pg8::Unit& u, int wr, int wc, int fr, int fq) const {
        const int row0 = u.pm * 256 + wr * 64 + fr, col0 = u.pn * 256 + wc * 32 + 8 * fq;
#pragma unroll
        for (int ai = 0; ai < 2; ++ai)
#pragma unroll
            for (int m = 0; m < 4; ++m) {
                const int row = row0 + ai * 128 + m * 16;
                bf16_t* rowp = Y + (size_t)row * D + col0;
                float s = 0.f;
#pragma unroll
                for (int bj = 0; bj < 2; ++bj) {
                    const f32x4 v0 = acc[ai][bj][m][0], v1 = acc[ai][bj][m][1];
                    s += v0[0] * v0[0] + v0[1] * v0[1] + v0[2] * v0[2] + v0[3] * v0[3] + v1[0] * v1[0] + v1[1] * v1[1] + v1[2] * v1[2] + v1[3] * v1[3];
                    u32x4 w; w.x = cvt_pk_bf16(v0[0], v0[1]); w.y = cvt_pk_bf16(v0[2], v0[3]); w.z = cvt_pk_bf16(v1[0], v1[1]); w.w = cvt_pk_bf16(v1[2], v1[3]);
                    *(u32x4*)(rowp + bj * 128) = w;
                }
                s += __shfl_xor(s, 16); s += __shfl_xor(s, 32);
                if (fq == 0) ssq[(size_t)row * 16 + u.pn * 4 + wc] = s;
            }
    }
};
struct EpiWin {
    bf16_t* ZT; bf16_t* HT; bf16_t* QB; bf16_t* KB; bf16_t* VB; const float* rope; float* newk; float* newv; int layer;
    __device__ __forceinline__ void operator()(const f32x4 (&acc)[2][2][4][2], const pg8::Unit& u, int wr, int wc, int fr, int fq) const {
        const int r0 = u.pm * 256 + wr * 64 + fr;
        const bool lat = u.pm >= 32;
        const int pn = u.pn;
        if (pn < 5) {
            bf16_t* base; int t0; size_t sch;
            if (pn < 2) {
                if (!lat) { const int b = u.pm; base = ZT + ((size_t)b * 256 * 2 + pn) * 256; sch = 512; t0 = r0 - u.pm * 256; }
                else { const int b = (u.pm - 32) >> 2; base = ZT + ZT_LAT + ((size_t)b * 256 * 2 + pn) * 1024; sch = 2048; t0 = r0 - NCTX - b * 1024; }
            } else {
                const int c0 = (pn - 2) * 256;
                if (!lat) { const int b = u.pm; base = HT + ((size_t)b * 768 + c0) * 256; sch = 256; t0 = r0 - u.pm * 256; }
                else { const int b = (u.pm - 32) >> 2; base = HT + HT_LAT + ((size_t)b * 768 + c0) * 1024; sch = 1024; t0 = r0 - NCTX - b * 1024; }
            }
#pragma unroll
            for (int ai = 0; ai < 2; ++ai)
#pragma unroll
                for (int m = 0; m < 4; ++m) {
                    const int t = t0 + ai * 128 + m * 16;
#pragma unroll
                    for (int bj = 0; bj < 2; ++bj)
#pragma unroll
                        for (int n = 0; n < 2; ++n) {
                            const int ch = bj * 128 + wc * 32 + n * 16 + 4 * fq;
                            const f32x4 v = acc[ai][bj][m][n];
#pragma unroll
                            for (int e = 0; e < 4; ++e) base[(size_t)(ch + e) * sch + t] = f2bf(v[e]);
                        }
                }
        } else {
            const int blk = wc & 1;
#pragma unroll
            for (int ai = 0; ai < 2; ++ai)
#pragma unroll
                for (int m = 0; m < 4; ++m) {
                    const int row = r0 + ai * 128 + m * 16;
                    f32x4 cs0 = {1.f, 0.f, 1.f, 0.f}, cs1 = {1.f, 0.f, 1.f, 0.f};
                    if (lat) { const int t = row & 1023; const int pos = blk ? (t & 63) : (t >> 6);
                        const f32x4* rp = (const f32x4*)(rope + (size_t)(pos * 16 + 4 * fq) * 2); cs0 = rp[0]; cs1 = rp[1]; }
#pragma unroll
                    for (int bj = 0; bj < 2; ++bj) {
                        f32x4 x1 = acc[ai][bj][m][0], x2 = acc[ai][bj][m][1];
                        const bool isv = (pn == 7 && bj == 1);
                        const bool isk = (pn == 7 && bj == 0);
                        const int cc = bj * 128 + wc * 32 + 4 * fq;
                        if ((isk || isv) && !lat) {
                            const int b = row >> 8, t = row & 255;
                            float* dst = (isk ? newk : newv) + (((size_t)b * 2 + layer) * 256 + t) * 128 + (cc & 127);
                            *(f32x4*)dst = x1; *(f32x4*)(dst + 16) = x2;
                        }
                        if (!isv) {
                            f32x4 o1, o2;
                            o1[0] = x1[0] * cs0[0] - x2[0] * cs0[1]; o2[0] = x2[0] * cs0[0] + x1[0] * cs0[1];
                            o1[1] = x1[1] * cs0[2] - x2[1] * cs0[3]; o2[1] = x2[1] * cs0[2] + x1[1] * cs0[3];
                            o1[2] = x1[2] * cs1[0] - x2[2] * cs1[1]; o2[2] = x2[2] * cs1[0] + x1[2] * cs1[1];
                            o1[3] = x1[3] * cs1[2] - x2[3] * cs1[3]; o2[3] = x2[3] * cs1[2] + x1[3] * cs1[3];
                            x1 = o1; x2 = o2;
                        }
                        bf16_t* dst;
                        if (pn < 7) { x1 *= 0.125f; x2 *= 0.125f; dst = QB + (size_t)row * 512 + (pn - 5) * 256 + cc; }
                        else if (isk) dst = KB + (size_t)row * 128 + cc;
                        else {
                            bf16_t* vb; size_t n_;
                            if (!lat) { vb = VB + (size_t)(row >> 8) * 128 * 256 + (row & 255); n_ = 256; } else { vb = VB + VT_LAT + (size_t)((row - NCTX) >> 10) * 128 * 1024 + (row & 1023); n_ = 1024; }
                            const int c0 = cc - 128;
#pragma unroll
                            for (int e = 0; e < 4; ++e) { vb[(size_t)(c0 + e) * n_] = f2bf(x1[e]); vb[(size_t)(c0 + 16 + e) * n_] = f2bf(x2[e]); }
                            continue;
                        }
                        u32x2 w1, w2; w1.x = cvt_pk_bf16(x1[0], x1[1]); w1.y = cvt_pk_bf16(x1[2], x1[3]); w2.x = cvt_pk_bf16(x2[0], x2[1]); w2.y = cvt_pk_bf16(x2[2], x2[3]);
                        *(u32x2*)dst = w1; *(u32x2*)(dst + 16) = w2;
                    }
                }
        }
    }
};
struct EpiFourier {
    bf16_t* YC; int rowbase, n;
    __device__ __forceinline__ void operator()(const f32x4 (&acc)[2][2][4][2], const pg8::Unit& u, int wr, int wc, int fr, int fq) const {
        const int kp0 = u.pm * 256 + wr * 64 + fr; const int b = u.pn;
#pragma unroll
        for (int ai = 0; ai < 2; ++ai)
#pragma unroll
            for (int m = 0; m < 4; ++m) {
                bf16_t* rowp = YC + (size_t)(rowbase + b * n + kp0 + ai * 128 + m * 16) * 1024 + wc * 32 + 4 * fq;
#pragma unroll
                for (int bj = 0; bj < 2; ++bj)
#pragma unroll
                    for (int nn = 0; nn < 2; ++nn) { const f32x4 v = acc[ai][bj][m][nn]; u32x2 w; w.x = cvt_pk_bf16(v[0], v[1]); w.y = cvt_pk_bf16(v[2], v[3]);
                        *(u32x2*)(rowp + bj * 128 + nn * 16) = w; }
            }
    }
};

template <bool PERM>
__device__ __forceinline__ void transpose_unit(const float* __restrict__ src, int ld, int k0, int cbase, bf16_t* __restrict__ dst, int Kd, int r0, float* tile) {
    const int tid = opaque_tid();
#pragma unroll
    for (int i = 0; i < 2; ++i) { const int idx = tid + 512 * i, kk = idx >> 4, c4 = idx & 15;
        const f32x4 v = *(const f32x4*)(src + (size_t)(k0 + kk) * ld + cbase + c4 * 4);
        float* tp = tile + kk * 65 + c4 * 4; tp[0] = v[0]; tp[1] = v[1]; tp[2] = v[2]; tp[3] = v[3]; }
    __syncthreads();
    { const int rr = tid >> 3, kc = tid & 7; const int cc = PERM ? ((rr & ~31) + perm32(rr & 31)) : rr;
        float v[8];
#pragma unroll
        for (int j = 0; j < 8; ++j) v[j] = tile[(kc * 8 + j) * 65 + cc];
        u32x4 w; w.x = cvt_pk_bf16(v[0], v[1]); w.y = cvt_pk_bf16(v[2], v[3]); w.z = cvt_pk_bf16(v[4], v[5]); w.w = cvt_pk_bf16(v[6], v[7]);
        *(u32x4*)(dst + (size_t)(r0 + rr) * Kd + k0 + kc * 8) = w; }
    __syncthreads();
}

__device__ void phase_prep(const Params& p, float* lds) {
    const int tid = opaque_tid(), nb = gridDim.x, bid = blockIdx.x;
    unsigned char* ws = p.ws;
    constexpr int U_GU = 4 * 88 * 16, U_D = 4 * 16 * 44, U_OUT = 2 * 16 * 16, U_IN = 2 * 24 * 16;
    for (int u = bid; u < U_GU + U_D + U_OUT + U_IN; u += nb) {
        if (u < U_GU) {
            const int ls = u / (88 * 16), rem = u % (88 * 16), rg = rem / 16, kb = rem % 16;
            const int r0 = rg * 64, pn = r0 >> 8, inner = r0 & 255, half = inner >> 7, q0 = inner & 127;
            const float* src = (half ? p.in[10] : p.in[9]) + (size_t)ls * 1024 * DFF;
            transpose_unit<true>(src, DFF, kb * 64, pn * 128 + q0, (bf16_t*)(ws + OFF_WGU + ls * SZ_WGU), 1024, r0, lds);
        } else if (u < U_GU + U_D) {
            const int v = u - U_GU; const int ls = v / (16 * 44), rem = v % (16 * 44), rg = rem / 44, kb = rem % 44;
            transpose_unit<true>(p.in[11] + (size_t)ls * DFF * 1024, 1024, kb * 64, rg * 64, (bf16_t*)(ws + OFF_WD + ls * SZ_WD), DFF, rg * 64, lds);
        } else if (u < U_GU + U_D + U_OUT) {
            const int v = u - U_GU - U_D; const int l = v / 256, rem = v % 256, rg = rem / 16, kb = rem % 16;
            transpose_unit<true>(p.in[13] + (size_t)l * 1024 * 1024, 1024, kb * 64, rg * 64, (bf16_t*)(ws + OFF_WOUT + l * SZ_WOUT), 1024, rg * 64, lds);
        } else {
            const int v = u - U_GU - U_D - U_OUT; const int l = v / (24 * 16), rem = v % (24 * 16), rg = rem / 16, kb = rem % 16;
            transpose_unit<false>(p.in[12] + (size_t)l * 1024 * INW, INW, kb * 64, 256 + rg * 64, (bf16_t*)(ws + OFF_WIN + l * SZ_WIN), 1024, 512 + rg * 64, lds);
        }
    }
    {
        float* tab = lds;
        if (tid < 64) { float sv, cv; sincosf(PI2 * (float)tid / 64.f, &sv, &cv); tab[tid] = cv; tab[64 + tid] = sv; }
        __syncthreads();
        const int lane = tid & 63, wv = tid >> 6;
        for (int u = bid * 8 + wv; u < 8192; u += nb * 8) {
            const int l = u >> 12, k = (u >> 2) & 1023, g = u & 3;
            const float* wrow = p.in[12] + ((size_t)l * 1024 + k) * INW + g * 64;
            const float wv_ = wrow[lane];
            float ac = 0.f, as = 0.f;
#pragma unroll 16
            for (int c = 0; c < 64; ++c) { const float w = __shfl(wv_, c); const int idx = (c * lane) & 63; ac += w * tab[idx]; as += w * tab[64 + idx]; }
            bf16_t* bt = (bf16_t*)(ws + OFF_WIN + l * SZ_WIN);
            bt[(size_t)(g * 64 + lane) * 1024 + k] = f2bf(ac);
            bt[(size_t)(256 + g * 64 + lane) * 1024 + k] = f2bf(as);
        }
        __syncthreads();
    }
    {
        float* sc = lds;
        float* part = lds + 9 * 1024;
        for (int i = tid; i < 9 * 1024; i += NTHREADS) { const int bc = i >> 10, k = i & 1023; const float cv = bc == 0 ? p.in[5][k] : p.in[4][(bc - 1) * 1024 + k]; sc[i] = cv / (1.0f + expf(-cv)); }
        __syncthreads();
        for (int cb = bid; cb < 256; cb += nb) {
            const int gc0 = cb * 72, l = gc0 / 9216, j0 = gc0 % 9216;
            const int col = tid % 72, kg = tid / 72;
            if (kg < 7) {
                float a[9];
#pragma unroll
                for (int i = 0; i < 9; ++i) a[i] = 0.f;
                const float* wp = p.in[6] + (size_t)l * 1024 * 9216 + j0 + col;
#pragma unroll 4
                for (int k = kg; k < 1024; k += 7) { const float w = wp[(size_t)k * 9216];
#pragma unroll
                    for (int i = 0; i < 9; ++i) a[i] += sc[i * 1024 + k] * w; }
#pragma unroll
                for (int i = 0; i < 9; ++i) part[(kg * 72 + col) * 9 + i] = a[i];
            }
            __syncthreads();
            for (int i = tid; i < 72 * 9; i += NTHREADS) { const int c2 = i / 9, bc = i % 9; float s = 0.f;
#pragma unroll
                for (int g = 0; g < 7; ++g) s += part[(g * 72 + c2) * 9 + bc];
                ((float*)(ws + OFF_MOD))[((size_t)l * 9 + bc) * 9216 + j0 + c2] = s + p.in[7][l * 9216 + j0 + c2]; }
            __syncthreads();
        }
    }
    {
        const int lane = tid & 63, wv = tid >> 6;
        for (int u = bid * 8 + wv; u < 2 * 320; u += nb * 8) {
            const int l = u / 320, gq = u % 320; const int pass = gq >= 64; const int n = pass ? 1024 : 256; const int d0 = (pass ? gq - 64 : gq) * 4;
            const float* w1 = p.in[15] + l * 33 * 64; const float* b1 = p.in[16] + l * 64; const float* w2 = p.in[17] + l * 64 * 64; const float* b2 = p.in[18] + l * 64;
            const float* w3 = p.in[19] + (size_t)l * 64 * 1024; const float fr = p.in[20][l * 64 + lane];
            float h2[4];
#pragma unroll
            for (int q = 0; q < 4; ++q) {
                const int d = d0 + q; const float tt = (float)d / (float)(n - 1);
                float feat = 0.f;
                if (lane == 0) feat = tt;
                else if (lane < 33) { const int j = (lane - 1) & 15; const float fj = 1e-4f + (float)j * ((15.0f - 1e-4f) / 15.0f); const float ang = (PI2 / (float)n) * (float)d * fj;
                    feat = lane < 17 ? cosf(ang) : -sinf(ang); }
                float a1 = b1[lane];
                for (int i = 0; i < 33; ++i) a1 += __shfl(feat, i) * w1[i * 64 + lane];
                const float h1 = sinf(fr * a1);
                float a2 = b2[lane];
                for (int i = 0; i < 64; ++i) a2 += __shfl(h1, i) * w2[i * 64 + lane];
                h2[q] = sinf(fr * a2);
            }
            float* fbase = (float*)(ws + OFF_FILT) + (size_t)l * FILT_L + (pass ? FILT_CTX : 0);
            for (int oc = 0; oc < 16; ++oc) {
                const int o = oc * 64 + lane;
                float a[4] = {0.f, 0.f, 0.f, 0.f};
                for (int i = 0; i < 64; ++i) { const float w = w3[i * 1024 + o];
#pragma unroll
                    for (int q = 0; q < 4; ++q) a[q] += __shfl(h2[q], i) * w; }
                const int ord = (o >> 8) & 1, c = o & 255;
                const float dec = fabsf(p.in[21][(l * 2 + ord) * 256 + c]);
#pragma unroll
                for (int q = 0; q < 4; ++q) { const int d = d0 + q; const float tt = (float)d / (float)(n - 1);
                    fbase[(size_t)o * n + d] = a[q] * expf(-tt * dec); }
            }
        }
    }
    {
        bf16_t* FC = (bf16_t*)(ws + OFF_FC); bf16_t* FL = (bf16_t*)(ws + OFF_FL);
        const int gt = bid * NTHREADS + tid, gn = nb * NTHREADS;
        for (int i = gt; i < 256 * 512 + 1024 * 2048; i += gn) {
            int n, k, col; bf16_t* dst;
            if (i < 256 * 512) { n = 256; k = i >> 9; col = i & 511; dst = FC + i; } else { const int j = i - 256 * 512; n = 1024; k = j >> 11; col = j & 2047; dst = FL + j; }
            const int s = col >= n, t = col - s * n; const int ph = (k * t) & (n - 1);
            float sv, cv; sincosf(PI2 * (float)ph / (float)n, &sv, &cv);
            const float sc = rsqrtf(64.0f * (float)n);
            *dst = f2bf((s ? -sv : cv) * sc);
        }
        { bf16_t* CK = (bf16_t*)(ws + OFF_CKB); bf16_t* CV = (bf16_t*)(ws + OFF_CVT);
            for (int i = gt; i < 2 * 8 * 256 * 128; i += gn) {
                { const int c = i & 127, key = (i >> 7) & 255, b = (i >> 15) & 7, l = i >> 18;
                    CK[i] = f2bf(p.in[2][(((size_t)b * 2 + l) * 256 + key) * 128 + c]); }
                { const int key = i & 255, c = (i >> 8) & 127, b = (i >> 15) & 7, l = i >> 18;
                    CV[i] = f2bf(p.in[3][(((size_t)b * 2 + l) * 256 + key) * 128 + c]); }
            } }
        if (bid == 0) for (int i = tid; i < 64 * 16; i += NTHREADS) { const int pos = i >> 4, j = i & 15; const float inv = powf(10000.0f, -(float)(2 * j) / 32.0f);
            float sv, cv; sincosf((float)pos * inv, &sv, &cv); float* rp = (float*)(ws + OFF_ROPE); rp[2 * i] = cv; rp[2 * i + 1] = sv; }
    }
}

template <int MODE>
__device__ void phase_row(const Params& p, int lpost, int spost, int lpre, int spre) {
    const int tid_ = opaque_tid(); const int lane = tid_ & 63, wv = tid_ >> 6;
    const float* mod = (const float*)(p.ws + OFF_MOD);
    const bf16_t* Y = (const bf16_t*)(p.ws + OFF_Y); const float* ssq = (const float*)(p.ws + OFF_SSQ);
    bf16_t* H = (bf16_t*)(p.ws + OFF_H);
    const float factor = (spost == 1) ? 1.0f : 0.5f;
    for (int row = blockIdx.x * 8 + wv; row < NTOK; row += gridDim.x * 8) {
        const int bc = row < NCTX ? 0 : 1 + ((row - NCTX) >> 10);
        float* xr = p.out + (size_t)row * D;
        f32x4 x[4];
        if (MODE == 0) { const float* src = row < NCTX ? p.in[0] + (size_t)row * D : p.in[1] + (size_t)(row - NCTX) * D;
#pragma unroll
            for (int j = 0; j < 4; ++j) x[j] = *(const f32x4*)(src + j * 256 + lane * 4); }
        else {
#pragma unroll
            for (int j = 0; j < 4; ++j) x[j] = *(const f32x4*)(xr + j * 256 + lane * 4);
            const f32x4* sp = (const f32x4*)(ssq + (size_t)row * 16);
            const f32x4 s0 = sp[0], s1 = sp[1], s2 = sp[2], s3 = sp[3];
            const float tot = (s0[0] + s0[1] + s0[2] + s0[3]) + (s1[0] + s1[1] + s1[2] + s1[3]) + (s2[0] + s2[1] + s2[2] + s2[3]) + (s3[0] + s3[1] + s3[2] + s3[3]);
            const float rstd = rsqrtf(tot * (1.0f / 1024.0f) + EPS) * factor;
            const float* gate = mod + ((size_t)lpost * 9 + bc) * 9216 + spost * 3072 + 2048;
            const float* gp = p.in[8] + (lpost * 6 + 2 * spost + 1) * 1024;
#pragma unroll
            for (int j = 0; j < 4; ++j) { const int c = j * 256 + lane * 4;
                const u32x2 yv = *(const u32x2*)(Y + (size_t)row * D + c);
                const f32x4 gt = *(const f32x4*)(gate + c), gg = *(const f32x4*)(gp + c);
                x[j][0] += gt[0] * gg[0] * rstd * __uint_as_float(yv.x << 16);
                x[j][1] += gt[1] * gg[1] * rstd * __uint_as_float(yv.x & 0xFFFF0000u);
                x[j][2] += gt[2] * gg[2] * rstd * __uint_as_float(yv.y << 16);
                x[j][3] += gt[3] * gg[3] * rstd * __uint_as_float(yv.y & 0xFFFF0000u); }
        }
#pragma unroll
        for (int j = 0; j < 4; ++j) *(f32x4*)(xr + j * 256 + lane * 4) = x[j];
        if (MODE != 2) {
            float s = 0.f;
#pragma unroll
            for (int j = 0; j < 4; ++j) s += x[j][0] * x[j][0] + x[j][1] * x[j][1] + x[j][2] * x[j][2] + x[j][3] * x[j][3];
#pragma unroll
            for (int o = 32; o >= 1; o >>= 1) s += __shfl_xor(s, o);
            const float rs = rsqrtf(s * (1.0f / 1024.0f) + EPS);
            const float* mb = mod + ((size_t)lpre * 9 + bc) * 9216 + spre * 3072;
            const float* gp = p.in[8] + (lpre * 6 + 2 * spre) * 1024;
#pragma unroll
            for (int j = 0; j < 4; ++j) { const int c = j * 256 + lane * 4;
                const f32x4 sh = *(const f32x4*)(mb + c), scl = *(const f32x4*)(mb + 1024 + c), gg = *(const f32x4*)(gp + c);
                f32x4 h;
#pragma unroll
                for (int e = 0; e < 4; ++e) h[e] = x[j][e] * rs * gg[e] * (1.0f + scl[e]) + sh[e];
                u32x2 w; w.x = cvt_pk_bf16(h[0], h[1]); w.y = cvt_pk_bf16(h[2], h[3]);
                *(u32x2*)(H + (size_t)row * D + c) = w; }
        }
    }
}

__device__ void hyena_naive(const Params& p, int l, float* lds) {
    const int tid = opaque_tid();
    const bf16_t* HT = (const bf16_t*)(p.ws + OFF_HT);
    bf16_t* YC = (bf16_t*)(p.ws + OFF_YCAT);
    const float* cw = p.in[14] + l * 3 * 768;
    for (int u = blockIdx.x; u < 2048 + 8192; u += gridDim.x) {
        const int pass = u < 2048; const int v = pass ? u : u - 2048; const int b = v >> 8, c = v & 255; const int n = pass ? 1024 : 256;
        const bf16_t* hb = HT + (pass ? HT_LAT + (size_t)b * 768 * 1024 : (size_t)b * 768 * 256);
        const int rowbase = pass ? NCTX + b * 1024 : b * 256;
        const float* fb = (const float*)(p.ws + OFF_FILT) + (size_t)l * FILT_L + (pass ? FILT_CTX : 0);
        float* sv = lds; float* sg1 = lds + n; float* sg2 = lds + 2 * n; float* sz = lds + 3 * n; float* k0 = lds + 4 * n; float* k1 = lds + 6 * n;
        for (int t = tid; t < n; t += NTHREADS) {
#pragma unroll
            for (int w = 0; w < 3; ++w) { const int ch = w * 256 + c; const bf16_t* r = hb + (size_t)ch * n;
                const float a = t > 0 ? bf2f(r[t - 1]) : 0.f, bb = bf2f(r[t]), cc = t < n - 1 ? bf2f(r[t + 1]) : 0.f;
                const float z = a * cw[ch] + bb * cw[768 + ch] + cc * cw[1536 + ch];
                (w == 0 ? sv : (w == 1 ? sg1 : sg2))[t] = z; }
            k0[n + t] = fb[((size_t)(0 * 2 + 0) * 256 + c) * n + t]; k1[n + t] = fb[((size_t)(0 * 2 + 1) * 256 + c) * n + t];
            if (t > 0) { k0[n - t] = fb[((size_t)(1 * 2 + 0) * 256 + c) * n + t]; k1[n - t] = fb[((size_t)(1 * 2 + 1) * 256 + c) * n + t]; }
            else { k0[0] = 0.f; k1[0] = 0.f; }
        }
        __syncthreads();
        const float inv2n = 1.0f / (float)(2 * n);
        const float bias0 = p.in[22][(l * 2 + 0) * 256 + c], bias1 = p.in[22][(l * 2 + 1) * 256 + c];
        for (int t = tid; t < n; t += NTHREADS) { float a = 0.f; const float* kp = k0 + n + t;
#pragma unroll 8
            for (int s = 0; s < n; ++s) a += sv[s] * kp[-s];
            const float y1 = a * inv2n + sv[t] * bias0; sz[t] = sg1[t] * y1; }
        __syncthreads();
        for (int t = tid; t < n; t += NTHREADS) { float a = 0.f; const float* kp = k1 + n + t;
#pragma unroll 8
            for (int s = 0; s < n; ++s) a += sz[s] * kp[-s];
            const float y2 = a * inv2n + sz[t] * bias1;
            YC[(size_t)(rowbase + t) * 1024 + 256 + c] = f2bf(sg2[t] * y2); }
        __syncthreads();
    }
}

__device__ void attn_naive(const Params& p, int l, float* lds) {
    const int tid = opaque_tid();
    const bf16_t* QB = (const bf16_t*)(p.ws + OFF_QB); const bf16_t* KB = (const bf16_t*)(p.ws + OFF_KB); const bf16_t* VB = (const bf16_t*)(p.ws + OFF_VB);
    bf16_t* YC = (bf16_t*)(p.ws + OFF_YCAT);
    float* Ks = lds; float* Vs = lds + 64 * 64;
    for (int u = blockIdx.x; u < 256; u += gridDim.x) {
        const int pass = u < 128; const int v = u & 127;
        int b, kvh, qb, n, rowbase;
        if (!pass) { b = v >> 2; kvh = (v >> 1) & 1; qb = v & 1; n = 256; rowbase = b * 256; }
        else { b = v >> 4; kvh = (v >> 3) & 1; qb = v & 7; n = 1024; rowbase = NCTX + b * 1024; }
        const int qi = tid & 127, g = tid >> 7, head = kvh * 4 + g, qpos = qb * 128 + qi, row = rowbase + qpos;
        float q[64], o[64];
        { const u32x4* qp = (const u32x4*)(QB + (size_t)row * 512 + head * 64);
#pragma unroll
            for (int i = 0; i < 8; ++i) { const u32x4 w = qp[i];
                q[8 * i + 0] = __uint_as_float(w.x << 16); q[8 * i + 1] = __uint_as_float(w.x & 0xFFFF0000u); q[8 * i + 2] = __uint_as_float(w.y << 16); q[8 * i + 3] = __uint_as_float(w.y & 0xFFFF0000u);
                q[8 * i + 4] = __uint_as_float(w.z << 16); q[8 * i + 5] = __uint_as_float(w.z & 0xFFFF0000u); q[8 * i + 6] = __uint_as_float(w.w << 16); q[8 * i + 7] = __uint_as_float(w.w & 0xFFFF0000u); } }
#pragma unroll
        for (int i = 0; i < 64; ++i) o[i] = 0.f;
        float m = p.in[23][l * 8 + head], lsum = 1.0f;
        int klo, khi;
        if (!pass) { klo = 0; khi = 256; } else { klo = qb * 128 - 128; if (klo < 0) klo = 0; khi = qb * 128 + 256; if (khi > n) khi = n; }
        const int nloc = (khi - klo) / 64, nchunks = nloc + (pass ? 4 : 0);
        for (int ch = 0; ch < nchunks; ++ch) {
            __syncthreads();
            { const int key = tid >> 3, d0 = (tid & 7) * 8;
                if (ch < nloc) {
                    const int krow = rowbase + klo + ch * 64 + key;
                    const u32x4 kw = *(const u32x4*)(KB + (size_t)krow * 128 + kvh * 64 + d0), vw = *(const u32x4*)(VB + (size_t)krow * 128 + kvh * 64 + d0);
                    float* kd = Ks + key * 64 + d0; float* vd = Vs + key * 64 + d0;
                    kd[0] = __uint_as_float(kw.x << 16); kd[1] = __uint_as_float(kw.x & 0xFFFF0000u); kd[2] = __uint_as_float(kw.y << 16); kd[3] = __uint_as_float(kw.y & 0xFFFF0000u);
                    kd[4] = __uint_as_float(kw.z << 16); kd[5] = __uint_as_float(kw.z & 0xFFFF0000u); kd[6] = __uint_as_float(kw.w << 16); kd[7] = __uint_as_float(kw.w & 0xFFFF0000u);
                    vd[0] = __uint_as_float(vw.x << 16); vd[1] = __uint_as_float(vw.x & 0xFFFF0000u); vd[2] = __uint_as_float(vw.y << 16); vd[3] = __uint_as_float(vw.y & 0xFFFF0000u);
                    vd[4] = __uint_as_float(vw.z << 16); vd[5] = __uint_as_float(vw.z & 0xFFFF0000u); vd[6] = __uint_as_float(vw.w << 16); vd[7] = __uint_as_float(vw.w & 0xFFFF0000u);
                } else {
                    const int ck = (ch - nloc) * 64 + key;
                    const size_t off = (((size_t)b * 2 + l) * 256 + ck) * 128 + kvh * 64 + d0;
                    const f32x4 k0 = *(const f32x4*)(p.in[2] + off), k1 = *(const f32x4*)(p.in[2] + off + 4), v0 = *(const f32x4*)(p.in[3] + off), v1 = *(const f32x4*)(p.in[3] + off + 4);
                    *(f32x4*)(Ks + key * 64 + d0) = k0; *(f32x4*)(Ks + key * 64 + d0 + 4) = k1; *(f32x4*)(Vs + key * 64 + d0) = v0; *(f32x4*)(Vs + key * 64 + d0 + 4) = v1;
                } }
            __syncthreads();
            for (int key = 0; key < 64; ++key) {
                const f32x4* kr = (const f32x4*)(Ks + key * 64);
                float s = 0.f;
#pragma unroll
                for (int i = 0; i < 16; ++i) { const f32x4 kv = kr[i]; s += q[4 * i] * kv[0] + q[4 * i + 1] * kv[1] + q[4 * i + 2] * kv[2] + q[4 * i + 3] * kv[3]; }
                bool valid = true;
                if (pass && ch < nloc) { const int kpos = klo + ch * 64 + key; int dd = kpos - qpos; if (dd < 0) dd = -dd; valid = dd <= 128; }
                if (valid) {
                    if (s > m) { const float corr = __expf(m - s); lsum *= corr;
#pragma unroll
                        for (int i = 0; i < 64; ++i) o[i] *= corr;
                        m = s; }
                    const float pe = __expf(s - m); lsum += pe;
                    const f32x4* vr = (const f32x4*)(Vs + key * 64);
#pragma unroll
                    for (int i = 0; i < 16; ++i) { const f32x4 vv = vr[i]; o[4 * i] += pe * vv[0]; o[4 * i + 1] += pe * vv[1]; o[4 * i + 2] += pe * vv[2]; o[4 * i + 3] += pe * vv[3]; }
                }
            }
        }
        const float inv = 1.0f / lsum;
        u32x4* op = (u32x4*)(YC + (size_t)row * 1024 + 512 + head * 64);
#pragma unroll
        for (int i = 0; i < 8; ++i) { u32x4 w; w.x = cvt_pk_bf16(o[8 * i] * inv, o[8 * i + 1] * inv); w.y = cvt_pk_bf16(o[8 * i + 2] * inv, o[8 * i + 3] * inv);
            w.z = cvt_pk_bf16(o[8 * i + 4] * inv, o[8 * i + 5] * inv); w.w = cvt_pk_bf16(o[8 * i + 6] * inv, o[8 * i + 7] * inv); op[i] = w; }
        __syncthreads();
    }
}


__device__ void attn_mfma(const Params& p, int l) {
    const int tid = opaque_tid(); const int lane = tid & 63, wv = tid >> 6, r = lane & 31, h = lane >> 5;
    const bf16_t* QB = (const bf16_t*)(p.ws + OFF_QB); const bf16_t* KB = (const bf16_t*)(p.ws + OFF_KB); const bf16_t* VT = (const bf16_t*)(p.ws + OFF_VB);
    const bf16_t* CK = (const bf16_t*)(p.ws + OFF_CKB); const bf16_t* CV = (const bf16_t*)(p.ws + OFF_CVT);
    bf16_t* YC = (bf16_t*)(p.ws + OFF_YCAT);
    const int g = wv & 3, qh = wv >> 2;
    for (int u = blockIdx.x; u < 512; u += gridDim.x) {
        const int pass = u < 256; const int v = u & 255;
        int b, kvh, qb, n, rowbase;
        if (!pass) { b = v >> 3; kvh = (v >> 2) & 1; qb = v & 3; n = 256; rowbase = b * 256; }
        else { b = v >> 5; kvh = (v >> 4) & 1; qb = v & 15; n = 1024; rowbase = NCTX + b * 1024; }
        const int head = kvh * 4 + g, q0w = qb * 64 + qh * 32;
        int klo = 0, khi = 256;
        if (pass) { klo = q0w - 128; if (klo < 0) klo = 0; khi = q0w + 160; if (khi > n) khi = n; }
        const int nA = (khi - klo) >> 5, nT = nA + (pass ? 8 : 0);
        const bf16_t* kA = KB + (size_t)(rowbase + klo) * 128 + kvh * 64;
        const bf16_t* vA = VT + (pass ? VT_LAT + (size_t)b * 128 * 1024 : (size_t)b * 128 * 256) + (size_t)kvh * 64 * n + klo;
        const bf16_t* kB = CK + ((size_t)(l * 8 + b) * 256) * 128 + kvh * 64;
        const bf16_t* vB = CV + ((size_t)(l * 8 + b) * 128 + kvh * 64) * 256;
        bf16x8 qf[4];
        { const bf16_t* qp = QB + (size_t)(rowbase + q0w + r) * 512 + head * 64 + 8 * h;
#pragma unroll
            for (int kk = 0; kk < 4; ++kk) qf[kk] = *(const bf16x8*)(qp + 16 * kk); }
        float m = p.in[23][l * 8 + head], lsum = 1.0f;
        f32x16 O0, O1;
#pragma unroll
        for (int i = 0; i < 16; ++i) { O0[i] = 0.f; O1[i] = 0.f; }
        bf16x8 kf[4];
        {
            const bf16_t* kp = (nA > 0 ? kA : kB) + (size_t)r * 128 + 8 * h;
#pragma unroll
            for (int kk = 0; kk < 4; ++kk) kf[kk] = *(const bf16x8*)(kp + 16 * kk);
        }
        for (int t = 0; t < nT; ++t) {
            const bool inA = t < nA;
            const bf16_t* vp = inA ? vA + (size_t)r * n + t * 32 + 4 * h : vB + (size_t)r * 256 + (t - nA) * 32 + 4 * h;
            const size_t vld = inA ? (size_t)n : (size_t)256;
            u32x2 vraw[2][2][2];
#pragma unroll
            for (int dt = 0; dt < 2; ++dt)
#pragma unroll
                for (int s = 0; s < 2; ++s)
#pragma unroll
                    for (int q = 0; q < 2; ++q) vraw[dt][s][q] = *(const u32x2*)(vp + (size_t)dt * 32 * vld + 16 * s + 8 * q);
            bf16x8 kn[4];
            { const int tn = (t + 1 < nT) ? t + 1 : t; const bool nInA = tn < nA;
                const bf16_t* kp = (nInA ? kA + (size_t)tn * 32 * 128 : kB + (size_t)(tn - nA) * 32 * 128) + (size_t)r * 128 + 8 * h;
#pragma unroll
                for (int kk = 0; kk < 4; ++kk) kn[kk] = *(const bf16x8*)(kp + 16 * kk); }
            f32x16 S;
#pragma unroll
            for (int i = 0; i < 16; ++i) S[i] = 0.f;
#pragma unroll
            for (int kk = 0; kk < 4; ++kk) S = __builtin_amdgcn_mfma_f32_32x32x16_bf16(kf[kk], qf[kk], S, 0, 0, 0);
            if (pass && inA) {
                const int dk = klo + t * 32 - q0w;
                if (dk <= -128 || dk >= 128) {
#pragma unroll
                    for (int i = 0; i < 16; ++i) { const int j = (i & 3) + 8 * (i >> 2) + 4 * h; int dd = dk + j - r; if (dd < 0) dd = -dd; if (dd > 128) S[i] = -1e30f; }
                }
            }
            float mx = S[0];
#pragma unroll
            for (int i = 1; i < 16; ++i) mx = fmaxf(mx, S[i]);
            mx = fmaxf(mx, __shfl_xor(mx, 32));
            const float mn = fmaxf(m, mx), corr = __expf(m - mn);
            m = mn;
            float rs = 0.f;
#pragma unroll
            for (int i = 0; i < 16; ++i) { S[i] = __expf(S[i] - mn); rs += S[i]; }
            rs += __shfl_xor(rs, 32);
            lsum = lsum * corr + rs;
#pragma unroll
            for (int i = 0; i < 16; ++i) { O0[i] *= corr; O1[i] *= corr; }
            bf16x8 pf[2];
#pragma unroll
            for (int s = 0; s < 2; ++s) { u32x4 w; w.x = pk_bf16(S[8 * s], S[8 * s + 1]); w.y = pk_bf16(S[8 * s + 2], S[8 * s + 3]); w.z = pk_bf16(S[8 * s + 4], S[8 * s + 5]); w.w = pk_bf16(S[8 * s + 6], S[8 * s + 7]);
                pf[s] = __builtin_bit_cast(bf16x8, w); }
#pragma unroll
            for (int s = 0; s < 2; ++s) {
                u32x4 a0; a0.x = vraw[0][s][0].x; a0.y = vraw[0][s][0].y; a0.z = vraw[0][s][1].x; a0.w = vraw[0][s][1].y;
                u32x4 a1; a1.x = vraw[1][s][0].x; a1.y = vraw[1][s][0].y; a1.z = vraw[1][s][1].x; a1.w = vraw[1][s][1].y;
                O0 = __builtin_amdgcn_mfma_f32_32x32x16_bf16(__builtin_bit_cast(bf16x8, a0), pf[s], O0, 0, 0, 0);
                O1 = __builtin_amdgcn_mfma_f32_32x32x16_bf16(__builtin_bit_cast(bf16x8, a1), pf[s], O1, 0, 0, 0);
            }
#pragma unroll
            for (int kk = 0; kk < 4; ++kk) kf[kk] = kn[kk];
        }
        const float inv = 1.0f / lsum;
        bf16_t* op = YC + (size_t)(rowbase + q0w + r) * 1024 + 512 + head * 64 + 4 * h;
#pragma unroll
        for (int gq = 0; gq < 4; ++gq) {
            u32x2 w0; w0.x = pk_bf16(O0[4 * gq] * inv, O0[4 * gq + 1] * inv); w0.y = pk_bf16(O0[4 * gq + 2] * inv, O0[4 * gq + 3] * inv);
            u32x2 w1; w1.x = pk_bf16(O1[4 * gq] * inv, O1[4 * gq + 1] * inv); w1.y = pk_bf16(O1[4 * gq + 2] * inv, O1[4 * gq + 3] * inv);
            *(u32x2*)(op + 8 * gq) = w0; *(u32x2*)(op + 32 + 8 * gq) = w1;
        }
    }
}


template <int NB  , int NBLK  >
__device__ __forceinline__ void hyena_unit(const Params& p, int l, int c, const bf16_t* __restrict__ HTp, int rowbase, const float* __restrict__ fb, LAS unsigned char* lds, int tid) {
    constexpr int n = 32 * NBLK, NI = 32 / NB, PAD = 32 * (NI - 1);
    constexpr int LENB = ((2 * n + 8) * 2 + 255) / 256 * 256 + 64;
    constexpr int LEN = LENB / 2;
    constexpr int UROWB = ((n + 2 * PAD) * 2 + 255) / 256 * 256 + 16;
    constexpr int OFF_F0 = 0, OFF_F1 = 8 * LENB, OFF_U = 16 * LENB, OFF_U2 = OFF_U + NB * UROWB, OFF_G1 = OFF_U2 + NB * UROWB, OFF_G2 = OFF_G1 + NB * n * 2;
    static_assert(OFF_G2 + NB * n * 2 <= 144 * 1024, "hyena LDS");
    const int lane = tid & 63, wv = tid >> 6, r = lane & 31, h = lane >> 5;
    const float* cw = p.in[14] + l * 3 * 768;
    for (int q = tid; q < 3 * NB * (n / 8); q += NTHREADS) {
        const int w = q / (NB * (n / 8)), rem = q % (NB * (n / 8)), b = rem / (n / 8), t0 = (rem % (n / 8)) * 8;
        const int ch = w * 256 + c; const bf16_t* row = HTp + ((size_t)b * 768 + ch) * n;
        const float w0 = cw[ch], w1 = cw[768 + ch], w2 = cw[1536 + ch];
        const u32x4 raw = *(const u32x4*)(row + t0);
        float x[10];
        x[0] = t0 > 0 ? bf2f(row[t0 - 1]) : 0.f; x[9] = t0 + 8 < n ? bf2f(row[t0 + 8]) : 0.f;
        x[1] = __uint_as_float(raw.x << 16); x[2] = __uint_as_float(raw.x & 0xFFFF0000u); x[3] = __uint_as_float(raw.y << 16); x[4] = __uint_as_float(raw.y & 0xFFFF0000u);
        x[5] = __uint_as_float(raw.z << 16); x[6] = __uint_as_float(raw.z & 0xFFFF0000u); x[7] = __uint_as_float(raw.w << 16); x[8] = __uint_as_float(raw.w & 0xFFFF0000u);
        float z[8];
#pragma unroll
        for (int e = 0; e < 8; ++e) z[e] = x[e] * w0 + x[e + 1] * w1 + x[e + 2] * w2;
        u32x4 o; o.x = pk_bf16(z[0], z[1]); o.y = pk_bf16(z[2], z[3]); o.z = pk_bf16(z[4], z[5]); o.w = pk_bf16(z[6], z[7]);
        LAS unsigned char* dst = w == 0 ? lds + OFF_U + b * UROWB + (PAD + t0) * 2 : lds + (w == 1 ? OFF_G1 : OFF_G2) + (b * n + t0) * 2;
        *(LAS u32x4*)dst = o;
    }
    if (PAD > 0) {
        constexpr int FR = PAD / 8, BK_ = (UROWB / 2 - PAD - n) / 8;
        for (int q = tid; q < 2 * NB * (FR + BK_); q += NTHREADS) {
            const int buf = q / (NB * (FR + BK_)), rem = q % (NB * (FR + BK_)), b = rem / (FR + BK_), k = rem % (FR + BK_);
            const int e0 = k < FR ? k * 8 : PAD + n + (k - FR) * 8;
            *(LAS u32x4*)(lds + (buf ? OFF_U2 : OFF_U) + b * UROWB + e0 * 2) = (u32x4){0u, 0u, 0u, 0u};
        }
    }
    {
        const float sc = 1.0f / (float)(2 * n);
        for (int q = tid; q < 2 * 8 * (LEN / 2); q += NTHREADS) {
            const int o = q / (8 * (LEN / 2)), rem = q % (8 * (LEN / 2)), s = rem / (LEN / 2), z = (rem % (LEN / 2)) * 2;
            const float* fw = fb + ((size_t)(0 * 2 + o) * 256 + c) * n; const float* bw = fb + ((size_t)(1 * 2 + o) * 256 + c) * n;
            float v2[2];
#pragma unroll
            for (int e = 0; e < 2; ++e) { const int y = z + s + e; v2[e] = y <= n - 1 ? fw[n - 1 - y] : (y <= 2 * n - 2 ? bw[y - n + 1] : 0.f); }
            *(LAS unsigned*)(lds + (o ? OFF_F1 : OFF_F0) + s * LENB + z * 2) = pk_bf16(v2[0] * sc, v2[1] * sc);
        }
    }
    __syncthreads();
    const int bcol = NB == 8 ? (r >> 2) : r, ioff = NB == 8 ? (r & 3) : 0, I0 = wv * NI, Icol = I0 + ioff;
    const int si = (7 - r) & 7;
    const int Dlo = I0 + NI - 1 - (NBLK - 1) - (NI - 1), Dhi = I0 + NI - 1;
    bf16_t* YC = (bf16_t*)(p.ws + OFF_YCAT);
#pragma unroll
    for (int o = 0; o < 2; ++o) {
        const LAS unsigned char* ap = lds + (o ? OFF_F1 : OFF_F0) + si * LENB + (n - 1 - r + 8 * h - si) * 2 - 64 * Dlo;
        const LAS unsigned char* bp = lds + (o ? OFF_U2 : OFF_U) + bcol * UROWB + (PAD + 32 * Icol + 8 * h) * 2 - 64 * Dlo;
        f32x16 acc;
#pragma unroll
        for (int i = 0; i < 16; ++i) acc[i] = 0.f;
#pragma unroll 4
        for (int D = Dlo; D <= Dhi; ++D) {
            const bf16x8 a0 = *(const LAS bf16x8*)ap, a1 = *(const LAS bf16x8*)(ap + 32);
            const bf16x8 b0 = *(const LAS bf16x8*)bp, b1 = *(const LAS bf16x8*)(bp + 32);
            acc = __builtin_amdgcn_mfma_f32_32x32x16_bf16(a0, b0, acc, 0, 0, 0);
            acc = __builtin_amdgcn_mfma_f32_32x32x16_bf16(a1, b1, acc, 0, 0, 0);
            ap -= 64; bp -= 64;
        }
        const float bias = p.in[22][(l * 2 + o) * 256 + c];
#pragma unroll
        for (int g = 0; g < 4; ++g) {
            const int t0 = 32 * Icol + 8 * g + 4 * h;
            const u32x2 uin = *(const LAS u32x2*)(lds + (o ? OFF_U2 : OFF_U) + bcol * UROWB + (PAD + t0) * 2);
            const u32x2 gin = *(const LAS u32x2*)(lds + (o ? OFF_G2 : OFF_G1) + (bcol * n + t0) * 2);
            float y[4];
            y[0] = __uint_as_float(gin.x << 16) * (acc[4 * g] + bias * __uint_as_float(uin.x << 16));
            y[1] = __uint_as_float(gin.x & 0xFFFF0000u) * (acc[4 * g + 1] + bias * __uint_as_float(uin.x & 0xFFFF0000u));
            y[2] = __uint_as_float(gin.y << 16) * (acc[4 * g + 2] + bias * __uint_as_float(uin.y << 16));
            y[3] = __uint_as_float(gin.y & 0xFFFF0000u) * (acc[4 * g + 3] + bias * __uint_as_float(uin.y & 0xFFFF0000u));
            if (o == 0) { u32x2 w; w.x = pk_bf16(y[0], y[1]); w.y = pk_bf16(y[2], y[3]);
                *(LAS u32x2*)(lds + OFF_U2 + bcol * UROWB + (PAD + t0) * 2) = w; }
            else { bf16_t* dst = YC + (size_t)(rowbase + bcol * n + t0) * 1024 + 256 + c;
#pragma unroll
                for (int e = 0; e < 4; ++e) dst[(size_t)e * 1024] = f2bf(y[e]); }
        }
        __syncthreads();
    }
}
__device__ void hyena_mfma(const Params& p, int l, LAS unsigned char* lds) {
    const int tid = opaque_tid();
    const bf16_t* HT = (const bf16_t*)(p.ws + OFF_HT);
    const float* fl = (const float*)(p.ws + OFF_FILT) + (size_t)l * FILT_L;
    for (int u = blockIdx.x; u < 512; u += gridDim.x) {
        if (u < 256) hyena_unit<8, 32>(p, l, u, HT + HT_LAT, NCTX, fl + FILT_CTX, lds, tid);
        else hyena_unit<32, 8>(p, l, u - 256, HT, 0, fl, lds, tid);
    }
}

__global__ void __launch_bounds__(NTHREADS, 2) fwd_megakernel(Params p) {
    extern __shared__ __attribute__((aligned(16))) unsigned char shm[];
    cg::grid_group grid = cg::this_grid();
    LAS unsigned char* lds = (LAS unsigned char*)shm;
    float* ldsf = (float*)shm;
    unsigned char* ws = p.ws;
    const int G = gridDim.x, c = blockIdx.x;

    phase_prep(p, ldsf);
    grid.sync();
    phase_row<0>(p, 0, 0, 0, 0);
    grid.sync();
    for (int l = 0; l < 2; ++l) {
        for (int s = 0; s < 3; ++s) {
            if (s != 1) {
                const int fs = s >> 1;
                { pg8::Gemm g{(const bf16_t*)(ws + OFF_H), (const bf16_t*)(ws + OFF_WGU + (l * 2 + fs) * SZ_WGU), NTOK, 5632, 1024, 1024, 1024};
                    pg8::StaticOrder S; S.init(g.M, g.N, G, c); EpiSwiglu E{(bf16_t*)(ws + OFF_ACT)};
                    pg8::gemm_phase(lds, g, S, E); }
                grid.sync();
                { pg8::Gemm g{(const bf16_t*)(ws + OFF_ACT), (const bf16_t*)(ws + OFF_WD + (l * 2 + fs) * SZ_WD), NTOK, 1024, DFF, DFF, DFF};
                    pg8::StaticOrder S; S.init(g.M, g.N, G, c); EpiYssq E{(bf16_t*)(ws + OFF_Y), (float*)(ws + OFF_SSQ)};
                    pg8::gemm_phase(lds, g, S, E); }
                grid.sync();
            } else {
                { pg8::Gemm g{(const bf16_t*)(ws + OFF_H), (const bf16_t*)(ws + OFF_WIN + l * SZ_WIN), NTOK, 2048, 1024, 1024, 1024};
                    pg8::StaticOrder S; S.init(g.M, g.N, G, c);
                    EpiWin E{(bf16_t*)(ws + OFF_ZT), (bf16_t*)(ws + OFF_HT), (bf16_t*)(ws + OFF_QB), (bf16_t*)(ws + OFF_KB), (bf16_t*)(ws + OFF_VB), (const float*)(ws + OFF_ROPE),
                             p.out + (size_t)NTOK * D, p.out + (size_t)NTOK * D + (size_t)32 * 2 * 256 * 128, l};
                    pg8::gemm_phase(lds, g, S, E); }
                grid.sync();
                { pg8::Gemm g{(const bf16_t*)(ws + OFF_FL), (const bf16_t*)(ws + OFF_ZT) + ZT_LAT, 1024, 2048, 2048, 2048, 2048};
                    pg8::StaticOrder S; S.init(g.M, g.N, G, c); EpiFourier E{(bf16_t*)(ws + OFF_YCAT), NCTX, 1024};
                    pg8::gemm_phase(lds, g, S, E); }
                { pg8::Gemm g{(const bf16_t*)(ws + OFF_FC), (const bf16_t*)(ws + OFF_ZT), 256, 8192, 512, 512, 512};
                    pg8::StaticOrder S; S.init(g.M, g.N, G, c - 32); EpiFourier E{(bf16_t*)(ws + OFF_YCAT), 0, 256};
                    pg8::gemm_phase(lds, g, S, E); }
                __syncthreads();
                hyena_mfma(p, l, lds);
                attn_mfma(p, l);
                grid.sync();
                { pg8::Gemm g{(const bf16_t*)(ws + OFF_YCAT), (const bf16_t*)(ws + OFF_WOUT + l * SZ_WOUT), NTOK, 1024, 1024, 1024, 1024};
                    pg8::StaticOrder S; S.init(g.M, g.N, G, c); EpiYssq E{(bf16_t*)(ws + OFF_Y), (float*)(ws + OFF_SSQ)};
                    pg8::gemm_phase(lds, g, S, E); }
                grid.sync();
            }
            if (l == 1 && s == 2) phase_row<2>(p, l, s, 0, 0);
            else { const int ln = s == 2 ? l + 1 : l, sn = s == 2 ? 0 : s + 1; phase_row<1>(p, l, s, ln, sn); }
            if (!(l == 1 && s == 2)) grid.sync();
        }
    }
}

extern "C" void kernel_launch(void* const* d_in, const int* in_sizes, int n_in, void* d_out, int out_size, void* d_ws, size_t ws_size, hipStream_t stream) {
    constexpr int LDS_BYTES = 144 * 1024;
    static int grid_blocks = 0;
    if (!grid_blocks) {
        if (n_in != 24 || ws_size < WS_END) { fprintf(stderr, "kernel_launch: bad inputs (n_in %d) or workspace too small (%zu < %zu)\n", n_in, ws_size, (size_t)WS_END); grid_blocks = -1; return; }
        int dev = 0, cus = 0, per_cu = 0;
        hipGetDevice(&dev);
        hipDeviceGetAttribute(&cus, hipDeviceAttributeMultiprocessorCount, dev);
        if (hipFuncSetAttribute((const void*)fwd_megakernel, hipFuncAttributeMaxDynamicSharedMemorySize, LDS_BYTES) != hipSuccess) fprintf(stderr, "kernel_launch: hipFuncSetAttribute failed\n");
        hipOccupancyMaxActiveBlocksPerMultiprocessor(&per_cu, (const void*)fwd_megakernel, NTHREADS, LDS_BYTES);
        if (per_cu < 1) { fprintf(stderr, "kernel_launch: occupancy query says %d blocks per CU\n", per_cu); per_cu = 1; }
        (void)hipGetLastError();
        grid_blocks = cus * per_cu;
        if (grid_blocks > 256) grid_blocks = 256;
    }
    if (grid_blocks < 0) return;
    Params p{};
    for (int i = 0; i < 24; ++i) p.in[i] = (const float*)d_in[i];
    p.out = (float*)d_out; p.ws = (unsigned char*)d_ws;
    void* args[] = {&p};
    hipError_t e = hipLaunchCooperativeKernel((const void*)fwd_megakernel, dim3(grid_blocks), dim3(NTHREADS), args, LDS_BYTES, stream);
    if (e != hipSuccess) fprintf(stderr, "cooperative launch failed: %s (grid %d)\n", hipGetErrorString(e), grid_blocks);
}
```

```cpp
#include <hip/hip_runtime.h>
#include <hip/hip_cooperative_groups.h>
#include <cstdio>
namespace cg = cooperative_groups;

#define LAS __attribute__((address_space(3)))
#ifndef DUP_GEMM
#define DUP_GEMM 1
#endif
#ifndef DUP_MIX
#define DUP_MIX 1
#endif
#ifndef DUP_PREP
#define DUP_PREP 1
#endif
#ifndef DUP_SYNC
#define DUP_SYNC 1
#endif
#define GSYNC() do { for (int _s = 0; _s < DUP_SYNC; ++_s) xcd_barrier(xb); } while (0)
typedef unsigned short bf16_t;
typedef short bf16x8 __attribute__((ext_vector_type(8)));
typedef float f32x4 __attribute__((ext_vector_type(4)));
typedef unsigned u32x4 __attribute__((ext_vector_type(4)));
typedef unsigned u32x2 __attribute__((ext_vector_type(2)));

constexpr int D = 1024, NTOK = 16384, NCTX = 8192, DFF = 2816, INW = 1792;
constexpr int NTHREADS = 512;
constexpr float EPS = 1e-6f;
constexpr float PI2 = 6.283185307179586f;

constexpr size_t AL(size_t x) { return (x + 255) & ~(size_t)255; }
constexpr size_t SZ_WGU = (size_t)5632 * 1024 * 2, SZ_WD = (size_t)1024 * 2816 * 2, SZ_WIN = (size_t)2048 * 1024 * 2, SZ_WOUT = (size_t)1024 * 1024 * 2;
constexpr size_t OFF_WGU = 0;
constexpr size_t OFF_WD = OFF_WGU + 4 * SZ_WGU;
constexpr size_t OFF_WIN = OFF_WD + 4 * SZ_WD;
constexpr size_t OFF_WOUT = OFF_WIN + 2 * SZ_WIN;
constexpr size_t OFF_H = OFF_WOUT + 2 * SZ_WOUT;
constexpr size_t OFF_Y = OFF_H + (size_t)NTOK * D * 2;
constexpr size_t OFF_SSQ = OFF_Y + (size_t)NTOK * D * 2;
constexpr size_t OFF_MOD = OFF_SSQ + (size_t)NTOK * 16 * 4;
constexpr size_t OFF_FILT = AL(OFF_MOD + (size_t)2 * 9 * 9216 * 4);
constexpr size_t FILT_CTX = (size_t)4 * 256 * 256, FILT_LAT = (size_t)4 * 256 * 1024, FILT_L = FILT_CTX + FILT_LAT;
constexpr size_t OFF_FC = AL(OFF_FILT + 2 * FILT_L * 4);
constexpr size_t OFF_FL = OFF_FC + (size_t)256 * 512 * 2;
constexpr size_t OFF_ROPE = OFF_FL + (size_t)1024 * 2048 * 2;
constexpr size_t OFF_BAR = AL(OFF_ROPE + 64 * 16 * 8);
constexpr size_t OFF_CKB = OFF_BAR + 16384;
constexpr size_t OFF_CVT = OFF_CKB + (size_t)2 * 8 * 256 * 128 * 2;
constexpr size_t OFF_UNION = AL(OFF_CVT + (size_t)2 * 8 * 256 * 128 * 2);
constexpr size_t OFF_ACT = OFF_UNION;
constexpr size_t OFF_ZT = OFF_UNION;
constexpr size_t ZT_LAT = (size_t)NCTX * 512;
constexpr size_t OFF_HT = OFF_ZT + (size_t)NTOK * 512 * 2;
constexpr size_t HT_LAT = (size_t)NCTX * 768;
constexpr size_t OFF_QB = OFF_HT + (size_t)NTOK * 768 * 2;
constexpr size_t OFF_KB = OFF_QB + (size_t)NTOK * 512 * 2;
constexpr size_t OFF_VB = OFF_KB + (size_t)NTOK * 128 * 2;
constexpr size_t VT_LAT = (size_t)NCTX * 128;
constexpr size_t OFF_YCAT = OFF_VB + (size_t)NTOK * 128 * 2;
constexpr size_t UNION_END = OFF_YCAT + (size_t)NTOK * 1024 * 2;
constexpr size_t ACT_END = OFF_ACT + (size_t)NTOK * DFF * 2;
constexpr size_t WS_END = (UNION_END > ACT_END ? UNION_END : ACT_END);

struct Params {
    const float* in[24];
    float* out;
    unsigned char* ws;
};

__device__ __forceinline__ unsigned short f2bf(float f) { unsigned u = __float_as_uint(f); u += 0x7FFFu + ((u >> 16) & 1u); return (unsigned short)(u >> 16); }
__device__ __forceinline__ float bf2f(unsigned short b) { return __uint_as_float(((unsigned)b) << 16); }
__device__ __forceinline__ unsigned cvt_pk_bf16(float lo, float hi) { unsigned r; asm volatile("v_cvt_pk_bf16_f32 %0, %1, %2" : "=v"(r) : "v"(lo), "v"(hi)); return r; }
typedef __bf16 bf16x2_t __attribute__((ext_vector_type(2)));
typedef float f32x2_t __attribute__((ext_vector_type(2)));
typedef float f32x16 __attribute__((ext_vector_type(16)));
__device__ __forceinline__ unsigned pk_bf16(float lo, float hi) { f32x2_t v = {lo, hi}; return __builtin_bit_cast(unsigned, __builtin_convertvector(v, bf16x2_t)); }
__device__ __forceinline__ float silu_f(float x) { return x * __builtin_amdgcn_rcpf(1.0f + __expf(-x)); }
__device__ __forceinline__ int perm32(int rho) { const int n = rho >> 4, i = rho & 15; return 8 * (i >> 2) + 4 * n + (i & 3); }

__device__ __forceinline__ int opaque_tid() { int t = threadIdx.x; asm volatile("" : "+v"(t)); return t; }


#define XB_TMO      128
#define XB_XCNT(j)  (256  + 64 * (j))
#define XB_XSUB(j)  (1280 + 64 * (j))
#define XB_XGEN(j)  (2304 + 64 * (j))
#define XB_TOP      3328
#define XB_TOPGEN   3392
#define XCD_BAR_WORDS 3456
#define XB_SPIN_CAP (1u << 22)
__device__ __forceinline__ unsigned xb_ld(unsigned* p)              { return __hip_atomic_load(p, __ATOMIC_RELAXED, __HIP_MEMORY_SCOPE_AGENT); }
__device__ __forceinline__ unsigned xb_add(unsigned* p, unsigned v) { return __hip_atomic_fetch_add(p, v, __ATOMIC_RELAXED, __HIP_MEMORY_SCOPE_AGENT); }
__device__ __forceinline__ unsigned xb_xcc_id() { return (unsigned)__builtin_amdgcn_s_getreg((3 << 11) | 20) & 0xFu; }
#define XB_SPIN(cond, bar) do { unsigned _sp = 0; while (cond) { __builtin_amdgcn_s_sleep(1); \
    if ((++_sp & 255u) == 0u) { if (xb_ld(&(bar)[XB_TMO])) break; if (_sp > XB_SPIN_CAP) { atomicAdd(&(bar)[XB_TMO], 1u); break; } } } } while (0)
struct XcdBarrier { unsigned* bar; unsigned x; volatile LAS unsigned* st; };
__device__ __forceinline__ XcdBarrier xcd_barrier_post(unsigned* bar, volatile LAS unsigned* st) {
    XcdBarrier b; b.bar = bar; b.x = xb_xcc_id(); b.st = st;
    if (threadIdx.x == 0) (void)xb_add(&bar[XB_XCNT(b.x)], 1u);
    return b;
}
__device__ __forceinline__ void xcd_barrier_complete(unsigned* bar, unsigned x, unsigned& nloc, unsigned& nx) {
    const unsigned G = gridDim.x * gridDim.y * gridDim.z;
    unsigned sum, cnt, mine, sp = 0u;
    for (;;) {
        sum = 0u; cnt = 0u; mine = 0u;
#pragma unroll
        for (unsigned j = 0; j < 16; ++j) { const unsigned c = xb_ld(&bar[XB_XCNT(j)]); sum += c; cnt += (c > 0u) ? 1u : 0u; mine = (j == x) ? c : mine; }
        if (sum == G) break;
        __builtin_amdgcn_s_sleep(1);
        if ((++sp & 255u) == 0u) { if (xb_ld(&bar[XB_TMO])) break; if (sp > XB_SPIN_CAP) { atomicAdd(&bar[XB_TMO], 1u); break; } }
    }
    nloc = mine > 0u ? mine : 1u; nx = cnt > 0u ? cnt : 1u;
}
__device__ __forceinline__ void xcd_barrier(const XcdBarrier& b) {
    asm volatile("s_waitcnt vmcnt(0)" ::: "memory");
    __syncthreads();
    if (threadIdx.x == 0) {
        unsigned* bar = b.bar;
        __builtin_amdgcn_s_waitcnt(0);
        unsigned nloc = b.st[0], nx = b.st[1];
        if (nloc == 0u) { xcd_barrier_complete(bar, b.x, nloc, nx); b.st[0] = nloc; b.st[1] = nx; }
        const unsigned old = xb_add(&bar[XB_XSUB(b.x)], 1u);
        const unsigned gen = old / nloc;
        if (old + 1u == (gen + 1u) * nloc) {
            __builtin_amdgcn_fence(__ATOMIC_RELEASE, "agent");
            asm volatile("s_waitcnt vmcnt(0)" ::: "memory");
            const unsigned og = xb_add(&bar[XB_TOP], 1u);
            const unsigned tg = og / nx;
            if (og + 1u == (tg + 1u) * nx) xb_add(&bar[XB_TOPGEN], 1u);
            else XB_SPIN(xb_ld(&bar[XB_TOPGEN]) == tg, bar);
            __builtin_amdgcn_fence(__ATOMIC_ACQUIRE, "agent");
            xb_add(&bar[XB_XGEN(b.x)], 1u);
            asm volatile("s_waitcnt vmcnt(0)" ::: "memory");
        } else {
            XB_SPIN(xb_ld(&bar[XB_XGEN(b.x)]) == gen, bar);
            __builtin_amdgcn_fence(__ATOMIC_ACQUIRE, "agent");
            asm volatile("s_waitcnt vmcnt(0)" ::: "memory");
        }
    }
    __syncthreads();
}

namespace pg8 {
constexpr int BM = 256, BK = 64, HALF = 128, HTB = HALF * BK * 2, STAGE_BYTES = 8 * HTB, NXCD = 8, WGM = 8;
__device__ __forceinline__ int lds_byte(int r, int c) { const int st = (r >> 4) * 2 + (c >> 5), rr = r & 15, cc = c & 31, ob = rr * 64 + cc * 2; return st * 1024 + (ob ^ (((ob >> 9) & 1) << 5)); }
__device__ __forceinline__ void stage_rc(int b, int& R, int& C) { const int st = b / 1024, sb = b % 1024, swz = sb ^ (((sb >> 9) & 1) << 5); R = (st >> 1) * 16 + swz / 64; C = (st & 1) * 32 + (swz % 64) / 2; }
struct Unit { int pm, pn; };
struct Gemm { const bf16_t* A; const bf16_t* Bt; int M, N, K, lda, ldb; };
struct StaticOrder {
    int nM, nN, nwg, G, c;
    __device__ void init(int M, int N, int G_, int c_) { nM = M / BM; nN = N / BM; nwg = nM * nN; G = G_; c = c_; }
    __device__ bool next(int i, Unit& u) const {
        if (c < 0) return false;
        const long L = (long)i * G + c; if (L >= nwg) return false;
        int wgid = (int)L; { const int q = nwg / NXCD, r = nwg % NXCD, xcd = wgid % NXCD, off = wgid / NXCD; wgid = (xcd < r ? xcd * (q + 1) : r * (q + 1) + (xcd - r) * q) + off; }
        const int nig = WGM * nN, gid = wgid / nig, fm = gid * WGM, gsz = (nM - fm) < WGM ? (nM - fm) : WGM;
        u.pm = fm + ((wgid % nig) % gsz); u.pn = (wgid % nig) / gsz; return true;
    }
    __device__ __forceinline__ void a_ready(const Unit&) const {}
    __device__ __forceinline__ void done(const Unit&) const {}
};

template <class Epi, class Sched>
__device__ __forceinline__ void gemm_phase(LAS unsigned char* lds, Gemm g, const Sched& S, const Epi& E) {
    asm volatile("" : "+s"(g.A), "+s"(g.Bt), "+s"(g.K), "+s"(g.lda), "+s"(g.ldb));
    int tid = threadIdx.x; asm volatile("" : "+v"(tid));
    const int wid = __builtin_amdgcn_readfirstlane(tid >> 6), lane = tid & 63, wr = wid >> 2, wc = wid & 3, fr = lane & 15, fq = lane >> 4;
    const int K = g.K, nt = K / BK;
    unsigned voffA[2], voffB[2];
#pragma unroll
    for (int i = 0; i < 2; ++i) { int R, C; stage_rc(tid * 16 + i * 8192, R, C);
        voffA[i] = (unsigned)(R * g.lda + C) * 2u; voffB[i] = (unsigned)(R * g.ldb + C) * 2u; }
    const size_t kstep = (size_t)(BK * 2);
    const size_t hstepA = (size_t)HALF * g.lda * 2, hstepB = (size_t)HALF * g.ldb * 2;
    const size_t tstepA = 2 * hstepA, tstepB = 2 * hstepB;
    const unsigned ldsw = (unsigned)wid * 1024u;
    const int aoff = lds_byte(wr * 64 + fr, fq * 8), boff = lds_byte(wc * 32 + fr, fq * 8);
#define PG8_SA(b, h) (((b) * 2 + (h)) * HTB)
#define PG8_SB(b, h) ((4 + (b) * 2 + (h)) * HTB)
#define PG8_STAGE(bufoff, gbase, voff) do { _Pragma("unroll") for (int _i = 0; _i < 2; ++_i) \
        __builtin_amdgcn_global_load_lds((const unsigned*)((const char*)(gbase) + (voff)[_i]), (LAS unsigned*)(lds + (bufoff) + ldsw + _i * 8192), 16, 0, 0); } while (0)
#define PG8_LDA(dst, b, h) do { _Pragma("unroll") for (int m = 0; m < 4; ++m) _Pragma("unroll") for (int k = 0; k < 2; ++k) dst[m][k] = *(const LAS bf16x8*)(lds + PG8_SA(b, h) + aoff + m * 2048 + k * 1024); } while (0)
#define PG8_LDB(dst, b, h) do { _Pragma("unroll") for (int n = 0; n < 2; ++n) _Pragma("unroll") for (int k = 0; k < 2; ++k) dst[n][k] = *(const LAS bf16x8*)(lds + PG8_SB(b, h) + boff + n * 2048 + k * 1024); } while (0)
#define PG8_MMA(ai, bj, At, Bt) do { __builtin_amdgcn_s_setprio(1); _Pragma("unroll") for (int m = 0; m < 4; ++m) _Pragma("unroll") for (int n = 0; n < 2; ++n) _Pragma("unroll") for (int k = 0; k < 2; ++k) \
        acc[ai][bj][m][n] = __builtin_amdgcn_mfma_f32_16x16x32_bf16(Bt[n][k], At[m][k], acc[ai][bj][m][n], 0, 0, 0); __builtin_amdgcn_s_setprio(0); } while (0)
#define PG8_WAIT_V(n) asm volatile("s_waitcnt vmcnt(" #n ")" ::: "memory")
#define PG8_WAIT_L(n) asm volatile("s_waitcnt lgkmcnt(" #n ")" ::: "memory")
#define PG8_BAR __builtin_amdgcn_s_barrier()
#define PG8_SCHED __builtin_amdgcn_sched_barrier(0)
    Unit cur, nxt; int ui = 0;
    if (!S.next(0, cur)) return;
    f32x4 acc[2][2][4][2];
#pragma unroll
    for (int a = 0; a < 2; ++a)
#pragma unroll
        for (int b = 0; b < 2; ++b)
#pragma unroll
            for (int m = 0; m < 4; ++m)
#pragma unroll
                for (int n = 0; n < 2; ++n) acc[a][b][m][n] = (f32x4){0.f, 0.f, 0.f, 0.f};
    bf16x8 At[4][2], B0[2][2], B1[2][2];
    const char* cA = (const char*)g.A + (size_t)cur.pm * tstepA; const char* cB = (const char*)g.Bt + (size_t)cur.pn * tstepB;
    S.a_ready(cur);
    PG8_STAGE(PG8_SB(0, 0), cB, voffB); PG8_STAGE(PG8_SA(0, 0), cA, voffA); PG8_STAGE(PG8_SB(0, 1), cB + hstepB, voffB); PG8_STAGE(PG8_SA(0, 1), cA + hstepA, voffA);
    if (wr == 1) PG8_BAR;
    PG8_WAIT_V(4); PG8_BAR;
    PG8_STAGE(PG8_SB(1, 0), cB + kstep, voffB); PG8_STAGE(PG8_SA(1, 0), cA + kstep, voffA); PG8_STAGE(PG8_SB(1, 1), cB + hstepB + kstep, voffB);
    PG8_WAIT_V(6); PG8_BAR;
    for (;;) {
        const bool has_next = S.next(ui + 1, nxt);
        const char* nA = has_next ? (const char*)g.A + (size_t)nxt.pm * tstepA : cA; const char* nB = has_next ? (const char*)g.Bt + (size_t)nxt.pn * tstepB : cB;
        for (int t = 0; t < nt; t += 2) {
            const bool last = (t == nt - 2);
            const char* a1 = cA + (size_t)(t + 1) * kstep;
            const char* a2 = last ? nA : cA + (size_t)(t + 2) * kstep; const char* b2 = last ? nB : cB + (size_t)(t + 2) * kstep;
            const char* a3 = a2 + kstep; const char* b3 = b2 + kstep;
            if (last && has_next) S.a_ready(nxt);
            PG8_LDB(B0, 0, 0); PG8_SCHED; PG8_LDA(At, 0, 0); PG8_STAGE(PG8_SA(1, 1), a1 + hstepA, voffA);
            PG8_WAIT_L(8); PG8_BAR; PG8_WAIT_L(0); PG8_MMA(0, 0, At, B0); PG8_BAR; PG8_SCHED;
            PG8_LDB(B1, 0, 1); PG8_STAGE(PG8_SB(0, 0), b2, voffB);
            PG8_BAR; PG8_WAIT_L(0); PG8_MMA(0, 1, At, B1); PG8_BAR;
            PG8_LDA(At, 0, 1); PG8_STAGE(PG8_SA(0, 0), a2, voffA);
            PG8_BAR; PG8_WAIT_L(0); PG8_MMA(1, 0, At, B0); PG8_BAR; PG8_SCHED;
            PG8_STAGE(PG8_SB(0, 1), b2 + hstepB, voffB);
            PG8_WAIT_V(6); PG8_BAR; PG8_MMA(1, 1, At, B1); PG8_BAR;
            PG8_LDB(B0, 1, 0); PG8_SCHED; PG8_LDA(At, 1, 0); PG8_STAGE(PG8_SA(0, 1), a2 + hstepA, voffA);
            PG8_WAIT_L(8); PG8_BAR; PG8_WAIT_L(0); PG8_MMA(0, 0, At, B0); PG8_BAR; PG8_SCHED;
            PG8_LDB(B1, 1, 1); PG8_STAGE(PG8_SB(1, 0), b3, voffB);
            PG8_BAR; PG8_WAIT_L(0); PG8_MMA(0, 1, At, B1); PG8_BAR;
            PG8_LDA(At, 1, 1); PG8_STAGE(PG8_SA(1, 0), a3, voffA);
            PG8_BAR; PG8_WAIT_L(0); PG8_MMA(1, 0, At, B0); PG8_BAR; PG8_SCHED;
            PG8_STAGE(PG8_SB(1, 1), b3 + hstepB, voffB);
            PG8_WAIT_V(6); PG8_BAR; PG8_MMA(1, 1, At, B1); PG8_BAR;
        }
        { int fr2 = fr, fq2 = fq, wr2 = wr, wc2 = wc; asm volatile("" : "+v"(fr2), "+v"(fq2), "+s"(wr2), "+s"(wc2));
            E(acc, cur, wr2, wc2, fr2, fq2); } S.done(cur);
        if (!has_next) break;
#pragma unroll
        for (int a = 0; a < 2; ++a)
#pragma unroll
            for (int b = 0; b < 2; ++b)
#pragma unroll
                for (int m = 0; m < 4; ++m)
#pragma unroll
                    for (int n = 0; n < 2; ++n) acc[a][b][m][n] = (f32x4){0.f, 0.f, 0.f, 0.f};
        cur = nxt; cA = nA; cB = nB; ++ui;
    }
    PG8_WAIT_V(0);
    if (wr == 0) PG8_BAR;
    PG8_BAR;
#undef PG8_SA
#undef PG8_SB
#undef PG8_STAGE
#undef PG8_LDA
#undef PG8_LDB
#undef PG8_MMA
#undef PG8_WAIT_V
#undef PG8_WAIT_L
#undef PG8_BAR
#undef PG8_SCHED
}
}

struct EpiSwiglu {
    bf16_t* O;
    __device__ __forceinline__ void operator()(const f32x4 (&acc)[2][2][4][2], const pg8::Unit& u, int wr, int wc, int fr, int fq) const {
        const int row0 = u.pm * 256 + wr * 64 + fr, col0 = u.pn * 128 + wc * 32 + 8 * fq;
#pragma unroll
        for (int ai = 0; ai < 2; ++ai)
#pragma unroll
            for (int m = 0; m < 4; ++m) {
                bf16_t* rowp = O + (size_t)(row0 + ai * 128 + m * 16) * DFF + col0;
                const f32x4 g0 = acc[ai][0][m][0], g1 = acc[ai][0][m][1], u0 = acc[ai][1][m][0], u1 = acc[ai][1][m][1];
                u32x4 w;
                w.x = cvt_pk_bf16(silu_f(g0[0]) * u0[0], silu_f(g0[1]) * u0[1]); w.y = cvt_pk_bf16(silu_f(g0[2]) * u0[2], silu_f(g0[3]) * u0[3]);
                w.z = cvt_pk_bf16(silu_f(g1[0]) * u1[0], silu_f(g1[1]) * u1[1]); w.w = cvt_pk_bf16(silu_f(g1[2]) * u1[2], silu_f(g1[3]) * u1[3]);
                *(u32x4*)rowp = w;
            }
    }
};
struct EpiYssq {
    bf16_t* Y; float* ssq;
    __device__ __forceinline__ void operator()(const f32x4 (&acc)[2][2][4][2], const pg8::Unit& u, int wr, int wc, int fr, int fq) const {
        const int row0 = u.pm * 256 + wr * 64 + fr, col0 = u.pn * 256 + wc * 32 + 8 * fq;
#pragma unroll
        for (int ai = 0; ai < 2; ++ai)
#pragma unroll
            for (int m = 0; m < 4; ++m) {
                const int row = row0 + ai * 128 + m * 16;
                bf16_t* rowp = Y + (size_t)row * D + col0;
                float s = 0.f;
#pragma unroll
                for (int bj = 0; bj < 2; ++bj) {
                    const f32x4 v0 = acc[ai][bj][m][0], v1 = acc[ai][bj][m][1];
                    s += v0[0] * v0[0] + v0[1] * v0[1] + v0[2] * v0[2] + v0[3] * v0[3] + v1[0] * v1[0] + v1[1] * v1[1] + v1[2] * v1[2] + v1[3] * v1[3];
                    u32x4 w; w.x = cvt_pk_bf16(v0[0], v0[1]); w.y = cvt_pk_bf16(v0[2], v0[3]); w.z = cvt_pk_bf16(v1[0], v1[1]); w.w = cvt_pk_bf16(v1[2], v1[3]);
                    *(u32x4*)(rowp + bj * 128) = w;
                }
                s += __shfl_xor(s, 16); s += __shfl_xor(s, 32);
                if (fq == 0) ssq[(size_t)row * 16 + u.pn * 4 + wc] = s;
            }
    }
};
struct EpiWin {
    bf16_t* ZT; bf16_t* HT; bf16_t* QB; bf16_t* KB; bf16_t* VB; const float* rope; float* newk; float* newv; int layer;
    __device__ __forceinline__ void operator()(const f32x4 (&acc)[2][2][4][2], const pg8::Unit& u, int wr, int wc, int fr, int fq) const {
        const int r0 = u.pm * 256 + wr * 64 + fr;
        const bool lat = u.pm >= 32;
        const int pn = u.pn;
        if (pn < 5) {
            bf16_t* base; int t0; size_t sch;
            if (pn < 2) {
                if (!lat) { const int b = u.pm; base = ZT + ((size_t)b * 256 * 2 + pn) * 256; sch = 512; t0 = r0 - u.pm * 256; }
                else { const int b = (u.pm - 32) >> 2; base = ZT + ZT_LAT + ((size_t)b * 256 * 2 + pn) * 1024; sch = 2048; t0 = r0 - NCTX - b * 1024; }
            } else {
                const int c0 = (pn - 2) * 256;
                if (!lat) { const int b = u.pm; base = HT + ((size_t)b * 768 + c0) * 256; sch = 256; t0 = r0 - u.pm * 256; }
                else { const int b = (u.pm - 32) >> 2; base = HT + HT_LAT + ((size_t)b * 768 + c0) * 1024; sch = 1024; t0 = r0 - NCTX - b * 1024; }
            }
#pragma unroll
            for (int ai = 0; ai < 2; ++ai)
#pragma unroll
                for (int m = 0; m < 4; ++m) {
                    const int t = t0 + ai * 128 + m * 16;
#pragma unroll
                    for (int bj = 0; bj < 2; ++bj)
#pragma unroll
                        for (int n = 0; n < 2; ++n) {
                            const int ch = bj * 128 + wc * 32 + n * 16 + 4 * fq;
                            const f32x4 v = acc[ai][bj][m][n];
#pragma unroll
                            for (int e = 0; e < 4; ++e) base[(size_t)(ch + e) * sch + t] = f2bf(v[e]);
                        }
                }
        } else {
            const int blk = wc & 1;
#pragma unroll
            for (int ai = 0; ai < 2; ++ai)
#pragma unroll
                for (int m = 0; m < 4; ++m) {
                    const int row = r0 + ai * 128 + m * 16;
                    f32x4 cs0 = {1.f, 0.f, 1.f, 0.f}, cs1 = {1.f, 0.f, 1.f, 0.f};
                    if (lat) { const int t = row & 1023; const int pos = blk ? (t & 63) : (t >> 6);
                        const f32x4* rp = (const f32x4*)(rope + (size_t)(pos * 16 + 4 * fq) * 2); cs0 = rp[0]; cs1 = rp[1]; }
#pragma unroll
                    for (int bj = 0; bj < 2; ++bj) {
                        f32x4 x1 = acc[ai][bj][m][0], x2 = acc[ai][bj][m][1];
                        const bool isv = (pn == 7 && bj == 1);
                        const bool isk = (pn == 7 && bj == 0);
                        const int cc = bj * 128 + wc * 32 + 4 * fq;
                        if ((isk || isv) && !lat) {
                            const int b = row >> 8, t = row & 255;
                            float* dst = (isk ? newk : newv) + (((size_t)b * 2 + layer) * 256 + t) * 128 + (cc & 127);
                            *(f32x4*)dst = x1; *(f32x4*)(dst + 16) = x2;
                        }
                        if (!isv) {
                            f32x4 o1, o2;
                            o1[0] = x1[0] * cs0[0] - x2[0] * cs0[1]; o2[0] = x2[0] * cs0[0] + x1[0] * cs0[1];
                            o1[1] = x1[1] * cs0[2] - x2[1] * cs0[3]; o2[1] = x2[1] * cs0[2] + x1[1] * cs0[3];
                            o1[2] = x1[2] * cs1[0] - x2[2] * cs1[1]; o2[2] = x2[2] * cs1[0] + x1[2] * cs1[1];
                            o1[3] = x1[3] * cs1[2] - x2[3] * cs1[3]; o2[3] = x2[3] * cs1[2] + x1[3] * cs1[3];
                            x1 = o1; x2 = o2;
                        }
                        bf16_t* dst;
                        if (pn < 7) { x1 *= 0.125f; x2 *= 0.125f; dst = QB + (size_t)row * 512 + (pn - 5) * 256 + cc; }
                        else if (isk) dst = KB + (size_t)row * 128 + cc;
                        else {
                            bf16_t* vb; size_t n_;
                            if (!lat) { vb = VB + (size_t)(row >> 8) * 128 * 256 + (row & 255); n_ = 256; } else { vb = VB + VT_LAT + (size_t)((row - NCTX) >> 10) * 128 * 1024 + (row & 1023); n_ = 1024; }
                            const int c0 = cc - 128;
#pragma unroll
                            for (int e = 0; e < 4; ++e) { vb[(size_t)(c0 + e) * n_] = f2bf(x1[e]); vb[(size_t)(c0 + 16 + e) * n_] = f2bf(x2[e]); }
                            continue;
                        }
                        u32x2 w1, w2; w1.x = cvt_pk_bf16(x1[0], x1[1]); w1.y = cvt_pk_bf16(x1[2], x1[3]); w2.x = cvt_pk_bf16(x2[0], x2[1]); w2.y = cvt_pk_bf16(x2[2], x2[3]);
                        *(u32x2*)dst = w1; *(u32x2*)(dst + 16) = w2;
                    }
                }
        }
    }
};
struct EpiFourier {
    bf16_t* YC; int rowbase, n;
    __device__ __forceinline__ void operator()(const f32x4 (&acc)[2][2][4][2], const pg8::Unit& u, int wr, int wc, int fr, int fq) const {
        const int kp0 = u.pm * 256 + wr * 64 + fr; const int b = u.pn;
#pragma unroll
        for (int ai = 0; ai < 2; ++ai)
#pragma unroll
            for (int m = 0; m < 4; ++m) {
                bf16_t* rowp = YC + (size_t)(rowbase + b * n + kp0 + ai * 128 + m * 16) * 1024 + wc * 32 + 4 * fq;
#pragma unroll
                for (int bj = 0; bj < 2; ++bj)
#pragma unroll
                    for (int nn = 0; nn < 2; ++nn) { const f32x4 v = acc[ai][bj][m][nn]; u32x2 w; w.x = cvt_pk_bf16(v[0], v[1]); w.y = cvt_pk_bf16(v[2], v[3]);
                        *(u32x2*)(rowp + bj * 128 + nn * 16) = w; }
            }
    }
};

template <bool PERM>
__device__ __forceinline__ void transpose_unit(const float* __restrict__ src, int ld, int k0, int cbase, bf16_t* __restrict__ dst, int Kd, int r0, float* tile) {
    const int tid = opaque_tid();
#pragma unroll
    for (int i = 0; i < 2; ++i) { const int idx = tid + 512 * i, kk = idx >> 4, c4 = idx & 15;
        const f32x4 v = *(const f32x4*)(src + (size_t)(k0 + kk) * ld + cbase + c4 * 4);
        float* tp = tile + kk * 65 + c4 * 4; tp[0] = v[0]; tp[1] = v[1]; tp[2] = v[2]; tp[3] = v[3]; }
    __syncthreads();
    { const int rr = tid >> 3, kc = tid & 7; const int cc = PERM ? ((rr & ~31) + perm32(rr & 31)) : rr;
        float v[8];
#pragma unroll
        for (int j = 0; j < 8; ++j) v[j] = tile[(kc * 8 + j) * 65 + cc];
        u32x4 w; w.x = cvt_pk_bf16(v[0], v[1]); w.y = cvt_pk_bf16(v[2], v[3]); w.z = cvt_pk_bf16(v[4], v[5]); w.w = cvt_pk_bf16(v[6], v[7]);
        *(u32x4*)(dst + (size_t)(r0 + rr) * Kd + k0 + kc * 8) = w; }
    __syncthreads();
}

__device__ void phase_prep(const Params& p, float* lds) {
    const int tid = opaque_tid(), nb = gridDim.x, bid = blockIdx.x;
    unsigned char* ws = p.ws;
    constexpr int U_GU = 4 * 88 * 16, U_D = 4 * 16 * 44, U_OUT = 2 * 16 * 16, U_IN = 2 * 24 * 16;
    for (int u = bid; u < U_GU + U_D + U_OUT + U_IN; u += nb) {
        if (u < U_GU) {
            const int ls = u / (88 * 16), rem = u % (88 * 16), rg = rem / 16, kb = rem % 16;
            const int r0 = rg * 64, pn = r0 >> 8, inner = r0 & 255, half = inner >> 7, q0 = inner & 127;
            const float* src = (half ? p.in[10] : p.in[9]) + (size_t)ls * 1024 * DFF;
            transpose_unit<true>(src, DFF, kb * 64, pn * 128 + q0, (bf16_t*)(ws + OFF_WGU + ls * SZ_WGU), 1024, r0, lds);
        } else if (u < U_GU + U_D) {
            const int v = u - U_GU; const int ls = v / (16 * 44), rem = v % (16 * 44), rg = rem / 44, kb = rem % 44;
            transpose_unit<true>(p.in[11] + (size_t)ls * DFF * 1024, 1024, kb * 64, rg * 64, (bf16_t*)(ws + OFF_WD + ls * SZ_WD), DFF, rg * 64, lds);
        } else if (u < U_GU + U_D + U_OUT) {
            const int v = u - U_GU - U_D; const int l = v / 256, rem = v % 256, rg = rem / 16, kb = rem % 16;
            transpose_unit<true>(p.in[13] + (size_t)l * 1024 * 1024, 1024, kb * 64, rg * 64, (bf16_t*)(ws + OFF_WOUT + l * SZ_WOUT), 1024, rg * 64, lds);
        } else {
            const int v = u - U_GU - U_D - U_OUT; const int l = v / (24 * 16), rem = v % (24 * 16), rg = rem / 16, kb = rem % 16;
            transpose_unit<false>(p.in[12] + (size_t)l * 1024 * INW, INW, kb * 64, 256 + rg * 64, (bf16_t*)(ws + OFF_WIN + l * SZ_WIN), 1024, 512 + rg * 64, lds);
        }
    }
    {
        float* tab = lds;
        if (tid < 64) { float sv, cv; sincosf(PI2 * (float)tid / 64.f, &sv, &cv); tab[tid] = cv; tab[64 + tid] = sv; }
        __syncthreads();
        const int lane = tid & 63, wv = tid >> 6;
        for (int u = bid * 8 + wv; u < 8192; u += nb * 8) {
            const int l = u >> 12, k = (u >> 2) & 1023, g = u & 3;
            const float* wrow = p.in[12] + ((size_t)l * 1024 + k) * INW + g * 64;
            const float wv_ = wrow[lane];
            float ac = 0.f, as = 0.f;
#pragma unroll 16
            for (int c = 0; c < 64; ++c) { const float w = __shfl(wv_, c); const int idx = (c * lane) & 63; ac += w * tab[idx]; as += w * tab[64 + idx]; }
            bf16_t* bt = (bf16_t*)(ws + OFF_WIN + l * SZ_WIN);
            bt[(size_t)(g * 64 + lane) * 1024 + k] = f2bf(ac);
            bt[(size_t)(256 + g * 64 + lane) * 1024 + k] = f2bf(as);
        }
        __syncthreads();
    }
    {
        float* sc = lds;
        float* part = lds + 9 * 1024;
        for (int i = tid; i < 9 * 1024; i += NTHREADS) { const int bc = i >> 10, k = i & 1023; const float cv = bc == 0 ? p.in[5][k] : p.in[4][(bc - 1) * 1024 + k]; sc[i] = cv / (1.0f + expf(-cv)); }
        __syncthreads();
        for (int cb = bid; cb < 256; cb += nb) {
            const int gc0 = cb * 72, l = gc0 / 9216, j0 = gc0 % 9216;
            const int col = tid % 72, kg = tid / 72;
            if (kg < 7) {
                float a[9];
#pragma unroll
                for (int i = 0; i < 9; ++i) a[i] = 0.f;
                const float* wp = p.in[6] + (size_t)l * 1024 * 9216 + j0 + col;
#pragma unroll 4
                for (int k = kg; k < 1024; k += 7) { const float w = wp[(size_t)k * 9216];
#pragma unroll
                    for (int i = 0; i < 9; ++i) a[i] += sc[i * 1024 + k] * w; }
#pragma unroll
                for (int i = 0; i < 9; ++i) part[(kg * 72 + col) * 9 + i] = a[i];
            }
            __syncthreads();
            for (int i = tid; i < 72 * 9; i += NTHREADS) { const int c2 = i / 9, bc = i % 9; float s = 0.f;
#pragma unroll
                for (int g = 0; g < 7; ++g) s += part[(g * 72 + c2) * 9 + bc];
                ((float*)(ws + OFF_MOD))[((size_t)l * 9 + bc) * 9216 + j0 + c2] = s + p.in[7][l * 9216 + j0 + c2]; }
            __syncthreads();
        }
    }
    {
        const int lane = tid & 63, wv = tid >> 6;
        for (int u = bid * 8 + wv; u < 2 * 320; u += nb * 8) {
            const int l = u / 320, gq = u % 320; const int pass = gq >= 64; const int n = pass ? 1024 : 256; const int d0 = (pass ? gq - 64 : gq) * 4;
            const float* w1 = p.in[15] + l * 33 * 64; const float* b1 = p.in[16] + l * 64; const float* w2 = p.in[17] + l * 64 * 64; const float* b2 = p.in[18] + l * 64;
            const float* w3 = p.in[19] + (size_t)l * 64 * 1024; const float fr = p.in[20][l * 64 + lane];
            float h2[4];
#pragma unroll
            for (int q = 0; q < 4; ++q) {
                const int d = d0 + q; const float tt = (float)d / (float)(n - 1);
                float feat = 0.f;
                if (lane == 0) feat = tt;
                else if (lane < 33) { const int j = (lane - 1) & 15; const float fj = 1e-4f + (float)j * ((15.0f - 1e-4f) / 15.0f); const float ang = (PI2 / (float)n) * (float)d * fj;
                    feat = lane < 17 ? cosf(ang) : -sinf(ang); }
                float a1 = b1[lane];
                for (int i = 0; i < 33; ++i) a1 += __shfl(feat, i) * w1[i * 64 + lane];
                const float h1 = sinf(fr * a1);
                float a2 = b2[lane];
                for (int i = 0; i < 64; ++i) a2 += __shfl(h1, i) * w2[i * 64 + lane];
                h2[q] = sinf(fr * a2);
            }
            float* fbase = (float*)(ws + OFF_FILT) + (size_t)l * FILT_L + (pass ? FILT_CTX : 0);
            for (int oc = 0; oc < 16; ++oc) {
                const int o = oc * 64 + lane;
                float a[4] = {0.f, 0.f, 0.f, 0.f};
                for (int i = 0; i < 64; ++i) { const float w = w3[i * 1024 + o];
#pragma unroll
                    for (int q = 0; q < 4; ++q) a[q] += __shfl(h2[q], i) * w; }
                const int ord = (o >> 8) & 1, c = o & 255;
                const float dec = fabsf(p.in[21][(l * 2 + ord) * 256 + c]);
#pragma unroll
                for (int q = 0; q < 4; ++q) { const int d = d0 + q; const float tt = (float)d / (float)(n - 1);
                    fbase[(size_t)o * n + d] = a[q] * expf(-tt * dec); }
            }
        }
    }
    {
        bf16_t* FC = (bf16_t*)(ws + OFF_FC); bf16_t* FL = (bf16_t*)(ws + OFF_FL);
        const int gt = bid * NTHREADS + tid, gn = nb * NTHREADS;
        for (int i = gt; i < 256 * 512 + 1024 * 2048; i += gn) {
            int n, k, col; bf16_t* dst;
            if (i < 256 * 512) { n = 256; k = i >> 9; col = i & 511; dst = FC + i; } else { const int j = i - 256 * 512; n = 1024; k = j >> 11; col = j & 2047; dst = FL + j; }
            const int s = col >= n, t = col - s * n; const int ph = (k * t) & (n - 1);
            float sv, cv; sincosf(PI2 * (float)ph / (float)n, &sv, &cv);
            const float sc = rsqrtf(64.0f * (float)n);
            *dst = f2bf((s ? -sv : cv) * sc);
        }
        { bf16_t* CK = (bf16_t*)(ws + OFF_CKB); bf16_t* CV = (bf16_t*)(ws + OFF_CVT);
            for (int i = gt; i < 2 * 8 * 256 * 128; i += gn) {
                { const int c = i & 127, key = (i >> 7) & 255, b = (i >> 15) & 7, l = i >> 18;
                    CK[i] = f2bf(p.in[2][(((size_t)b * 2 + l) * 256 + key) * 128 + c]); }
                { const int key = i & 255, c = (i >> 8) & 127, b = (i >> 15) & 7, l = i >> 18;
                    CV[i] = f2bf(p.in[3][(((size_t)b * 2 + l) * 256 + key) * 128 + c]); }
            } }
        if (bid == 0) for (int i = tid; i < 64 * 16; i += NTHREADS) { const int pos = i >> 4, j = i & 15; const float inv = powf(10000.0f, -(float)(2 * j) / 32.0f);
            float sv, cv; sincosf((float)pos * inv, &sv, &cv); float* rp = (float*)(ws + OFF_ROPE); rp[2 * i] = cv; rp[2 * i + 1] = sv; }
    }
}

template <int MODE>
__device__ void phase_row(const Params& p, int lpost, int spost, int lpre, int spre) {
    const int tid_ = opaque_tid(); const int lane = tid_ & 63, wv = tid_ >> 6;
    const float* mod = (const float*)(p.ws + OFF_MOD);
    const bf16_t* Y = (const bf16_t*)(p.ws + OFF_Y); const float* ssq = (const float*)(p.ws + OFF_SSQ);
    bf16_t* H = (bf16_t*)(p.ws + OFF_H);
    const float factor = (spost == 1) ? 1.0f : 0.5f;
    for (int row = blockIdx.x * 8 + wv; row < NTOK; row += gridDim.x * 8) {
        const int bc = row < NCTX ? 0 : 1 + ((row - NCTX) >> 10);
        float* xr = p.out + (size_t)row * D;
        f32x4 x[4];
        if (MODE == 0) { const float* src = row < NCTX ? p.in[0] + (size_t)row * D : p.in[1] + (size_t)(row - NCTX) * D;
#pragma unroll
            for (int j = 0; j < 4; ++j) x[j] = *(const f32x4*)(src + j * 256 + lane * 4); }
        else {
#pragma unroll
            for (int j = 0; j < 4; ++j) x[j] = *(const f32x4*)(xr + j * 256 + lane * 4);
            const f32x4* sp = (const f32x4*)(ssq + (size_t)row * 16);
            const f32x4 s0 = sp[0], s1 = sp[1], s2 = sp[2], s3 = sp[3];
            const float tot = (s0[0] + s0[1] + s0[2] + s0[3]) + (s1[0] + s1[1] + s1[2] + s1[3]) + (s2[0] + s2[1] + s2[2] + s2[3]) + (s3[0] + s3[1] + s3[2] + s3[3]);
            const float rstd = rsqrtf(tot * (1.0f / 1024.0f) + EPS) * factor;
            const float* gate = mod + ((size_t)lpost * 9 + bc) * 9216 + spost * 3072 + 2048;
            const float* gp = p.in[8] + (lpost * 6 + 2 * spost + 1) * 1024;
#pragma unroll
            for (int j = 0; j < 4; ++j) { const int c = j * 256 + lane * 4;
                const u32x2 yv = *(const u32x2*)(Y + (size_t)row * D + c);
                const f32x4 gt = *(const f32x4*)(gate + c), gg = *(const f32x4*)(gp + c);
                x[j][0] += gt[0] * gg[0] * rstd * __uint_as_float(yv.x << 16);
                x[j][1] += gt[1] * gg[1] * rstd * __uint_as_float(yv.x & 0xFFFF0000u);
                x[j][2] += gt[2] * gg[2] * rstd * __uint_as_float(yv.y << 16);
                x[j][3] += gt[3] * gg[3] * rstd * __uint_as_float(yv.y & 0xFFFF0000u); }
        }
#pragma unroll
        for (int j = 0; j < 4; ++j) *(f32x4*)(xr + j * 256 + lane * 4) = x[j];
        if (MODE != 2) {
            float s = 0.f;
#pragma unroll
            for (int j = 0; j < 4; ++j) s += x[j][0] * x[j][0] + x[j][1] * x[j][1] + x[j][2] * x[j][2] + x[j][3] * x[j][3];
#pragma unroll
            for (int o = 32; o >= 1; o >>= 1) s += __shfl_xor(s, o);
            const float rs = rsqrtf(s * (1.0f / 1024.0f) + EPS);
            const float* mb = mod + ((size_t)lpre * 9 + bc) * 9216 + spre * 3072;
            const float* gp = p.in[8] + (lpre * 6 + 2 * spre) * 1024;
#pragma unroll
            for (int j = 0; j < 4; ++j) { const int c = j * 256 + lane * 4;
                const f32x4 sh = *(const f32x4*)(mb + c), scl = *(const f32x4*)(mb + 1024 + c), gg = *(const f32x4*)(gp + c);
                f32x4 h;
#pragma unroll
                for (int e = 0; e < 4; ++e) h[e] = x[j][e] * rs * gg[e] * (1.0f + scl[e]) + sh[e];
                u32x2 w; w.x = cvt_pk_bf16(h[0], h[1]); w.y = cvt_pk_bf16(h[2], h[3]);
                *(u32x2*)(H + (size_t)row * D + c) = w; }
        }
    }
}

__device__ void attn_mfma(const Params& p, int l) {
    const int tid = opaque_tid(); const int lane = tid & 63, wv = tid >> 6, r = lane & 31, h = lane >> 5;
    const bf16_t* QB = (const bf16_t*)(p.ws + OFF_QB); const bf16_t* KB = (const bf16_t*)(p.ws + OFF_KB); const bf16_t* VT = (const bf16_t*)(p.ws + OFF_VB);
    const bf16_t* CK = (const bf16_t*)(p.ws + OFF_CKB); const bf16_t* CV = (const bf16_t*)(p.ws + OFF_CVT);
    bf16_t* YC = (bf16_t*)(p.ws + OFF_YCAT);
    const int g = wv & 3, qh = wv >> 2;
    for (int u = blockIdx.x; u < 512; u += gridDim.x) {
        const int pass = u < 256; const int v = u & 255;
        int b, kvh, qb, n, rowbase;
        if (!pass) { b = v >> 3; kvh = (v >> 2) & 1; qb = v & 3; n = 256; rowbase = b * 256; }
        else { b = v >> 5; kvh = (v >> 4) & 1; qb = v & 15; n = 1024; rowbase = NCTX + b * 1024; }
        const int head = kvh * 4 + g, q0w = qb * 64 + qh * 32;
        int klo = 0, khi = 256;
        if (pass) { klo = q0w - 128; if (klo < 0) klo = 0; khi = q0w + 160; if (khi > n) khi = n; }
        const int nA = (khi - klo) >> 5, nT = nA + (pass ? 8 : 0);
        const bf16_t* kA = KB + (size_t)(rowbase + klo) * 128 + kvh * 64;
        const bf16_t* vA = VT + (pass ? VT_LAT + (size_t)b * 128 * 1024 : (size_t)b * 128 * 256) + (size_t)kvh * 64 * n + klo;
        const bf16_t* kB = CK + ((size_t)(l * 8 + b) * 256) * 128 + kvh * 64;
        const bf16_t* vB = CV + ((size_t)(l * 8 + b) * 128 + kvh * 64) * 256;
        bf16x8 qf[4];
        { const bf16_t* qp = QB + (size_t)(rowbase + q0w + r) * 512 + head * 64 + 8 * h;
#pragma unroll
            for (int kk = 0; kk < 4; ++kk) qf[kk] = *(const bf16x8*)(qp + 16 * kk); }
        float m = p.in[23][l * 8 + head], lsum = 1.0f;
        f32x16 O0, O1;
#pragma unroll
        for (int i = 0; i < 16; ++i) { O0[i] = 0.f; O1[i] = 0.f; }
        bf16x8 kf[4];
        {
            const bf16_t* kp = (nA > 0 ? kA : kB) + (size_t)r * 128 + 8 * h;
#pragma unroll
            for (int kk = 0; kk < 4; ++kk) kf[kk] = *(const bf16x8*)(kp + 16 * kk);
        }
        for (int t = 0; t < nT; ++t) {
            const bool inA = t < nA;
            const bf16_t* vp = inA ? vA + (size_t)r * n + t * 32 + 4 * h : vB + (size_t)r * 256 + (t - nA) * 32 + 4 * h;
            const size_t vld = inA ? (size_t)n : (size_t)256;
            u32x2 vraw[2][2][2];
#pragma unroll
            for (int dt = 0; dt < 2; ++dt)
#pragma unroll
                for (int s = 0; s < 2; ++s)
#pragma unroll
                    for (int q = 0; q < 2; ++q) vraw[dt][s][q] = *(const u32x2*)(vp + (size_t)dt * 32 * vld + 16 * s + 8 * q);
            bf16x8 kn[4];
            { const int tn = (t + 1 < nT) ? t + 1 : t; const bool nInA = tn < nA;
                const bf16_t* kp = (nInA ? kA + (size_t)tn * 32 * 128 : kB + (size_t)(tn - nA) * 32 * 128) + (size_t)r * 128 + 8 * h;
#pragma unroll
                for (int kk = 0; kk < 4; ++kk) kn[kk] = *(const bf16x8*)(kp + 16 * kk); }
            f32x16 S;
#pragma unroll
            for (int i = 0; i < 16; ++i) S[i] = 0.f;
#pragma unroll
            for (int kk = 0; kk < 4; ++kk) S = __builtin_amdgcn_mfma_f32_32x32x16_bf16(kf[kk], qf[kk], S, 0, 0, 0);
            if (pass && inA) {
                const int dk = klo + t * 32 - q0w;
                if (dk <= -128 || dk >= 128) {
#pragma unroll
                    for (int i = 0; i < 16; ++i) { const int j = (i & 3) + 8 * (i >> 2) + 4 * h; int dd = dk + j - r; if (dd < 0) dd = -dd; if (dd > 128) S[i] = -1e30f; }
                }
            }
            float mx = S[0];
#pragma unroll
            for (int i = 1; i < 16; ++i) mx = fmaxf(mx, S[i]);
            mx = fmaxf(mx, __shfl_xor(mx, 32));
            const float mn = fmaxf(m, mx), corr = __expf(m - mn);
            m = mn;
            float rs = 0.f;
#pragma unroll
            for (int i = 0; i < 16; ++i) { S[i] = __expf(S[i] - mn); rs += S[i]; }
            rs += __shfl_xor(rs, 32);
            lsum = lsum * corr + rs;
#pragma unroll
            for (int i = 0; i < 16; ++i) { O0[i] *= corr; O1[i] *= corr; }
            bf16x8 pf[2];
#pragma unroll
            for (int s = 0; s < 2; ++s) { u32x4 w; w.x = pk_bf16(S[8 * s], S[8 * s + 1]); w.y = pk_bf16(S[8 * s + 2], S[8 * s + 3]); w.z = pk_bf16(S[8 * s + 4], S[8 * s + 5]); w.w = pk_bf16(S[8 * s + 6], S[8 * s + 7]);
                pf[s] = __builtin_bit_cast(bf16x8, w); }
#pragma unroll
            for (int s = 0; s < 2; ++s) {
                u32x4 a0; a0.x = vraw[0][s][0].x; a0.y = vraw[0][s][0].y; a0.z = vraw[0][s][1].x; a0.w = vraw[0][s][1].y;
                u32x4 a1; a1.x = vraw[1][s][0].x; a1.y = vraw[1][s][0].y; a1.z = vraw[1][s][1].x; a1.w = vraw[1][s][1].y;
                O0 = __builtin_amdgcn_mfma_f32_32x32x16_bf16(__builtin_bit_cast(bf16x8, a0), pf[s], O0, 0, 0, 0);
                O1 = __builtin_amdgcn_mfma_f32_32x32x16_bf16(__builtin_bit_cast(bf16x8, a1), pf[s], O1, 0, 0, 0);
            }
#pragma unroll
            for (int kk = 0; kk < 4; ++kk) kf[kk] = kn[kk];
        }
        const float inv = 1.0f / lsum;
        bf16_t* op = YC + (size_t)(rowbase + q0w + r) * 1024 + 512 + head * 64 + 4 * h;
#pragma unroll
        for (int gq = 0; gq < 4; ++gq) {
            u32x2 w0; w0.x = pk_bf16(O0[4 * gq] * inv, O0[4 * gq + 1] * inv); w0.y = pk_bf16(O0[4 * gq + 2] * inv, O0[4 * gq + 3] * inv);
            u32x2 w1; w1.x = pk_bf16(O1[4 * gq] * inv, O1[4 * gq + 1] * inv); w1.y = pk_bf16(O1[4 * gq + 2] * inv, O1[4 * gq + 3] * inv);
            *(u32x2*)(op + 8 * gq) = w0; *(u32x2*)(op + 32 + 8 * gq) = w1;
        }
    }
}


template <int NB  , int NBLK  >
__device__ __forceinline__ void hyena_unit(const Params& p, int l, int c, const bf16_t* __restrict__ HTp, int rowbase, const float* __restrict__ fb, LAS unsigned char* lds, int tid) {
    constexpr int n = 32 * NBLK, NI = 32 / NB, PAD = 32 * (NI - 1);
    constexpr int LENB = ((2 * n + 8) * 2 + 255) / 256 * 256 + 64;
    constexpr int LEN = LENB / 2;
    constexpr int UROWB = ((n + 2 * PAD) * 2 + 255) / 256 * 256 + 16;
    constexpr int OFF_F0 = 0, OFF_F1 = 8 * LENB, OFF_U = 16 * LENB, OFF_U2 = OFF_U + NB * UROWB, OFF_G1 = OFF_U2 + NB * UROWB, OFF_G2 = OFF_G1 + NB * n * 2;
    static_assert(OFF_G2 + NB * n * 2 <= 144 * 1024, "hyena LDS");
    const int lane = tid & 63, wv = tid >> 6, r = lane & 31, h = lane >> 5;
    const float* cw = p.in[14] + l * 3 * 768;
    for (int q = tid; q < 3 * NB * (n / 8); q += NTHREADS) {
        const int w = q / (NB * (n / 8)), rem = q % (NB * (n / 8)), b = rem / (n / 8), t0 = (rem % (n / 8)) * 8;
        const int ch = w * 256 + c; const bf16_t* row = HTp + ((size_t)b * 768 + ch) * n;
        const float w0 = cw[ch], w1 = cw[768 + ch], w2 = cw[1536 + ch];
        const u32x4 raw = *(const u32x4*)(row + t0);
        float x[10];
        x[0] = t0 > 0 ? bf2f(row[t0 - 1]) : 0.f; x[9] = t0 + 8 < n ? bf2f(row[t0 + 8]) : 0.f;
        x[1] = __uint_as_float(raw.x << 16); x[2] = __uint_as_float(raw.x & 0xFFFF0000u); x[3] = __uint_as_float(raw.y << 16); x[4] = __uint_as_float(raw.y & 0xFFFF0000u);
        x[5] = __uint_as_float(raw.z << 16); x[6] = __uint_as_float(raw.z & 0xFFFF0000u); x[7] = __uint_as_float(raw.w << 16); x[8] = __uint_as_float(raw.w & 0xFFFF0000u);
        float z[8];
#pragma unroll
        for (int e = 0; e < 8; ++e) z[e] = x[e] * w0 + x[e + 1] * w1 + x[e + 2] * w2;
        u32x4 o; o.x = pk_bf16(z[0], z[1]); o.y = pk_bf16(z[2], z[3]); o.z = pk_bf16(z[4], z[5]); o.w = pk_bf16(z[6], z[7]);
        LAS unsigned char* dst = w == 0 ? lds + OFF_U + b * UROWB + (PAD + t0) * 2 : lds + (w == 1 ? OFF_G1 : OFF_G2) + (b * n + t0) * 2;
        *(LAS u32x4*)dst = o;
    }
    if (PAD > 0) {
        constexpr int FR = PAD / 8, BK_ = (UROWB / 2 - PAD - n) / 8;
        for (int q = tid; q < 2 * NB * (FR + BK_); q += NTHREADS) {
            const int buf = q / (NB * (FR + BK_)), rem = q % (NB * (FR + BK_)), b = rem / (FR + BK_), k = rem % (FR + BK_);
            const int e0 = k < FR ? k * 8 : PAD + n + (k - FR) * 8;
            *(LAS u32x4*)(lds + (buf ? OFF_U2 : OFF_U) + b * UROWB + e0 * 2) = (u32x4){0u, 0u, 0u, 0u};
        }
    }
    {
        const float sc = 1.0f / (float)(2 * n);
        for (int q = tid; q < 2 * 8 * (LEN / 2); q += NTHREADS) {
            const int o = q / (8 * (LEN / 2)), rem = q % (8 * (LEN / 2)), s = rem / (LEN / 2), z = (rem % (LEN / 2)) * 2;
            const float* fw = fb + ((size_t)(0 * 2 + o) * 256 + c) * n; const float* bw = fb + ((size_t)(1 * 2 + o) * 256 + c) * n;
            float v2[2];
#pragma unroll
            for (int e = 0; e < 2; ++e) { const int y = z + s + e; v2[e] = y <= n - 1 ? fw[n - 1 - y] : (y <= 2 * n - 2 ? bw[y - n + 1] : 0.f); }
            *(LAS unsigned*)(lds + (o ? OFF_F1 : OFF_F0) + s * LENB + z * 2) = pk_bf16(v2[0] * sc, v2[1] * sc);
        }
    }
    __syncthreads();
    const int bcol = NB == 8 ? (r >> 2) : r, ioff = NB == 8 ? (r & 3) : 0, I0 = wv * NI, Icol = I0 + ioff;
    const int si = (7 - r) & 7;
    const int Dlo = I0 + NI - 1 - (NBLK - 1) - (NI - 1), Dhi = I0 + NI - 1;
    bf16_t* YC = (bf16_t*)(p.ws + OFF_YCAT);
#pragma unroll
    for (int o = 0; o < 2; ++o) {
        const LAS unsigned char* ap = lds + (o ? OFF_F1 : OFF_F0) + si * LENB + (n - 1 - r + 8 * h - si) * 2 - 64 * Dlo;
        const LAS unsigned char* bp = lds + (o ? OFF_U2 : OFF_U) + bcol * UROWB + (PAD + 32 * Icol + 8 * h) * 2 - 64 * Dlo;
        f32x16 acc;
#pragma unroll
        for (int i = 0; i < 16; ++i) acc[i] = 0.f;
#pragma unroll 4
        for (int D = Dlo; D <= Dhi; ++D) {
            const bf16x8 a0 = *(const LAS bf16x8*)ap, a1 = *(const LAS bf16x8*)(ap + 32);
            const bf16x8 b0 = *(const LAS bf16x8*)bp, b1 = *(const LAS bf16x8*)(bp + 32);
            acc = __builtin_amdgcn_mfma_f32_32x32x16_bf16(a0, b0, acc, 0, 0, 0);
            acc = __builtin_amdgcn_mfma_f32_32x32x16_bf16(a1, b1, acc, 0, 0, 0);
            ap -= 64; bp -= 64;
        }
        const float bias = p.in[22][(l * 2 + o) * 256 + c];
#pragma unroll
        for (int g = 0; g < 4; ++g) {
            const int t0 = 32 * Icol + 8 * g + 4 * h;
            const u32x2 uin = *(const LAS u32x2*)(lds + (o ? OFF_U2 : OFF_U) + bcol * UROWB + (PAD + t0) * 2);
            const u32x2 gin = *(const LAS u32x2*)(lds + (o ? OFF_G2 : OFF_G1) + (bcol * n + t0) * 2);
            float y[4];
            y[0] = __uint_as_float(gin.x << 16) * (acc[4 * g] + bias * __uint_as_float(uin.x << 16));
            y[1] = __uint_as_float(gin.x & 0xFFFF0000u) * (acc[4 * g + 1] + bias * __uint_as_float(uin.x & 0xFFFF0000u));
            y[2] = __uint_as_float(gin.y << 16) * (acc[4 * g + 2] + bias * __uint_as_float(uin.y << 16));
            y[3] = __uint_as_float(gin.y & 0xFFFF0000u) * (acc[4 * g + 3] + bias * __uint_as_float(uin.y & 0xFFFF0000u));
            if (o == 0) { u32x2 w; w.x = pk_bf16(y[0], y[1]); w.y = pk_bf16(y[2], y[3]);
                *(LAS u32x2*)(lds + OFF_U2 + bcol * UROWB + (PAD + t0) * 2) = w; }
            else { bf16_t* dst = YC + (size_t)(rowbase + bcol * n + t0) * 1024 + 256 + c;
#pragma unroll
                for (int e = 0; e < 4; ++e) dst[(size_t)e * 1024] = f2bf(y[e]); }
        }
        __syncthreads();
    }
}
__device__ void hyena_mfma(const Params& p, int l, LAS unsigned char* lds) {
    const int tid = opaque_tid();
    const bf16_t* HT = (const bf16_t*)(p.ws + OFF_HT);
    const float* fl = (const float*)(p.ws + OFF_FILT) + (size_t)l * FILT_L;
    for (int u = blockIdx.x; u < 512; u += gridDim.x) {
        if (u < 256) hyena_unit<8, 32>(p, l, u, HT + HT_LAT, NCTX, fl + FILT_CTX, lds, tid);
        else hyena_unit<32, 8>(p, l, u - 256, HT, 0, fl, lds, tid);
    }
}

__global__ void __launch_bounds__(NTHREADS, 2) fwd_megakernel(Params p) {
    extern __shared__ __attribute__((aligned(16))) unsigned char shm[];
    cg::grid_group grid = cg::this_grid();
    LAS unsigned char* lds = (LAS unsigned char*)shm;
    float* ldsf = (float*)shm;
    unsigned char* ws = p.ws;
    const int G = gridDim.x, c = blockIdx.x;

    volatile LAS unsigned* xst = (volatile LAS unsigned*)(lds + 144 * 1024);
    if (threadIdx.x < 4) xst[threadIdx.x] = 0u;
    __syncthreads();
    const XcdBarrier xb = xcd_barrier_post((unsigned*)(ws + OFF_BAR), xst);
    for (int _d = 0; _d < DUP_PREP; ++_d) { phase_prep(p, ldsf); __syncthreads(); }
    grid.sync();
    phase_row<0>(p, 0, 0, 0, 0);
    GSYNC();
    for (int l = 0; l < 2; ++l) {
        for (int s = 0; s < 3; ++s) {
            if (s != 1) {
                const int fs = s >> 1;
                { pg8::Gemm g{(const bf16_t*)(ws + OFF_H), (const bf16_t*)(ws + OFF_WGU + (l * 2 + fs) * SZ_WGU), NTOK, 5632, 1024, 1024, 1024};
                    pg8::StaticOrder S; S.init(g.M, g.N, G, c); EpiSwiglu E{(bf16_t*)(ws + OFF_ACT)};
                    for (int _d = 0; _d < DUP_GEMM; ++_d) pg8::gemm_phase(lds, g, S, E); }
                GSYNC();
                { pg8::Gemm g{(const bf16_t*)(ws + OFF_ACT), (const bf16_t*)(ws + OFF_WD + (l * 2 + fs) * SZ_WD), NTOK, 1024, DFF, DFF, DFF};
                    pg8::StaticOrder S; S.init(g.M, g.N, G, c); EpiYssq E{(bf16_t*)(ws + OFF_Y), (float*)(ws + OFF_SSQ)};
                    for (int _d = 0; _d < DUP_GEMM; ++_d) pg8::gemm_phase(lds, g, S, E); }
                GSYNC();
            } else {
                { pg8::Gemm g{(const bf16_t*)(ws + OFF_H), (const bf16_t*)(ws + OFF_WIN + l * SZ_WIN), NTOK, 2048, 1024, 1024, 1024};
                    pg8::StaticOrder S; S.init(g.M, g.N, G, c);
                    EpiWin E{(bf16_t*)(ws + OFF_ZT), (bf16_t*)(ws + OFF_HT), (bf16_t*)(ws + OFF_QB), (bf16_t*)(ws + OFF_KB), (bf16_t*)(ws + OFF_VB), (const float*)(ws + OFF_ROPE),
                             p.out + (size_t)NTOK * D, p.out + (size_t)NTOK * D + (size_t)32 * 2 * 256 * 128, l};
                    for (int _d = 0; _d < DUP_GEMM; ++_d) pg8::gemm_phase(lds, g, S, E); }
                GSYNC();
                { pg8::Gemm g{(const bf16_t*)(ws + OFF_FL), (const bf16_t*)(ws + OFF_ZT) + ZT_LAT, 1024, 2048, 2048, 2048, 2048};
                    pg8::StaticOrder S; S.init(g.M, g.N, G, c); EpiFourier E{(bf16_t*)(ws + OFF_YCAT), NCTX, 1024};
                    for (int _d = 0; _d < DUP_GEMM; ++_d) pg8::gemm_phase(lds, g, S, E); }
                { pg8::Gemm g{(const bf16_t*)(ws + OFF_FC), (const bf16_t*)(ws + OFF_ZT), 256, 8192, 512, 512, 512};
                    pg8::StaticOrder S; S.init(g.M, g.N, G, c - 32); EpiFourier E{(bf16_t*)(ws + OFF_YCAT), 0, 256};
                    for (int _d = 0; _d < DUP_GEMM; ++_d) pg8::gemm_phase(lds, g, S, E); }
                __syncthreads();
                for (int _d = 0; _d < DUP_MIX; ++_d) { hyena_mfma(p, l, lds); attn_mfma(p, l); }
                GSYNC();
                { pg8::Gemm g{(const bf16_t*)(ws + OFF_YCAT), (const bf16_t*)(ws + OFF_WOUT + l * SZ_WOUT), NTOK, 1024, 1024, 1024, 1024};
                    pg8::StaticOrder S; S.init(g.M, g.N, G, c); EpiYssq E{(bf16_t*)(ws + OFF_Y), (float*)(ws + OFF_SSQ)};
                    for (int _d = 0; _d < DUP_GEMM; ++_d) pg8::gemm_phase(lds, g, S, E); }
                GSYNC();
            }
            if (l == 1 && s == 2) phase_row<2>(p, l, s, 0, 0);
            else { const int ln = s == 2 ? l + 1 : l, sn = s == 2 ? 0 : s + 1; phase_row<1>(p, l, s, ln, sn); }
            if (!(l == 1 && s == 2)) GSYNC();
        }
    }
}

extern "C" void kernel_launch(void* const* d_in, const int* in_sizes, int n_in, void* d_out, int out_size, void* d_ws, size_t ws_size, hipStream_t stream) {
    constexpr int LDS_BYTES = 144 * 1024 + 256;
    static int grid_blocks = 0;
    if (!grid_blocks) {
        if (n_in != 24 || ws_size < WS_END) { fprintf(stderr, "kernel_launch: bad inputs (n_in %d) or workspace too small (%zu < %zu)\n", n_in, ws_size, (size_t)WS_END); grid_blocks = -1; return; }
        int dev = 0, cus = 0, per_cu = 0;
        hipGetDevice(&dev);
        hipDeviceGetAttribute(&cus, hipDeviceAttributeMultiprocessorCount, dev);
        if (hipFuncSetAttribute((const void*)fwd_megakernel, hipFuncAttributeMaxDynamicSharedMemorySize, LDS_BYTES) != hipSuccess) fprintf(stderr, "kernel_launch: hipFuncSetAttribute failed\n");
        hipOccupancyMaxActiveBlocksPerMultiprocessor(&per_cu, (const void*)fwd_megakernel, NTHREADS, LDS_BYTES);
        if (per_cu < 1) { fprintf(stderr, "kernel_launch: occupancy query says %d blocks per CU\n", per_cu); per_cu = 1; }
        (void)hipGetLastError();
        grid_blocks = cus * per_cu;
        if (grid_blocks > 256) grid_blocks = 256;
    }
    if (grid_blocks < 0) return;
    Params p{};
    for (int i = 0; i < 24; ++i) p.in[i] = (const float*)d_in[i];
    p.out = (float*)d_out; p.ws = (unsigned char*)d_ws;
    (void)hipMemsetAsync((unsigned char*)d_ws + OFF_BAR, 0, 16384, stream);
    void* args[] = {&p};
    hipError_t e = hipLaunchCooperativeKernel((const void*)fwd_megakernel, dim3(grid_blocks), dim3(NTHREADS), args, LDS_BYTES, stream);
    if (e != hipSuccess) fprintf(stderr, "cooperative launch failed: %s (grid %d)\n", hipGetErrorString(e), grid_blocks);
}
```

```cpp
#include <hip/hip_runtime.h>
#include <hip/hip_cooperative_groups.h>
#include <cstdio>
namespace cg = cooperative_groups;

#define LAS __attribute__((address_space(3)))
#ifndef DUP_PA
#define DUP_PA 1
#endif
#ifndef DUP_PB
#define DUP_PB 1
#endif
#ifndef DUP_PC
#define DUP_PC 1
#endif
#ifndef DUP_PD
#define DUP_PD 1
#endif
#ifndef DUP_HY
#define DUP_HY 1
#endif
#ifndef DUP_AT
#define DUP_AT 1
#endif
#ifndef DUP_GEMM
#define DUP_GEMM 1
#endif
#ifndef DUP_MIX
#define DUP_MIX 1
#endif
#ifndef DUP_PREP
#define DUP_PREP 1
#endif
#ifndef DUP_SYNC
#define DUP_SYNC 1
#endif
#define GSYNC() do { for (int _s = 0; _s < DUP_SYNC; ++_s) xcd_barrier(xb); } while (0)
typedef unsigned short bf16_t;
typedef short bf16x8 __attribute__((ext_vector_type(8)));
typedef float f32x4 __attribute__((ext_vector_type(4)));
typedef unsigned u32x4 __attribute__((ext_vector_type(4)));
typedef unsigned u32x2 __attribute__((ext_vector_type(2)));

constexpr int D = 1024, NTOK = 16384, NCTX = 8192, DFF = 2816, INW = 1792;
constexpr int NTHREADS = 512;
constexpr float EPS = 1e-6f;
constexpr float PI2 = 6.283185307179586f;

constexpr size_t AL(size_t x) { return (x + 255) & ~(size_t)255; }
constexpr size_t SZ_WGU = (size_t)5632 * 1024 * 2, SZ_WD = (size_t)1024 * 2816 * 2, SZ_WIN = (size_t)2048 * 1024 * 2, SZ_WOUT = (size_t)1024 * 1024 * 2;
constexpr size_t OFF_WGU = 0;
constexpr size_t OFF_WD = OFF_WGU + 4 * SZ_WGU;
constexpr size_t OFF_WIN = OFF_WD + 4 * SZ_WD;
constexpr size_t OFF_WOUT = OFF_WIN + 2 * SZ_WIN;
constexpr size_t OFF_H = OFF_WOUT + 2 * SZ_WOUT;
constexpr size_t OFF_Y = OFF_H + (size_t)NTOK * D * 2;
constexpr size_t OFF_SSQ = OFF_Y + (size_t)NTOK * D * 2;
constexpr size_t OFF_MOD = OFF_SSQ + (size_t)NTOK * 16 * 4;
constexpr size_t OFF_FILT = AL(OFF_MOD + (size_t)2 * 9 * 9216 * 4);
constexpr size_t FILT_CTX = (size_t)4 * 256 * 256, FILT_LAT = (size_t)4 * 256 * 1024, FILT_L = FILT_CTX + FILT_LAT;
constexpr size_t G_CTX = (size_t)2 * 256 * 512, G_LAT = (size_t)2 * 256 * 2048, G_L = G_CTX + G_LAT;
constexpr size_t OFF_FC = AL(OFF_FILT + 2 * FILT_L * 4);
constexpr size_t OFF_FL = OFF_FC + (size_t)256 * 512 * 2;
constexpr size_t OFF_ROPE = OFF_FL + (size_t)1024 * 2048 * 2;
constexpr size_t OFF_BAR = AL(OFF_ROPE + 64 * 16 * 8);
constexpr size_t OFF_CKB = OFF_BAR + 16384;
constexpr size_t OFF_CVT = OFF_CKB + (size_t)2 * 8 * 256 * 128 * 2;
constexpr size_t OFF_UNION = AL(OFF_CVT + (size_t)2 * 8 * 256 * 128 * 2);
constexpr size_t OFF_ACT = OFF_UNION;
constexpr size_t OFF_ZT = OFF_UNION;
constexpr size_t ZT_LAT = (size_t)NCTX * 512;
constexpr size_t OFF_HT = OFF_ZT + (size_t)NTOK * 512 * 2;
constexpr size_t HT_LAT = (size_t)NCTX * 768;
constexpr size_t OFF_QB = OFF_HT + (size_t)NTOK * 768 * 2;
constexpr size_t OFF_KB = OFF_QB + (size_t)NTOK * 512 * 2;
constexpr size_t OFF_VB = OFF_KB + (size_t)NTOK * 128 * 2;
constexpr size_t VT_LAT = (size_t)NCTX * 128;
constexpr size_t OFF_YCAT = OFF_VB + (size_t)NTOK * 128 * 2;
constexpr size_t UNION_END = OFF_YCAT + (size_t)NTOK * 1024 * 2;
constexpr size_t ACT_END = OFF_ACT + (size_t)NTOK * DFF * 2;
constexpr size_t WS_END = (UNION_END > ACT_END ? UNION_END : ACT_END);

struct Params {
    const float* in[24];
    float* out;
    unsigned char* ws;
};

__device__ __forceinline__ unsigned short f2bf(float f) { unsigned u = __float_as_uint(f); u += 0x7FFFu + ((u >> 16) & 1u); return (unsigned short)(u >> 16); }
__device__ __forceinline__ float bf2f(unsigned short b) { return __uint_as_float(((unsigned)b) << 16); }
__device__ __forceinline__ unsigned cvt_pk_bf16(float lo, float hi) { unsigned r; asm volatile("v_cvt_pk_bf16_f32 %0, %1, %2" : "=v"(r) : "v"(lo), "v"(hi)); return r; }
typedef __bf16 bf16x2_t __attribute__((ext_vector_type(2)));
typedef float f32x2_t __attribute__((ext_vector_type(2)));
typedef float f32x16 __attribute__((ext_vector_type(16)));
__device__ __forceinline__ unsigned pk_bf16(float lo, float hi) { f32x2_t v = {lo, hi}; return __builtin_bit_cast(unsigned, __builtin_convertvector(v, bf16x2_t)); }
__device__ __forceinline__ float silu_f(float x) { return x * __builtin_amdgcn_rcpf(1.0f + __expf(-x)); }
__device__ __forceinline__ int perm32(int rho) { const int n = rho >> 4, i = rho & 15; return 8 * (i >> 2) + 4 * n + (i & 3); }

__device__ __forceinline__ int opaque_tid() { int t = threadIdx.x; asm volatile("" : "+v"(t)); return t; }


#define XB_TMO      128
#define XB_XCNT(j)  (256  + 64 * (j))
#define XB_XSUB(j)  (1280 + 64 * (j))
#define XB_XGEN(j)  (2304 + 64 * (j))
#define XB_TOP      3328
#define XB_TOPGEN   3392
#define XCD_BAR_WORDS 3456
#define XB_SPIN_CAP (1u << 22)
__device__ __forceinline__ unsigned xb_ld(unsigned* p)              { return __hip_atomic_load(p, __ATOMIC_RELAXED, __HIP_MEMORY_SCOPE_AGENT); }
__device__ __forceinline__ unsigned xb_add(unsigned* p, unsigned v) { return __hip_atomic_fetch_add(p, v, __ATOMIC_RELAXED, __HIP_MEMORY_SCOPE_AGENT); }
__device__ __forceinline__ unsigned xb_xcc_id() { return (unsigned)__builtin_amdgcn_s_getreg((3 << 11) | 20) & 0xFu; }
#define XB_SPIN(cond, bar) do { unsigned _sp = 0; while (cond) { __builtin_amdgcn_s_sleep(1); \
    if ((++_sp & 255u) == 0u) { if (xb_ld(&(bar)[XB_TMO])) break; if (_sp > XB_SPIN_CAP) { atomicAdd(&(bar)[XB_TMO], 1u); break; } } } } while (0)
struct XcdBarrier { unsigned* bar; unsigned x; volatile LAS unsigned* st; };
__device__ __forceinline__ XcdBarrier xcd_barrier_post(unsigned* bar, volatile LAS unsigned* st) {
    XcdBarrier b; b.bar = bar; b.x = xb_xcc_id(); b.st = st;
    if (threadIdx.x == 0) (void)xb_add(&bar[XB_XCNT(b.x)], 1u);
    return b;
}
__device__ __forceinline__ void xcd_barrier_complete(unsigned* bar, unsigned x, unsigned& nloc, unsigned& nx) {
    const unsigned G = gridDim.x * gridDim.y * gridDim.z;
    unsigned sum, cnt, mine, sp = 0u;
    for (;;) {
        sum = 0u; cnt = 0u; mine = 0u;
#pragma unroll
        for (unsigned j = 0; j < 16; ++j) { const unsigned c = xb_ld(&bar[XB_XCNT(j)]); sum += c; cnt += (c > 0u) ? 1u : 0u; mine = (j == x) ? c : mine; }
        if (sum == G) break;
        __builtin_amdgcn_s_sleep(1);
        if ((++sp & 255u) == 0u) { if (xb_ld(&bar[XB_TMO])) break; if (sp > XB_SPIN_CAP) { atomicAdd(&bar[XB_TMO], 1u); break; } }
    }
    nloc = mine > 0u ? mine : 1u; nx = cnt > 0u ? cnt : 1u;
}
__device__ __forceinline__ void xcd_barrier(const XcdBarrier& b) {
    asm volatile("s_waitcnt vmcnt(0)" ::: "memory");
    __syncthreads();
    if (threadIdx.x == 0) {
        unsigned* bar = b.bar;
        __builtin_amdgcn_s_waitcnt(0);
        unsigned nloc = b.st[0], nx = b.st[1];
        if (nloc == 0u) { xcd_barrier_complete(bar, b.x, nloc, nx); b.st[0] = nloc; b.st[1] = nx; }
        const unsigned old = xb_add(&bar[XB_XSUB(b.x)], 1u);
        const unsigned gen = old / nloc;
        if (old + 1u == (gen + 1u) * nloc) {
            __builtin_amdgcn_fence(__ATOMIC_RELEASE, "agent");
            asm volatile("s_waitcnt vmcnt(0)" ::: "memory");
            const unsigned og = xb_add(&bar[XB_TOP], 1u);
            const unsigned tg = og / nx;
            if (og + 1u == (tg + 1u) * nx) xb_add(&bar[XB_TOPGEN], 1u);
            else XB_SPIN(xb_ld(&bar[XB_TOPGEN]) == tg, bar);
            __builtin_amdgcn_fence(__ATOMIC_ACQUIRE, "agent");
            xb_add(&bar[XB_XGEN(b.x)], 1u);
            asm volatile("s_waitcnt vmcnt(0)" ::: "memory");
        } else {
            XB_SPIN(xb_ld(&bar[XB_XGEN(b.x)]) == gen, bar);
            __builtin_amdgcn_fence(__ATOMIC_ACQUIRE, "agent");
            asm volatile("s_waitcnt vmcnt(0)" ::: "memory");
        }
    }
    __syncthreads();
}

namespace pg8 {
constexpr int BM = 256, BK = 64, HALF = 128, HTB = HALF * BK * 2, STAGE_BYTES = 8 * HTB, NXCD = 8, WGM = 8;
__device__ __forceinline__ int lds_byte(int r, int c) { const int st = (r >> 4) * 2 + (c >> 5), rr = r & 15, cc = c & 31, ob = rr * 64 + cc * 2; return st * 1024 + (ob ^ (((ob >> 9) & 1) << 5)); }
__device__ __forceinline__ void stage_rc(int b, int& R, int& C) { const int st = b / 1024, sb = b % 1024, swz = sb ^ (((sb >> 9) & 1) << 5); R = (st >> 1) * 16 + swz / 64; C = (st & 1) * 32 + (swz % 64) / 2; }
struct Unit { int pm, pn; };
struct Gemm { const bf16_t* A; const bf16_t* Bt; int M, N, K, lda, ldb; };
struct StaticOrder {
    int nM, nN, nwg, G, c;
    __device__ void init(int M, int N, int G_, int c_) { nM = M / BM; nN = N / BM; nwg = nM * nN; G = G_; c = c_; }
    __device__ bool next(int i, Unit& u) const {
        if (c < 0) return false;
        const long L = (long)i * G + c; if (L >= nwg) return false;
        int wgid = (int)L; { const int q = nwg / NXCD, r = nwg % NXCD, xcd = wgid % NXCD, off = wgid / NXCD; wgid = (xcd < r ? xcd * (q + 1) : r * (q + 1) + (xcd - r) * q) + off; }
        const int nig = WGM * nN, gid = wgid / nig, fm = gid * WGM, gsz = (nM - fm) < WGM ? (nM - fm) : WGM;
        u.pm = fm + ((wgid % nig) % gsz); u.pn = (wgid % nig) / gsz; return true;
    }
    __device__ __forceinline__ void a_ready(const Unit&) const {}
    __device__ __forceinline__ void done(const Unit&) const {}
};

template <class Epi, class Sched>
__device__ __forceinline__ void gemm_phase(LAS unsigned char* lds, Gemm g, const Sched& S, const Epi& E) {
    asm volatile("" : "+s"(g.A), "+s"(g.Bt), "+s"(g.K), "+s"(g.lda), "+s"(g.ldb));
    int tid = threadIdx.x; asm volatile("" : "+v"(tid));
    const int wid = __builtin_amdgcn_readfirstlane(tid >> 6), lane = tid & 63, wr = wid >> 2, wc = wid & 3, fr = lane & 15, fq = lane >> 4;
    const int K = g.K, nt = K / BK;
    unsigned voffA[2], voffB[2];
#pragma unroll
    for (int i = 0; i < 2; ++i) { int R, C; stage_rc(tid * 16 + i * 8192, R, C);
        voffA[i] = (unsigned)(R * g.lda + C) * 2u; voffB[i] = (unsigned)(R * g.ldb + C) * 2u; }
    const size_t kstep = (size_t)(BK * 2);
    const size_t hstepA = (size_t)HALF * g.lda * 2, hstepB = (size_t)HALF * g.ldb * 2;
    const size_t tstepA = 2 * hstepA, tstepB = 2 * hstepB;
    const unsigned ldsw = (unsigned)wid * 1024u;
    const int aoff = lds_byte(wr * 64 + fr, fq * 8), boff = lds_byte(wc * 32 + fr, fq * 8);
#define PG8_SA(b, h) (((b) * 2 + (h)) * HTB)
#define PG8_SB(b, h) ((4 + (b) * 2 + (h)) * HTB)
#define PG8_STAGE(bufoff, gbase, voff) do { _Pragma("unroll") for (int _i = 0; _i < 2; ++_i) \
        __builtin_amdgcn_global_load_lds((const unsigned*)((const char*)(gbase) + (voff)[_i]), (LAS unsigned*)(lds + (bufoff) + ldsw + _i * 8192), 16, 0, 0); } while (0)
#define PG8_LDA(dst, b, h) do { _Pragma("unroll") for (int m = 0; m < 4; ++m) _Pragma("unroll") for (int k = 0; k < 2; ++k) dst[m][k] = *(const LAS bf16x8*)(lds + PG8_SA(b, h) + aoff + m * 2048 + k * 1024); } while (0)
#define PG8_LDB(dst, b, h) do { _Pragma("unroll") for (int n = 0; n < 2; ++n) _Pragma("unroll") for (int k = 0; k < 2; ++k) dst[n][k] = *(const LAS bf16x8*)(lds + PG8_SB(b, h) + boff + n * 2048 + k * 1024); } while (0)
#define PG8_MMA(ai, bj, At, Bt) do { __builtin_amdgcn_s_setprio(1); _Pragma("unroll") for (int m = 0; m < 4; ++m) _Pragma("unroll") for (int n = 0; n < 2; ++n) _Pragma("unroll") for (int k = 0; k < 2; ++k) \
        acc[ai][bj][m][n] = __builtin_amdgcn_mfma_f32_16x16x32_bf16(Bt[n][k], At[m][k], acc[ai][bj][m][n], 0, 0, 0); __builtin_amdgcn_s_setprio(0); } while (0)
#define PG8_WAIT_V(n) asm volatile("s_waitcnt vmcnt(" #n ")" ::: "memory")
#define PG8_WAIT_L(n) asm volatile("s_waitcnt lgkmcnt(" #n ")" ::: "memory")
#define PG8_BAR __builtin_amdgcn_s_barrier()
#define PG8_SCHED __builtin_amdgcn_sched_barrier(0)
    Unit cur, nxt; int ui = 0;
    if (!S.next(0, cur)) return;
    f32x4 acc[2][2][4][2];
#pragma unroll
    for (int a = 0; a < 2; ++a)
#pragma unroll
        for (int b = 0; b < 2; ++b)
#pragma unroll
            for (int m = 0; m < 4; ++m)
#pragma unroll
                for (int n = 0; n < 2; ++n) acc[a][b][m][n] = (f32x4){0.f, 0.f, 0.f, 0.f};
    bf16x8 At[4][2], B0[2][2], B1[2][2];
    const char* cA = (const char*)g.A + (size_t)cur.pm * tstepA; const char* cB = (const char*)g.Bt + (size_t)cur.pn * tstepB;
    S.a_ready(cur);
    PG8_STAGE(PG8_SB(0, 0), cB, voffB); PG8_STAGE(PG8_SA(0, 0), cA, voffA); PG8_STAGE(PG8_SB(0, 1), cB + hstepB, voffB); PG8_STAGE(PG8_SA(0, 1), cA + hstepA, voffA);
    if (wr == 1) PG8_BAR;
    PG8_WAIT_V(4); PG8_BAR;
    PG8_STAGE(PG8_SB(1, 0), cB + kstep, voffB); PG8_STAGE(PG8_SA(1, 0), cA + kstep, voffA); PG8_STAGE(PG8_SB(1, 1), cB + hstepB + kstep, voffB);
    PG8_WAIT_V(6); PG8_BAR;
    for (;;) {
        const bool has_next = S.next(ui + 1, nxt);
        const char* nA = has_next ? (const char*)g.A + (size_t)nxt.pm * tstepA : cA; const char* nB = has_next ? (const char*)g.Bt + (size_t)nxt.pn * tstepB : cB;
        for (int t = 0; t < nt; t += 2) {
            const bool last = (t == nt - 2);
            const char* a1 = cA + (size_t)(t + 1) * kstep;
            const char* a2 = last ? nA : cA + (size_t)(t + 2) * kstep; const char* b2 = last ? nB : cB + (size_t)(t + 2) * kstep;
            const char* a3 = a2 + kstep; const char* b3 = b2 + kstep;
            if (last && has_next) S.a_ready(nxt);
            PG8_LDB(B0, 0, 0); PG8_SCHED; PG8_LDA(At, 0, 0); PG8_STAGE(PG8_SA(1, 1), a1 + hstepA, voffA);
            PG8_WAIT_L(8); PG8_BAR; PG8_WAIT_L(0); PG8_MMA(0, 0, At, B0); PG8_BAR; PG8_SCHED;
            PG8_LDB(B1, 0, 1); PG8_STAGE(PG8_SB(0, 0), b2, voffB);
            PG8_BAR; PG8_WAIT_L(0); PG8_MMA(0, 1, At, B1); PG8_BAR;
            PG8_LDA(At, 0, 1); PG8_STAGE(PG8_SA(0, 0), a2, voffA);
            PG8_BAR; PG8_WAIT_L(0); PG8_MMA(1, 0, At, B0); PG8_BAR; PG8_SCHED;
            PG8_STAGE(PG8_SB(0, 1), b2 + hstepB, voffB);
            PG8_WAIT_V(6); PG8_BAR; PG8_MMA(1, 1, At, B1); PG8_BAR;
            PG8_LDB(B0, 1, 0); PG8_SCHED; PG8_LDA(At, 1, 0); PG8_STAGE(PG8_SA(0, 1), a2 + hstepA, voffA);
            PG8_WAIT_L(8); PG8_BAR; PG8_WAIT_L(0); PG8_MMA(0, 0, At, B0); PG8_BAR; PG8_SCHED;
            PG8_LDB(B1, 1, 1); PG8_STAGE(PG8_SB(1, 0), b3, voffB);
            PG8_BAR; PG8_WAIT_L(0); PG8_MMA(0, 1, At, B1); PG8_BAR;
            PG8_LDA(At, 1, 1); PG8_STAGE(PG8_SA(1, 0), a3, voffA);
            PG8_BAR; PG8_WAIT_L(0); PG8_MMA(1, 0, At, B0); PG8_BAR; PG8_SCHED;
            PG8_STAGE(PG8_SB(1, 1), b3 + hstepB, voffB);
            PG8_WAIT_V(6); PG8_BAR; PG8_MMA(1, 1, At, B1); PG8_BAR;
        }
        { int fr2 = fr, fq2 = fq, wr2 = wr, wc2 = wc; asm volatile("" : "+v"(fr2), "+v"(fq2), "+s"(wr2), "+s"(wc2));
            E(acc, cur, wr2, wc2, fr2, fq2); } S.done(cur);
        if (!has_next) break;
#pragma unroll
        for (int a = 0; a < 2; ++a)
#pragma unroll
            for (int b = 0; b < 2; ++b)
#pragma unroll
                for (int m = 0; m < 4; ++m)
#pragma unroll
                    for (int n = 0; n < 2; ++n) acc[a][b][m][n] = (f32x4){0.f, 0.f, 0.f, 0.f};
        cur = nxt; cA = nA; cB = nB; ++ui;
    }
    PG8_WAIT_V(0);
    if (wr == 0) PG8_BAR;
    PG8_BAR;
#undef PG8_SA
#undef PG8_SB
#undef PG8_STAGE
#undef PG8_LDA
#undef PG8_LDB
#undef PG8_MMA
#undef PG8_WAIT_V
#undef PG8_WAIT_L
#undef PG8_BAR
#undef PG8_SCHED
}
}

struct EpiSwiglu {
    bf16_t* O;
    __device__ __forceinline__ void operator()(const f32x4 (&acc)[2][2][4][2], const pg8::Unit& u, int wr, int wc, int fr, int fq) const {
        const int row0 = u.pm * 256 + wr * 64 + fr, col0 = u.pn * 128 + wc * 32 + 8 * fq;
#pragma unroll
        for (int ai = 0; ai < 2; ++ai)
#pragma unroll
            for (int m = 0; m < 4; ++m) {
                bf16_t* rowp = O + (size_t)(row0 + ai * 128 + m * 16) * DFF + col0;
                const f32x4 g0 = acc[ai][0][m][0], g1 = acc[ai][0][m][1], u0 = acc[ai][1][m][0], u1 = acc[ai][1][m][1];
                u32x4 w;
                w.x = cvt_pk_bf16(silu_f(g0[0]) * u0[0], silu_f(g0[1]) * u0[1]); w.y = cvt_pk_bf16(silu_f(g0[2]) * u0[2], silu_f(g0[3]) * u0[3]);
                w.z = cvt_pk_bf16(silu_f(g1[0]) * u1[0], silu_f(g1[1]) * u1[1]); w.w = cvt_pk_bf16(silu_f(g1[2]) * u1[2], silu_f(g1[3]) * u1[3]);
                *(u32x4*)rowp = w;
            }
    }
};
struct EpiYssq {
    bf16_t* Y; float* ssq;
    __device__ __forceinline__ void operator()(const f32x4 (&acc)[2][2][4][2], const pg8::Unit& u, int wr, int wc, int fr, int fq) const {
        const int row0 = u.pm * 256 + wr * 64 + fr, col0 = u.pn * 256 + wc * 32 + 8 * fq;
#pragma unroll
        for (int ai = 0; ai < 2; ++ai)
#pragma unroll
            for (int m = 0; m < 4; ++m) {
                const int row = row0 + ai * 128 + m * 16;
                bf16_t* rowp = Y + (size_t)row * D + col0;
                float s = 0.f;
#pragma unroll
                for (int bj = 0; bj < 2; ++bj) {
                    const f32x4 v0 = acc[ai][bj][m][0], v1 = acc[ai][bj][m][1];
                    s += v0[0] * v0[0] + v0[1] * v0[1] + v0[2] * v0[2] + v0[3] * v0[3] + v1[0] * v1[0] + v1[1] * v1[1] + v1[2] * v1[2] + v1[3] * v1[3];
                    u32x4 w; w.x = cvt_pk_bf16(v0[0], v0[1]); w.y = cvt_pk_bf16(v0[2], v0[3]); w.z = cvt_pk_bf16(v1[0], v1[1]); w.w = cvt_pk_bf16(v1[2], v1[3]);
                    *(u32x4*)(rowp + bj * 128) = w;
                }
                s += __shfl_xor(s, 16); s += __shfl_xor(s, 32);
                if (fq == 0) ssq[(size_t)row * 16 + u.pn * 4 + wc] = s;
            }
    }
};
struct EpiWin {
    bf16_t* ZT; bf16_t* HT; bf16_t* QB; bf16_t* KB; bf16_t* VB; const float* rope; float* newk; float* newv; int layer;
    __device__ __forceinline__ void operator()(const f32x4 (&acc)[2][2][4][2], const pg8::Unit& u, int wr, int wc, int fr, int fq) const {
        const int r0 = u.pm * 256 + wr * 64 + fr;
        const bool lat = u.pm >= 32;
        const int pn = u.pn;
        if (pn < 5) {
            bf16_t* base; int t0; size_t sch;
            if (pn < 2) {
                if (!lat) { const int b = u.pm; base = ZT + ((size_t)b * 256 * 2 + pn) * 256; sch = 512; t0 = r0 - u.pm * 256; }
                else { const int b = (u.pm - 32) >> 2; base = ZT + ZT_LAT + ((size_t)b * 256 * 2 + pn) * 1024; sch = 2048; t0 = r0 - NCTX - b * 1024; }
            } else {
                const int c0 = (pn - 2) * 256;
                if (!lat) { const int b = u.pm; base = HT + ((size_t)b * 768 + c0) * 256; sch = 256; t0 = r0 - u.pm * 256; }
                else { const int b = (u.pm - 32) >> 2; base = HT + HT_LAT + ((size_t)b * 768 + c0) * 1024; sch = 1024; t0 = r0 - NCTX - b * 1024; }
            }
#pragma unroll
            for (int ai = 0; ai < 2; ++ai)
#pragma unroll
                for (int m = 0; m < 4; ++m) {
                    const int t = t0 + ai * 128 + m * 16;
#pragma unroll
                    for (int bj = 0; bj < 2; ++bj)
#pragma unroll
                        for (int n = 0; n < 2; ++n) {
                            const int ch = bj * 128 + wc * 32 + n * 16 + 4 * fq;
                            const f32x4 v = acc[ai][bj][m][n];
#pragma unroll
                            for (int e = 0; e < 4; ++e) base[(size_t)(ch + e) * sch + t] = f2bf(v[e]);
                        }
                }
        } else {
            const int blk = wc & 1;
#pragma unroll
            for (int ai = 0; ai < 2; ++ai)
#pragma unroll
                for (int m = 0; m < 4; ++m) {
                    const int row = r0 + ai * 128 + m * 16;
                    f32x4 cs0 = {1.f, 0.f, 1.f, 0.f}, cs1 = {1.f, 0.f, 1.f, 0.f};
                    if (lat) { const int t = row & 1023; const int pos = blk ? (t & 63) : (t >> 6);
                        const f32x4* rp = (const f32x4*)(rope + (size_t)(pos * 16 + 4 * fq) * 2); cs0 = rp[0]; cs1 = rp[1]; }
#pragma unroll
                    for (int bj = 0; bj < 2; ++bj) {
                        f32x4 x1 = acc[ai][bj][m][0], x2 = acc[ai][bj][m][1];
                        const bool isv = (pn == 7 && bj == 1);
                        const bool isk = (pn == 7 && bj == 0);
                        const int cc = bj * 128 + wc * 32 + 4 * fq;
                        if ((isk || isv) && !lat) {
                            const int b = row >> 8, t = row & 255;
                            float* dst = (isk ? newk : newv) + (((size_t)b * 2 + layer) * 256 + t) * 128 + (cc & 127);
                            *(f32x4*)dst = x1; *(f32x4*)(dst + 16) = x2;
                        }
                        if (!isv) {
                            f32x4 o1, o2;
                            o1[0] = x1[0] * cs0[0] - x2[0] * cs0[1]; o2[0] = x2[0] * cs0[0] + x1[0] * cs0[1];
                            o1[1] = x1[1] * cs0[2] - x2[1] * cs0[3]; o2[1] = x2[1] * cs0[2] + x1[1] * cs0[3];
                            o1[2] = x1[2] * cs1[0] - x2[2] * cs1[1]; o2[2] = x2[2] * cs1[0] + x1[2] * cs1[1];
                            o1[3] = x1[3] * cs1[2] - x2[3] * cs1[3]; o2[3] = x2[3] * cs1[2] + x1[3] * cs1[3];
                            x1 = o1; x2 = o2;
                        }
                        bf16_t* dst;
                        if (pn < 7) { x1 *= 0.125f; x2 *= 0.125f; dst = QB + (size_t)row * 512 + (pn - 5) * 256 + cc; }
                        else if (isk) dst = KB + (size_t)row * 128 + cc;
                        else {
                            bf16_t* vb; size_t n_;
                            if (!lat) { vb = VB + (size_t)(row >> 8) * 128 * 256 + (row & 255); n_ = 256; } else { vb = VB + VT_LAT + (size_t)((row - NCTX) >> 10) * 128 * 1024 + (row & 1023); n_ = 1024; }
                            const int c0 = cc - 128;
#pragma unroll
                            for (int e = 0; e < 4; ++e) { vb[(size_t)(c0 + e) * n_] = f2bf(x1[e]); vb[(size_t)(c0 + 16 + e) * n_] = f2bf(x2[e]); }
                            continue;
                        }
                        u32x2 w1, w2; w1.x = cvt_pk_bf16(x1[0], x1[1]); w1.y = cvt_pk_bf16(x1[2], x1[3]); w2.x = cvt_pk_bf16(x2[0], x2[1]); w2.y = cvt_pk_bf16(x2[2], x2[3]);
                        *(u32x2*)dst = w1; *(u32x2*)(dst + 16) = w2;
                    }
                }
        }
    }
};
struct EpiFourier {
    bf16_t* YC; int rowbase, n;
    __device__ __forceinline__ void operator()(const f32x4 (&acc)[2][2][4][2], const pg8::Unit& u, int wr, int wc, int fr, int fq) const {
        const int kp0 = u.pm * 256 + wr * 64 + fr; const int b = u.pn;
#pragma unroll
        for (int ai = 0; ai < 2; ++ai)
#pragma unroll
            for (int m = 0; m < 4; ++m) {
                bf16_t* rowp = YC + (size_t)(rowbase + b * n + kp0 + ai * 128 + m * 16) * 1024 + wc * 32 + 4 * fq;
#pragma unroll
                for (int bj = 0; bj < 2; ++bj)
#pragma unroll
                    for (int nn = 0; nn < 2; ++nn) { const f32x4 v = acc[ai][bj][m][nn]; u32x2 w; w.x = cvt_pk_bf16(v[0], v[1]); w.y = cvt_pk_bf16(v[2], v[3]);
                        *(u32x2*)(rowp + bj * 128 + nn * 16) = w; }
            }
    }
};

struct TrUnit { const float* src; bf16_t* dst; int ld, k0, cbase, Kd, r0, perm; };
__device__ __forceinline__ TrUnit tr_unit(const Params& p, int u) {
    constexpr int U_GU = 4 * 44 * 16, U_D = 4 * 8 * 44, U_OUT = 2 * 8 * 16;
    TrUnit t; unsigned char* ws = p.ws;
    if (u < U_GU) { const int ls = u / (44 * 16), rem = u % (44 * 16), rg = rem / 16, kb = rem % 16; const int pn = rg >> 1, half = rg & 1;
        t.src = (half ? p.in[10] : p.in[9]) + (size_t)ls * 1024 * DFF; t.ld = DFF; t.k0 = kb * 64; t.cbase = pn * 128; t.dst = (bf16_t*)(ws + OFF_WGU + ls * SZ_WGU); t.Kd = 1024; t.r0 = rg * 128; t.perm = 1; }
    else if (u < U_GU + U_D) { const int v = u - U_GU; const int ls = v / (8 * 44), rem = v % (8 * 44), rg = rem / 44, kb = rem % 44;
        t.src = p.in[11] + (size_t)ls * DFF * 1024; t.ld = 1024; t.k0 = kb * 64; t.cbase = rg * 128; t.dst = (bf16_t*)(ws + OFF_WD + ls * SZ_WD); t.Kd = DFF; t.r0 = rg * 128; t.perm = 1; }
    else if (u < U_GU + U_D + U_OUT) { const int v = u - U_GU - U_D; const int l = v / 128, rem = v % 128, rg = rem / 16, kb = rem % 16;
        t.src = p.in[13] + (size_t)l * 1024 * 1024; t.ld = 1024; t.k0 = kb * 64; t.cbase = rg * 128; t.dst = (bf16_t*)(ws + OFF_WOUT + l * SZ_WOUT); t.Kd = 1024; t.r0 = rg * 128; t.perm = 1; }
    else { const int v = u - U_GU - U_D - U_OUT; const int l = v / (12 * 16), rem = v % (12 * 16), rg = rem / 16, kb = rem % 16;
        t.src = p.in[12] + (size_t)l * 1024 * INW; t.ld = INW; t.k0 = kb * 64; t.cbase = 256 + rg * 128; t.dst = (bf16_t*)(ws + OFF_WIN + l * SZ_WIN); t.Kd = 1024; t.r0 = 512 + rg * 128; t.perm = 0; }
    return t;
}
__device__ __forceinline__ void tr_load(const TrUnit& t, int tid, f32x4 (&v)[4]) {
#pragma unroll
    for (int i = 0; i < 4; ++i) { const int idx = tid + 512 * i, kk = idx >> 5, c4 = idx & 31;
        v[i] = *(const f32x4*)(t.src + (size_t)(t.k0 + kk) * t.ld + t.cbase + c4 * 4); }
}
__device__ void phase_prep(const Params& p, float* lds) {
    const int tid = opaque_tid(), nb = gridDim.x, bid = blockIdx.x;
    unsigned char* ws = p.ws;
    {
        constexpr int NU = 4 * 44 * 16 + 4 * 8 * 44 + 2 * 8 * 16 + 2 * 12 * 16;
        constexpr int TS = 132;
        f32x4 v[4];
        int u = bid;
        TrUnit cur; if (u < NU) { cur = tr_unit(p, u); tr_load(cur, tid, v); }
        while (u < NU) {
#pragma unroll
            for (int i = 0; i < 4; ++i) { const int idx = tid + 512 * i, kk = idx >> 5, c4 = idx & 31; *(f32x4*)(lds + kk * TS + c4 * 4) = v[i]; }
            __syncthreads();
            const int un = u + nb; TrUnit nxt = cur;
            if (un < NU) { nxt = tr_unit(p, un); tr_load(nxt, tid, v); }
            { const int rr = tid >> 2, kc = tid & 3; const int cc = cur.perm ? ((rr & ~31) + perm32(rr & 31)) : rr;
                float x[16];
#pragma unroll
                for (int j = 0; j < 16; ++j) x[j] = lds[(kc * 16 + j) * TS + cc];
                u32x4 w0, w1; w0.x = pk_bf16(x[0], x[1]); w0.y = pk_bf16(x[2], x[3]); w0.z = pk_bf16(x[4], x[5]); w0.w = pk_bf16(x[6], x[7]);
                w1.x = pk_bf16(x[8], x[9]); w1.y = pk_bf16(x[10], x[11]); w1.z = pk_bf16(x[12], x[13]); w1.w = pk_bf16(x[14], x[15]);
                bf16_t* d = cur.dst + (size_t)(cur.r0 + rr) * cur.Kd + cur.k0 + kc * 16;
                *(u32x4*)d = w0; *(u32x4*)(d + 8) = w1; }
            __syncthreads();
            cur = nxt; u = un;
        }
    }
    __syncthreads();
    {
        float* tab = lds;
        if (tid < 64) { float sv, cv; sincosf(PI2 * (float)tid / 64.f, &sv, &cv); tab[tid] = cv; tab[64 + tid] = sv; }
        __syncthreads();
        const int lane = tid & 63, wv = tid >> 6;
        for (int u = bid * 8 + wv; u < 8192; u += nb * 8) {
            const int l = u >> 12, k = (u >> 2) & 1023, g = u & 3;
            const float* wrow = p.in[12] + ((size_t)l * 1024 + k) * INW + g * 64;
            const float wv_ = wrow[lane];
            float ac = 0.f, as = 0.f;
#pragma unroll 16
            for (int c = 0; c < 64; ++c) { const float w = __shfl(wv_, c); const int idx = (c * lane) & 63; ac += w * tab[idx]; as += w * tab[64 + idx]; }
            bf16_t* bt = (bf16_t*)(ws + OFF_WIN + l * SZ_WIN);
            bt[(size_t)(g * 64 + lane) * 1024 + k] = f2bf(ac);
            bt[(size_t)(256 + g * 64 + lane) * 1024 + k] = f2bf(as);
        }
        __syncthreads();
    }
    {
        float* sc = lds;
        float* part = lds + 12 * 1024;
        for (int i = tid; i < 9 * 1024; i += NTHREADS) { const int bc = i >> 10, k = i & 1023; const float cv = bc == 0 ? p.in[5][k] : p.in[4][(bc - 1) * 1024 + k]; sc[k * 12 + bc] = cv / (1.0f + expf(-cv)); }
        __syncthreads();
        for (int cb = bid; cb < 256; cb += nb) {
            const int gc0 = cb * 72, l = gc0 / 9216, j0 = gc0 % 9216;
            const int cg = tid % 18, kg = tid / 18;
            if (kg < 28) {
                f32x4 a[9];
#pragma unroll
                for (int i = 0; i < 9; ++i) a[i] = (f32x4){0.f, 0.f, 0.f, 0.f};
                const float* wp = p.in[6] + (size_t)l * 1024 * 9216 + j0 + cg * 4;
#pragma unroll 4
                for (int k = kg; k < 1024; k += 28) { const f32x4 w = *(const f32x4*)(wp + (size_t)k * 9216);
                    const f32x4 s0 = *(const f32x4*)(sc + k * 12), s1 = *(const f32x4*)(sc + k * 12 + 4); const float s8 = sc[k * 12 + 8];
                    a[0] += w * s0[0]; a[1] += w * s0[1]; a[2] += w * s0[2]; a[3] += w * s0[3]; a[4] += w * s1[0]; a[5] += w * s1[1]; a[6] += w * s1[2]; a[7] += w * s1[3]; a[8] += w * s8; }
#pragma unroll
                for (int i = 0; i < 9; ++i)
#pragma unroll
                    for (int e = 0; e < 4; ++e) part[(kg * 72 + cg * 4 + e) * 9 + i] = a[i][e];
            }
            __syncthreads();
            for (int i = tid; i < 72 * 9; i += NTHREADS) { const int c2 = i / 9, bc = i % 9; float s = 0.f;
#pragma unroll
                for (int g = 0; g < 28; ++g) s += part[(g * 72 + c2) * 9 + bc];
                ((float*)(ws + OFF_MOD))[((size_t)l * 9 + bc) * 9216 + j0 + c2] = s + p.in[7][l * 9216 + j0 + c2]; }
            __syncthreads();
        }
    }
    __syncthreads();
    {
        const int lane = tid & 63, wv = tid >> 6;
        float* h2s = lds;
        const int u0 = bid * 10; const int l = u0 / 1280;
        if (u0 < 2560) {
            const float* w1 = p.in[15] + l * 33 * 64; const float* b1 = p.in[16] + l * 64; const float* w2 = p.in[17] + l * 64 * 64; const float* b2 = p.in[18] + l * 64;
            const float* w3 = p.in[19] + (size_t)l * 64 * 1024; const float fr = p.in[20][l * 64 + lane];
            for (int q = wv; q < 10; q += 8) {
                const int rem = (u0 + q) % 1280; const int pass = rem >= 256; const int n = pass ? 1024 : 256; const int d = pass ? rem - 256 : rem;
                const float tt = (float)d / (float)(n - 1);
                float feat = 0.f;
                if (lane == 0) feat = tt;
                else if (lane < 33) { const int j = (lane - 1) & 15; const float fj = 1e-4f + (float)j * ((15.0f - 1e-4f) / 15.0f); const float ang = (PI2 / (float)n) * (float)d * fj;
                    feat = lane < 17 ? cosf(ang) : -sinf(ang); }
                float a1 = b1[lane];
#pragma unroll
                for (int i = 0; i < 33; ++i) a1 += __shfl(feat, i) * w1[i * 64 + lane];
                const float h1 = sinf(fr * a1);
                float a2 = b2[lane];
#pragma unroll
                for (int i = 0; i < 64; ++i) a2 += __shfl(h1, i) * w2[i * 64 + lane];
                h2s[lane * 12 + q] = sinf(fr * a2);
            }
            __syncthreads();
            float acc[2][10];
#pragma unroll
            for (int q = 0; q < 10; ++q) { acc[0][q] = 0.f; acc[1][q] = 0.f; }
#pragma unroll 8
            for (int i = 0; i < 64; ++i) {
                const float wa = w3[i * 1024 + tid], wb = w3[i * 1024 + 512 + tid];
                const f32x4 ha = *(const f32x4*)(h2s + i * 12), hb = *(const f32x4*)(h2s + i * 12 + 4); const float h8 = h2s[i * 12 + 8], h9 = h2s[i * 12 + 9];
                acc[0][0] += ha[0] * wa; acc[0][1] += ha[1] * wa; acc[0][2] += ha[2] * wa; acc[0][3] += ha[3] * wa; acc[0][4] += hb[0] * wa; acc[0][5] += hb[1] * wa; acc[0][6] += hb[2] * wa; acc[0][7] += hb[3] * wa; acc[0][8] += h8 * wa; acc[0][9] += h9 * wa;
                acc[1][0] += ha[0] * wb; acc[1][1] += ha[1] * wb; acc[1][2] += ha[2] * wb; acc[1][3] += ha[3] * wb; acc[1][4] += hb[0] * wb; acc[1][5] += hb[1] * wb; acc[1][6] += hb[2] * wb; acc[1][7] += hb[3] * wb; acc[1][8] += h8 * wb; acc[1][9] += h9 * wb;
            }
            const int ord = (tid >> 8) & 1, c = tid & 255;
            const float dec = fabsf(p.in[21][(l * 2 + ord) * 256 + c]);
            bf16_t* gl = (bf16_t*)(ws + OFF_FILT) + (size_t)l * G_L;
#pragma unroll
            for (int q = 0; q < 10; ++q) {
                const int rem = (u0 + q) % 1280; const int pass = rem >= 256; const int n = pass ? 1024 : 256; const int d = pass ? rem - 256 : rem;
                const float tt = (float)d / (float)(n - 1); const float win = expf(-tt * dec) / (float)(2 * n);
                bf16_t* g = gl + (pass ? G_CTX : 0) + ((size_t)ord * 256 + c) * (2 * n);
                g[n - 1 - d] = f2bf(acc[0][q] * win);
                g[d == 0 ? 2 * n - 1 : n - 1 + d] = d == 0 ? (bf16_t)0 : f2bf(acc[1][q] * win);
            }
        }
        __syncthreads();
    }
    __syncthreads();
    {
        bf16_t* FC = (bf16_t*)(ws + OFF_FC); bf16_t* FL = (bf16_t*)(ws + OFF_FL);
        const int gt = bid * NTHREADS + tid, gn = nb * NTHREADS;
        for (int i = gt; i < 256 * 512 + 1024 * 2048; i += gn) {
            int n, k, col; bf16_t* dst;
            if (i < 256 * 512) { n = 256; k = i >> 9; col = i & 511; dst = FC + i; } else { const int j = i - 256 * 512; n = 1024; k = j >> 11; col = j & 2047; dst = FL + j; }
            const int s = col >= n, t = col - s * n; const int ph = (k * t) & (n - 1);
            float sv, cv; sincosf(PI2 * (float)ph / (float)n, &sv, &cv);
            const float sc = rsqrtf(64.0f * (float)n);
            *dst = f2bf((s ? -sv : cv) * sc);
        }
        { bf16_t* CK = (bf16_t*)(ws + OFF_CKB); bf16_t* CV = (bf16_t*)(ws + OFF_CVT);
            for (int i = gt; i < 2 * 8 * 256 * 128; i += gn) {
                { const int c = i & 127, key = (i >> 7) & 255, b = (i >> 15) & 7, l = i >> 18;
                    CK[i] = f2bf(p.in[2][(((size_t)b * 2 + l) * 256 + key) * 128 + c]); }
                { const int key = i & 255, c = (i >> 8) & 127, b = (i >> 15) & 7, l = i >> 18;
                    CV[i] = f2bf(p.in[3][(((size_t)b * 2 + l) * 256 + key) * 128 + c]); }
            } }
        if (bid == 0) for (int i = tid; i < 64 * 16; i += NTHREADS) { const int pos = i >> 4, j = i & 15; const float inv = powf(10000.0f, -(float)(2 * j) / 32.0f);
            float sv, cv; sincosf((float)pos * inv, &sv, &cv); float* rp = (float*)(ws + OFF_ROPE); rp[2 * i] = cv; rp[2 * i + 1] = sv; }
    }
    __syncthreads();
}

template <int MODE>
__device__ void phase_row(const Params& p, int lpost, int spost, int lpre, int spre) {
    const int tid_ = opaque_tid(); const int lane = tid_ & 63, wv = tid_ >> 6;
    const float* mod = (const float*)(p.ws + OFF_MOD);
    const bf16_t* Y = (const bf16_t*)(p.ws + OFF_Y); const float* ssq = (const float*)(p.ws + OFF_SSQ);
    bf16_t* H = (bf16_t*)(p.ws + OFF_H);
    const float factor = (spost == 1) ? 1.0f : 0.5f;
    const int stride = gridDim.x * 8;
    for (int row0 = blockIdx.x * 8 + wv; row0 < NTOK; row0 += 2 * stride) {
        f32x4 x[2][4]; u32x2 yv[2][4]; f32x4 sq[2][4]; int bc[2]; bool ok[2];
#pragma unroll
        for (int q = 0; q < 2; ++q) {
            const int row = row0 + q * stride; ok[q] = row < NTOK; const int rw = ok[q] ? row : row0;
            bc[q] = rw < NCTX ? 0 : 1 + ((rw - NCTX) >> 10);
            if (MODE == 0) { const float* src = rw < NCTX ? p.in[0] + (size_t)rw * D : p.in[1] + (size_t)(rw - NCTX) * D;
#pragma unroll
                for (int j = 0; j < 4; ++j) x[q][j] = *(const f32x4*)(src + j * 256 + lane * 4); }
            else {
#pragma unroll
                for (int j = 0; j < 4; ++j) { x[q][j] = *(const f32x4*)(p.out + (size_t)rw * D + j * 256 + lane * 4); yv[q][j] = *(const u32x2*)(Y + (size_t)rw * D + j * 256 + lane * 4); }
                const f32x4* sp = (const f32x4*)(ssq + (size_t)rw * 16);
#pragma unroll
                for (int j = 0; j < 4; ++j) sq[q][j] = sp[j];
            }
        }
#pragma unroll
        for (int q = 0; q < 2; ++q) {
            const int row = row0 + q * stride;
            if (!ok[q]) continue;
            float* xr = p.out + (size_t)row * D;
            if (MODE != 0) {
                float tot = 0.f;
#pragma unroll
                for (int j = 0; j < 4; ++j) tot += (sq[q][j][0] + sq[q][j][1]) + (sq[q][j][2] + sq[q][j][3]);
                const float rstd = rsqrtf(tot * (1.0f / 1024.0f) + EPS) * factor;
                const float* gate = mod + ((size_t)lpost * 9 + bc[q]) * 9216 + spost * 3072 + 2048;
                const float* gp = p.in[8] + (lpost * 6 + 2 * spost + 1) * 1024;
#pragma unroll
                for (int j = 0; j < 4; ++j) { const int c = j * 256 + lane * 4;
                    const f32x4 gt = *(const f32x4*)(gate + c), gg = *(const f32x4*)(gp + c);
                    x[q][j][0] += gt[0] * gg[0] * rstd * __uint_as_float(yv[q][j].x << 16);
                    x[q][j][1] += gt[1] * gg[1] * rstd * __uint_as_float(yv[q][j].x & 0xFFFF0000u);
                    x[q][j][2] += gt[2] * gg[2] * rstd * __uint_as_float(yv[q][j].y << 16);
                    x[q][j][3] += gt[3] * gg[3] * rstd * __uint_as_float(yv[q][j].y & 0xFFFF0000u); }
            }
#pragma unroll
            for (int j = 0; j < 4; ++j) *(f32x4*)(xr + j * 256 + lane * 4) = x[q][j];
            if (MODE != 2) {
                float s = 0.f;
#pragma unroll
                for (int j = 0; j < 4; ++j) s += x[q][j][0] * x[q][j][0] + x[q][j][1] * x[q][j][1] + x[q][j][2] * x[q][j][2] + x[q][j][3] * x[q][j][3];
#pragma unroll
                for (int o = 32; o >= 1; o >>= 1) s += __shfl_xor(s, o);
                const float rs = rsqrtf(s * (1.0f / 1024.0f) + EPS);
                const float* mb = mod + ((size_t)lpre * 9 + bc[q]) * 9216 + spre * 3072;
                const float* gp = p.in[8] + (lpre * 6 + 2 * spre) * 1024;
#pragma unroll
                for (int j = 0; j < 4; ++j) { const int c = j * 256 + lane * 4;
                    const f32x4 sh = *(const f32x4*)(mb + c), scl = *(const f32x4*)(mb + 1024 + c), gg = *(const f32x4*)(gp + c);
                    f32x4 hh;
#pragma unroll
                    for (int e = 0; e < 4; ++e) hh[e] = x[q][j][e] * rs * gg[e] * (1.0f + scl[e]) + sh[e];
                    u32x2 w; w.x = pk_bf16(hh[0], hh[1]); w.y = pk_bf16(hh[2], hh[3]);
                    *(u32x2*)(H + (size_t)row * D + c) = w; }
            }
        }
    }
}

__device__ void attn_mfma(const Params& p, int l) {
    const int tid = opaque_tid(); const int lane = tid & 63, wv = tid >> 6, r = lane & 31, h = lane >> 5;
    const bf16_t* QB = (const bf16_t*)(p.ws + OFF_QB); const bf16_t* KB = (const bf16_t*)(p.ws + OFF_KB); const bf16_t* VT = (const bf16_t*)(p.ws + OFF_VB);
    const bf16_t* CK = (const bf16_t*)(p.ws + OFF_CKB); const bf16_t* CV = (const bf16_t*)(p.ws + OFF_CVT);
    bf16_t* YC = (bf16_t*)(p.ws + OFF_YCAT);
    const int g = wv & 3, qh = wv >> 2;
    for (int u = blockIdx.x; u < 512; u += gridDim.x) {
        const int pass = u < 256; const int v = u & 255;
        int b, kvh, qb, n, rowbase;
        if (!pass) { b = v >> 3; kvh = (v >> 2) & 1; qb = v & 3; n = 256; rowbase = b * 256; }
        else { b = v >> 5; kvh = (v >> 4) & 1; qb = v & 15; n = 1024; rowbase = NCTX + b * 1024; }
        const int head = kvh * 4 + g, q0w = qb * 64 + qh * 32;
        int klo = 0, khi = 256;
        if (pass) { klo = q0w - 128; if (klo < 0) klo = 0; khi = q0w + 160; if (khi > n) khi = n; }
        const int nA = (khi - klo) >> 5, nT = nA + (pass ? 8 : 0);
        const bf16_t* kA = KB + (size_t)(rowbase + klo) * 128 + kvh * 64;
        const bf16_t* vA = VT + (pass ? VT_LAT + (size_t)b * 128 * 1024 : (size_t)b * 128 * 256) + (size_t)kvh * 64 * n + klo;
        const bf16_t* kB = CK + ((size_t)(l * 8 + b) * 256) * 128 + kvh * 64;
        const bf16_t* vB = CV + ((size_t)(l * 8 + b) * 128 + kvh * 64) * 256;
        bf16x8 qf[4];
        { const bf16_t* qp = QB + (size_t)(rowbase + q0w + r) * 512 + head * 64 + 8 * h;
#pragma unroll
            for (int kk = 0; kk < 4; ++kk) qf[kk] = *(const bf16x8*)(qp + 16 * kk); }
        float m = p.in[23][l * 8 + head], lsum = 1.0f;
        f32x16 O0, O1;
#pragma unroll
        for (int i = 0; i < 16; ++i) { O0[i] = 0.f; O1[i] = 0.f; }
        bf16x8 kf[4];
        {
            const bf16_t* kp = (nA > 0 ? kA : kB) + (size_t)r * 128 + 8 * h;
#pragma unroll
            for (int kk = 0; kk < 4; ++kk) kf[kk] = *(const bf16x8*)(kp + 16 * kk);
        }
        for (int t = 0; t < nT; ++t) {
            const bool inA = t < nA;
            const bf16_t* vp = inA ? vA + (size_t)r * n + t * 32 + 4 * h : vB + (size_t)r * 256 + (t - nA) * 32 + 4 * h;
            const size_t vld = inA ? (size_t)n : (size_t)256;
            u32x2 vraw[2][2][2];
#pragma unroll
            for (int dt = 0; dt < 2; ++dt)
#pragma unroll
                for (int s = 0; s < 2; ++s)
#pragma unroll
                    for (int q = 0; q < 2; ++q) vraw[dt][s][q] = *(const u32x2*)(vp + (size_t)dt * 32 * vld + 16 * s + 8 * q);
            bf16x8 kn[4];
            { const int tn = (t + 1 < nT) ? t + 1 : t; const bool nInA = tn < nA;
                const bf16_t* kp = (nInA ? kA + (size_t)tn * 32 * 128 : kB + (size_t)(tn - nA) * 32 * 128) + (size_t)r * 128 + 8 * h;
#pragma unroll
                for (int kk = 0; kk < 4; ++kk) kn[kk] = *(const bf16x8*)(kp + 16 * kk); }
            f32x16 S;
#pragma unroll
            for (int i = 0; i < 16; ++i) S[i] = 0.f;
#pragma unroll
            for (int kk = 0; kk < 4; ++kk) S = __builtin_amdgcn_mfma_f32_32x32x16_bf16(kf[kk], qf[kk], S, 0, 0, 0);
            if (pass && inA) {
                const int dk = klo + t * 32 - q0w;
                if (dk <= -128 || dk >= 128) {
#pragma unroll
                    for (int i = 0; i < 16; ++i) { const int j = (i & 3) + 8 * (i >> 2) + 4 * h; int dd = dk + j - r; if (dd < 0) dd = -dd; if (dd > 128) S[i] = -1e30f; }
                }
            }
            float mx = S[0];
#pragma unroll
            for (int i = 1; i < 16; ++i) mx = fmaxf(mx, S[i]);
            mx = fmaxf(mx, __shfl_xor(mx, 32));
            const float mn = fmaxf(m, mx), corr = __expf(m - mn);
            m = mn;
            float rs = 0.f;
#pragma unroll
            for (int i = 0; i < 16; ++i) { S[i] = __expf(S[i] - mn); rs += S[i]; }
            rs += __shfl_xor(rs, 32);
            lsum = lsum * corr + rs;
#pragma unroll
            for (int i = 0; i < 16; ++i) { O0[i] *= corr; O1[i] *= corr; }
            bf16x8 pf[2];
#pragma unroll
            for (int s = 0; s < 2; ++s) { u32x4 w; w.x = pk_bf16(S[8 * s], S[8 * s + 1]); w.y = pk_bf16(S[8 * s + 2], S[8 * s + 3]); w.z = pk_bf16(S[8 * s + 4], S[8 * s + 5]); w.w = pk_bf16(S[8 * s + 6], S[8 * s + 7]);
                pf[s] = __builtin_bit_cast(bf16x8, w); }
#pragma unroll
            for (int s = 0; s < 2; ++s) {
                u32x4 a0; a0.x = vraw[0][s][0].x; a0.y = vraw[0][s][0].y; a0.z = vraw[0][s][1].x; a0.w = vraw[0][s][1].y;
                u32x4 a1; a1.x = vraw[1][s][0].x; a1.y = vraw[1][s][0].y; a1.z = vraw[1][s][1].x; a1.w = vraw[1][s][1].y;
                O0 = __builtin_amdgcn_mfma_f32_32x32x16_bf16(__builtin_bit_cast(bf16x8, a0), pf[s], O0, 0, 0, 0);
                O1 = __builtin_amdgcn_mfma_f32_32x32x16_bf16(__builtin_bit_cast(bf16x8, a1), pf[s], O1, 0, 0, 0);
            }
#pragma unroll
            for (int kk = 0; kk < 4; ++kk) kf[kk] = kn[kk];
        }
        const float inv = 1.0f / lsum;
        bf16_t* op = YC + (size_t)(rowbase + q0w + r) * 1024 + 512 + head * 64 + 4 * h;
#pragma unroll
        for (int gq = 0; gq < 4; ++gq) {
            u32x2 w0; w0.x = pk_bf16(O0[4 * gq] * inv, O0[4 * gq + 1] * inv); w0.y = pk_bf16(O0[4 * gq + 2] * inv, O0[4 * gq + 3] * inv);
            u32x2 w1; w1.x = pk_bf16(O1[4 * gq] * inv, O1[4 * gq + 1] * inv); w1.y = pk_bf16(O1[4 * gq + 2] * inv, O1[4 * gq + 3] * inv);
            *(u32x2*)(op + 8 * gq) = w0; *(u32x2*)(op + 32 + 8 * gq) = w1;
        }
    }
}


template <int NB  , int NBLK  >
__device__ __forceinline__ void hyena_unit(const Params& p, int l, int c, const bf16_t* __restrict__ HTp, int rowbase, const bf16_t* __restrict__ gb, LAS unsigned char* lds, int tid) {
    constexpr int n = 32 * NBLK, NI = 32 / NB, PAD = 32 * (NI - 1);
    constexpr int LENB = (2 * n * 2 - 64 + 255) / 256 * 256 + 64;
    constexpr int UROWB = ((n + 2 * PAD) * 2 + 255) / 256 * 256 + 16;
    constexpr int GSB = (2 * n + 8) * 2;
    constexpr int OFF_F0 = 0, OFF_F1 = 8 * LENB, OFF_U = 16 * LENB, OFF_U2 = OFF_U + NB * UROWB, OFF_G1 = OFF_U2 + NB * UROWB, OFF_G2 = OFF_G1 + NB * n * 2, OFF_GS = OFF_G2 + NB * n * 2;
    static_assert(OFF_GS + 2 * GSB <= 149 * 1024, "hyena LDS");
    const int lane = tid & 63, wv = tid >> 6, r = lane & 31, h = lane >> 5;
    const float* cw = p.in[14] + l * 3 * 768;
    if (tid < 2 * (2 * n / 8)) { const int o = tid / (2 * n / 8), k = tid % (2 * n / 8);
        *(LAS u32x4*)(lds + OFF_GS + o * GSB + k * 16) = *(const u32x4*)(gb + ((size_t)o * 256 + c) * (2 * n) + k * 8); }
    if (tid < 2) *(LAS u32x4*)(lds + OFF_GS + tid * GSB + 2 * n * 2) = (u32x4){0u, 0u, 0u, 0u};
    constexpr int NQ = 3 * NB * (n / 8) / NTHREADS;
#pragma unroll
    for (int it = 0; it < NQ; ++it) {
        const int q = tid + it * NTHREADS;
        const int w = q / (NB * (n / 8)), rem = q % (NB * (n / 8)), b = rem / (n / 8), t0 = (rem % (n / 8)) * 8;
        const int ch = w * 256 + c; const bf16_t* row = HTp + ((size_t)b * 768 + ch) * n;
        const float w0 = cw[ch], w1 = cw[768 + ch], w2 = cw[1536 + ch];
        const u32x4 raw = *(const u32x4*)(row + t0);
        float x[10];
        x[0] = t0 > 0 ? bf2f(row[t0 - 1]) : 0.f; x[9] = t0 + 8 < n ? bf2f(row[t0 + 8]) : 0.f;
        x[1] = __uint_as_float(raw.x << 16); x[2] = __uint_as_float(raw.x & 0xFFFF0000u); x[3] = __uint_as_float(raw.y << 16); x[4] = __uint_as_float(raw.y & 0xFFFF0000u);
        x[5] = __uint_as_float(raw.z << 16); x[6] = __uint_as_float(raw.z & 0xFFFF0000u); x[7] = __uint_as_float(raw.w << 16); x[8] = __uint_as_float(raw.w & 0xFFFF0000u);
        float z[8];
#pragma unroll
        for (int e = 0; e < 8; ++e) z[e] = x[e] * w0 + x[e + 1] * w1 + x[e + 2] * w2;
        u32x4 o; o.x = pk_bf16(z[0], z[1]); o.y = pk_bf16(z[2], z[3]); o.z = pk_bf16(z[4], z[5]); o.w = pk_bf16(z[6], z[7]);
        LAS unsigned char* dst = w == 0 ? lds + OFF_U + b * UROWB + (PAD + t0) * 2 : lds + (w == 1 ? OFF_G1 : OFF_G2) + (b * n + t0) * 2;
        *(LAS u32x4*)dst = o;
    }
    if (PAD > 0) {
        constexpr int FR = PAD / 8, BK_ = (UROWB / 2 - PAD - n) / 8;
        for (int q = tid; q < 2 * NB * (FR + BK_); q += NTHREADS) {
            const int buf = q / (NB * (FR + BK_)), rem = q % (NB * (FR + BK_)), b = rem / (FR + BK_), k = rem % (FR + BK_);
            const int e0 = k < FR ? k * 8 : PAD + n + (k - FR) * 8;
            *(LAS u32x4*)(lds + (buf ? OFF_U2 : OFF_U) + b * UROWB + e0 * 2) = (u32x4){0u, 0u, 0u, 0u};
        }
    }
    __syncthreads();
    if (tid < 2 * (2 * n / 8)) { const int o = tid / (2 * n / 8), k = tid % (2 * n / 8);
        const u32x4 lo = *(const LAS u32x4*)(lds + OFF_GS + o * GSB + k * 16), hi = *(const LAS u32x4*)(lds + OFF_GS + o * GSB + k * 16 + 16);
        const unsigned d[8] = {lo.x, lo.y, lo.z, lo.w, hi.x, hi.y, hi.z, hi.w};
        LAS unsigned char* fdst = lds + (o ? OFF_F1 : OFF_F0) + k * 16;
#pragma unroll
        for (int s = 0; s < 8; ++s) { u32x4 w;
            if ((s & 1) == 0) { w.x = d[s / 2]; w.y = d[s / 2 + 1]; w.z = d[s / 2 + 2]; w.w = d[s / 2 + 3]; }
            else { w.x = __builtin_amdgcn_alignbyte(d[s / 2 + 1], d[s / 2], 2); w.y = __builtin_amdgcn_alignbyte(d[s / 2 + 2], d[s / 2 + 1], 2);
                   w.z = __builtin_amdgcn_alignbyte(d[s / 2 + 3], d[s / 2 + 2], 2); w.w = __builtin_amdgcn_alignbyte(d[s / 2 + 4], d[s / 2 + 3], 2); }
            *(LAS u32x4*)(fdst + s * LENB) = w; }
    }
    __syncthreads();
    const int bcol = NB == 8 ? (r >> 2) : r, ioff = NB == 8 ? (r & 3) : 0, I0 = wv * NI, Icol = I0 + ioff;
    const int si = (7 - r) & 7;
    const int Dlo = I0 + NI - 1 - (NBLK - 1) - (NI - 1), Dhi = I0 + NI - 1;
    bf16_t* YC = (bf16_t*)(p.ws + OFF_YCAT);
#pragma unroll
    for (int o = 0; o < 2; ++o) {
        const LAS unsigned char* ap = lds + (o ? OFF_F1 : OFF_F0) + si * LENB + (n - 1 - r + 8 * h - si) * 2 - 64 * Dlo;
        const LAS unsigned char* bp = lds + (o ? OFF_U2 : OFF_U) + bcol * UROWB + (PAD + 32 * Icol + 8 * h) * 2 - 64 * Dlo;
        f32x16 acc;
#pragma unroll
        for (int i = 0; i < 16; ++i) acc[i] = 0.f;
#pragma unroll 4
        for (int D = Dlo; D <= Dhi; ++D) {
            const bf16x8 a0 = *(const LAS bf16x8*)ap, a1 = *(const LAS bf16x8*)(ap + 32);
            const bf16x8 b0 = *(const LAS bf16x8*)bp, b1 = *(const LAS bf16x8*)(bp + 32);
            acc = __builtin_amdgcn_mfma_f32_32x32x16_bf16(a0, b0, acc, 0, 0, 0);
            acc = __builtin_amdgcn_mfma_f32_32x32x16_bf16(a1, b1, acc, 0, 0, 0);
            ap -= 64; bp -= 64;
        }
        const float bias = p.in[22][(l * 2 + o) * 256 + c];
#pragma unroll
        for (int g = 0; g < 4; ++g) {
            const int t0 = 32 * Icol + 8 * g + 4 * h;
            const u32x2 uin = *(const LAS u32x2*)(lds + (o ? OFF_U2 : OFF_U) + bcol * UROWB + (PAD + t0) * 2);
            const u32x2 gin = *(const LAS u32x2*)(lds + (o ? OFF_G2 : OFF_G1) + (bcol * n + t0) * 2);
            float y[4];
            y[0] = __uint_as_float(gin.x << 16) * (acc[4 * g] + bias * __uint_as_float(uin.x << 16));
            y[1] = __uint_as_float(gin.x & 0xFFFF0000u) * (acc[4 * g + 1] + bias * __uint_as_float(uin.x & 0xFFFF0000u));
            y[2] = __uint_as_float(gin.y << 16) * (acc[4 * g + 2] + bias * __uint_as_float(uin.y << 16));
            y[3] = __uint_as_float(gin.y & 0xFFFF0000u) * (acc[4 * g + 3] + bias * __uint_as_float(uin.y & 0xFFFF0000u));
            if (o == 0) { u32x2 w; w.x = pk_bf16(y[0], y[1]); w.y = pk_bf16(y[2], y[3]);
                *(LAS u32x2*)(lds + OFF_U2 + bcol * UROWB + (PAD + t0) * 2) = w; }
            else { bf16_t* dst = YC + (size_t)(rowbase + bcol * n + t0) * 1024 + 256 + c;
#pragma unroll
                for (int e = 0; e < 4; ++e) dst[(size_t)e * 1024] = f2bf(y[e]); }
        }
        __syncthreads();
    }
}
__device__ void hyena_mfma(const Params& p, int l, LAS unsigned char* lds) {
    const int tid = opaque_tid();
    const bf16_t* HT = (const bf16_t*)(p.ws + OFF_HT);
    const bf16_t* gl = (const bf16_t*)(p.ws + OFF_FILT) + (size_t)l * G_L;
    for (int u = blockIdx.x; u < 512; u += gridDim.x) {
        if (u < 256) hyena_unit<8, 32>(p, l, u, HT + HT_LAT, NCTX, gl + G_CTX, lds, tid);
        else hyena_unit<32, 8>(p, l, u - 256, HT, 0, gl, lds, tid);
    }
}

__global__ void __launch_bounds__(NTHREADS, 2) fwd_megakernel(Params p) {
    extern __shared__ __attribute__((aligned(16))) unsigned char shm[];
    cg::grid_group grid = cg::this_grid();
    LAS unsigned char* lds = (LAS unsigned char*)shm;
    float* ldsf = (float*)shm;
    unsigned char* ws = p.ws;
    const int G = gridDim.x, c = blockIdx.x;

    volatile LAS unsigned* xst = (volatile LAS unsigned*)(lds + 149 * 1024);
    if (threadIdx.x < 4) xst[threadIdx.x] = 0u;
    __syncthreads();
    const XcdBarrier xb = xcd_barrier_post((unsigned*)(ws + OFF_BAR), xst);
    for (int _d = 0; _d < DUP_PREP; ++_d) { phase_prep(p, ldsf); __syncthreads(); }
    if (p.ws == nullptr) grid.sync();
    GSYNC();
    phase_row<0>(p, 0, 0, 0, 0);
    GSYNC();
    for (int l = 0; l < 2; ++l) {
        for (int s = 0; s < 3; ++s) {
            if (s != 1) {
                const int fs = s >> 1;
                { pg8::Gemm g{(const bf16_t*)(ws + OFF_H), (const bf16_t*)(ws + OFF_WGU + (l * 2 + fs) * SZ_WGU), NTOK, 5632, 1024, 1024, 1024};
                    pg8::StaticOrder S; S.init(g.M, g.N, G, c); EpiSwiglu E{(bf16_t*)(ws + OFF_ACT)};
                    for (int _d = 0; _d < DUP_GEMM; ++_d) pg8::gemm_phase(lds, g, S, E); }
                GSYNC();
                { pg8::Gemm g{(const bf16_t*)(ws + OFF_ACT), (const bf16_t*)(ws + OFF_WD + (l * 2 + fs) * SZ_WD), NTOK, 1024, DFF, DFF, DFF};
                    pg8::StaticOrder S; S.init(g.M, g.N, G, c); EpiYssq E{(bf16_t*)(ws + OFF_Y), (float*)(ws + OFF_SSQ)};
                    for (int _d = 0; _d < DUP_GEMM; ++_d) pg8::gemm_phase(lds, g, S, E); }
                GSYNC();
            } else {
                { pg8::Gemm g{(const bf16_t*)(ws + OFF_H), (const bf16_t*)(ws + OFF_WIN + l * SZ_WIN), NTOK, 2048, 1024, 1024, 1024};
                    pg8::StaticOrder S; S.init(g.M, g.N, G, c);
                    EpiWin E{(bf16_t*)(ws + OFF_ZT), (bf16_t*)(ws + OFF_HT), (bf16_t*)(ws + OFF_QB), (bf16_t*)(ws + OFF_KB), (bf16_t*)(ws + OFF_VB), (const float*)(ws + OFF_ROPE),
                             p.out + (size_t)NTOK * D, p.out + (size_t)NTOK * D + (size_t)32 * 2 * 256 * 128, l};
                    for (int _d = 0; _d < DUP_GEMM; ++_d) pg8::gemm_phase(lds, g, S, E); }
                GSYNC();
                { pg8::Gemm g{(const bf16_t*)(ws + OFF_FL), (const bf16_t*)(ws + OFF_ZT) + ZT_LAT, 1024, 2048, 2048, 2048, 2048};
                    pg8::StaticOrder S; S.init(g.M, g.N, G, c); EpiFourier E{(bf16_t*)(ws + OFF_YCAT), NCTX, 1024};
                    for (int _d = 0; _d < DUP_GEMM; ++_d) pg8::gemm_phase(lds, g, S, E); }
                { pg8::Gemm g{(const bf16_t*)(ws + OFF_FC), (const bf16_t*)(ws + OFF_ZT), 256, 8192, 512, 512, 512};
                    pg8::StaticOrder S; S.init(g.M, g.N, G, c - 32); EpiFourier E{(bf16_t*)(ws + OFF_YCAT), 0, 256};
                    for (int _d = 0; _d < DUP_GEMM; ++_d) pg8::gemm_phase(lds, g, S, E); }
                __syncthreads();
                for (int _d = 0; _d < DUP_HY; ++_d) hyena_mfma(p, l, lds);
                for (int _d = 0; _d < DUP_AT; ++_d) attn_mfma(p, l);
                GSYNC();
                { pg8::Gemm g{(const bf16_t*)(ws + OFF_YCAT), (const bf16_t*)(ws + OFF_WOUT + l * SZ_WOUT), NTOK, 1024, 1024, 1024, 1024};
                    pg8::StaticOrder S; S.init(g.M, g.N, G, c); EpiYssq E{(bf16_t*)(ws + OFF_Y), (float*)(ws + OFF_SSQ)};
                    for (int _d = 0; _d < DUP_GEMM; ++_d) pg8::gemm_phase(lds, g, S, E); }
                GSYNC();
            }
            if (l == 1 && s == 2) phase_row<2>(p, l, s, 0, 0);
            else { const int ln = s == 2 ? l + 1 : l, sn = s == 2 ? 0 : s + 1; phase_row<1>(p, l, s, ln, sn); }
            if (!(l == 1 && s == 2)) GSYNC();
        }
    }
}

extern "C" void kernel_launch(void* const* d_in, const int* in_sizes, int n_in, void* d_out, int out_size, void* d_ws, size_t ws_size, hipStream_t stream) {
    constexpr int LDS_BYTES = 149 * 1024 + 256;
    static int grid_blocks = 0;
    if (!grid_blocks) {
        if (n_in != 24 || ws_size < WS_END) { fprintf(stderr, "kernel_launch: bad inputs (n_in %d) or workspace too small (%zu < %zu)\n", n_in, ws_size, (size_t)WS_END); grid_blocks = -1; return; }
        int dev = 0, cus = 0, per_cu = 0;
        hipGetDevice(&dev);
        hipDeviceGetAttribute(&cus, hipDeviceAttributeMultiprocessorCount, dev);
        if (hipFuncSetAttribute((const void*)fwd_megakernel, hipFuncAttributeMaxDynamicSharedMemorySize, LDS_BYTES) != hipSuccess) fprintf(stderr, "kernel_launch: hipFuncSetAttribute failed\n");
        hipOccupancyMaxActiveBlocksPerMultiprocessor(&per_cu, (const void*)fwd_megakernel, NTHREADS, LDS_BYTES);
        if (per_cu < 1) { fprintf(stderr, "kernel_launch: occupancy query says %d blocks per CU\n", per_cu); per_cu = 1; }
        (void)hipGetLastError();
        grid_blocks = cus * per_cu;
        if (grid_blocks > 256) grid_blocks = 256;
    }
    if (grid_blocks < 0) return;
    Params p{};
    for (int i = 0; i < 24; ++i) p.in[i] = (const float*)d_in[i];
    p.out = (float*)d_out; p.ws = (unsigned char*)d_ws;
    (void)hipMemsetAsync((unsigned char*)d_ws + OFF_BAR, 0, 16384, stream);
    void* args[] = {&p};
    hipError_t e = hipLaunchCooperativeKernel((const void*)fwd_megakernel, dim3(grid_blocks), dim3(NTHREADS), args, LDS_BYTES, stream);
    if (e != hipSuccess) fprintf(stderr, "cooperative launch failed: %s (grid %d)\n", hipGetErrorString(e), grid_blocks);
}
```

```cpp
#include <hip/hip_runtime.h>
#include <hip/hip_cooperative_groups.h>
#include <cstdio>
namespace cg = cooperative_groups;

#define LAS __attribute__((address_space(3)))
#ifndef DUP_PA
#define DUP_PA 1
#endif
#ifndef DUP_PB
#define DUP_PB 1
#endif
#ifndef DUP_PC
#define DUP_PC 1
#endif
#ifndef DUP_PD
#define DUP_PD 1
#endif
#ifndef DUP_HY
#define DUP_HY 1
#endif
#ifndef DUP_AT
#define DUP_AT 1
#endif
#ifndef DUP_GEMM
#define DUP_GEMM 1
#endif
#ifndef DUP_MIX
#define DUP_MIX 1
#endif
#ifndef DUP_PREP
#define DUP_PREP 1
#endif
#ifndef DUP_SYNC
#define DUP_SYNC 1
#endif
#define GSYNC() do { for (int _s = 0; _s < DUP_SYNC; ++_s) xcd_barrier(xb); } while (0)
typedef unsigned short bf16_t;
typedef short bf16x8 __attribute__((ext_vector_type(8)));
typedef float f32x4 __attribute__((ext_vector_type(4)));
typedef unsigned u32x4 __attribute__((ext_vector_type(4)));
typedef unsigned u32x2 __attribute__((ext_vector_type(2)));

constexpr int D = 1024, NTOK = 16384, NCTX = 8192, DFF = 2816, INW = 1792;
constexpr int NTHREADS = 512;
constexpr float EPS = 1e-6f;
constexpr float PI2 = 6.283185307179586f;

constexpr size_t AL(size_t x) { return (x + 255) & ~(size_t)255; }
constexpr size_t SZ_WGU = (size_t)5632 * 1024 * 2, SZ_WD = (size_t)1024 * 2816 * 2, SZ_WIN = (size_t)2048 * 1024 * 2, SZ_WOUT = (size_t)1024 * 1024 * 2;
constexpr size_t OFF_WGU = 0;
constexpr size_t OFF_WD = OFF_WGU + 4 * SZ_WGU;
constexpr size_t OFF_WIN = OFF_WD + 4 * SZ_WD;
constexpr size_t OFF_WOUT = OFF_WIN + 2 * SZ_WIN;
constexpr size_t OFF_H = OFF_WOUT + 2 * SZ_WOUT;
constexpr size_t OFF_Y = OFF_H + (size_t)NTOK * D * 2;
constexpr size_t OFF_SSQ = OFF_Y + (size_t)NTOK * D * 2;
constexpr size_t OFF_MOD = OFF_SSQ + (size_t)NTOK * 16 * 4;
constexpr size_t OFF_FILT = AL(OFF_MOD + (size_t)2 * 9 * 9216 * 4);
constexpr size_t FILT_CTX = (size_t)4 * 256 * 256, FILT_LAT = (size_t)4 * 256 * 1024, FILT_L = FILT_CTX + FILT_LAT;
constexpr size_t G_CTX = (size_t)2 * 256 * 512, G_LAT = (size_t)2 * 256 * 2048, G_L = G_CTX + G_LAT;
constexpr size_t OFF_FC = AL(OFF_FILT + 2 * FILT_L * 4);
constexpr size_t OFF_FL = OFF_FC + (size_t)256 * 512 * 2;
constexpr size_t OFF_ROPE = OFF_FL + (size_t)1024 * 2048 * 2;
constexpr size_t OFF_BAR = AL(OFF_ROPE + 64 * 16 * 8);
constexpr size_t OFF_CKB = OFF_BAR + 16384;
constexpr size_t OFF_CVT = OFF_CKB + (size_t)2 * 8 * 256 * 128 * 2;
constexpr size_t OFF_UNION = AL(OFF_CVT + (size_t)2 * 8 * 256 * 128 * 2);
constexpr size_t OFF_ACT = OFF_UNION;
constexpr size_t OFF_ZT = OFF_UNION;
constexpr size_t ZT_LAT = (size_t)NCTX * 512;
constexpr size_t OFF_HT = OFF_ZT + (size_t)NTOK * 512 * 2;
constexpr size_t HT_LAT = (size_t)NCTX * 768;
constexpr size_t OFF_QB = OFF_HT + (size_t)NTOK * 768 * 2;
constexpr size_t OFF_KB = OFF_QB + (size_t)NTOK * 512 * 2;
constexpr size_t OFF_VB = OFF_KB + (size_t)NTOK * 128 * 2;
constexpr size_t VT_LAT = (size_t)NCTX * 128;
constexpr size_t OFF_YCAT = OFF_VB + (size_t)NTOK * 128 * 2;
constexpr size_t UNION_END = OFF_YCAT + (size_t)NTOK * 1024 * 2;
constexpr size_t ACT_END = OFF_ACT + (size_t)NTOK * DFF * 2;
constexpr size_t WS_END = (UNION_END > ACT_END ? UNION_END : ACT_END);

struct Params {
    const float* in[24];
    float* out;
    unsigned char* ws;
};

__device__ __forceinline__ unsigned short f2bf(float f) { unsigned u = __float_as_uint(f); u += 0x7FFFu + ((u >> 16) & 1u); return (unsigned short)(u >> 16); }
__device__ __forceinline__ float bf2f(unsigned short b) { return __uint_as_float(((unsigned)b) << 16); }
__device__ __forceinline__ unsigned cvt_pk_bf16(float lo, float hi) { unsigned r; asm volatile("v_cvt_pk_bf16_f32 %0, %1, %2" : "=v"(r) : "v"(lo), "v"(hi)); return r; }
typedef __bf16 bf16x2_t __attribute__((ext_vector_type(2)));
typedef float f32x2_t __attribute__((ext_vector_type(2)));
typedef float f32x16 __attribute__((ext_vector_type(16)));
__device__ __forceinline__ unsigned pk_bf16(float lo, float hi) { f32x2_t v = {lo, hi}; return __builtin_bit_cast(unsigned, __builtin_convertvector(v, bf16x2_t)); }
__device__ __forceinline__ float silu_f(float x) { return x * __builtin_amdgcn_rcpf(1.0f + __expf(-x)); }
__device__ __forceinline__ int perm32(int rho) { const int n = rho >> 4, i = rho & 15; return 8 * (i >> 2) + 4 * n + (i & 3); }

__device__ __forceinline__ int opaque_tid() { int t = threadIdx.x; asm volatile("" : "+v"(t)); return t; }


#define XB_TMO      128
#define XB_XCNT(j)  (256  + 64 * (j))
#define XB_XSUB(j)  (1280 + 64 * (j))
#define XB_XGEN(j)  (2304 + 64 * (j))
#define XB_TOP      3328
#define XB_TOPGEN   3392
#define XCD_BAR_WORDS 3456
#define XB_SPIN_CAP (1u << 22)
__device__ __forceinline__ unsigned xb_ld(unsigned* p)              { return __hip_atomic_load(p, __ATOMIC_RELAXED, __HIP_MEMORY_SCOPE_AGENT); }
__device__ __forceinline__ unsigned xb_add(unsigned* p, unsigned v) { return __hip_atomic_fetch_add(p, v, __ATOMIC_RELAXED, __HIP_MEMORY_SCOPE_AGENT); }
__device__ __forceinline__ unsigned xb_xcc_id() { return (unsigned)__builtin_amdgcn_s_getreg((3 << 11) | 20) & 0xFu; }
#define XB_SPIN(cond, bar) do { unsigned _sp = 0; while (cond) { __builtin_amdgcn_s_sleep(1); \
    if ((++_sp & 255u) == 0u) { if (xb_ld(&(bar)[XB_TMO])) break; if (_sp > XB_SPIN_CAP) { atomicAdd(&(bar)[XB_TMO], 1u); break; } } } } while (0)
struct XcdBarrier { unsigned* bar; unsigned x; volatile LAS unsigned* st; };
__device__ __forceinline__ XcdBarrier xcd_barrier_post(unsigned* bar, volatile LAS unsigned* st) {
    XcdBarrier b; b.bar = bar; b.x = xb_xcc_id(); b.st = st;
    if (threadIdx.x == 0) (void)xb_add(&bar[XB_XCNT(b.x)], 1u);
    return b;
}
__device__ __forceinline__ void xcd_barrier_complete(unsigned* bar, unsigned x, unsigned& nloc, unsigned& nx) {
    const unsigned G = gridDim.x * gridDim.y * gridDim.z;
    unsigned sum, cnt, mine, sp = 0u;
    for (;;) {
        sum = 0u; cnt = 0u; mine = 0u;
#pragma unroll
        for (unsigned j = 0; j < 16; ++j) { const unsigned c = xb_ld(&bar[XB_XCNT(j)]); sum += c; cnt += (c > 0u) ? 1u : 0u; mine = (j == x) ? c : mine; }
        if (sum == G) break;
        __builtin_amdgcn_s_sleep(1);
        if ((++sp & 255u) == 0u) { if (xb_ld(&bar[XB_TMO])) break; if (sp > XB_SPIN_CAP) { atomicAdd(&bar[XB_TMO], 1u); break; } }
    }
    nloc = mine > 0u ? mine : 1u; nx = cnt > 0u ? cnt : 1u;
}
__device__ __forceinline__ void xcd_barrier(const XcdBarrier& b) {
    asm volatile("s_waitcnt vmcnt(0)" ::: "memory");
    __syncthreads();
    if (threadIdx.x == 0) {
        unsigned* bar = b.bar;
        __builtin_amdgcn_s_waitcnt(0);
        unsigned nloc = b.st[0], nx = b.st[1];
        if (nloc == 0u) { xcd_barrier_complete(bar, b.x, nloc, nx); b.st[0] = nloc; b.st[1] = nx; }
        const unsigned old = xb_add(&bar[XB_XSUB(b.x)], 1u);
        const unsigned gen = old / nloc;
        if (old + 1u == (gen + 1u) * nloc) {
            __builtin_amdgcn_fence(__ATOMIC_RELEASE, "agent");
            asm volatile("s_waitcnt vmcnt(0)" ::: "memory");
            const unsigned og = xb_add(&bar[XB_TOP], 1u);
            const unsigned tg = og / nx;
            if (og + 1u == (tg + 1u) * nx) xb_add(&bar[XB_TOPGEN], 1u);
            else XB_SPIN(xb_ld(&bar[XB_TOPGEN]) == tg, bar);
            __builtin_amdgcn_fence(__ATOMIC_ACQUIRE, "agent");
            xb_add(&bar[XB_XGEN(b.x)], 1u);
            asm volatile("s_waitcnt vmcnt(0)" ::: "memory");
        } else {
            XB_SPIN(xb_ld(&bar[XB_XGEN(b.x)]) == gen, bar);
            __builtin_amdgcn_fence(__ATOMIC_ACQUIRE, "agent");
            asm volatile("s_waitcnt vmcnt(0)" ::: "memory");
        }
    }
    __syncthreads();
}

namespace pg8 {
constexpr int BM = 256, BK = 64, HALF = 128, HTB = HALF * BK * 2, STAGE_BYTES = 8 * HTB, NXCD = 8, WGM = 8;
__device__ __forceinline__ int lds_byte(int r, int c) { const int st = (r >> 4) * 2 + (c >> 5), rr = r & 15, cc = c & 31, ob = rr * 64 + cc * 2; return st * 1024 + (ob ^ (((ob >> 9) & 1) << 5)); }
__device__ __forceinline__ void stage_rc(int b, int& R, int& C) { const int st = b / 1024, sb = b % 1024, swz = sb ^ (((sb >> 9) & 1) << 5); R = (st >> 1) * 16 + swz / 64; C = (st & 1) * 32 + (swz % 64) / 2; }
struct Unit { int pm, pn; };
struct Gemm { const bf16_t* A; const bf16_t* Bt; int M, N, K, lda, ldb; };
struct StaticOrder {
    int nM, nN, nwg, G, c;
    __device__ void init(int M, int N, int G_, int c_) { nM = M / BM; nN = N / BM; nwg = nM * nN; G = G_; c = c_; }
    __device__ bool next(int i, Unit& u) const {
        if (c < 0) return false;
        const long L = (long)i * G + c; if (L >= nwg) return false;
        int wgid = (int)L; { const int q = nwg / NXCD, r = nwg % NXCD, xcd = wgid % NXCD, off = wgid / NXCD; wgid = (xcd < r ? xcd * (q + 1) : r * (q + 1) + (xcd - r) * q) + off; }
        const int nig = WGM * nN, gid = wgid / nig, fm = gid * WGM, gsz = (nM - fm) < WGM ? (nM - fm) : WGM;
        u.pm = fm + ((wgid % nig) % gsz); u.pn = (wgid % nig) / gsz; return true;
    }
    __device__ __forceinline__ void a_ready(const Unit&) const {}
    __device__ __forceinline__ void done(const Unit&) const {}
};

template <class Epi, class Sched>
__device__ __forceinline__ void gemm_phase(LAS unsigned char* lds, Gemm g, const Sched& S, const Epi& E) {
    asm volatile("" : "+s"(g.A), "+s"(g.Bt), "+s"(g.K), "+s"(g.lda), "+s"(g.ldb));
    int tid = threadIdx.x; asm volatile("" : "+v"(tid));
    const int wid = __builtin_amdgcn_readfirstlane(tid >> 6), lane = tid & 63, wr = wid >> 2, wc = wid & 3, fr = lane & 15, fq = lane >> 4;
    const int K = g.K, nt = K / BK;
    unsigned voffA[2], voffB[2];
#pragma unroll
    for (int i = 0; i < 2; ++i) { int R, C; stage_rc(tid * 16 + i * 8192, R, C);
        voffA[i] = (unsigned)(R * g.lda + C) * 2u; voffB[i] = (unsigned)(R * g.ldb + C) * 2u; }
    const size_t kstep = (size_t)(BK * 2);
    const size_t hstepA = (size_t)HALF * g.lda * 2, hstepB = (size_t)HALF * g.ldb * 2;
    const size_t tstepA = 2 * hstepA, tstepB = 2 * hstepB;
    const unsigned ldsw = (unsigned)wid * 1024u;
    const int aoff = lds_byte(wr * 64 + fr, fq * 8), boff = lds_byte(wc * 32 + fr, fq * 8);
#define PG8_SA(b, h) (((b) * 2 + (h)) * HTB)
#define PG8_SB(b, h) ((4 + (b) * 2 + (h)) * HTB)
#define PG8_STAGE(bufoff, gbase, voff) do { _Pragma("unroll") for (int _i = 0; _i < 2; ++_i) \
        __builtin_amdgcn_global_load_lds((const unsigned*)((const char*)(gbase) + (voff)[_i]), (LAS unsigned*)(lds + (bufoff) + ldsw + _i * 8192), 16, 0, 0); } while (0)
#define PG8_LDA(dst, b, h) do { _Pragma("unroll") for (int m = 0; m < 4; ++m) _Pragma("unroll") for (int k = 0; k < 2; ++k) dst[m][k] = *(const LAS bf16x8*)(lds + PG8_SA(b, h) + aoff + m * 2048 + k * 1024); } while (0)
#define PG8_LDB(dst, b, h) do { _Pragma("unroll") for (int n = 0; n < 2; ++n) _Pragma("unroll") for (int k = 0; k < 2; ++k) dst[n][k] = *(const LAS bf16x8*)(lds + PG8_SB(b, h) + boff + n * 2048 + k * 1024); } while (0)
#define PG8_MMA(ai, bj, At, Bt) do { __builtin_amdgcn_s_setprio(1); _Pragma("unroll") for (int m = 0; m < 4; ++m) _Pragma("unroll") for (int n = 0; n < 2; ++n) _Pragma("unroll") for (int k = 0; k < 2; ++k) \
        acc[ai][bj][m][n] = __builtin_amdgcn_mfma_f32_16x16x32_bf16(Bt[n][k], At[m][k], acc[ai][bj][m][n], 0, 0, 0); __builtin_amdgcn_s_setprio(0); } while (0)
#define PG8_WAIT_V(n) asm volatile("s_waitcnt vmcnt(" #n ")" ::: "memory")
#define PG8_WAIT_L(n) asm volatile("s_waitcnt lgkmcnt(" #n ")" ::: "memory")
#define PG8_BAR __builtin_amdgcn_s_barrier()
#define PG8_SCHED __builtin_amdgcn_sched_barrier(0)
    Unit cur, nxt; int ui = 0;
    if (!S.next(0, cur)) return;
    f32x4 acc[2][2][4][2];
#pragma unroll
    for (int a = 0; a < 2; ++a)
#pragma unroll
        for (int b = 0; b < 2; ++b)
#pragma unroll
            for (int m = 0; m < 4; ++m)
#pragma unroll
                for (int n = 0; n < 2; ++n) acc[a][b][m][n] = (f32x4){0.f, 0.f, 0.f, 0.f};
    bf16x8 At[4][2], B0[2][2], B1[2][2];
    const char* cA = (const char*)g.A + (size_t)cur.pm * tstepA; const char* cB = (const char*)g.Bt + (size_t)cur.pn * tstepB;
    S.a_ready(cur);
    PG8_STAGE(PG8_SB(0, 0), cB, voffB); PG8_STAGE(PG8_SA(0, 0), cA, voffA); PG8_STAGE(PG8_SB(0, 1), cB + hstepB, voffB); PG8_STAGE(PG8_SA(0, 1), cA + hstepA, voffA);
    if (wr == 1) PG8_BAR;
    PG8_WAIT_V(4); PG8_BAR;
    PG8_STAGE(PG8_SB(1, 0), cB + kstep, voffB); PG8_STAGE(PG8_SA(1, 0), cA + kstep, voffA); PG8_STAGE(PG8_SB(1, 1), cB + hstepB + kstep, voffB);
    PG8_WAIT_V(6); PG8_BAR;
    for (;;) {
        const bool has_next = S.next(ui + 1, nxt);
        const char* nA = has_next ? (const char*)g.A + (size_t)nxt.pm * tstepA : cA; const char* nB = has_next ? (const char*)g.Bt + (size_t)nxt.pn * tstepB : cB;
        for (int t = 0; t < nt; t += 2) {
            const bool last = (t == nt - 2);
            const char* a1 = cA + (size_t)(t + 1) * kstep;
            const char* a2 = last ? nA : cA + (size_t)(t + 2) * kstep; const char* b2 = last ? nB : cB + (size_t)(t + 2) * kstep;
            const char* a3 = a2 + kstep; const char* b3 = b2 + kstep;
            if (last && has_next) S.a_ready(nxt);
            PG8_LDB(B0, 0, 0); PG8_SCHED; PG8_LDA(At, 0, 0); PG8_STAGE(PG8_SA(1, 1), a1 + hstepA, voffA);
            PG8_WAIT_L(8); PG8_BAR; PG8_WAIT_L(0); PG8_MMA(0, 0, At, B0); PG8_BAR; PG8_SCHED;
            PG8_LDB(B1, 0, 1); PG8_STAGE(PG8_SB(0, 0), b2, voffB);
            PG8_BAR; PG8_WAIT_L(0); PG8_MMA(0, 1, At, B1); PG8_BAR;
            PG8_LDA(At, 0, 1); PG8_STAGE(PG8_SA(0, 0), a2, voffA);
            PG8_BAR; PG8_WAIT_L(0); PG8_MMA(1, 0, At, B0); PG8_BAR; PG8_SCHED;
            PG8_STAGE(PG8_SB(0, 1), b2 + hstepB, voffB);
            PG8_WAIT_V(6); PG8_BAR; PG8_MMA(1, 1, At, B1); PG8_BAR;
            PG8_LDB(B0, 1, 0); PG8_SCHED; PG8_LDA(At, 1, 0); PG8_STAGE(PG8_SA(0, 1), a2 + hstepA, voffA);
            PG8_WAIT_L(8); PG8_BAR; PG8_WAIT_L(0); PG8_MMA(0, 0, At, B0); PG8_BAR; PG8_SCHED;
            PG8_LDB(B1, 1, 1); PG8_STAGE(PG8_SB(1, 0), b3, voffB);
            PG8_BAR; PG8_WAIT_L(0); PG8_MMA(0, 1, At, B1); PG8_BAR;
            PG8_LDA(At, 1, 1); PG8_STAGE(PG8_SA(1, 0), a3, voffA);
            PG8_BAR; PG8_WAIT_L(0); PG8_MMA(1, 0, At, B0); PG8_BAR; PG8_SCHED;
            PG8_STAGE(PG8_SB(1, 1), b3 + hstepB, voffB);
            PG8_WAIT_V(6); PG8_BAR; PG8_MMA(1, 1, At, B1); PG8_BAR;
        }
        { int fr2 = fr, fq2 = fq, wr2 = wr, wc2 = wc; asm volatile("" : "+v"(fr2), "+v"(fq2), "+s"(wr2), "+s"(wc2));
            E(acc, cur, wr2, wc2, fr2, fq2); } S.done(cur);
        if (!has_next) break;
#pragma unroll
        for (int a = 0; a < 2; ++a)
#pragma unroll
            for (int b = 0; b < 2; ++b)
#pragma unroll
                for (int m = 0; m < 4; ++m)
#pragma unroll
                    for (int n = 0; n < 2; ++n) acc[a][b][m][n] = (f32x4){0.f, 0.f, 0.f, 0.f};
        cur = nxt; cA = nA; cB = nB; ++ui;
    }
    PG8_WAIT_V(0);
    if (wr == 0) PG8_BAR;
    PG8_BAR;
#undef PG8_SA
#undef PG8_SB
#undef PG8_STAGE
#undef PG8_LDA
#undef PG8_LDB
#undef PG8_MMA
#undef PG8_WAIT_V
#undef PG8_WAIT_L
#undef PG8_BAR
#undef PG8_SCHED
}
}

struct EpiSwiglu {
    bf16_t* O;
    __device__ __forceinline__ void operator()(const f32x4 (&acc)[2][2][4][2], const pg8::Unit& u, int wr, int wc, int fr, int fq) const {
        const int row0 = u.pm * 256 + wr * 64 + fr, col0 = u.pn * 128 + wc * 32 + 8 * fq;
#pragma unroll
        for (int ai = 0; ai < 2; ++ai)
#pragma unroll
            for (int m = 0; m < 4; ++m) {
                bf16_t* rowp = O + (size_t)(row0 + ai * 128 + m * 16) * DFF + col0;
                const f32x4 g0 = acc[ai][0][m][0], g1 = acc[ai][0][m][1], u0 = acc[ai][1][m][0], u1 = acc[ai][1][m][1];
                u32x4 w;
                w.x = cvt_pk_bf16(silu_f(g0[0]) * u0[0], silu_f(g0[1]) * u0[1]); w.y = cvt_pk_bf16(silu_f(g0[2]) * u0[2], silu_f(g0[3]) * u0[3]);
                w.z = cvt_pk_bf16(silu_f(g1[0]) * u1[0], silu_f(g1[1]) * u1[1]); w.w = cvt_pk_bf16(silu_f(g1[2]) * u1[2], silu_f(g1[3]) * u1[3]);
                *(u32x4*)rowp = w;
            }
    }
};
struct EpiYssq {
    bf16_t* Y; float* ssq;
    __device__ __forceinline__ void operator()(const f32x4 (&acc)[2][2][4][2], const pg8::Unit& u, int wr, int wc, int fr, int fq) const {
        const int row0 = u.pm * 256 + wr * 64 + fr, col0 = u.pn * 256 + wc * 32 + 8 * fq;
#pragma unroll
        for (int ai = 0; ai < 2; ++ai)
#pragma unroll
            for (int m = 0; m < 4; ++m) {
                const int row = row0 + ai * 128 + m * 16;
                bf16_t* rowp = Y + (size_t)row * D + col0;
                float s = 0.f;
#pragma unroll
                for (int bj = 0; bj < 2; ++bj) {
                    const f32x4 v0 = acc[ai][bj][m][0], v1 = acc[ai][bj][m][1];
                    s += v0[0] * v0[0] + v0[1] * v0[1] + v0[2] * v0[2] + v0[3] * v0[3] + v1[0] * v1[0] + v1[1] * v1[1] + v1[2] * v1[2] + v1[3] * v1[3];
                    u32x4 w; w.x = cvt_pk_bf16(v0[0], v0[1]); w.y = cvt_pk_bf16(v0[2], v0[3]); w.z = cvt_pk_bf16(v1[0], v1[1]); w.w = cvt_pk_bf16(v1[2], v1[3]);
                    *(u32x4*)(rowp + bj * 128) = w;
                }
                s += __shfl_xor(s, 16); s += __shfl_xor(s, 32);
                if (fq == 0) ssq[(size_t)row * 16 + u.pn * 4 + wc] = s;
            }
    }
};
struct EpiWin {
    bf16_t* ZT; bf16_t* HT; bf16_t* QB; bf16_t* KB; bf16_t* VB; const float* rope; float* newk; float* newv; int layer;
    __device__ __forceinline__ void operator()(const f32x4 (&acc)[2][2][4][2], const pg8::Unit& u, int wr, int wc, int fr, int fq) const {
        const int r0 = u.pm * 256 + wr * 64 + fr;
        const bool lat = u.pm >= 32;
        const int pn = u.pn;
        if (pn < 5) {
            bf16_t* base; int t0; size_t sch;
            if (pn < 2) {
                if (!lat) { const int b = u.pm; base = ZT + ((size_t)b * 256 * 2 + pn) * 256; sch = 512; t0 = r0 - u.pm * 256; }
                else { const int b = (u.pm - 32) >> 2; base = ZT + ZT_LAT + ((size_t)b * 256 * 2 + pn) * 1024; sch = 2048; t0 = r0 - NCTX - b * 1024; }
            } else {
                const int c0 = (pn - 2) * 256;
                if (!lat) { const int b = u.pm; base = HT + ((size_t)b * 768 + c0) * 256; sch = 256; t0 = r0 - u.pm * 256; }
                else { const int b = (u.pm - 32) >> 2; base = HT + HT_LAT + ((size_t)b * 768 + c0) * 1024; sch = 1024; t0 = r0 - NCTX - b * 1024; }
            }
#pragma unroll
            for (int ai = 0; ai < 2; ++ai)
#pragma unroll
                for (int m = 0; m < 4; ++m) {
                    const int t = t0 + ai * 128 + m * 16;
#pragma unroll
                    for (int bj = 0; bj < 2; ++bj)
#pragma unroll
                        for (int n = 0; n < 2; ++n) {
                            const int ch = bj * 128 + wc * 32 + n * 16 + 4 * fq;
                            const f32x4 v = acc[ai][bj][m][n];
#pragma unroll
                            for (int e = 0; e < 4; ++e) base[(size_t)(ch + e) * sch + t] = f2bf(v[e]);
                        }
                }
        } else {
            const int blk = wc & 1;
#pragma unroll
            for (int ai = 0; ai < 2; ++ai)
#pragma unroll
                for (int m = 0; m < 4; ++m) {
                    const int row = r0 + ai * 128 + m * 16;
                    f32x4 cs0 = {1.f, 0.f, 1.f, 0.f}, cs1 = {1.f, 0.f, 1.f, 0.f};
                    if (lat) { const int t = row & 1023; const int pos = blk ? (t & 63) : (t >> 6);
                        const f32x4* rp = (const f32x4*)(rope + (size_t)(pos * 16 + 4 * fq) * 2); cs0 = rp[0]; cs1 = rp[1]; }
#pragma unroll
                    for (int bj = 0; bj < 2; ++bj) {
                        f32x4 x1 = acc[ai][bj][m][0], x2 = acc[ai][bj][m][1];
                        const bool isv = (pn == 7 && bj == 1);
                        const bool isk = (pn == 7 && bj == 0);
                        const int cc = bj * 128 + wc * 32 + 4 * fq;
                        if ((isk || isv) && !lat) {
                            const int b = row >> 8, t = row & 255;
                            float* dst = (isk ? newk : newv) + (((size_t)b * 2 + layer) * 256 + t) * 128 + (cc & 127);
                            *(f32x4*)dst = x1; *(f32x4*)(dst + 16) = x2;
                        }
                        if (!isv) {
                            f32x4 o1, o2;
                            o1[0] = x1[0] * cs0[0] - x2[0] * cs0[1]; o2[0] = x2[0] * cs0[0] + x1[0] * cs0[1];
                            o1[1] = x1[1] * cs0[2] - x2[1] * cs0[3]; o2[1] = x2[1] * cs0[2] + x1[1] * cs0[3];
                            o1[2] = x1[2] * cs1[0] - x2[2] * cs1[1]; o2[2] = x2[2] * cs1[0] + x1[2] * cs1[1];
                            o1[3] = x1[3] * cs1[2] - x2[3] * cs1[3]; o2[3] = x2[3] * cs1[2] + x1[3] * cs1[3];
                            x1 = o1; x2 = o2;
                        }
                        bf16_t* dst;
                        if (pn < 7) { x1 *= 0.125f; x2 *= 0.125f; dst = QB + (size_t)row * 512 + (pn - 5) * 256 + cc; }
                        else if (isk) dst = KB + (size_t)row * 128 + cc;
                        else {
                            bf16_t* vb; size_t n_;
                            if (!lat) { vb = VB + (size_t)(row >> 8) * 128 * 256 + (row & 255); n_ = 256; } else { vb = VB + VT_LAT + (size_t)((row - NCTX) >> 10) * 128 * 1024 + (row & 1023); n_ = 1024; }
                            const int c0 = cc - 128;
#pragma unroll
                            for (int e = 0; e < 4; ++e) { vb[(size_t)(c0 + e) * n_] = f2bf(x1[e]); vb[(size_t)(c0 + 16 + e) * n_] = f2bf(x2[e]); }
                            continue;
                        }
                        u32x2 w1, w2; w1.x = cvt_pk_bf16(x1[0], x1[1]); w1.y = cvt_pk_bf16(x1[2], x1[3]); w2.x = cvt_pk_bf16(x2[0], x2[1]); w2.y = cvt_pk_bf16(x2[2], x2[3]);
                        *(u32x2*)dst = w1; *(u32x2*)(dst + 16) = w2;
                    }
                }
        }
    }
};
struct EpiFourier {
    bf16_t* YC; int rowbase, n;
    __device__ __forceinline__ void operator()(const f32x4 (&acc)[2][2][4][2], const pg8::Unit& u, int wr, int wc, int fr, int fq) const {
        const int kp0 = u.pm * 256 + wr * 64 + fr; const int b = u.pn;
#pragma unroll
        for (int ai = 0; ai < 2; ++ai)
#pragma unroll
            for (int m = 0; m < 4; ++m) {
                bf16_t* rowp = YC + (size_t)(rowbase + b * n + kp0 + ai * 128 + m * 16) * 1024 + wc * 32 + 4 * fq;
#pragma unroll
                for (int bj = 0; bj < 2; ++bj)
#pragma unroll
                    for (int nn = 0; nn < 2; ++nn) { const f32x4 v = acc[ai][bj][m][nn]; u32x2 w; w.x = cvt_pk_bf16(v[0], v[1]); w.y = cvt_pk_bf16(v[2], v[3]);
                        *(u32x2*)(rowp + bj * 128 + nn * 16) = w; }
            }
    }
};

struct TrUnit { const float* src; bf16_t* dst; int ld, k0, cbase, Kd, r0, perm; };
__device__ __forceinline__ TrUnit tr_unit(const Params& p, int u) {
    constexpr int U_GU = 4 * 44 * 16, U_D = 4 * 8 * 44, U_OUT = 2 * 8 * 16;
    TrUnit t; unsigned char* ws = p.ws;
    if (u < U_GU) { const int ls = u / (44 * 16), rem = u % (44 * 16), rg = rem / 16, kb = rem % 16; const int pn = rg >> 1, half = rg & 1;
        t.src = (half ? p.in[10] : p.in[9]) + (size_t)ls * 1024 * DFF; t.ld = DFF; t.k0 = kb * 64; t.cbase = pn * 128; t.dst = (bf16_t*)(ws + OFF_WGU + ls * SZ_WGU); t.Kd = 1024; t.r0 = rg * 128; t.perm = 1; }
    else if (u < U_GU + U_D) { const int v = u - U_GU; const int ls = v / (8 * 44), rem = v % (8 * 44), rg = rem / 44, kb = rem % 44;
        t.src = p.in[11] + (size_t)ls * DFF * 1024; t.ld = 1024; t.k0 = kb * 64; t.cbase = rg * 128; t.dst = (bf16_t*)(ws + OFF_WD + ls * SZ_WD); t.Kd = DFF; t.r0 = rg * 128; t.perm = 1; }
    else if (u < U_GU + U_D + U_OUT) { const int v = u - U_GU - U_D; const int l = v / 128, rem = v % 128, rg = rem / 16, kb = rem % 16;
        t.src = p.in[13] + (size_t)l * 1024 * 1024; t.ld = 1024; t.k0 = kb * 64; t.cbase = rg * 128; t.dst = (bf16_t*)(ws + OFF_WOUT + l * SZ_WOUT); t.Kd = 1024; t.r0 = rg * 128; t.perm = 1; }
    else { const int v = u - U_GU - U_D - U_OUT; const int l = v / (12 * 16), rem = v % (12 * 16), rg = rem / 16, kb = rem % 16;
        t.src = p.in[12] + (size_t)l * 1024 * INW; t.ld = INW; t.k0 = kb * 64; t.cbase = 256 + rg * 128; t.dst = (bf16_t*)(ws + OFF_WIN + l * SZ_WIN); t.Kd = 1024; t.r0 = 512 + rg * 128; t.perm = 0; }
    return t;
}
__device__ __forceinline__ void tr_load(const TrUnit& t, int tid, f32x4 (&v)[4]) {
#pragma unroll
    for (int i = 0; i < 4; ++i) { const int idx = tid + 512 * i, kk = idx >> 5, c4 = idx & 31;
        v[i] = *(const f32x4*)(t.src + (size_t)(t.k0 + kk) * t.ld + t.cbase + c4 * 4); }
}
__device__ void phase_prep(const Params& p, float* lds) {
    const int tid = opaque_tid(), nb = gridDim.x, bid = blockIdx.x;
    unsigned char* ws = p.ws;
    {
        constexpr int NU = 4 * 44 * 16 + 4 * 8 * 44 + 2 * 8 * 16 + 2 * 12 * 16;
        constexpr int TS = 132;
        f32x4 v[4];
        int u = bid;
        TrUnit cur; if (u < NU) { cur = tr_unit(p, u); tr_load(cur, tid, v); }
        while (u < NU) {
#pragma unroll
            for (int i = 0; i < 4; ++i) { const int idx = tid + 512 * i, kk = idx >> 5, c4 = idx & 31; *(f32x4*)(lds + kk * TS + c4 * 4) = v[i]; }
            __syncthreads();
            const int un = u + nb; TrUnit nxt = cur;
            if (un < NU) { nxt = tr_unit(p, un); tr_load(nxt, tid, v); }
            { const int rr = tid >> 2, kc = tid & 3; const int cc = cur.perm ? ((rr & ~31) + perm32(rr & 31)) : rr;
                float x[16];
#pragma unroll
                for (int j = 0; j < 16; ++j) x[j] = lds[(kc * 16 + j) * TS + cc];
                u32x4 w0, w1; w0.x = pk_bf16(x[0], x[1]); w0.y = pk_bf16(x[2], x[3]); w0.z = pk_bf16(x[4], x[5]); w0.w = pk_bf16(x[6], x[7]);
                w1.x = pk_bf16(x[8], x[9]); w1.y = pk_bf16(x[10], x[11]); w1.z = pk_bf16(x[12], x[13]); w1.w = pk_bf16(x[14], x[15]);
                bf16_t* d = cur.dst + (size_t)(cur.r0 + rr) * cur.Kd + cur.k0 + kc * 16;
                *(u32x4*)d = w0; *(u32x4*)(d + 8) = w1; }
            __syncthreads();
            cur = nxt; u = un;
        }
    }
    __syncthreads();
    {
        float* tab = lds;
        if (tid < 64) { float sv, cv; sincosf(PI2 * (float)tid / 64.f, &sv, &cv); tab[tid] = cv; tab[64 + tid] = sv; }
        __syncthreads();
        const int lane = tid & 63, wv = tid >> 6;
        for (int u = bid * 8 + wv; u < 8192; u += nb * 8) {
            const int l = u >> 12, k = (u >> 2) & 1023, g = u & 3;
            const float* wrow = p.in[12] + ((size_t)l * 1024 + k) * INW + g * 64;
            const float wv_ = wrow[lane];
            float ac = 0.f, as = 0.f;
#pragma unroll 16
            for (int c = 0; c < 64; ++c) { const float w = __shfl(wv_, c); const int idx = (c * lane) & 63; ac += w * tab[idx]; as += w * tab[64 + idx]; }
            bf16_t* bt = (bf16_t*)(ws + OFF_WIN + l * SZ_WIN);
            bt[(size_t)(g * 64 + lane) * 1024 + k] = f2bf(ac);
            bt[(size_t)(256 + g * 64 + lane) * 1024 + k] = f2bf(as);
        }
        __syncthreads();
    }
    {
        float* sc = lds;
        float* part = lds + 12 * 1024;
        for (int i = tid; i < 9 * 1024; i += NTHREADS) { const int bc = i >> 10, k = i & 1023; const float cv = bc == 0 ? p.in[5][k] : p.in[4][(bc - 1) * 1024 + k]; sc[k * 12 + bc] = cv / (1.0f + expf(-cv)); }
        __syncthreads();
        for (int cb = bid; cb < 256; cb += nb) {
            const int gc0 = cb * 72, l = gc0 / 9216, j0 = gc0 % 9216;
            const int cg = tid % 18, kg = tid / 18;
            if (kg < 28) {
                f32x4 a[9];
#pragma unroll
                for (int i = 0; i < 9; ++i) a[i] = (f32x4){0.f, 0.f, 0.f, 0.f};
                const float* wp = p.in[6] + (size_t)l * 1024 * 9216 + j0 + cg * 4;
#pragma unroll 4
                for (int k = kg; k < 1024; k += 28) { const f32x4 w = *(const f32x4*)(wp + (size_t)k * 9216);
                    const f32x4 s0 = *(const f32x4*)(sc + k * 12), s1 = *(const f32x4*)(sc + k * 12 + 4); const float s8 = sc[k * 12 + 8];
                    a[0] += w * s0[0]; a[1] += w * s0[1]; a[2] += w * s0[2]; a[3] += w * s0[3]; a[4] += w * s1[0]; a[5] += w * s1[1]; a[6] += w * s1[2]; a[7] += w * s1[3]; a[8] += w * s8; }
#pragma unroll
                for (int i = 0; i < 9; ++i)
#pragma unroll
                    for (int e = 0; e < 4; ++e) part[(kg * 72 + cg * 4 + e) * 9 + i] = a[i][e];
            }
            __syncthreads();
            for (int i = tid; i < 72 * 9; i += NTHREADS) { const int c2 = i / 9, bc = i % 9; float s = 0.f;
#pragma unroll
                for (int g = 0; g < 28; ++g) s += part[(g * 72 + c2) * 9 + bc];
                ((float*)(ws + OFF_MOD))[((size_t)l * 9 + bc) * 9216 + j0 + c2] = s + p.in[7][l * 9216 + j0 + c2]; }
            __syncthreads();
        }
    }
    __syncthreads();
    {
        const int lane = tid & 63, wv = tid >> 6;
        float* h2s = lds;
        const int u0 = bid * 10; const int l = u0 / 1280;
        if (u0 < 2560) {
            const float* w1 = p.in[15] + l * 33 * 64; const float* b1 = p.in[16] + l * 64; const float* w2 = p.in[17] + l * 64 * 64; const float* b2 = p.in[18] + l * 64;
            const float* w3 = p.in[19] + (size_t)l * 64 * 1024; const float fr = p.in[20][l * 64 + lane];
            for (int q = wv; q < 10; q += 8) {
                const int rem = (u0 + q) % 1280; const int pass = rem >= 256; const int n = pass ? 1024 : 256; const int d = pass ? rem - 256 : rem;
                const float tt = (float)d / (float)(n - 1);
                float feat = 0.f;
                if (lane == 0) feat = tt;
                else if (lane < 33) { const int j = (lane - 1) & 15; const float fj = 1e-4f + (float)j * ((15.0f - 1e-4f) / 15.0f); const float ang = (PI2 / (float)n) * (float)d * fj;
                    feat = lane < 17 ? cosf(ang) : -sinf(ang); }
                float a1 = b1[lane];
#pragma unroll
                for (int i = 0; i < 33; ++i) a1 += __shfl(feat, i) * w1[i * 64 + lane];
                const float h1 = sinf(fr * a1);
                float a2 = b2[lane];
#pragma unroll
                for (int i = 0; i < 64; ++i) a2 += __shfl(h1, i) * w2[i * 64 + lane];
                h2s[lane * 12 + q] = sinf(fr * a2);
            }
            __syncthreads();
            float acc[2][10];
#pragma unroll
            for (int q = 0; q < 10; ++q) { acc[0][q] = 0.f; acc[1][q] = 0.f; }
#pragma unroll 8
            for (int i = 0; i < 64; ++i) {
                const float wa = w3[i * 1024 + tid], wb = w3[i * 1024 + 512 + tid];
                const f32x4 ha = *(const f32x4*)(h2s + i * 12), hb = *(const f32x4*)(h2s + i * 12 + 4); const float h8 = h2s[i * 12 + 8], h9 = h2s[i * 12 + 9];
                acc[0][0] += ha[0] * wa; acc[0][1] += ha[1] * wa; acc[0][2] += ha[2] * wa; acc[0][3] += ha[3] * wa; acc[0][4] += hb[0] * wa; acc[0][5] += hb[1] * wa; acc[0][6] += hb[2] * wa; acc[0][7] += hb[3] * wa; acc[0][8] += h8 * wa; acc[0][9] += h9 * wa;
                acc[1][0] += ha[0] * wb; acc[1][1] += ha[1] * wb; acc[1][2] += ha[2] * wb; acc[1][3] += ha[3] * wb; acc[1][4] += hb[0] * wb; acc[1][5] += hb[1] * wb; acc[1][6] += hb[2] * wb; acc[1][7] += hb[3] * wb; acc[1][8] += h8 * wb; acc[1][9] += h9 * wb;
            }
            const int ord = (tid >> 8) & 1, c = tid & 255;
            const float dec = fabsf(p.in[21][(l * 2 + ord) * 256 + c]);
            bf16_t* gl = (bf16_t*)(ws + OFF_FILT) + (size_t)l * G_L;
#pragma unroll
            for (int q = 0; q < 10; ++q) {
                const int rem = (u0 + q) % 1280; const int pass = rem >= 256; const int n = pass ? 1024 : 256; const int d = pass ? rem - 256 : rem;
                const float tt = (float)d / (float)(n - 1); const float win = expf(-tt * dec) / (float)(2 * n);
                bf16_t* g = gl + (pass ? G_CTX : 0) + ((size_t)ord * 256 + c) * (2 * n);
                g[n - 1 - d] = f2bf(acc[0][q] * win);
                g[d == 0 ? 2 * n - 1 : n - 1 + d] = d == 0 ? (bf16_t)0 : f2bf(acc[1][q] * win);
            }
        }
        __syncthreads();
    }
    __syncthreads();
    {
        bf16_t* FC = (bf16_t*)(ws + OFF_FC); bf16_t* FL = (bf16_t*)(ws + OFF_FL);
        const int gt = bid * NTHREADS + tid, gn = nb * NTHREADS;
        for (int i = gt; i < 256 * 512 + 1024 * 2048; i += gn) {
            int n, k, col; bf16_t* dst;
            if (i < 256 * 512) { n = 256; k = i >> 9; col = i & 511; dst = FC + i; } else { const int j = i - 256 * 512; n = 1024; k = j >> 11; col = j & 2047; dst = FL + j; }
            const int s = col >= n, t = col - s * n; const int ph = (k * t) & (n - 1);
            float sv, cv; sincosf(PI2 * (float)ph / (float)n, &sv, &cv);
            const float sc = rsqrtf(64.0f * (float)n);
            *dst = f2bf((s ? -sv : cv) * sc);
        }
        { bf16_t* CK = (bf16_t*)(ws + OFF_CKB); bf16_t* CV = (bf16_t*)(ws + OFF_CVT);
            for (int i = gt; i < 2 * 8 * 256 * 128; i += gn) {
                { const int c = i & 127, key = (i >> 7) & 255, b = (i >> 15) & 7, l = i >> 18;
                    CK[i] = f2bf(p.in[2][(((size_t)b * 2 + l) * 256 + key) * 128 + c]); }
                { const int key = i & 255, c = (i >> 8) & 127, b = (i >> 15) & 7, l = i >> 18;
                    CV[i] = f2bf(p.in[3][(((size_t)b * 2 + l) * 256 + key) * 128 + c]); }
            } }
        if (bid == 0) for (int i = tid; i < 64 * 16; i += NTHREADS) { const int pos = i >> 4, j = i & 15; const float inv = powf(10000.0f, -(float)(2 * j) / 32.0f);
            float sv, cv; sincosf((float)pos * inv, &sv, &cv); float* rp = (float*)(ws + OFF_ROPE); rp[2 * i] = cv; rp[2 * i + 1] = sv; }
    }
    __syncthreads();
}

template <int MODE>
__device__ void phase_row(const Params& p, int lpost, int spost, int lpre, int spre) {
    const int tid_ = opaque_tid(); const int lane = tid_ & 63, wv = tid_ >> 6;
    const float* mod = (const float*)(p.ws + OFF_MOD);
    const bf16_t* Y = (const bf16_t*)(p.ws + OFF_Y); const float* ssq = (const float*)(p.ws + OFF_SSQ);
    bf16_t* H = (bf16_t*)(p.ws + OFF_H);
    const float factor = (spost == 1) ? 1.0f : 0.5f;
    const int stride = gridDim.x * 8;
    for (int row0 = blockIdx.x * 8 + wv; row0 < NTOK; row0 += 2 * stride) {
        f32x4 x[2][4]; u32x2 yv[2][4]; f32x4 sq[2][4]; int bc[2]; bool ok[2];
#pragma unroll
        for (int q = 0; q < 2; ++q) {
            const int row = row0 + q * stride; ok[q] = row < NTOK; const int rw = ok[q] ? row : row0;
            bc[q] = rw < NCTX ? 0 : 1 + ((rw - NCTX) >> 10);
            if (MODE == 0) { const float* src = rw < NCTX ? p.in[0] + (size_t)rw * D : p.in[1] + (size_t)(rw - NCTX) * D;
#pragma unroll
                for (int j = 0; j < 4; ++j) x[q][j] = *(const f32x4*)(src + j * 256 + lane * 4); }
            else {
#pragma unroll
                for (int j = 0; j < 4; ++j) { x[q][j] = *(const f32x4*)(p.out + (size_t)rw * D + j * 256 + lane * 4); yv[q][j] = *(const u32x2*)(Y + (size_t)rw * D + j * 256 + lane * 4); }
                const f32x4* sp = (const f32x4*)(ssq + (size_t)rw * 16);
#pragma unroll
                for (int j = 0; j < 4; ++j) sq[q][j] = sp[j];
            }
        }
#pragma unroll
        for (int q = 0; q < 2; ++q) {
            const int row = row0 + q * stride;
            if (!ok[q]) continue;
            float* xr = p.out + (size_t)row * D;
            if (MODE != 0) {
                float tot = 0.f;
#pragma unroll
                for (int j = 0; j < 4; ++j) tot += (sq[q][j][0] + sq[q][j][1]) + (sq[q][j][2] + sq[q][j][3]);
                const float rstd = rsqrtf(tot * (1.0f / 1024.0f) + EPS) * factor;
                const float* gate = mod + ((size_t)lpost * 9 + bc[q]) * 9216 + spost * 3072 + 2048;
                const float* gp = p.in[8] + (lpost * 6 + 2 * spost + 1) * 1024;
#pragma unroll
                for (int j = 0; j < 4; ++j) { const int c = j * 256 + lane * 4;
                    const f32x4 gt = *(const f32x4*)(gate + c), gg = *(const f32x4*)(gp + c);
                    x[q][j][0] += gt[0] * gg[0] * rstd * __uint_as_float(yv[q][j].x << 16);
                    x[q][j][1] += gt[1] * gg[1] * rstd * __uint_as_float(yv[q][j].x & 0xFFFF0000u);
                    x[q][j][2] += gt[2] * gg[2] * rstd * __uint_as_float(yv[q][j].y << 16);
                    x[q][j][3] += gt[3] * gg[3] * rstd * __uint_as_float(yv[q][j].y & 0xFFFF0000u); }
            }
#pragma unroll
            for (int j = 0; j < 4; ++j) *(f32x4*)(xr + j * 256 + lane * 4) = x[q][j];
            if (MODE != 2) {
                float s = 0.f;
#pragma unroll
                for (int j = 0; j < 4; ++j) s += x[q][j][0] * x[q][j][0] + x[q][j][1] * x[q][j][1] + x[q][j][2] * x[q][j][2] + x[q][j][3] * x[q][j][3];
#pragma unroll
                for (int o = 32; o >= 1; o >>= 1) s += __shfl_xor(s, o);
                const float rs = rsqrtf(s * (1.0f / 1024.0f) + EPS);
                const float* mb = mod + ((size_t)lpre * 9 + bc[q]) * 9216 + spre * 3072;
                const float* gp = p.in[8] + (lpre * 6 + 2 * spre) * 1024;
#pragma unroll
                for (int j = 0; j < 4; ++j) { const int c = j * 256 + lane * 4;
                    const f32x4 sh = *(const f32x4*)(mb + c), scl = *(const f32x4*)(mb + 1024 + c), gg = *(const f32x4*)(gp + c);
                    f32x4 hh;
#pragma unroll
                    for (int e = 0; e < 4; ++e) hh[e] = x[q][j][e] * rs * gg[e] * (1.0f + scl[e]) + sh[e];
                    u32x2 w; w.x = pk_bf16(hh[0], hh[1]); w.y = pk_bf16(hh[2], hh[3]);
                    *(u32x2*)(H + (size_t)row * D + c) = w; }
            }
        }
    }
}

constexpr int AT_KROWB = 144;
constexpr int AT_VROWB_A = 784, AT_VROWB_B = 528;
constexpr int AT_OFF_V = 320 * AT_KROWB;
struct AttnState { f32x16 O0, O1; float m, lsum; };
template <bool MASK>
__device__ __forceinline__ void attn_tiles(AttnState& st, const bf16x8 (&qf)[4], const LAS unsigned char* Kl, const LAS unsigned char* Vl, int vrowb, int t0, int t1, int dk0, int r, int h) {
    for (int t = t0; t < t1; ++t) {
        const LAS unsigned char* kp = Kl + (t * 32 + r) * AT_KROWB + h * 16;
        bf16x8 kf[4];
#pragma unroll
        for (int kk = 0; kk < 4; ++kk) kf[kk] = *(const LAS bf16x8*)(kp + kk * 32);
        const LAS unsigned char* vp = Vl + r * vrowb + (t * 32 + 4 * h) * 2;
        u32x2 vraw[2][2][2];
#pragma unroll
        for (int dt = 0; dt < 2; ++dt)
#pragma unroll
            for (int s = 0; s < 2; ++s)
#pragma unroll
                for (int q = 0; q < 2; ++q) vraw[dt][s][q] = *(const LAS u32x2*)(vp + dt * 32 * vrowb + (16 * s + 8 * q) * 2);
        f32x16 S;
#pragma unroll
        for (int i = 0; i < 16; ++i) S[i] = 0.f;
#pragma unroll
        for (int kk = 0; kk < 4; ++kk) S = __builtin_amdgcn_mfma_f32_32x32x16_bf16(kf[kk], qf[kk], S, 0, 0, 0);
        if (MASK) {
            const int dk = dk0 + t * 32;
            if (dk <= -128 || dk >= 128) {
#pragma unroll
                for (int i = 0; i < 16; ++i) { const int j = (i & 3) + 8 * (i >> 2) + 4 * h; int dd = dk + j - r; if (dd < 0) dd = -dd; if (dd > 128) S[i] = -1e30f; }
            }
        }
        float mx = S[0];
#pragma unroll
        for (int i = 1; i < 16; ++i) mx = fmaxf(mx, S[i]);
        mx = fmaxf(mx, __shfl_xor(mx, 32));
        const float mn = fmaxf(st.m, mx), corr = __expf(st.m - mn);
        st.m = mn;
        float rs = 0.f;
#pragma unroll
        for (int i = 0; i < 16; ++i) { S[i] = __expf(S[i] - mn); rs += S[i]; }
        rs += __shfl_xor(rs, 32);
        st.lsum = st.lsum * corr + rs;
#pragma unroll
        for (int i = 0; i < 16; ++i) { st.O0[i] *= corr; st.O1[i] *= corr; }
        bf16x8 pf[2];
#pragma unroll
        for (int s = 0; s < 2; ++s) { u32x4 w; w.x = pk_bf16(S[8 * s], S[8 * s + 1]); w.y = pk_bf16(S[8 * s + 2], S[8 * s + 3]); w.z = pk_bf16(S[8 * s + 4], S[8 * s + 5]); w.w = pk_bf16(S[8 * s + 6], S[8 * s + 7]);
            pf[s] = __builtin_bit_cast(bf16x8, w); }
#pragma unroll
        for (int s = 0; s < 2; ++s) {
            u32x4 a0; a0.x = vraw[0][s][0].x; a0.y = vraw[0][s][0].y; a0.z = vraw[0][s][1].x; a0.w = vraw[0][s][1].y;
            u32x4 a1; a1.x = vraw[1][s][0].x; a1.y = vraw[1][s][0].y; a1.z = vraw[1][s][1].x; a1.w = vraw[1][s][1].y;
            st.O0 = __builtin_amdgcn_mfma_f32_32x32x16_bf16(__builtin_bit_cast(bf16x8, a0), pf[s], st.O0, 0, 0, 0);
            st.O1 = __builtin_amdgcn_mfma_f32_32x32x16_bf16(__builtin_bit_cast(bf16x8, a1), pf[s], st.O1, 0, 0, 0);
        }
    }
}
__device__ __forceinline__ void attn_unit(const Params& p, int l, int u, LAS unsigned char* lds, int tid) {
    const int lane = tid & 63, wv = tid >> 6, r = lane & 31, h = lane >> 5;
    const bf16_t* QB = (const bf16_t*)(p.ws + OFF_QB); const bf16_t* KB = (const bf16_t*)(p.ws + OFF_KB); const bf16_t* VT = (const bf16_t*)(p.ws + OFF_VB);
    const bf16_t* CK = (const bf16_t*)(p.ws + OFF_CKB); const bf16_t* CV = (const bf16_t*)(p.ws + OFF_CVT);
    bf16_t* YC = (bf16_t*)(p.ws + OFF_YCAT);
    const int g = wv & 3, qh = wv >> 2;
    const int pass = u < 256; const int v = u & 255;
    int b, kvh, qb, n, rowbase;
    if (!pass) { b = v >> 3; kvh = (v >> 2) & 1; qb = v & 3; n = 256; rowbase = b * 256; }
    else { b = v >> 5; kvh = (v >> 4) & 1; qb = v & 15; n = 1024; rowbase = NCTX + b * 1024; }
    const int head = kvh * 4 + g, q0w = qb * 64 + qh * 32;
    int kloU = 0, khiU = 256;
    if (pass) { kloU = qb * 64 - 128; if (kloU < 0) kloU = 0; khiU = qb * 64 + 192; if (khiU > n) khiU = n; }
    const int nkA = khiU - kloU, npc = nkA * 8, vpr = nkA >> 3;
    const bf16_t* kA = KB + (size_t)(rowbase + kloU) * 128 + kvh * 64;
    const bf16_t* vA = VT + (pass ? VT_LAT + (size_t)b * 128 * 1024 : (size_t)b * 128 * 256) + (size_t)kvh * 64 * n + kloU;
    {
        u32x4 kr[5], vr[5];
#pragma unroll
        for (int it = 0; it < 5; ++it) { const int idx = tid + it * NTHREADS;
            if (idx < npc) { kr[it] = *(const u32x4*)(kA + (size_t)(idx >> 3) * 128 + (idx & 7) * 8);
                const int d = idx / vpr, j = idx - d * vpr; vr[it] = *(const u32x4*)(vA + (size_t)d * n + j * 8); } }
#pragma unroll
        for (int it = 0; it < 5; ++it) { const int idx = tid + it * NTHREADS;
            if (idx < npc) { *(LAS u32x4*)(lds + (idx >> 3) * AT_KROWB + (idx & 7) * 16) = kr[it];
                const int d = idx / vpr, j = idx - d * vpr; *(LAS u32x4*)(lds + AT_OFF_V + d * AT_VROWB_A + j * 16) = vr[it]; } }
    }
    bf16x8 qf[4];
    { const bf16_t* qp = QB + (size_t)(rowbase + q0w + r) * 512 + head * 64 + 8 * h;
#pragma unroll
        for (int kk = 0; kk < 4; ++kk) qf[kk] = *(const bf16x8*)(qp + 16 * kk); }
    AttnState st; st.m = p.in[23][l * 8 + head]; st.lsum = 1.0f;
#pragma unroll
    for (int i = 0; i < 16; ++i) { st.O0[i] = 0.f; st.O1[i] = 0.f; }
    __syncthreads();
    u32x4 kb[4], vb[4];
    if (pass) {
        const bf16_t* kB = CK + ((size_t)(l * 8 + b) * 256) * 128 + kvh * 64;
        const bf16_t* vB = CV + ((size_t)(l * 8 + b) * 128 + kvh * 64) * 256;
#pragma unroll
        for (int it = 0; it < 4; ++it) { const int idx = tid + it * NTHREADS;
            kb[it] = *(const u32x4*)(kB + (size_t)(idx >> 3) * 128 + (idx & 7) * 8);
            vb[it] = *(const u32x4*)(vB + (size_t)(idx >> 5) * 256 + (idx & 31) * 8); }
    }
    {
        int klo = 0, khi = 256;
        if (pass) { klo = q0w - 128; if (klo < 0) klo = 0; khi = q0w + 160; if (khi > n) khi = n; }
        const int t0 = (klo - kloU) >> 5, t1 = (khi - kloU) >> 5;
        if (pass) attn_tiles<true>(st, qf, lds, lds + AT_OFF_V, AT_VROWB_A, t0, t1, kloU - q0w, r, h);
        else attn_tiles<false>(st, qf, lds, lds + AT_OFF_V, AT_VROWB_A, t0, t1, 0, r, h);
    }
    if (pass) {
        __syncthreads();
#pragma unroll
        for (int it = 0; it < 4; ++it) { const int idx = tid + it * NTHREADS;
            *(LAS u32x4*)(lds + (idx >> 3) * AT_KROWB + (idx & 7) * 16) = kb[it];
            *(LAS u32x4*)(lds + AT_OFF_V + (idx >> 5) * AT_VROWB_B + (idx & 31) * 16) = vb[it]; }
        __syncthreads();
        attn_tiles<false>(st, qf, lds, lds + AT_OFF_V, AT_VROWB_B, 0, 8, 0, r, h);
    }
    const float inv = 1.0f / st.lsum;
    bf16_t* op = YC + (size_t)(rowbase + q0w + r) * 1024 + 512 + head * 64 + 4 * h;
#pragma unroll
    for (int gq = 0; gq < 4; ++gq) {
        u32x2 w0; w0.x = pk_bf16(st.O0[4 * gq] * inv, st.O0[4 * gq + 1] * inv); w0.y = pk_bf16(st.O0[4 * gq + 2] * inv, st.O0[4 * gq + 3] * inv);
        u32x2 w1; w1.x = pk_bf16(st.O1[4 * gq] * inv, st.O1[4 * gq + 1] * inv); w1.y = pk_bf16(st.O1[4 * gq + 2] * inv, st.O1[4 * gq + 3] * inv);
        *(u32x2*)(op + 8 * gq) = w0; *(u32x2*)(op + 32 + 8 * gq) = w1;
    }
    __syncthreads();
}
__device__ void attn_mfma(const Params& p, int l, LAS unsigned char* lds) {
    const int tid = opaque_tid();
    for (int u = blockIdx.x; u < 512; u += gridDim.x) attn_unit(p, l, u, lds, tid);
}

template <int NB  , int NBLK  >
__device__ __forceinline__ void hyena_unit(const Params& p, int l, int c, const bf16_t* __restrict__ HTp, int rowbase, const bf16_t* __restrict__ gb, LAS unsigned char* lds, int tid) {
    constexpr int n = 32 * NBLK, NI = 32 / NB, PAD = 32 * (NI - 1);
    constexpr int LENB = (2 * n * 2 - 64 + 255) / 256 * 256 + 64;
    constexpr int UROWB = ((n + 2 * PAD) * 2 + 255) / 256 * 256 + 16;
    constexpr int GSB = (2 * n + 8) * 2;
    constexpr int OFF_F0 = 0, OFF_F1 = 8 * LENB, OFF_U = 16 * LENB, OFF_U2 = OFF_U + NB * UROWB, OFF_G1 = OFF_U2 + NB * UROWB, OFF_G2 = OFF_G1 + NB * n * 2, OFF_GS = OFF_G2 + NB * n * 2;
    static_assert(OFF_GS + 2 * GSB <= 149 * 1024, "hyena LDS");
    const int lane = tid & 63, wv = tid >> 6, r = lane & 31, h = lane >> 5;
    const float* cw = p.in[14] + l * 3 * 768;
    if (tid < 2 * (2 * n / 8)) { const int o = tid / (2 * n / 8), k = tid % (2 * n / 8);
        *(LAS u32x4*)(lds + OFF_GS + o * GSB + k * 16) = *(const u32x4*)(gb + ((size_t)o * 256 + c) * (2 * n) + k * 8); }
    if (tid < 2) *(LAS u32x4*)(lds + OFF_GS + tid * GSB + 2 * n * 2) = (u32x4){0u, 0u, 0u, 0u};
    constexpr int NQ = 3 * NB * (n / 8) / NTHREADS;
#pragma unroll
    for (int it = 0; it < NQ; ++it) {
        const int q = tid + it * NTHREADS;
        const int w = q / (NB * (n / 8)), rem = q % (NB * (n / 8)), b = rem / (n / 8), t0 = (rem % (n / 8)) * 8;
        const int ch = w * 256 + c; const bf16_t* row = HTp + ((size_t)b * 768 + ch) * n;
        const float w0 = cw[ch], w1 = cw[768 + ch], w2 = cw[1536 + ch];
        const u32x4 raw = *(const u32x4*)(row + t0);
        float x[10];
        x[0] = t0 > 0 ? bf2f(row[t0 - 1]) : 0.f; x[9] = t0 + 8 < n ? bf2f(row[t0 + 8]) : 0.f;
        x[1] = __uint_as_float(raw.x << 16); x[2] = __uint_as_float(raw.x & 0xFFFF0000u); x[3] = __uint_as_float(raw.y << 16); x[4] = __uint_as_float(raw.y & 0xFFFF0000u);
        x[5] = __uint_as_float(raw.z << 16); x[6] = __uint_as_float(raw.z & 0xFFFF0000u); x[7] = __uint_as_float(raw.w << 16); x[8] = __uint_as_float(raw.w & 0xFFFF0000u);
        float z[8];
#pragma unroll
        for (int e = 0; e < 8; ++e) z[e] = x[e] * w0 + x[e + 1] * w1 + x[e + 2] * w2;
        u32x4 o; o.x = pk_bf16(z[0], z[1]); o.y = pk_bf16(z[2], z[3]); o.z = pk_bf16(z[4], z[5]); o.w = pk_bf16(z[6], z[7]);
        LAS unsigned char* dst = w == 0 ? lds + OFF_U + b * UROWB + (PAD + t0) * 2 : lds + (w == 1 ? OFF_G1 : OFF_G2) + (b * n + t0) * 2;
        *(LAS u32x4*)dst = o;
    }
    if (PAD > 0) {
        constexpr int FR = PAD / 8, BK_ = (UROWB / 2 - PAD - n) / 8;
        for (int q = tid; q < 2 * NB * (FR + BK_); q += NTHREADS) {
            const int buf = q / (NB * (FR + BK_)), rem = q % (NB * (FR + BK_)), b = rem / (FR + BK_), k = rem % (FR + BK_);
            const int e0 = k < FR ? k * 8 : PAD + n + (k - FR) * 8;
            *(LAS u32x4*)(lds + (buf ? OFF_U2 : OFF_U) + b * UROWB + e0 * 2) = (u32x4){0u, 0u, 0u, 0u};
        }
    }
    __syncthreads();
    if (tid < 2 * (2 * n / 8)) { const int o = tid / (2 * n / 8), k = tid % (2 * n / 8);
        const u32x4 lo = *(const LAS u32x4*)(lds + OFF_GS + o * GSB + k * 16), hi = *(const LAS u32x4*)(lds + OFF_GS + o * GSB + k * 16 + 16);
        const unsigned d[8] = {lo.x, lo.y, lo.z, lo.w, hi.x, hi.y, hi.z, hi.w};
        LAS unsigned char* fdst = lds + (o ? OFF_F1 : OFF_F0) + k * 16;
#pragma unroll
        for (int s = 0; s < 8; ++s) { u32x4 w;
            if ((s & 1) == 0) { w.x = d[s / 2]; w.y = d[s / 2 + 1]; w.z = d[s / 2 + 2]; w.w = d[s / 2 + 3]; }
            else { w.x = __builtin_amdgcn_alignbyte(d[s / 2 + 1], d[s / 2], 2); w.y = __builtin_amdgcn_alignbyte(d[s / 2 + 2], d[s / 2 + 1], 2);
                   w.z = __builtin_amdgcn_alignbyte(d[s / 2 + 3], d[s / 2 + 2], 2); w.w = __builtin_amdgcn_alignbyte(d[s / 2 + 4], d[s / 2 + 3], 2); }
            *(LAS u32x4*)(fdst + s * LENB) = w; }
    }
    __syncthreads();
    const int bcol = NB == 8 ? (r >> 2) : r, ioff = NB == 8 ? (r & 3) : 0, I0 = wv * NI, Icol = I0 + ioff;
    const int si = (7 - r) & 7;
    const int Dlo = I0 + NI - 1 - (NBLK - 1) - (NI - 1), Dhi = I0 + NI - 1;
    bf16_t* YC = (bf16_t*)(p.ws + OFF_YCAT);
#pragma unroll
    for (int o = 0; o < 2; ++o) {
        const LAS unsigned char* ap = lds + (o ? OFF_F1 : OFF_F0) + si * LENB + (n - 1 - r + 8 * h - si) * 2 - 64 * Dlo;
        const LAS unsigned char* bp = lds + (o ? OFF_U2 : OFF_U) + bcol * UROWB + (PAD + 32 * Icol + 8 * h) * 2 - 64 * Dlo;
        f32x16 acc;
#pragma unroll
        for (int i = 0; i < 16; ++i) acc[i] = 0.f;
#pragma unroll 4
        for (int D = Dlo; D <= Dhi; ++D) {
            const bf16x8 a0 = *(const LAS bf16x8*)ap, a1 = *(const LAS bf16x8*)(ap + 32);
            const bf16x8 b0 = *(const LAS bf16x8*)bp, b1 = *(const LAS bf16x8*)(bp + 32);
            acc = __builtin_amdgcn_mfma_f32_32x32x16_bf16(a0, b0, acc, 0, 0, 0);
            acc = __builtin_amdgcn_mfma_f32_32x32x16_bf16(a1, b1, acc, 0, 0, 0);
            ap -= 64; bp -= 64;
        }
        const float bias = p.in[22][(l * 2 + o) * 256 + c];
#pragma unroll
        for (int g = 0; g < 4; ++g) {
            const int t0 = 32 * Icol + 8 * g + 4 * h;
            const u32x2 uin = *(const LAS u32x2*)(lds + (o ? OFF_U2 : OFF_U) + bcol * UROWB + (PAD + t0) * 2);
            const u32x2 gin = *(const LAS u32x2*)(lds + (o ? OFF_G2 : OFF_G1) + (bcol * n + t0) * 2);
            float y[4];
            y[0] = __uint_as_float(gin.x << 16) * (acc[4 * g] + bias * __uint_as_float(uin.x << 16));
            y[1] = __uint_as_float(gin.x & 0xFFFF0000u) * (acc[4 * g + 1] + bias * __uint_as_float(uin.x & 0xFFFF0000u));
            y[2] = __uint_as_float(gin.y << 16) * (acc[4 * g + 2] + bias * __uint_as_float(uin.y << 16));
            y[3] = __uint_as_float(gin.y & 0xFFFF0000u) * (acc[4 * g + 3] + bias * __uint_as_float(uin.y & 0xFFFF0000u));
            if (o == 0) { u32x2 w; w.x = pk_bf16(y[0], y[1]); w.y = pk_bf16(y[2], y[3]);
                *(LAS u32x2*)(lds + OFF_U2 + bcol * UROWB + (PAD + t0) * 2) = w; }
            else { bf16_t* dst = YC + (size_t)(rowbase + bcol * n + t0) * 1024 + 256 + c;
#pragma unroll
                for (int e = 0; e < 4; ++e) dst[(size_t)e * 1024] = f2bf(y[e]); }
        }
        __syncthreads();
    }
}
__device__ void hyena_mfma(const Params& p, int l, LAS unsigned char* lds) {
    const int tid = opaque_tid();
    const bf16_t* HT = (const bf16_t*)(p.ws + OFF_HT);
    const bf16_t* gl = (const bf16_t*)(p.ws + OFF_FILT) + (size_t)l * G_L;
    for (int u = blockIdx.x; u < 512; u += gridDim.x) {
        if (u < 256) hyena_unit<8, 32>(p, l, u, HT + HT_LAT, NCTX, gl + G_CTX, lds, tid);
        else hyena_unit<32, 8>(p, l, u - 256, HT, 0, gl, lds, tid);
    }
}

__global__ void __launch_bounds__(NTHREADS, 2) fwd_megakernel(Params p) {
    extern __shared__ __attribute__((aligned(16))) unsigned char shm[];
    cg::grid_group grid = cg::this_grid();
    LAS unsigned char* lds = (LAS unsigned char*)shm;
    float* ldsf = (float*)shm;
    unsigned char* ws = p.ws;
    const int G = gridDim.x, c = blockIdx.x;

    volatile LAS unsigned* xst = (volatile LAS unsigned*)(lds + 149 * 1024);
    if (threadIdx.x < 4) xst[threadIdx.x] = 0u;
    __syncthreads();
    const XcdBarrier xb = xcd_barrier_post((unsigned*)(ws + OFF_BAR), xst);
    for (int _d = 0; _d < DUP_PREP; ++_d) { phase_prep(p, ldsf); __syncthreads(); }
    if (p.ws == nullptr) grid.sync();
    GSYNC();
    phase_row<0>(p, 0, 0, 0, 0);
    GSYNC();
    for (int l = 0; l < 2; ++l) {
        for (int s = 0; s < 3; ++s) {
            if (s != 1) {
                const int fs = s >> 1;
                { pg8::Gemm g{(const bf16_t*)(ws + OFF_H), (const bf16_t*)(ws + OFF_WGU + (l * 2 + fs) * SZ_WGU), NTOK, 5632, 1024, 1024, 1024};
                    pg8::StaticOrder S; S.init(g.M, g.N, G, c); EpiSwiglu E{(bf16_t*)(ws + OFF_ACT)};
                    for (int _d = 0; _d < DUP_GEMM; ++_d) pg8::gemm_phase(lds, g, S, E); }
                GSYNC();
                { pg8::Gemm g{(const bf16_t*)(ws + OFF_ACT), (const bf16_t*)(ws + OFF_WD + (l * 2 + fs) * SZ_WD), NTOK, 1024, DFF, DFF, DFF};
                    pg8::StaticOrder S; S.init(g.M, g.N, G, c); EpiYssq E{(bf16_t*)(ws + OFF_Y), (float*)(ws + OFF_SSQ)};
                    for (int _d = 0; _d < DUP_GEMM; ++_d) pg8::gemm_phase(lds, g, S, E); }
                GSYNC();
            } else {
                { pg8::Gemm g{(const bf16_t*)(ws + OFF_H), (const bf16_t*)(ws + OFF_WIN + l * SZ_WIN), NTOK, 2048, 1024, 1024, 1024};
                    pg8::StaticOrder S; S.init(g.M, g.N, G, c);
                    EpiWin E{(bf16_t*)(ws + OFF_ZT), (bf16_t*)(ws + OFF_HT), (bf16_t*)(ws + OFF_QB), (bf16_t*)(ws + OFF_KB), (bf16_t*)(ws + OFF_VB), (const float*)(ws + OFF_ROPE),
                             p.out + (size_t)NTOK * D, p.out + (size_t)NTOK * D + (size_t)32 * 2 * 256 * 128, l};
                    for (int _d = 0; _d < DUP_GEMM; ++_d) pg8::gemm_phase(lds, g, S, E); }
                GSYNC();
                { pg8::Gemm g{(const bf16_t*)(ws + OFF_FL), (const bf16_t*)(ws + OFF_ZT) + ZT_LAT, 1024, 2048, 2048, 2048, 2048};
                    pg8::StaticOrder S; S.init(g.M, g.N, G, c); EpiFourier E{(bf16_t*)(ws + OFF_YCAT), NCTX, 1024};
                    for (int _d = 0; _d < DUP_GEMM; ++_d) pg8::gemm_phase(lds, g, S, E); }
                { pg8::Gemm g{(const bf16_t*)(ws + OFF_FC), (const bf16_t*)(ws + OFF_ZT), 256, 8192, 512, 512, 512};
                    pg8::StaticOrder S; S.init(g.M, g.N, G, c - 32); EpiFourier E{(bf16_t*)(ws + OFF_YCAT), 0, 256};
                    for (int _d = 0; _d < DUP_GEMM; ++_d) pg8::gemm_phase(lds, g, S, E); }
                __syncthreads();
                for (int _d = 0; _d < DUP_HY; ++_d) hyena_mfma(p, l, lds);
                for (int _d = 0; _d < DUP_AT; ++_d) attn_mfma(p, l, lds);
                GSYNC();
                { pg8::Gemm g{(const bf16_t*)(ws + OFF_YCAT), (const bf16_t*)(ws + OFF_WOUT + l * SZ_WOUT), NTOK, 1024, 1024, 1024, 1024};
                    pg8::StaticOrder S; S.init(g.M, g.N, G, c); EpiYssq E{(bf16_t*)(ws + OFF_Y), (float*)(ws + OFF_SSQ)};
                    for (int _d = 0; _d < DUP_GEMM; ++_d) pg8::gemm_phase(lds, g, S, E); }
                GSYNC();
            }
            if (l == 1 && s == 2) phase_row<2>(p, l, s, 0, 0);
            else { const int ln = s == 2 ? l + 1 : l, sn = s == 2 ? 0 : s + 1; phase_row<1>(p, l, s, ln, sn); }
            if (!(l == 1 && s == 2)) GSYNC();
        }
    }
}

extern "C" void kernel_launch(void* const* d_in, const int* in_sizes, int n_in, void* d_out, int out_size, void* d_ws, size_t ws_size, hipStream_t stream) {
    constexpr int LDS_BYTES = 149 * 1024 + 256;
    static int grid_blocks = 0;
    if (!grid_blocks) {
        if (n_in != 24 || ws_size < WS_END) { fprintf(stderr, "kernel_launch: bad inputs (n_in %d) or workspace too small (%zu < %zu)\n", n_in, ws_size, (size_t)WS_END); grid_blocks = -1; return; }
        int dev = 0, cus = 0, per_cu = 0;
        hipGetDevice(&dev);
        hipDeviceGetAttribute(&cus, hipDeviceAttributeMultiprocessorCount, dev);
        if (hipFuncSetAttribute((const void*)fwd_megakernel, hipFuncAttributeMaxDynamicSharedMemorySize, LDS_BYTES) != hipSuccess) fprintf(stderr, "kernel_launch: hipFuncSetAttribute failed\n");
        hipOccupancyMaxActiveBlocksPerMultiprocessor(&per_cu, (const void*)fwd_megakernel, NTHREADS, LDS_BYTES);
        if (per_cu < 1) { fprintf(stderr, "kernel_launch: occupancy query says %d blocks per CU\n", per_cu); per_cu = 1; }
        (void)hipGetLastError();
        grid_blocks = cus * per_cu;
        if (grid_blocks > 256) grid_blocks = 256;
    }
    if (grid_blocks < 0) return;
    Params p{};
    for (int i = 0; i < 24; ++i) p.in[i] = (const float*)d_in[i];
    p.out = (float*)d_out; p.ws = (unsigned char*)d_ws;
    (void)hipMemsetAsync((unsigned char*)d_ws + OFF_BAR, 0, 16384, stream);
    void* args[] = {&p};
    hipError_t e = hipLaunchCooperativeKernel((const void*)fwd_megakernel, dim3(grid_blocks), dim3(NTHREADS), args, LDS_BYTES, stream);
    if (e != hipSuccess) fprintf(stderr, "cooperative launch failed: %s (grid %d)\n", hipGetErrorString(e), grid_blocks);
}
```

```cpp
#include <hip/hip_runtime.h>
#include <hip/hip_cooperative_groups.h>
#include <cstdio>
namespace cg = cooperative_groups;

#define LAS __attribute__((address_space(3)))
#ifndef DUP_PA
#define DUP_PA 1
#endif
#ifndef DUP_PB
#define DUP_PB 1
#endif
#ifndef DUP_PC
#define DUP_PC 1
#endif
#ifndef DUP_PD
#define DUP_PD 1
#endif
#ifndef DUP_HY
#define DUP_HY 1
#endif
#ifndef DUP_AT
#define DUP_AT 1
#endif
#ifndef DUP_GEMM
#define DUP_GEMM 1
#endif
#ifndef DUP_MIX
#define DUP_MIX 1
#endif
#ifndef DUP_PREP
#define DUP_PREP 1
#endif
#ifndef DUP_SYNC
#define DUP_SYNC 1
#endif
#define GSYNC() do { for (int _s = 0; _s < DUP_SYNC; ++_s) xcd_barrier(xb); } while (0)
typedef unsigned short bf16_t;
typedef short bf16x8 __attribute__((ext_vector_type(8)));
typedef float f32x4 __attribute__((ext_vector_type(4)));
typedef unsigned u32x4 __attribute__((ext_vector_type(4)));
typedef unsigned u32x2 __attribute__((ext_vector_type(2)));

constexpr int D = 1024, NTOK = 16384, NCTX = 8192, DFF = 2816, INW = 1792;
constexpr int NTHREADS = 512;
constexpr float EPS = 1e-6f;
constexpr float PI2 = 6.283185307179586f;

constexpr size_t AL(size_t x) { return (x + 255) & ~(size_t)255; }
constexpr size_t SZ_WGU = (size_t)5632 * 1024 * 2, SZ_WD = (size_t)1024 * 2816 * 2, SZ_WIN = (size_t)2048 * 1024 * 2, SZ_WOUT = (size_t)1024 * 1024 * 2;
constexpr size_t OFF_WGU = 0;
constexpr size_t OFF_WD = OFF_WGU + 4 * SZ_WGU;
constexpr size_t OFF_WIN = OFF_WD + 4 * SZ_WD;
constexpr size_t OFF_WOUT = OFF_WIN + 2 * SZ_WIN;
constexpr size_t OFF_H = OFF_WOUT + 2 * SZ_WOUT;
constexpr size_t OFF_Y = OFF_H + (size_t)NTOK * D * 2;
constexpr size_t OFF_SSQ = OFF_Y + (size_t)NTOK * D * 2;
constexpr size_t OFF_MOD = OFF_SSQ + (size_t)NTOK * 16 * 4;
constexpr size_t OFF_FILT = AL(OFF_MOD + (size_t)2 * 9 * 9216 * 4);
constexpr size_t FILT_CTX = (size_t)4 * 256 * 256, FILT_LAT = (size_t)4 * 256 * 1024, FILT_L = FILT_CTX + FILT_LAT;
constexpr size_t G_CTX = (size_t)2 * 256 * 512, G_LAT = (size_t)2 * 256 * 2048, G_L = G_CTX + G_LAT;
constexpr size_t OFF_FC = AL(OFF_FILT + 2 * FILT_L * 4);
constexpr size_t OFF_FL = OFF_FC + (size_t)256 * 512 * 2;
constexpr size_t OFF_ROPE = OFF_FL + (size_t)1024 * 2048 * 2;
constexpr size_t OFF_BAR = AL(OFF_ROPE + 64 * 16 * 8);
constexpr size_t OFF_CKB = OFF_BAR + 16384;
constexpr size_t OFF_CVT = OFF_CKB + (size_t)2 * 8 * 256 * 128 * 2;
constexpr size_t OFF_UNION = AL(OFF_CVT + (size_t)2 * 8 * 256 * 128 * 2);
constexpr size_t OFF_ACT = OFF_UNION;
constexpr size_t OFF_ZT = OFF_UNION;
constexpr size_t ZT_LAT = (size_t)NCTX * 512;
constexpr size_t OFF_HT = OFF_ZT + (size_t)NTOK * 512 * 2;
constexpr size_t HT_LAT = (size_t)NCTX * 768;
constexpr size_t OFF_QB = OFF_HT + (size_t)NTOK * 768 * 2;
constexpr size_t OFF_KB = OFF_QB + (size_t)NTOK * 512 * 2;
constexpr size_t OFF_VB = OFF_KB + (size_t)NTOK * 128 * 2;
constexpr size_t VT_LAT = (size_t)NCTX * 128;
constexpr size_t OFF_YCAT = OFF_VB + (size_t)NTOK * 128 * 2;
constexpr size_t UNION_END = OFF_YCAT + (size_t)NTOK * 1024 * 2;
constexpr size_t ACT_END = OFF_ACT + (size_t)NTOK * DFF * 2;
constexpr size_t WS_END = (UNION_END > ACT_END ? UNION_END : ACT_END);

struct Params {
    const float* in[24];
    float* out;
    unsigned char* ws;
};

__device__ __forceinline__ unsigned short f2bf(float f) { unsigned u = __float_as_uint(f); u += 0x7FFFu + ((u >> 16) & 1u); return (unsigned short)(u >> 16); }
__device__ __forceinline__ float bf2f(unsigned short b) { return __uint_as_float(((unsigned)b) << 16); }
__device__ __forceinline__ unsigned cvt_pk_bf16(float lo, float hi) { unsigned r; asm volatile("v_cvt_pk_bf16_f32 %0, %1, %2" : "=v"(r) : "v"(lo), "v"(hi)); return r; }
typedef __bf16 bf16x2_t __attribute__((ext_vector_type(2)));
typedef float f32x2_t __attribute__((ext_vector_type(2)));
typedef float f32x16 __attribute__((ext_vector_type(16)));
__device__ __forceinline__ unsigned pk_bf16(float lo, float hi) { f32x2_t v = {lo, hi}; return __builtin_bit_cast(unsigned, __builtin_convertvector(v, bf16x2_t)); }
__device__ __forceinline__ float silu_f(float x) { return x * __builtin_amdgcn_rcpf(1.0f + __expf(-x)); }
__device__ __forceinline__ int perm32(int rho) { const int n = rho >> 4, i = rho & 15; return 8 * (i >> 2) + 4 * n + (i & 3); }

__device__ __forceinline__ int opaque_tid() { int t = threadIdx.x; asm volatile("" : "+v"(t)); return t; }


#define XB_TMO      128
#define XB_XCNT(j)  (256  + 64 * (j))
#define XB_XSUB(j)  (1280 + 64 * (j))
#define XB_XGEN(j)  (2304 + 64 * (j))
#define XB_TOP      3328
#define XB_TOPGEN   3392
#define XCD_BAR_WORDS 3456
#define XB_SPIN_CAP (1u << 22)
__device__ __forceinline__ unsigned xb_ld(unsigned* p)              { return __hip_atomic_load(p, __ATOMIC_RELAXED, __HIP_MEMORY_SCOPE_AGENT); }
__device__ __forceinline__ unsigned xb_add(unsigned* p, unsigned v) { return __hip_atomic_fetch_add(p, v, __ATOMIC_RELAXED, __HIP_MEMORY_SCOPE_AGENT); }
__device__ __forceinline__ unsigned xb_xcc_id() { return (unsigned)__builtin_amdgcn_s_getreg((3 << 11) | 20) & 0xFu; }
#define XB_SPIN(cond, bar) do { unsigned _sp = 0; while (cond) { __builtin_amdgcn_s_sleep(1); \
    if ((++_sp & 255u) == 0u) { if (xb_ld(&(bar)[XB_TMO])) break; if (_sp > XB_SPIN_CAP) { atomicAdd(&(bar)[XB_TMO], 1u); break; } } } } while (0)
struct XcdBarrier { unsigned* bar; unsigned x; volatile LAS unsigned* st; };
__device__ __forceinline__ XcdBarrier xcd_barrier_post(unsigned* bar, volatile LAS unsigned* st) {
    XcdBarrier b; b.bar = bar; b.x = xb_xcc_id(); b.st = st;
    if (threadIdx.x == 0) (void)xb_add(&bar[XB_XCNT(b.x)], 1u);
    return b;
}
__device__ __forceinline__ void xcd_barrier_complete(unsigned* bar, unsigned x, unsigned& nloc, unsigned& nx) {
    const unsigned G = gridDim.x * gridDim.y * gridDim.z;
    unsigned sum, cnt, mine, sp = 0u;
    for (;;) {
        sum = 0u; cnt = 0u; mine = 0u;
#pragma unroll
        for (unsigned j = 0; j < 16; ++j) { const unsigned c = xb_ld(&bar[XB_XCNT(j)]); sum += c; cnt += (c > 0u) ? 1u : 0u; mine = (j == x) ? c : mine; }
        if (sum == G) break;
        __builtin_amdgcn_s_sleep(1);
        if ((++sp & 255u) == 0u) { if (xb_ld(&bar[XB_TMO])) break; if (sp > XB_SPIN_CAP) { atomicAdd(&bar[XB_TMO], 1u); break; } }
    }
    nloc = mine > 0u ? mine : 1u; nx = cnt > 0u ? cnt : 1u;
}
__device__ __forceinline__ void xcd_barrier(const XcdBarrier& b) {
    asm volatile("s_waitcnt vmcnt(0)" ::: "memory");
    __syncthreads();
    if (threadIdx.x == 0) {
        unsigned* bar = b.bar;
        __builtin_amdgcn_s_waitcnt(0);
        unsigned nloc = b.st[0], nx = b.st[1];
        if (nloc == 0u) { xcd_barrier_complete(bar, b.x, nloc, nx); b.st[0] = nloc; b.st[1] = nx; }
        const unsigned old = xb_add(&bar[XB_XSUB(b.x)], 1u);
        const unsigned gen = old / nloc;
        if (old + 1u == (gen + 1u) * nloc) {
            __builtin_amdgcn_fence(__ATOMIC_RELEASE, "agent");
            asm volatile("s_waitcnt vmcnt(0)" ::: "memory");
            const unsigned og = xb_add(&bar[XB_TOP], 1u);
            const unsigned tg = og / nx;
            if (og + 1u == (tg + 1u) * nx) xb_add(&bar[XB_TOPGEN], 1u);
            else XB_SPIN(xb_ld(&bar[XB_TOPGEN]) == tg, bar);
            __builtin_amdgcn_fence(__ATOMIC_ACQUIRE, "agent");
            xb_add(&bar[XB_XGEN(b.x)], 1u);
            asm volatile("s_waitcnt vmcnt(0)" ::: "memory");
        } else {
            XB_SPIN(xb_ld(&bar[XB_XGEN(b.x)]) == gen, bar);
            __builtin_amdgcn_fence(__ATOMIC_ACQUIRE, "agent");
            asm volatile("s_waitcnt vmcnt(0)" ::: "memory");
        }
    }
    __syncthreads();
}

namespace pg8 {
constexpr int BM = 256, BK = 64, HALF = 128, HTB = HALF * BK * 2, STAGE_BYTES = 8 * HTB, NXCD = 8, WGM = 8;
__device__ __forceinline__ int lds_byte(int r, int c) { const int st = (r >> 4) * 2 + (c >> 5), rr = r & 15, cc = c & 31, ob = rr * 64 + cc * 2; return st * 1024 + (ob ^ (((ob >> 9) & 1) << 5)); }
__device__ __forceinline__ void stage_rc(int b, int& R, int& C) { const int st = b / 1024, sb = b % 1024, swz = sb ^ (((sb >> 9) & 1) << 5); R = (st >> 1) * 16 + swz / 64; C = (st & 1) * 32 + (swz % 64) / 2; }
struct Unit { int pm, pn; };
struct Gemm { const bf16_t* A; const bf16_t* Bt; int M, N, K, lda, ldb; };
struct StaticOrder {
    int nM, nN, nwg, G, c;
    __device__ void init(int M, int N, int G_, int c_) { nM = M / BM; nN = N / BM; nwg = nM * nN; G = G_; c = c_; }
    __device__ bool next(int i, Unit& u) const {
        if (c < 0) return false;
        const long L = (long)i * G + c; if (L >= nwg) return false;
        int wgid = (int)L; { const int q = nwg / NXCD, r = nwg % NXCD, xcd = wgid % NXCD, off = wgid / NXCD; wgid = (xcd < r ? xcd * (q + 1) : r * (q + 1) + (xcd - r) * q) + off; }
        const int nig = WGM * nN, gid = wgid / nig, fm = gid * WGM, gsz = (nM - fm) < WGM ? (nM - fm) : WGM;
        u.pm = fm + ((wgid % nig) % gsz); u.pn = (wgid % nig) / gsz; return true;
    }
    __device__ __forceinline__ void a_ready(const Unit&) const {}
    __device__ __forceinline__ void done(const Unit&) const {}
};

template <class Epi, class Sched>
__device__ __forceinline__ void gemm_phase(LAS unsigned char* lds, Gemm g, const Sched& S, const Epi& E) {
    asm volatile("" : "+s"(g.A), "+s"(g.Bt), "+s"(g.K), "+s"(g.lda), "+s"(g.ldb));
    int tid = threadIdx.x; asm volatile("" : "+v"(tid));
    const int wid = __builtin_amdgcn_readfirstlane(tid >> 6), lane = tid & 63, wr = wid >> 2, wc = wid & 3, fr = lane & 15, fq = lane >> 4;
    const int K = g.K, nt = K / BK;
    unsigned voffA[2], voffB[2];
#pragma unroll
    for (int i = 0; i < 2; ++i) { int R, C; stage_rc(tid * 16 + i * 8192, R, C);
        voffA[i] = (unsigned)(R * g.lda + C) * 2u; voffB[i] = (unsigned)(R * g.ldb + C) * 2u; }
    const size_t kstep = (size_t)(BK * 2);
    const size_t hstepA = (size_t)HALF * g.lda * 2, hstepB = (size_t)HALF * g.ldb * 2;
    const size_t tstepA = 2 * hstepA, tstepB = 2 * hstepB;
    const unsigned ldsw = (unsigned)wid * 1024u;
    const int aoff = lds_byte(wr * 64 + fr, fq * 8), boff = lds_byte(wc * 32 + fr, fq * 8);
#define PG8_SA(b, h) (((b) * 2 + (h)) * HTB)
#define PG8_SB(b, h) ((4 + (b) * 2 + (h)) * HTB)
#define PG8_STAGE(bufoff, gbase, voff) do { _Pragma("unroll") for (int _i = 0; _i < 2; ++_i) \
        __builtin_amdgcn_global_load_lds((const unsigned*)((const char*)(gbase) + (voff)[_i]), (LAS unsigned*)(lds + (bufoff) + ldsw + _i * 8192), 16, 0, 0); } while (0)
#define PG8_LDA(dst, b, h) do { _Pragma("unroll") for (int m = 0; m < 4; ++m) _Pragma("unroll") for (int k = 0; k < 2; ++k) dst[m][k] = *(const LAS bf16x8*)(lds + PG8_SA(b, h) + aoff + m * 2048 + k * 1024); } while (0)
#define PG8_LDB(dst, b, h) do { _Pragma("unroll") for (int n = 0; n < 2; ++n) _Pragma("unroll") for (int k = 0; k < 2; ++k) dst[n][k] = *(const LAS bf16x8*)(lds + PG8_SB(b, h) + boff + n * 2048 + k * 1024); } while (0)
#define PG8_MMA(ai, bj, At, Bt) do { __builtin_amdgcn_s_setprio(1); _Pragma("unroll") for (int m = 0; m < 4; ++m) _Pragma("unroll") for (int n = 0; n < 2; ++n) _Pragma("unroll") for (int k = 0; k < 2; ++k) \
        acc[ai][bj][m][n] = __builtin_amdgcn_mfma_f32_16x16x32_bf16(Bt[n][k], At[m][k], acc[ai][bj][m][n], 0, 0, 0); __builtin_amdgcn_s_setprio(0); } while (0)
#define PG8_WAIT_V(n) asm volatile("s_waitcnt vmcnt(" #n ")" ::: "memory")
#define PG8_WAIT_L(n) asm volatile("s_waitcnt lgkmcnt(" #n ")" ::: "memory")
#define PG8_BAR __builtin_amdgcn_s_barrier()
#define PG8_SCHED __builtin_amdgcn_sched_barrier(0)
    Unit cur, nxt; int ui = 0;
    if (!S.next(0, cur)) return;
    f32x4 acc[2][2][4][2];
#pragma unroll
    for (int a = 0; a < 2; ++a)
#pragma unroll
        for (int b = 0; b < 2; ++b)
#pragma unroll
            for (int m = 0; m < 4; ++m)
#pragma unroll
                for (int n = 0; n < 2; ++n) acc[a][b][m][n] = (f32x4){0.f, 0.f, 0.f, 0.f};
    bf16x8 At[4][2], B0[2][2], B1[2][2];
    const char* cA = (const char*)g.A + (size_t)cur.pm * tstepA; const char* cB = (const char*)g.Bt + (size_t)cur.pn * tstepB;
    S.a_ready(cur);
    PG8_STAGE(PG8_SB(0, 0), cB, voffB); PG8_STAGE(PG8_SA(0, 0), cA, voffA); PG8_STAGE(PG8_SB(0, 1), cB + hstepB, voffB); PG8_STAGE(PG8_SA(0, 1), cA + hstepA, voffA);
    if (wr == 1) PG8_BAR;
    PG8_WAIT_V(4); PG8_BAR;
    PG8_STAGE(PG8_SB(1, 0), cB + kstep, voffB); PG8_STAGE(PG8_SA(1, 0), cA + kstep, voffA); PG8_STAGE(PG8_SB(1, 1), cB + hstepB + kstep, voffB);
    PG8_WAIT_V(6); PG8_BAR;
    for (;;) {
        const bool has_next = S.next(ui + 1, nxt);
        const char* nA = has_next ? (const char*)g.A + (size_t)nxt.pm * tstepA : cA; const char* nB = has_next ? (const char*)g.Bt + (size_t)nxt.pn * tstepB : cB;
        for (int t = 0; t < nt; t += 2) {
            const bool last = (t == nt - 2);
            const char* a1 = cA + (size_t)(t + 1) * kstep;
            const char* a2 = last ? nA : cA + (size_t)(t + 2) * kstep; const char* b2 = last ? nB : cB + (size_t)(t + 2) * kstep;
            const char* a3 = a2 + kstep; const char* b3 = b2 + kstep;
            if (last && has_next) S.a_ready(nxt);
            PG8_LDB(B0, 0, 0); PG8_SCHED; PG8_LDA(At, 0, 0); PG8_STAGE(PG8_SA(1, 1), a1 + hstepA, voffA);
            PG8_WAIT_L(8); PG8_BAR; PG8_WAIT_L(0); PG8_MMA(0, 0, At, B0); PG8_BAR; PG8_SCHED;
            PG8_LDB(B1, 0, 1); PG8_STAGE(PG8_SB(0, 0), b2, voffB);
            PG8_BAR; PG8_WAIT_L(0); PG8_MMA(0, 1, At, B1); PG8_BAR;
            PG8_LDA(At, 0, 1); PG8_STAGE(PG8_SA(0, 0), a2, voffA);
            PG8_BAR; PG8_WAIT_L(0); PG8_MMA(1, 0, At, B0); PG8_BAR; PG8_SCHED;
            PG8_STAGE(PG8_SB(0, 1), b2 + hstepB, voffB);
            PG8_WAIT_V(6); PG8_BAR; PG8_MMA(1, 1, At, B1); PG8_BAR;
            PG8_LDB(B0, 1, 0); PG8_SCHED; PG8_LDA(At, 1, 0); PG8_STAGE(PG8_SA(0, 1), a2 + hstepA, voffA);
            PG8_WAIT_L(8); PG8_BAR; PG8_WAIT_L(0); PG8_MMA(0, 0, At, B0); PG8_BAR; PG8_SCHED;
            PG8_LDB(B1, 1, 1); PG8_STAGE(PG8_SB(1, 0), b3, voffB);
            PG8_BAR; PG8_WAIT_L(0); PG8_MMA(0, 1, At, B1); PG8_BAR;
            PG8_LDA(At, 1, 1); PG8_STAGE(PG8_SA(1, 0), a3, voffA);
            PG8_BAR; PG8_WAIT_L(0); PG8_MMA(1, 0, At, B0); PG8_BAR; PG8_SCHED;
            PG8_STAGE(PG8_SB(1, 1), b3 + hstepB, voffB);
            PG8_WAIT_V(6); PG8_BAR; PG8_MMA(1, 1, At, B1); PG8_BAR;
        }
        { int fr2 = fr, fq2 = fq, wr2 = wr, wc2 = wc; asm volatile("" : "+v"(fr2), "+v"(fq2), "+s"(wr2), "+s"(wc2));
            E(acc, cur, wr2, wc2, fr2, fq2); } S.done(cur);
        if (!has_next) break;
#pragma unroll
        for (int a = 0; a < 2; ++a)
#pragma unroll
            for (int b = 0; b < 2; ++b)
#pragma unroll
                for (int m = 0; m < 4; ++m)
#pragma unroll
                    for (int n = 0; n < 2; ++n) acc[a][b][m][n] = (f32x4){0.f, 0.f, 0.f, 0.f};
        cur = nxt; cA = nA; cB = nB; ++ui;
    }
    PG8_WAIT_V(0);
    if (wr == 0) PG8_BAR;
    PG8_BAR;
#undef PG8_SA
#undef PG8_SB
#undef PG8_STAGE
#undef PG8_LDA
#undef PG8_LDB
#undef PG8_MMA
#undef PG8_WAIT_V
#undef PG8_WAIT_L
#undef PG8_BAR
#undef PG8_SCHED
}
}

struct EpiSwiglu {
    bf16_t* O;
    __device__ __forceinline__ void operator()(const f32x4 (&acc)[2][2][4][2], const pg8::Unit& u, int wr, int wc, int fr, int fq) const {
        const int row0 = u.pm * 256 + wr * 64 + fr, col0 = u.pn * 128 + wc * 32 + 8 * fq;
#pragma unroll
        for (int ai = 0; ai < 2; ++ai)
#pragma unroll
            for (int m = 0; m < 4; ++m) {
                bf16_t* rowp = O + (size_t)(row0 + ai * 128 + m * 16) * DFF + col0;
                const f32x4 g0 = acc[ai][0][m][0], g1 = acc[ai][0][m][1], u0 = acc[ai][1][m][0], u1 = acc[ai][1][m][1];
                u32x4 w;
                w.x = cvt_pk_bf16(silu_f(g0[0]) * u0[0], silu_f(g0[1]) * u0[1]); w.y = cvt_pk_bf16(silu_f(g0[2]) * u0[2], silu_f(g0[3]) * u0[3]);
                w.z = cvt_pk_bf16(silu_f(g1[0]) * u1[0], silu_f(g1[1]) * u1[1]); w.w = cvt_pk_bf16(silu_f(g1[2]) * u1[2], silu_f(g1[3]) * u1[3]);
                *(u32x4*)rowp = w;
            }
    }
};
struct EpiYssq {
    bf16_t* Y; float* ssq;
    __device__ __forceinline__ void operator()(const f32x4 (&acc)[2][2][4][2], const pg8::Unit& u, int wr, int wc, int fr, int fq) const {
        const int row0 = u.pm * 256 + wr * 64 + fr, col0 = u.pn * 256 + wc * 32 + 8 * fq;
#pragma unroll
        for (int ai = 0; ai < 2; ++ai)
#pragma unroll
            for (int m = 0; m < 4; ++m) {
                const int row = row0 + ai * 128 + m * 16;
                bf16_t* rowp = Y + (size_t)row * D + col0;
                float s = 0.f;
#pragma unroll
                for (int bj = 0; bj < 2; ++bj) {
                    const f32x4 v0 = acc[ai][bj][m][0], v1 = acc[ai][bj][m][1];
                    s += v0[0] * v0[0] + v0[1] * v0[1] + v0[2] * v0[2] + v0[3] * v0[3] + v1[0] * v1[0] + v1[1] * v1[1] + v1[2] * v1[2] + v1[3] * v1[3];
                    u32x4 w; w.x = cvt_pk_bf16(v0[0], v0[1]); w.y = cvt_pk_bf16(v0[2], v0[3]); w.z = cvt_pk_bf16(v1[0], v1[1]); w.w = cvt_pk_bf16(v1[2], v1[3]);
                    *(u32x4*)(rowp + bj * 128) = w;
                }
                s += __shfl_xor(s, 16); s += __shfl_xor(s, 32);
                if (fq == 0) ssq[(size_t)row * 16 + u.pn * 4 + wc] = s;
            }
    }
};
struct EpiWin {
    bf16_t* ZT; bf16_t* HT; bf16_t* QB; bf16_t* KB; bf16_t* VB; const float* rope; float* newk; float* newv; int layer;
    __device__ __forceinline__ void operator()(const f32x4 (&acc)[2][2][4][2], const pg8::Unit& u, int wr, int wc, int fr, int fq) const {
        const int r0 = u.pm * 256 + wr * 64 + fr;
        const bool lat = u.pm >= 32;
        const int pn = u.pn;
        if (pn < 5) {
            bf16_t* base; int t0; size_t sch;
            if (pn < 2) {
                if (!lat) { const int b = u.pm; base = ZT + ((size_t)b * 256 * 2 + pn) * 256; sch = 512; t0 = r0 - u.pm * 256; }
                else { const int b = (u.pm - 32) >> 2; base = ZT + ZT_LAT + ((size_t)b * 256 * 2 + pn) * 1024; sch = 2048; t0 = r0 - NCTX - b * 1024; }
            } else {
                const int c0 = (pn - 2) * 256;
                if (!lat) { const int b = u.pm; base = HT + ((size_t)b * 768 + c0) * 256; sch = 256; t0 = r0 - u.pm * 256; }
                else { const int b = (u.pm - 32) >> 2; base = HT + HT_LAT + ((size_t)b * 768 + c0) * 1024; sch = 1024; t0 = r0 - NCTX - b * 1024; }
            }
#pragma unroll
            for (int ai = 0; ai < 2; ++ai)
#pragma unroll
                for (int m = 0; m < 4; ++m) {
                    const int t = t0 + ai * 128 + m * 16;
#pragma unroll
                    for (int bj = 0; bj < 2; ++bj)
#pragma unroll
                        for (int n = 0; n < 2; ++n) {
                            const int ch = bj * 128 + wc * 32 + n * 16 + 4 * fq;
                            const f32x4 v = acc[ai][bj][m][n];
#pragma unroll
                            for (int e = 0; e < 4; ++e) base[(size_t)(ch + e) * sch + t] = f2bf(v[e]);
                        }
                }
        } else {
            const int blk = wc & 1;
#pragma unroll
            for (int ai = 0; ai < 2; ++ai)
#pragma unroll
                for (int m = 0; m < 4; ++m) {
                    const int row = r0 + ai * 128 + m * 16;
                    f32x4 cs0 = {1.f, 0.f, 1.f, 0.f}, cs1 = {1.f, 0.f, 1.f, 0.f};
                    if (lat) { const int t = row & 1023; const int pos = blk ? (t & 63) : (t >> 6);
                        const f32x4* rp = (const f32x4*)(rope + (size_t)(pos * 16 + 4 * fq) * 2); cs0 = rp[0]; cs1 = rp[1]; }
#pragma unroll
                    for (int bj = 0; bj < 2; ++bj) {
                        f32x4 x1 = acc[ai][bj][m][0], x2 = acc[ai][bj][m][1];
                        const bool isv = (pn == 7 && bj == 1);
                        const bool isk = (pn == 7 && bj == 0);
                        const int cc = bj * 128 + wc * 32 + 4 * fq;
                        if ((isk || isv) && !lat) {
                            const int b = row >> 8, t = row & 255;
                            float* dst = (isk ? newk : newv) + (((size_t)b * 2 + layer) * 256 + t) * 128 + (cc & 127);
                            *(f32x4*)dst = x1; *(f32x4*)(dst + 16) = x2;
                        }
                        if (!isv) {
                            f32x4 o1, o2;
                            o1[0] = x1[0] * cs0[0] - x2[0] * cs0[1]; o2[0] = x2[0] * cs0[0] + x1[0] * cs0[1];
                            o1[1] = x1[1] * cs0[2] - x2[1] * cs0[3]; o2[1] = x2[1] * cs0[2] + x1[1] * cs0[3];
                            o1[2] = x1[2] * cs1[0] - x2[2] * cs1[1]; o2[2] = x2[2] * cs1[0] + x1[2] * cs1[1];
                            o1[3] = x1[3] * cs1[2] - x2[3] * cs1[3]; o2[3] = x2[3] * cs1[2] + x1[3] * cs1[3];
                            x1 = o1; x2 = o2;
                        }
                        bf16_t* dst;
                        if (pn < 7) { x1 *= 0.125f; x2 *= 0.125f; dst = QB + (size_t)row * 512 + (pn - 5) * 256 + cc; }
                        else if (isk) dst = KB + (size_t)row * 128 + cc;
                        else {
                            bf16_t* vb; size_t n_;
                            if (!lat) { vb = VB + (size_t)(row >> 8) * 128 * 256 + (row & 255); n_ = 256; } else { vb = VB + VT_LAT + (size_t)((row - NCTX) >> 10) * 128 * 1024 + (row & 1023); n_ = 1024; }
                            const int c0 = cc - 128;
#pragma unroll
                            for (int e = 0; e < 4; ++e) { vb[(size_t)(c0 + e) * n_] = f2bf(x1[e]); vb[(size_t)(c0 + 16 + e) * n_] = f2bf(x2[e]); }
                            continue;
                        }
                        u32x2 w1, w2; w1.x = cvt_pk_bf16(x1[0], x1[1]); w1.y = cvt_pk_bf16(x1[2], x1[3]); w2.x = cvt_pk_bf16(x2[0], x2[1]); w2.y = cvt_pk_bf16(x2[2], x2[3]);
                        *(u32x2*)dst = w1; *(u32x2*)(dst + 16) = w2;
                    }
                }
        }
    }
};
struct EpiFourier {
    bf16_t* YC; int rowbase, n;
    __device__ __forceinline__ void operator()(const f32x4 (&acc)[2][2][4][2], const pg8::Unit& u, int wr, int wc, int fr, int fq) const {
        const int kp0 = u.pm * 256 + wr * 64 + fr; const int b = u.pn;
#pragma unroll
        for (int ai = 0; ai < 2; ++ai)
#pragma unroll
            for (int m = 0; m < 4; ++m) {
                bf16_t* rowp = YC + (size_t)(rowbase + b * n + kp0 + ai * 128 + m * 16) * 1024 + wc * 32 + 4 * fq;
#pragma unroll
                for (int bj = 0; bj < 2; ++bj)
#pragma unroll
                    for (int nn = 0; nn < 2; ++nn) { const f32x4 v = acc[ai][bj][m][nn]; u32x2 w; w.x = cvt_pk_bf16(v[0], v[1]); w.y = cvt_pk_bf16(v[2], v[3]);
                        *(u32x2*)(rowp + bj * 128 + nn * 16) = w; }
            }
    }
};

struct TrUnit { const float* src; bf16_t* dst; int ld, k0, cbase, Kd, r0, perm; };
__device__ __forceinline__ TrUnit tr_unit(const Params& p, int u) {
    constexpr int U_GU = 4 * 44 * 16, U_D = 4 * 8 * 44, U_OUT = 2 * 8 * 16;
    TrUnit t; unsigned char* ws = p.ws;
    if (u < U_GU) { const int ls = u / (44 * 16), rem = u % (44 * 16), rg = rem / 16, kb = rem % 16; const int pn = rg >> 1, half = rg & 1;
        t.src = (half ? p.in[10] : p.in[9]) + (size_t)ls * 1024 * DFF; t.ld = DFF; t.k0 = kb * 64; t.cbase = pn * 128; t.dst = (bf16_t*)(ws + OFF_WGU + ls * SZ_WGU); t.Kd = 1024; t.r0 = rg * 128; t.perm = 1; }
    else if (u < U_GU + U_D) { const int v = u - U_GU; const int ls = v / (8 * 44), rem = v % (8 * 44), rg = rem / 44, kb = rem % 44;
        t.src = p.in[11] + (size_t)ls * DFF * 1024; t.ld = 1024; t.k0 = kb * 64; t.cbase = rg * 128; t.dst = (bf16_t*)(ws + OFF_WD + ls * SZ_WD); t.Kd = DFF; t.r0 = rg * 128; t.perm = 1; }
    else if (u < U_GU + U_D + U_OUT) { const int v = u - U_GU - U_D; const int l = v / 128, rem = v % 128, rg = rem / 16, kb = rem % 16;
        t.src = p.in[13] + (size_t)l * 1024 * 1024; t.ld = 1024; t.k0 = kb * 64; t.cbase = rg * 128; t.dst = (bf16_t*)(ws + OFF_WOUT + l * SZ_WOUT); t.Kd = 1024; t.r0 = rg * 128; t.perm = 1; }
    else { const int v = u - U_GU - U_D - U_OUT; const int l = v / (12 * 16), rem = v % (12 * 16), rg = rem / 16, kb = rem % 16;
        t.src = p.in[12] + (size_t)l * 1024 * INW; t.ld = INW; t.k0 = kb * 64; t.cbase = 256 + rg * 128; t.dst = (bf16_t*)(ws + OFF_WIN + l * SZ_WIN); t.Kd = 1024; t.r0 = 512 + rg * 128; t.perm = 0; }
    return t;
}
__device__ __forceinline__ void tr_load(const TrUnit& t, int tid, f32x4 (&v)[4]) {
#pragma unroll
    for (int i = 0; i < 4; ++i) { const int idx = tid + 512 * i, kk = idx >> 5, c4 = idx & 31;
        v[i] = *(const f32x4*)(t.src + (size_t)(t.k0 + kk) * t.ld + t.cbase + c4 * 4); }
}
__device__ void phase_prep(const Params& p, float* lds) {
    const int tid = opaque_tid(), nb = gridDim.x, bid = blockIdx.x;
    unsigned char* ws = p.ws;
    {
        constexpr int NU = 4 * 44 * 16 + 4 * 8 * 44 + 2 * 8 * 16 + 2 * 12 * 16;
        constexpr int TS = 132;
        f32x4 v[4];
        int u = bid;
        TrUnit cur; if (u < NU) { cur = tr_unit(p, u); tr_load(cur, tid, v); }
        while (u < NU) {
#pragma unroll
            for (int i = 0; i < 4; ++i) { const int idx = tid + 512 * i, kk = idx >> 5, c4 = idx & 31; *(f32x4*)(lds + kk * TS + c4 * 4) = v[i]; }
            __syncthreads();
            const int un = u + nb; TrUnit nxt = cur;
            if (un < NU) { nxt = tr_unit(p, un); tr_load(nxt, tid, v); }
            { const int rr = tid >> 2, kc = tid & 3; const int cc = cur.perm ? ((rr & ~31) + perm32(rr & 31)) : rr;
                float x[16];
#pragma unroll
                for (int j = 0; j < 16; ++j) x[j] = lds[(kc * 16 + j) * TS + cc];
                u32x4 w0, w1; w0.x = pk_bf16(x[0], x[1]); w0.y = pk_bf16(x[2], x[3]); w0.z = pk_bf16(x[4], x[5]); w0.w = pk_bf16(x[6], x[7]);
                w1.x = pk_bf16(x[8], x[9]); w1.y = pk_bf16(x[10], x[11]); w1.z = pk_bf16(x[12], x[13]); w1.w = pk_bf16(x[14], x[15]);
                bf16_t* d = cur.dst + (size_t)(cur.r0 + rr) * cur.Kd + cur.k0 + kc * 16;
                *(u32x4*)d = w0; *(u32x4*)(d + 8) = w1; }
            __syncthreads();
            cur = nxt; u = un;
        }
    }
    __syncthreads();
    {
        float* tab = lds;
        if (tid < 64) { float sv, cv; sincosf(PI2 * (float)tid / 64.f, &sv, &cv); tab[tid] = cv; tab[64 + tid] = sv; }
        __syncthreads();
        const int lane = tid & 63, wv = tid >> 6;
        for (int u = bid * 8 + wv; u < 8192; u += nb * 8) {
            const int l = u >> 12, k = (u >> 2) & 1023, g = u & 3;
            const float* wrow = p.in[12] + ((size_t)l * 1024 + k) * INW + g * 64;
            const float wv_ = wrow[lane];
            float ac = 0.f, as = 0.f;
#pragma unroll 16
            for (int c = 0; c < 64; ++c) { const float w = __shfl(wv_, c); const int idx = (c * lane) & 63; ac += w * tab[idx]; as += w * tab[64 + idx]; }
            bf16_t* bt = (bf16_t*)(ws + OFF_WIN + l * SZ_WIN);
            bt[(size_t)(g * 64 + lane) * 1024 + k] = f2bf(ac);
            bt[(size_t)(256 + g * 64 + lane) * 1024 + k] = f2bf(as);
        }
        __syncthreads();
    }
    {
        float* sc = lds;
        float* part = lds + 12 * 1024;
        for (int i = tid; i < 9 * 1024; i += NTHREADS) { const int bc = i >> 10, k = i & 1023; const float cv = bc == 0 ? p.in[5][k] : p.in[4][(bc - 1) * 1024 + k]; sc[k * 12 + bc] = cv / (1.0f + expf(-cv)); }
        __syncthreads();
        for (int cb = bid; cb < 256; cb += nb) {
            const int gc0 = cb * 72, l = gc0 / 9216, j0 = gc0 % 9216;
            const int cg = tid % 18, kg = tid / 18;
            if (kg < 28) {
                f32x4 a[9];
#pragma unroll
                for (int i = 0; i < 9; ++i) a[i] = (f32x4){0.f, 0.f, 0.f, 0.f};
                const float* wp = p.in[6] + (size_t)l * 1024 * 9216 + j0 + cg * 4;
#pragma unroll 4
                for (int k = kg; k < 1024; k += 28) { const f32x4 w = *(const f32x4*)(wp + (size_t)k * 9216);
                    const f32x4 s0 = *(const f32x4*)(sc + k * 12), s1 = *(const f32x4*)(sc + k * 12 + 4); const float s8 = sc[k * 12 + 8];
                    a[0] += w * s0[0]; a[1] += w * s0[1]; a[2] += w * s0[2]; a[3] += w * s0[3]; a[4] += w * s1[0]; a[5] += w * s1[1]; a[6] += w * s1[2]; a[7] += w * s1[3]; a[8] += w * s8; }
#pragma unroll
                for (int i = 0; i < 9; ++i)
#pragma unroll
                    for (int e = 0; e < 4; ++e) part[(kg * 72 + cg * 4 + e) * 9 + i] = a[i][e];
            }
            __syncthreads();
            for (int i = tid; i < 72 * 9; i += NTHREADS) { const int c2 = i / 9, bc = i % 9; float s = 0.f;
#pragma unroll
                for (int g = 0; g < 28; ++g) s += part[(g * 72 + c2) * 9 + bc];
                ((float*)(ws + OFF_MOD))[((size_t)l * 9 + bc) * 9216 + j0 + c2] = s + p.in[7][l * 9216 + j0 + c2]; }
            __syncthreads();
        }
    }
    __syncthreads();
    {
        const int lane = tid & 63, wv = tid >> 6;
        float* h2s = lds;
        const int u0 = bid * 10; const int l = u0 / 1280;
        if (u0 < 2560) {
            const float* w1 = p.in[15] + l * 33 * 64; const float* b1 = p.in[16] + l * 64; const float* w2 = p.in[17] + l * 64 * 64; const float* b2 = p.in[18] + l * 64;
            const float* w3 = p.in[19] + (size_t)l * 64 * 1024; const float fr = p.in[20][l * 64 + lane];
            for (int q = wv; q < 10; q += 8) {
                const int rem = (u0 + q) % 1280; const int pass = rem >= 256; const int n = pass ? 1024 : 256; const int d = pass ? rem - 256 : rem;
                const float tt = (float)d / (float)(n - 1);
                float feat = 0.f;
                if (lane == 0) feat = tt;
                else if (lane < 33) { const int j = (lane - 1) & 15; const float fj = 1e-4f + (float)j * ((15.0f - 1e-4f) / 15.0f); const float ang = (PI2 / (float)n) * (float)d * fj;
                    feat = lane < 17 ? cosf(ang) : -sinf(ang); }
                float a1 = b1[lane];
#pragma unroll
                for (int i = 0; i < 33; ++i) a1 += __shfl(feat, i) * w1[i * 64 + lane];
                const float h1 = sinf(fr * a1);
                float a2 = b2[lane];
#pragma unroll
                for (int i = 0; i < 64; ++i) a2 += __shfl(h1, i) * w2[i * 64 + lane];
                h2s[lane * 12 + q] = sinf(fr * a2);
            }
            __syncthreads();
            float acc[2][10];
#pragma unroll
            for (int q = 0; q < 10; ++q) { acc[0][q] = 0.f; acc[1][q] = 0.f; }
#pragma unroll 8
            for (int i = 0; i < 64; ++i) {
                const float wa = w3[i * 1024 + tid], wb = w3[i * 1024 + 512 + tid];
                const f32x4 ha = *(const f32x4*)(h2s + i * 12), hb = *(const f32x4*)(h2s + i * 12 + 4); const float h8 = h2s[i * 12 + 8], h9 = h2s[i * 12 + 9];
                acc[0][0] += ha[0] * wa; acc[0][1] += ha[1] * wa; acc[0][2] += ha[2] * wa; acc[0][3] += ha[3] * wa; acc[0][4] += hb[0] * wa; acc[0][5] += hb[1] * wa; acc[0][6] += hb[2] * wa; acc[0][7] += hb[3] * wa; acc[0][8] += h8 * wa; acc[0][9] += h9 * wa;
                acc[1][0] += ha[0] * wb; acc[1][1] += ha[1] * wb; acc[1][2] += ha[2] * wb; acc[1][3] += ha[3] * wb; acc[1][4] += hb[0] * wb; acc[1][5] += hb[1] * wb; acc[1][6] += hb[2] * wb; acc[1][7] += hb[3] * wb; acc[1][8] += h8 * wb; acc[1][9] += h9 * wb;
            }
            const int ord = (tid >> 8) & 1, c = tid & 255;
            const float dec = fabsf(p.in[21][(l * 2 + ord) * 256 + c]);
            bf16_t* gl = (bf16_t*)(ws + OFF_FILT) + (size_t)l * G_L;
#pragma unroll
            for (int q = 0; q < 10; ++q) {
                const int rem = (u0 + q) % 1280; const int pass = rem >= 256; const int n = pass ? 1024 : 256; const int d = pass ? rem - 256 : rem;
                const float tt = (float)d / (float)(n - 1); const float win = expf(-tt * dec) / (float)(2 * n);
                bf16_t* g = gl + (pass ? G_CTX : 0) + ((size_t)ord * 256 + c) * (2 * n);
                g[n - 1 - d] = f2bf(acc[0][q] * win);
                g[d == 0 ? 2 * n - 1 : n - 1 + d] = d == 0 ? (bf16_t)0 : f2bf(acc[1][q] * win);
            }
        }
        __syncthreads();
    }
    __syncthreads();
    {
        bf16_t* FC = (bf16_t*)(ws + OFF_FC); bf16_t* FL = (bf16_t*)(ws + OFF_FL);
        const int gt = bid * NTHREADS + tid, gn = nb * NTHREADS;
        for (int i = gt; i < 256 * 512 + 1024 * 2048; i += gn) {
            int n, k, col; bf16_t* dst;
            if (i < 256 * 512) { n = 256; k = i >> 9; col = i & 511; dst = FC + i; } else { const int j = i - 256 * 512; n = 1024; k = j >> 11; col = j & 2047; dst = FL + j; }
            const int s = col >= n, t = col - s * n; const int ph = (k * t) & (n - 1);
            float sv, cv; sincosf(PI2 * (float)ph / (float)n, &sv, &cv);
            const float sc = rsqrtf(64.0f * (float)n);
            *dst = f2bf((s ? -sv : cv) * sc);
        }
        { bf16_t* CK = (bf16_t*)(ws + OFF_CKB); bf16_t* CV = (bf16_t*)(ws + OFF_CVT);
            for (int i = gt; i < 2 * 8 * 256 * 128; i += gn) {
                { const int c = i & 127, key = (i >> 7) & 255, b = (i >> 15) & 7, l = i >> 18;
                    CK[i] = f2bf(p.in[2][(((size_t)b * 2 + l) * 256 + key) * 128 + c]); }
                { const int key = i & 255, c = (i >> 8) & 127, b = (i >> 15) & 7, l = i >> 18;
                    CV[i] = f2bf(p.in[3][(((size_t)b * 2 + l) * 256 + key) * 128 + c]); }
            } }
        if (bid == 0) for (int i = tid; i < 64 * 16; i += NTHREADS) { const int pos = i >> 4, j = i & 15; const float inv = powf(10000.0f, -(float)(2 * j) / 32.0f);
            float sv, cv; sincosf((float)pos * inv, &sv, &cv); float* rp = (float*)(ws + OFF_ROPE); rp[2 * i] = cv; rp[2 * i + 1] = sv; }
    }
    __syncthreads();
}

template <int MODE>
__device__ void phase_row(const Params& p, int lpost, int spost, int lpre, int spre) {
    const int tid_ = opaque_tid(); const int lane = tid_ & 63, wv = tid_ >> 6;
    const float* mod = (const float*)(p.ws + OFF_MOD);
    const bf16_t* Y = (const bf16_t*)(p.ws + OFF_Y); const float* ssq = (const float*)(p.ws + OFF_SSQ);
    bf16_t* H = (bf16_t*)(p.ws + OFF_H);
    const float factor = (spost == 1) ? 1.0f : 0.5f;
    const int stride = gridDim.x * 8;
    for (int row0 = blockIdx.x * 8 + wv; row0 < NTOK; row0 += 2 * stride) {
        f32x4 x[2][4]; u32x2 yv[2][4]; f32x4 sq[2][4]; int bc[2]; bool ok[2];
#pragma unroll
        for (int q = 0; q < 2; ++q) {
            const int row = row0 + q * stride; ok[q] = row < NTOK; const int rw = ok[q] ? row : row0;
            bc[q] = rw < NCTX ? 0 : 1 + ((rw - NCTX) >> 10);
            if (MODE == 0) { const float* src = rw < NCTX ? p.in[0] + (size_t)rw * D : p.in[1] + (size_t)(rw - NCTX) * D;
#pragma unroll
                for (int j = 0; j < 4; ++j) x[q][j] = *(const f32x4*)(src + j * 256 + lane * 4); }
            else {
#pragma unroll
                for (int j = 0; j < 4; ++j) { x[q][j] = *(const f32x4*)(p.out + (size_t)rw * D + j * 256 + lane * 4); yv[q][j] = *(const u32x2*)(Y + (size_t)rw * D + j * 256 + lane * 4); }
                const f32x4* sp = (const f32x4*)(ssq + (size_t)rw * 16);
#pragma unroll
                for (int j = 0; j < 4; ++j) sq[q][j] = sp[j];
            }
        }
#pragma unroll
        for (int q = 0; q < 2; ++q) {
            const int row = row0 + q * stride;
            if (!ok[q]) continue;
            float* xr = p.out + (size_t)row * D;
            if (MODE != 0) {
                float tot = 0.f;
#pragma unroll
                for (int j = 0; j < 4; ++j) tot += (sq[q][j][0] + sq[q][j][1]) + (sq[q][j][2] + sq[q][j][3]);
                const float rstd = rsqrtf(tot * (1.0f / 1024.0f) + EPS) * factor;
                const float* gate = mod + ((size_t)lpost * 9 + bc[q]) * 9216 + spost * 3072 + 2048;
                const float* gp = p.in[8] + (lpost * 6 + 2 * spost + 1) * 1024;
#pragma unroll
                for (int j = 0; j < 4; ++j) { const int c = j * 256 + lane * 4;
                    const f32x4 gt = *(const f32x4*)(gate + c), gg = *(const f32x4*)(gp + c);
                    x[q][j][0] += gt[0] * gg[0] * rstd * __uint_as_float(yv[q][j].x << 16);
                    x[q][j][1] += gt[1] * gg[1] * rstd * __uint_as_float(yv[q][j].x & 0xFFFF0000u);
                    x[q][j][2] += gt[2] * gg[2] * rstd * __uint_as_float(yv[q][j].y << 16);
                    x[q][j][3] += gt[3] * gg[3] * rstd * __uint_as_float(yv[q][j].y & 0xFFFF0000u); }
            }
#pragma unroll
            for (int j = 0; j < 4; ++j) *(f32x4*)(xr + j * 256 + lane * 4) = x[q][j];
            if (MODE != 2) {
                float s = 0.f;
#pragma unroll
                for (int j = 0; j < 4; ++j) s += x[q][j][0] * x[q][j][0] + x[q][j][1] * x[q][j][1] + x[q][j][2] * x[q][j][2] + x[q][j][3] * x[q][j][3];
#pragma unroll
                for (int o = 32; o >= 1; o >>= 1) s += __shfl_xor(s, o);
                const float rs = rsqrtf(s * (1.0f / 1024.0f) + EPS);
                const float* mb = mod + ((size_t)lpre * 9 + bc[q]) * 9216 + spre * 3072;
                const float* gp = p.in[8] + (lpre * 6 + 2 * spre) * 1024;
#pragma unroll
                for (int j = 0; j < 4; ++j) { const int c = j * 256 + lane * 4;
                    const f32x4 sh = *(const f32x4*)(mb + c), scl = *(const f32x4*)(mb + 1024 + c), gg = *(const f32x4*)(gp + c);
                    f32x4 hh;
#pragma unroll
                    for (int e = 0; e < 4; ++e) hh[e] = x[q][j][e] * rs * gg[e] * (1.0f + scl[e]) + sh[e];
                    u32x2 w; w.x = pk_bf16(hh[0], hh[1]); w.y = pk_bf16(hh[2], hh[3]);
                    *(u32x2*)(H + (size_t)row * D + c) = w; }
            }
        }
    }
}

constexpr int AT_KROWB = 144;
constexpr int AT_VROWB_A = 784, AT_VROWB_B = 528;
constexpr int AT_OFF_V = 320 * AT_KROWB;
struct AttnState { f32x16 O0, O1; float m, lsum; };
template <bool MASK>
__device__ __forceinline__ void attn_tiles(AttnState& st, const bf16x8 (&qf)[4], const LAS unsigned char* Kl, const LAS unsigned char* Vl, int vrowb, int t0, int t1, int dk0, int r, int h) {
    for (int t = t0; t < t1; ++t) {
        const LAS unsigned char* kp = Kl + (t * 32 + r) * AT_KROWB + h * 16;
        bf16x8 kf[4];
#pragma unroll
        for (int kk = 0; kk < 4; ++kk) kf[kk] = *(const LAS bf16x8*)(kp + kk * 32);
        const LAS unsigned char* vp = Vl + r * vrowb + (t * 32 + 4 * h) * 2;
        u32x2 vraw[2][2][2];
#pragma unroll
        for (int dt = 0; dt < 2; ++dt)
#pragma unroll
            for (int s = 0; s < 2; ++s)
#pragma unroll
                for (int q = 0; q < 2; ++q) vraw[dt][s][q] = *(const LAS u32x2*)(vp + dt * 32 * vrowb + (16 * s + 8 * q) * 2);
        f32x16 S;
#pragma unroll
        for (int i = 0; i < 16; ++i) S[i] = 0.f;
#pragma unroll
        for (int kk = 0; kk < 4; ++kk) S = __builtin_amdgcn_mfma_f32_32x32x16_bf16(kf[kk], qf[kk], S, 0, 0, 0);
        if (MASK) {
            const int dk = dk0 + t * 32;
            if (dk <= -128 || dk >= 128) {
#pragma unroll
                for (int i = 0; i < 16; ++i) { const int j = (i & 3) + 8 * (i >> 2) + 4 * h; int dd = dk + j - r; if (dd < 0) dd = -dd; if (dd > 128) S[i] = -1e30f; }
            }
        }
        float mx = S[0];
#pragma unroll
        for (int i = 1; i < 16; ++i) mx = fmaxf(mx, S[i]);
        mx = fmaxf(mx, __shfl_xor(mx, 32));
        const float mn = fmaxf(st.m, mx), corr = __expf(st.m - mn);
        st.m = mn;
        float rs = 0.f;
#pragma unroll
        for (int i = 0; i < 16; ++i) { S[i] = __expf(S[i] - mn); rs += S[i]; }
        rs += __shfl_xor(rs, 32);
        st.lsum = st.lsum * corr + rs;
#pragma unroll
        for (int i = 0; i < 16; ++i) { st.O0[i] *= corr; st.O1[i] *= corr; }
        bf16x8 pf[2];
#pragma unroll
        for (int s = 0; s < 2; ++s) { u32x4 w; w.x = pk_bf16(S[8 * s], S[8 * s + 1]); w.y = pk_bf16(S[8 * s + 2], S[8 * s + 3]); w.z = pk_bf16(S[8 * s + 4], S[8 * s + 5]); w.w = pk_bf16(S[8 * s + 6], S[8 * s + 7]);
            pf[s] = __builtin_bit_cast(bf16x8, w); }
#pragma unroll
        for (int s = 0; s < 2; ++s) {
            u32x4 a0; a0.x = vraw[0][s][0].x; a0.y = vraw[0][s][0].y; a0.z = vraw[0][s][1].x; a0.w = vraw[0][s][1].y;
            u32x4 a1; a1.x = vraw[1][s][0].x; a1.y = vraw[1][s][0].y; a1.z = vraw[1][s][1].x; a1.w = vraw[1][s][1].y;
            st.O0 = __builtin_amdgcn_mfma_f32_32x32x16_bf16(__builtin_bit_cast(bf16x8, a0), pf[s], st.O0, 0, 0, 0);
            st.O1 = __builtin_amdgcn_mfma_f32_32x32x16_bf16(__builtin_bit_cast(bf16x8, a1), pf[s], st.O1, 0, 0, 0);
        }
    }
}
__device__ __forceinline__ void attn_unit(const Params& p, int l, int u, LAS unsigned char* lds, int tid) {
    const int lane = tid & 63, wv = tid >> 6, r = lane & 31, h = lane >> 5;
    const bf16_t* QB = (const bf16_t*)(p.ws + OFF_QB); const bf16_t* KB = (const bf16_t*)(p.ws + OFF_KB); const bf16_t* VT = (const bf16_t*)(p.ws + OFF_VB);
    const bf16_t* CK = (const bf16_t*)(p.ws + OFF_CKB); const bf16_t* CV = (const bf16_t*)(p.ws + OFF_CVT);
    bf16_t* YC = (bf16_t*)(p.ws + OFF_YCAT);
    const int g = wv & 3, qh = wv >> 2;
    const int pass = u < 256; const int v = u & 255;
    int b, kvh, qb, n, rowbase;
    if (!pass) { b = v >> 3; kvh = (v >> 2) & 1; qb = v & 3; n = 256; rowbase = b * 256; }
    else { b = v >> 5; kvh = (v >> 4) & 1; qb = v & 15; n = 1024; rowbase = NCTX + b * 1024; }
    const int head = kvh * 4 + g, q0w = qb * 64 + qh * 32;
    int kloU = 0, khiU = 256;
    if (pass) { kloU = qb * 64 - 128; if (kloU < 0) kloU = 0; khiU = qb * 64 + 192; if (khiU > n) khiU = n; }
    const int nkA = khiU - kloU, npc = nkA * 8, vpr = nkA >> 3;
    const bf16_t* kA = KB + (size_t)(rowbase + kloU) * 128 + kvh * 64;
    const bf16_t* vA = VT + (pass ? VT_LAT + (size_t)b * 128 * 1024 : (size_t)b * 128 * 256) + (size_t)kvh * 64 * n + kloU;
    {
        u32x4 kr[5], vr[5];
#pragma unroll
        for (int it = 0; it < 5; ++it) { const int idx = tid + it * NTHREADS;
            if (idx < npc) { kr[it] = *(const u32x4*)(kA + (size_t)(idx >> 3) * 128 + (idx & 7) * 8);
                const int d = idx / vpr, j = idx - d * vpr; vr[it] = *(const u32x4*)(vA + (size_t)d * n + j * 8); } }
#pragma unroll
        for (int it = 0; it < 5; ++it) { const int idx = tid + it * NTHREADS;
            if (idx < npc) { *(LAS u32x4*)(lds + (idx >> 3) * AT_KROWB + (idx & 7) * 16) = kr[it];
                const int d = idx / vpr, j = idx - d * vpr; *(LAS u32x4*)(lds + AT_OFF_V + d * AT_VROWB_A + j * 16) = vr[it]; } }
    }
    bf16x8 qf[4];
    { const bf16_t* qp = QB + (size_t)(rowbase + q0w + r) * 512 + head * 64 + 8 * h;
#pragma unroll
        for (int kk = 0; kk < 4; ++kk) qf[kk] = *(const bf16x8*)(qp + 16 * kk); }
    AttnState st; st.m = p.in[23][l * 8 + head]; st.lsum = 1.0f;
#pragma unroll
    for (int i = 0; i < 16; ++i) { st.O0[i] = 0.f; st.O1[i] = 0.f; }
    __syncthreads();
    u32x4 kb[4], vb[4];
    if (pass) {
        const bf16_t* kB = CK + ((size_t)(l * 8 + b) * 256) * 128 + kvh * 64;
        const bf16_t* vB = CV + ((size_t)(l * 8 + b) * 128 + kvh * 64) * 256;
#pragma unroll
        for (int it = 0; it < 4; ++it) { const int idx = tid + it * NTHREADS;
            kb[it] = *(const u32x4*)(kB + (size_t)(idx >> 3) * 128 + (idx & 7) * 8);
            vb[it] = *(const u32x4*)(vB + (size_t)(idx >> 5) * 256 + (idx & 31) * 8); }
    }
    {
        int klo = 0, khi = 256;
        if (pass) { klo = q0w - 128; if (klo < 0) klo = 0; khi = q0w + 160; if (khi > n) khi = n; }
        const int t0 = (klo - kloU) >> 5, t1 = (khi - kloU) >> 5;
        if (pass) attn_tiles<true>(st, qf, lds, lds + AT_OFF_V, AT_VROWB_A, t0, t1, kloU - q0w, r, h);
        else attn_tiles<false>(st, qf, lds, lds + AT_OFF_V, AT_VROWB_A, t0, t1, 0, r, h);
    }
    if (pass) {
        __syncthreads();
#pragma unroll
        for (int it = 0; it < 4; ++it) { const int idx = tid + it * NTHREADS;
            *(LAS u32x4*)(lds + (idx >> 3) * AT_KROWB + (idx & 7) * 16) = kb[it];
            *(LAS u32x4*)(lds + AT_OFF_V + (idx >> 5) * AT_VROWB_B + (idx & 31) * 16) = vb[it]; }
        __syncthreads();
        attn_tiles<false>(st, qf, lds, lds + AT_OFF_V, AT_VROWB_B, 0, 8, 0, r, h);
    }
    const float inv = 1.0f / st.lsum;
    bf16_t* op = YC + (size_t)(rowbase + q0w + r) * 1024 + 512 + head * 64 + 4 * h;
#pragma unroll
    for (int gq = 0; gq < 4; ++gq) {
        u32x2 w0; w0.x = pk_bf16(st.O0[4 * gq] * inv, st.O0[4 * gq + 1] * inv); w0.y = pk_bf16(st.O0[4 * gq + 2] * inv, st.O0[4 * gq + 3] * inv);
        u32x2 w1; w1.x = pk_bf16(st.O1[4 * gq] * inv, st.O1[4 * gq + 1] * inv); w1.y = pk_bf16(st.O1[4 * gq + 2] * inv, st.O1[4 * gq + 3] * inv);
        *(u32x2*)(op + 8 * gq) = w0; *(u32x2*)(op + 32 + 8 * gq) = w1;
    }
    __syncthreads();
}
__device__ void attn_mfma(const Params& p, int l, LAS unsigned char* lds) {
    const int tid = opaque_tid();
    for (int u = blockIdx.x; u < 512; u += gridDim.x) attn_unit(p, l, u, lds, tid);
}

template <int NB  , int NBLK  >
__device__ __forceinline__ void hyena_unit(const Params& p, int l, int c, const bf16_t* __restrict__ HTp, int rowbase, const bf16_t* __restrict__ gb, LAS unsigned char* lds, int tid) {
    constexpr int n = 32 * NBLK, NI = 32 / NB, PAD = 32 * (NI - 1);
    constexpr int LENB = (2 * n * 2 - 64 + 255) / 256 * 256 + 64;
    constexpr int UROWB = ((n + 2 * PAD) * 2 + 255) / 256 * 256 + 16;
    constexpr int GSB = (2 * n + 8) * 2;
    constexpr int OFF_F0 = 0, OFF_F1 = 8 * LENB, OFF_U = 16 * LENB, OFF_U2 = OFF_U + NB * UROWB, OFF_G1 = OFF_U2 + NB * UROWB, OFF_G2 = OFF_G1 + NB * n * 2, OFF_GS = OFF_G2 + NB * n * 2;
    static_assert(OFF_GS + 2 * GSB <= 149 * 1024, "hyena LDS");
    const int lane = tid & 63, wv = tid >> 6, r = lane & 31, h = lane >> 5;
    const float* cw = p.in[14] + l * 3 * 768;
    if (tid < 2 * (2 * n / 8)) { const int o = tid / (2 * n / 8), k = tid % (2 * n / 8);
        *(LAS u32x4*)(lds + OFF_GS + o * GSB + k * 16) = *(const u32x4*)(gb + ((size_t)o * 256 + c) * (2 * n) + k * 8); }
    if (tid < 2) *(LAS u32x4*)(lds + OFF_GS + tid * GSB + 2 * n * 2) = (u32x4){0u, 0u, 0u, 0u};
    constexpr int NQ = 3 * NB * (n / 8) / NTHREADS;
#pragma unroll
    for (int it = 0; it < NQ; ++it) {
        const int q = tid + it * NTHREADS;
        const int w = q / (NB * (n / 8)), rem = q % (NB * (n / 8)), b = rem / (n / 8), t0 = (rem % (n / 8)) * 8;
        const int ch = w * 256 + c; const bf16_t* row = HTp + ((size_t)b * 768 + ch) * n;
        const float w0 = cw[ch], w1 = cw[768 + ch], w2 = cw[1536 + ch];
        const u32x4 raw = *(const u32x4*)(row + t0);
        float x[10];
        x[0] = t0 > 0 ? bf2f(row[t0 - 1]) : 0.f; x[9] = t0 + 8 < n ? bf2f(row[t0 + 8]) : 0.f;
        x[1] = __uint_as_float(raw.x << 16); x[2] = __uint_as_float(raw.x & 0xFFFF0000u); x[3] = __uint_as_float(raw.y << 16); x[4] = __uint_as_float(raw.y & 0xFFFF0000u);
        x[5] = __uint_as_float(raw.z << 16); x[6] = __uint_as_float(raw.z & 0xFFFF0000u); x[7] = __uint_as_float(raw.w << 16); x[8] = __uint_as_float(raw.w & 0xFFFF0000u);
        float z[8];
#pragma unroll
        for (int e = 0; e < 8; ++e) z[e] = x[e] * w0 + x[e + 1] * w1 + x[e + 2] * w2;
        u32x4 o; o.x = pk_bf16(z[0], z[1]); o.y = pk_bf16(z[2], z[3]); o.z = pk_bf16(z[4], z[5]); o.w = pk_bf16(z[6], z[7]);
        LAS unsigned char* dst = w == 0 ? lds + OFF_U + b * UROWB + (PAD + t0) * 2 : lds + (w == 1 ? OFF_G1 : OFF_G2) + (b * n + t0) * 2;
        *(LAS u32x4*)dst = o;
    }
    if (PAD > 0) {
        constexpr int FR = PAD / 8, BK_ = (UROWB / 2 - PAD - n) / 8;
        for (int q = tid; q < 2 * NB * (FR + BK_); q += NTHREADS) {
            const int buf = q / (NB * (FR + BK_)), rem = q % (NB * (FR + BK_)), b = rem / (FR + BK_), k = rem % (FR + BK_);
            const int e0 = k < FR ? k * 8 : PAD + n + (k - FR) * 8;
            *(LAS u32x4*)(lds + (buf ? OFF_U2 : OFF_U) + b * UROWB + e0 * 2) = (u32x4){0u, 0u, 0u, 0u};
        }
    }
    __syncthreads();
    if (tid < 2 * (2 * n / 8)) { const int o = tid / (2 * n / 8), k = tid % (2 * n / 8);
        const u32x4 lo = *(const LAS u32x4*)(lds + OFF_GS + o * GSB + k * 16), hi = *(const LAS u32x4*)(lds + OFF_GS + o * GSB + k * 16 + 16);
        const unsigned d[8] = {lo.x, lo.y, lo.z, lo.w, hi.x, hi.y, hi.z, hi.w};
        LAS unsigned char* fdst = lds + (o ? OFF_F1 : OFF_F0) + k * 16;
#pragma unroll
        for (int s = 0; s < 8; ++s) { u32x4 w;
            if ((s & 1) == 0) { w.x = d[s / 2]; w.y = d[s / 2 + 1]; w.z = d[s / 2 + 2]; w.w = d[s / 2 + 3]; }
            else { w.x = __builtin_amdgcn_alignbyte(d[s / 2 + 1], d[s / 2], 2); w.y = __builtin_amdgcn_alignbyte(d[s / 2 + 2], d[s / 2 + 1], 2);
                   w.z = __builtin_amdgcn_alignbyte(d[s / 2 + 3], d[s / 2 + 2], 2); w.w = __builtin_amdgcn_alignbyte(d[s / 2 + 4], d[s / 2 + 3], 2); }
            *(LAS u32x4*)(fdst + s * LENB) = w; }
    }
    __syncthreads();
    const int bcol = NB == 8 ? (r >> 2) : r, ioff = NB == 8 ? (r & 3) : 0, I0 = wv * NI, Icol = I0 + ioff;
    const int si = (7 - r) & 7;
    const int Dlo = I0 + NI - 1 - (NBLK - 1) - (NI - 1), Dhi = I0 + NI - 1;
    bf16_t* YC = (bf16_t*)(p.ws + OFF_YCAT);
#pragma unroll
    for (int o = 0; o < 2; ++o) {
        const LAS unsigned char* ap = lds + (o ? OFF_F1 : OFF_F0) + si * LENB + (n - 1 - r + 8 * h - si) * 2 - 64 * Dlo;
        const LAS unsigned char* bp = lds + (o ? OFF_U2 : OFF_U) + bcol * UROWB + (PAD + 32 * Icol + 8 * h) * 2 - 64 * Dlo;
        f32x16 acc;
#pragma unroll
        for (int i = 0; i < 16; ++i) acc[i] = 0.f;
#pragma unroll 4
        for (int D = Dlo; D <= Dhi; ++D) {
            const bf16x8 a0 = *(const LAS bf16x8*)ap, a1 = *(const LAS bf16x8*)(ap + 32);
            const bf16x8 b0 = *(const LAS bf16x8*)bp, b1 = *(const LAS bf16x8*)(bp + 32);
            acc = __builtin_amdgcn_mfma_f32_32x32x16_bf16(a0, b0, acc, 0, 0, 0);
            acc = __builtin_amdgcn_mfma_f32_32x32x16_bf16(a1, b1, acc, 0, 0, 0);
            ap -= 64; bp -= 64;
        }
        const float bias = p.in[22][(l * 2 + o) * 256 + c];
#pragma unroll
        for (int g = 0; g < 4; ++g) {
            const int t0 = 32 * Icol + 8 * g + 4 * h;
            const u32x2 uin = *(const LAS u32x2*)(lds + (o ? OFF_U2 : OFF_U) + bcol * UROWB + (PAD + t0) * 2);
            const u32x2 gin = *(const LAS u32x2*)(lds + (o ? OFF_G2 : OFF_G1) + (bcol * n + t0) * 2);
            float y[4];
            y[0] = __uint_as_float(gin.x << 16) * (acc[4 * g] + bias * __uint_as_float(uin.x << 16));
            y[1] = __uint_as_float(gin.x & 0xFFFF0000u) * (acc[4 * g + 1] + bias * __uint_as_float(uin.x & 0xFFFF0000u));
            y[2] = __uint_as_float(gin.y << 16) * (acc[4 * g + 2] + bias * __uint_as_float(uin.y << 16));
            y[3] = __uint_as_float(gin.y & 0xFFFF0000u) * (acc[4 * g + 3] + bias * __uint_as_float(uin.y & 0xFFFF0000u));
            if (o == 0) { u32x2 w; w.x = pk_bf16(y[0], y[1]); w.y = pk_bf16(y[2], y[3]);
                *(LAS u32x2*)(lds + OFF_U2 + bcol * UROWB + (PAD + t0) * 2) = w; }
            else { bf16_t* dst = YC + (size_t)(rowbase + bcol * n + t0) * 1024 + 256 + c;
#pragma unroll
                for (int e = 0; e < 4; ++e) dst[(size_t)e * 1024] = f2bf(y[e]); }
        }
        __syncthreads();
    }
}
__device__ void hyena_mfma(const Params& p, int l, LAS unsigned char* lds) {
    const int tid = opaque_tid();
    const bf16_t* HT = (const bf16_t*)(p.ws + OFF_HT);
    const bf16_t* gl = (const bf16_t*)(p.ws + OFF_FILT) + (size_t)l * G_L;
    for (int u = blockIdx.x; u < 512; u += gridDim.x) {
        if (u < 256) hyena_unit<8, 32>(p, l, u, HT + HT_LAT, NCTX, gl + G_CTX, lds, tid);
        else hyena_unit<32, 8>(p, l, u - 256, HT, 0, gl, lds, tid);
    }
}


struct OneUnit { int pm, pn;
    __device__ __forceinline__ bool next(int i, pg8::Unit& u) const { if (i) return false; u.pm = pm; u.pn = pn; return true; }
    __device__ __forceinline__ void a_ready(const pg8::Unit&) const {}
    __device__ __forceinline__ void done(const pg8::Unit&) const {} };
__device__ void mixer_phase(const Params& p, int l, LAS unsigned char* lds) {
    constexpr int NU = 32 + 256 + 256 + 32 + 256 + 256;
    unsigned char* ws = p.ws;
    unsigned* ctr = (unsigned*)(ws + OFF_BAR) + 64 * l;
    volatile LAS unsigned* slot = (volatile LAS unsigned*)(lds + 149 * 1024 + 8);
    const bf16_t* HT = (const bf16_t*)(ws + OFF_HT);
    const bf16_t* gl = (const bf16_t*)(ws + OFF_FILT) + (size_t)l * G_L;
    int u = blockIdx.x;
    while (u < NU) {
        unsigned ticket = 0;
        if (threadIdx.x == 0) ticket = __hip_atomic_fetch_add(ctr, 1u, __ATOMIC_RELAXED, __HIP_MEMORY_SCOPE_AGENT);
        const int tid = opaque_tid();
        if (u < 32) {
            pg8::Gemm g{(const bf16_t*)(ws + OFF_FL), (const bf16_t*)(ws + OFF_ZT) + ZT_LAT, 1024, 2048, 2048, 2048, 2048};
            OneUnit S{u & 3, u >> 2}; EpiFourier E{(bf16_t*)(ws + OFF_YCAT), NCTX, 1024};
            pg8::gemm_phase(lds, g, S, E);
        } else if (u < 288) attn_unit(p, l, u - 32, lds, tid);
        else if (u < 544) hyena_unit<8, 32>(p, l, u - 288, HT + HT_LAT, NCTX, gl + G_CTX, lds, tid);
        else if (u < 576) {
            pg8::Gemm g{(const bf16_t*)(ws + OFF_FC), (const bf16_t*)(ws + OFF_ZT), 256, 8192, 512, 512, 512};
            OneUnit S{0, u - 544}; EpiFourier E{(bf16_t*)(ws + OFF_YCAT), 0, 256};
            pg8::gemm_phase(lds, g, S, E);
        } else if (u < 832) attn_unit(p, l, 256 + (u - 576), lds, tid);
        else hyena_unit<32, 8>(p, l, u - 832, HT, 0, gl, lds, tid);
        if (threadIdx.x == 0) *slot = ticket + 256u;
        __syncthreads();
        u = (int)*slot;
        __syncthreads();
    }
}

__global__ void __launch_bounds__(NTHREADS, 2) fwd_megakernel(Params p) {
    extern __shared__ __attribute__((aligned(16))) unsigned char shm[];
    cg::grid_group grid = cg::this_grid();
    LAS unsigned char* lds = (LAS unsigned char*)shm;
    float* ldsf = (float*)shm;
    unsigned char* ws = p.ws;
    const int G = gridDim.x, c = blockIdx.x;

    volatile LAS unsigned* xst = (volatile LAS unsigned*)(lds + 149 * 1024);
    if (threadIdx.x < 4) xst[threadIdx.x] = 0u;
    __syncthreads();
    const XcdBarrier xb = xcd_barrier_post((unsigned*)(ws + OFF_BAR), xst);
    for (int _d = 0; _d < DUP_PREP; ++_d) { phase_prep(p, ldsf); __syncthreads(); }
    if (p.ws == nullptr) grid.sync();
    GSYNC();
    phase_row<0>(p, 0, 0, 0, 0);
    GSYNC();
    for (int l = 0; l < 2; ++l) {
        for (int s = 0; s < 3; ++s) {
            if (s != 1) {
                const int fs = s >> 1;
                { pg8::Gemm g{(const bf16_t*)(ws + OFF_H), (const bf16_t*)(ws + OFF_WGU + (l * 2 + fs) * SZ_WGU), NTOK, 5632, 1024, 1024, 1024};
                    pg8::StaticOrder S; S.init(g.M, g.N, G, c); EpiSwiglu E{(bf16_t*)(ws + OFF_ACT)};
                    for (int _d = 0; _d < DUP_GEMM; ++_d) pg8::gemm_phase(lds, g, S, E); }
                GSYNC();
                { pg8::Gemm g{(const bf16_t*)(ws + OFF_ACT), (const bf16_t*)(ws + OFF_WD + (l * 2 + fs) * SZ_WD), NTOK, 1024, DFF, DFF, DFF};
                    pg8::StaticOrder S; S.init(g.M, g.N, G, c); EpiYssq E{(bf16_t*)(ws + OFF_Y), (float*)(ws + OFF_SSQ)};
                    for (int _d = 0; _d < DUP_GEMM; ++_d) pg8::gemm_phase(lds, g, S, E); }
                GSYNC();
            } else {
                { pg8::Gemm g{(const bf16_t*)(ws + OFF_H), (const bf16_t*)(ws + OFF_WIN + l * SZ_WIN), NTOK, 2048, 1024, 1024, 1024};
                    pg8::StaticOrder S; S.init(g.M, g.N, G, c);
                    EpiWin E{(bf16_t*)(ws + OFF_ZT), (bf16_t*)(ws + OFF_HT), (bf16_t*)(ws + OFF_QB), (bf16_t*)(ws + OFF_KB), (bf16_t*)(ws + OFF_VB), (const float*)(ws + OFF_ROPE),
                             p.out + (size_t)NTOK * D, p.out + (size_t)NTOK * D + (size_t)32 * 2 * 256 * 128, l};
                    for (int _d = 0; _d < DUP_GEMM; ++_d) pg8::gemm_phase(lds, g, S, E); }
                GSYNC();
                mixer_phase(p, l, lds);
                GSYNC();
                { pg8::Gemm g{(const bf16_t*)(ws + OFF_YCAT), (const bf16_t*)(ws + OFF_WOUT + l * SZ_WOUT), NTOK, 1024, 1024, 1024, 1024};
                    pg8::StaticOrder S; S.init(g.M, g.N, G, c); EpiYssq E{(bf16_t*)(ws + OFF_Y), (float*)(ws + OFF_SSQ)};
                    for (int _d = 0; _d < DUP_GEMM; ++_d) pg8::gemm_phase(lds, g, S, E); }
                GSYNC();
            }
            if (l == 1 && s == 2) phase_row<2>(p, l, s, 0, 0);
            else { const int ln = s == 2 ? l + 1 : l, sn = s == 2 ? 0 : s + 1; phase_row<1>(p, l, s, ln, sn); }
            if (!(l == 1 && s == 2)) GSYNC();
        }
    }
}

extern "C" void kernel_launch(void* const* d_in, const int* in_sizes, int n_in, void* d_out, int out_size, void* d_ws, size_t ws_size, hipStream_t stream) {
    constexpr int LDS_BYTES = 149 * 1024 + 256;
    static int grid_blocks = 0;
    if (!grid_blocks) {
        if (n_in != 24 || ws_size < WS_END) { fprintf(stderr, "kernel_launch: bad inputs (n_in %d) or workspace too small (%zu < %zu)\n", n_in, ws_size, (size_t)WS_END); grid_blocks = -1; return; }
        int dev = 0, cus = 0, per_cu = 0;
        hipGetDevice(&dev);
        hipDeviceGetAttribute(&cus, hipDeviceAttributeMultiprocessorCount, dev);
        if (hipFuncSetAttribute((const void*)fwd_megakernel, hipFuncAttributeMaxDynamicSharedMemorySize, LDS_BYTES) != hipSuccess) fprintf(stderr, "kernel_launch: hipFuncSetAttribute failed\n");
        hipOccupancyMaxActiveBlocksPerMultiprocessor(&per_cu, (const void*)fwd_megakernel, NTHREADS, LDS_BYTES);
        if (per_cu < 1) { fprintf(stderr, "kernel_launch: occupancy query says %d blocks per CU\n", per_cu); per_cu = 1; }
        (void)hipGetLastError();
        grid_blocks = cus * per_cu;
        if (grid_blocks > 256) grid_blocks = 256;
    }
    if (grid_blocks < 0) return;
    Params p{};
    for (int i = 0; i < 24; ++i) p.in[i] = (const float*)d_in[i];
    p.out = (float*)d_out; p.ws = (unsigned char*)d_ws;
    (void)hipMemsetAsync((unsigned char*)d_ws + OFF_BAR, 0, 16384, stream);
    void* args[] = {&p};
    hipError_t e = hipLaunchCooperativeKernel((const void*)fwd_megakernel, dim3(grid_blocks), dim3(NTHREADS), args, LDS_BYTES, stream);
    if (e != hipSuccess) fprintf(stderr, "cooperative launch failed: %s (grid %d)\n", hipGetErrorString(e), grid_blocks);
}
```

```cpp
#include <hip/hip_runtime.h>
#include <hip/hip_cooperative_groups.h>
#include <cstdio>
namespace cg = cooperative_groups;

#define LAS __attribute__((address_space(3)))
#ifndef DUP_PA
#define DUP_PA 1
#endif
#ifndef DUP_PB
#define DUP_PB 1
#endif
#ifndef DUP_PC
#define DUP_PC 1
#endif
#ifndef DUP_PD
#define DUP_PD 1
#endif
#ifndef DUP_HY
#define DUP_HY 1
#endif
#ifndef DUP_AT
#define DUP_AT 1
#endif
#ifndef DUP_GEMM
#define DUP_GEMM 1
#endif
#ifndef DUP_MIX
#define DUP_MIX 1
#endif
#ifndef DUP_PREP
#define DUP_PREP 1
#endif
#ifndef DUP_SYNC
#define DUP_SYNC 1
#endif
#define GSYNC() do { for (int _s = 0; _s < DUP_SYNC; ++_s) xcd_barrier(xb); } while (0)
typedef unsigned short bf16_t;
typedef short bf16x8 __attribute__((ext_vector_type(8)));
typedef float f32x4 __attribute__((ext_vector_type(4)));
typedef unsigned u32x4 __attribute__((ext_vector_type(4)));
typedef unsigned u32x2 __attribute__((ext_vector_type(2)));

constexpr int D = 1024, NTOK = 16384, NCTX = 8192, DFF = 2816, INW = 1792;
constexpr int NTHREADS = 512;
constexpr float EPS = 1e-6f;
constexpr float PI2 = 6.283185307179586f;

constexpr size_t AL(size_t x) { return (x + 255) & ~(size_t)255; }
constexpr size_t SZ_WGU = (size_t)5632 * 1024 * 2, SZ_WD = (size_t)1024 * 2816 * 2, SZ_WIN = (size_t)2048 * 1024 * 2, SZ_WOUT = (size_t)1024 * 1024 * 2;
constexpr size_t OFF_WGU = 0;
constexpr size_t OFF_WD = OFF_WGU + 4 * SZ_WGU;
constexpr size_t OFF_WIN = OFF_WD + 4 * SZ_WD;
constexpr size_t OFF_WOUT = OFF_WIN + 2 * SZ_WIN;
constexpr size_t OFF_H = OFF_WOUT + 2 * SZ_WOUT;
constexpr size_t OFF_Y = OFF_H + (size_t)NTOK * D * 2;
constexpr size_t OFF_SSQ = OFF_Y + (size_t)NTOK * D * 2;
constexpr size_t OFF_MOD = OFF_SSQ + (size_t)NTOK * 16 * 4;
constexpr size_t OFF_FILT = AL(OFF_MOD + (size_t)2 * 9 * 9216 * 4);
constexpr size_t FILT_CTX = (size_t)4 * 256 * 256, FILT_LAT = (size_t)4 * 256 * 1024, FILT_L = FILT_CTX + FILT_LAT;
constexpr size_t G_CTX = (size_t)2 * 256 * 512, G_LAT = (size_t)2 * 256 * 2048, G_L = G_CTX + G_LAT;
constexpr size_t OFF_FC = AL(OFF_FILT + 2 * FILT_L * 4);
constexpr size_t OFF_FL = OFF_FC + (size_t)256 * 512 * 2;
constexpr size_t OFF_ROPE = OFF_FL + (size_t)1024 * 2048 * 2;
constexpr size_t OFF_BAR = AL(OFF_ROPE + 64 * 16 * 8);
constexpr size_t OFF_CKB = OFF_BAR + 16384;
constexpr size_t OFF_CVT = OFF_CKB + (size_t)2 * 8 * 256 * 128 * 2;
constexpr size_t OFF_UNION = AL(OFF_CVT + (size_t)2 * 8 * 256 * 128 * 2);
constexpr size_t OFF_ACT = OFF_UNION;
constexpr size_t OFF_ZT = OFF_UNION;
constexpr size_t ZT_LAT = (size_t)NCTX * 512;
constexpr size_t OFF_HT = OFF_ZT + (size_t)NTOK * 512 * 2;
constexpr size_t HT_LAT = (size_t)NCTX * 768;
constexpr size_t OFF_QB = OFF_HT + (size_t)NTOK * 768 * 2;
constexpr size_t OFF_KB = OFF_QB + (size_t)NTOK * 512 * 2;
constexpr size_t OFF_VB = OFF_KB + (size_t)NTOK * 128 * 2;
constexpr size_t VT_LAT = (size_t)NCTX * 128;
constexpr size_t OFF_YCAT = OFF_VB + (size_t)NTOK * 128 * 2;
constexpr size_t UNION_END = OFF_YCAT + (size_t)NTOK * 1024 * 2;
constexpr size_t ACT_END = OFF_ACT + (size_t)NTOK * DFF * 2;
constexpr size_t WS_END = (UNION_END > ACT_END ? UNION_END : ACT_END);

struct Params {
    const float* in[24];
    float* out;
    unsigned char* ws;
};

__device__ __forceinline__ unsigned short f2bf(float f) { unsigned u = __float_as_uint(f); u += 0x7FFFu + ((u >> 16) & 1u); return (unsigned short)(u >> 16); }
__device__ __forceinline__ float bf2f(unsigned short b) { return __uint_as_float(((unsigned)b) << 16); }
__device__ __forceinline__ unsigned cvt_pk_bf16(float lo, float hi) { unsigned r; asm volatile("v_cvt_pk_bf16_f32 %0, %1, %2" : "=v"(r) : "v"(lo), "v"(hi)); return r; }
typedef __bf16 bf16x2_t __attribute__((ext_vector_type(2)));
typedef float f32x2_t __attribute__((ext_vector_type(2)));
typedef float f32x16 __attribute__((ext_vector_type(16)));
__device__ __forceinline__ unsigned pk_bf16(float lo, float hi) { f32x2_t v = {lo, hi}; return __builtin_bit_cast(unsigned, __builtin_convertvector(v, bf16x2_t)); }
__device__ __forceinline__ float silu_f(float x) { return x * __builtin_amdgcn_rcpf(1.0f + __expf(-x)); }
__device__ __forceinline__ int perm32(int rho) { const int n = rho >> 4, i = rho & 15; return 8 * (i >> 2) + 4 * n + (i & 3); }

__device__ __forceinline__ int opaque_tid() { int t = threadIdx.x; asm volatile("" : "+v"(t)); return t; }


#define XB_TMO      128
#define XB_XCNT(j)  (256  + 64 * (j))
#define XB_XSUB(j)  (1280 + 64 * (j))
#define XB_XGEN(j)  (2304 + 64 * (j))
#define XB_TOP      3328
#define XB_TOPGEN   3392
#define XCD_BAR_WORDS 3456
#define XB_SPIN_CAP (1u << 22)
__device__ __forceinline__ unsigned xb_ld(unsigned* p)              { return __hip_atomic_load(p, __ATOMIC_RELAXED, __HIP_MEMORY_SCOPE_AGENT); }
__device__ __forceinline__ unsigned xb_add(unsigned* p, unsigned v) { return __hip_atomic_fetch_add(p, v, __ATOMIC_RELAXED, __HIP_MEMORY_SCOPE_AGENT); }
__device__ __forceinline__ unsigned xb_xcc_id() { return (unsigned)__builtin_amdgcn_s_getreg((3 << 11) | 20) & 0xFu; }
#define XB_SPIN(cond, bar) do { unsigned _sp = 0; while (cond) { __builtin_amdgcn_s_sleep(1); \
    if ((++_sp & 255u) == 0u) { if (xb_ld(&(bar)[XB_TMO])) break; if (_sp > XB_SPIN_CAP) { atomicAdd(&(bar)[XB_TMO], 1u); break; } } } } while (0)
struct XcdBarrier { unsigned* bar; unsigned x; volatile LAS unsigned* st; };
__device__ __forceinline__ XcdBarrier xcd_barrier_post(unsigned* bar, volatile LAS unsigned* st) {
    XcdBarrier b; b.bar = bar; b.x = xb_xcc_id(); b.st = st;
    if (threadIdx.x == 0) (void)xb_add(&bar[XB_XCNT(b.x)], 1u);
    return b;
}
__device__ __forceinline__ void xcd_barrier_complete(unsigned* bar, unsigned x, unsigned& nloc, unsigned& nx) {
    const unsigned G = gridDim.x * gridDim.y * gridDim.z;
    unsigned sum, cnt, mine, sp = 0u;
    for (;;) {
        sum = 0u; cnt = 0u; mine = 0u;
#pragma unroll
        for (unsigned j = 0; j < 16; ++j) { const unsigned c = xb_ld(&bar[XB_XCNT(j)]); sum += c; cnt += (c > 0u) ? 1u : 0u; mine = (j == x) ? c : mine; }
        if (sum == G) break;
        __builtin_amdgcn_s_sleep(1);
        if ((++sp & 255u) == 0u) { if (xb_ld(&bar[XB_TMO])) break; if (sp > XB_SPIN_CAP) { atomicAdd(&bar[XB_TMO], 1u); break; } }
    }
    nloc = mine > 0u ? mine : 1u; nx = cnt > 0u ? cnt : 1u;
}
__device__ __forceinline__ void xcd_barrier(const XcdBarrier& b) {
    asm volatile("s_waitcnt vmcnt(0)" ::: "memory");
    __syncthreads();
    if (threadIdx.x == 0) {
        unsigned* bar = b.bar;
        __builtin_amdgcn_s_waitcnt(0);
        unsigned nloc = b.st[0], nx = b.st[1];
        if (nloc == 0u) { xcd_barrier_complete(bar, b.x, nloc, nx); b.st[0] = nloc; b.st[1] = nx; }
        const unsigned old = xb_add(&bar[XB_XSUB(b.x)], 1u);
        const unsigned gen = old / nloc;
        if (old + 1u == (gen + 1u) * nloc) {
            __builtin_amdgcn_fence(__ATOMIC_RELEASE, "agent");
            asm volatile("s_waitcnt vmcnt(0)" ::: "memory");
            const unsigned og = xb_add(&bar[XB_TOP], 1u);
            const unsigned tg = og / nx;
            if (og + 1u == (tg + 1u) * nx) xb_add(&bar[XB_TOPGEN], 1u);
            else XB_SPIN(xb_ld(&bar[XB_TOPGEN]) == tg, bar);
            __builtin_amdgcn_fence(__ATOMIC_ACQUIRE, "agent");
            xb_add(&bar[XB_XGEN(b.x)], 1u);
            asm volatile("s_waitcnt vmcnt(0)" ::: "memory");
        } else {
            XB_SPIN(xb_ld(&bar[XB_XGEN(b.x)]) == gen, bar);
            __builtin_amdgcn_fence(__ATOMIC_ACQUIRE, "agent");
            asm volatile("s_waitcnt vmcnt(0)" ::: "memory");
        }
    }
    __syncthreads();
}

namespace pg8 {
constexpr int BM = 256, BK = 64, HALF = 128, HTB = HALF * BK * 2, STAGE_BYTES = 8 * HTB, NXCD = 8, WGM = 8;
__device__ __forceinline__ int lds_byte(int r, int c) { const int st = (r >> 4) * 2 + (c >> 5), rr = r & 15, cc = c & 31, ob = rr * 64 + cc * 2; return st * 1024 + (ob ^ (((ob >> 9) & 1) << 5)); }
__device__ __forceinline__ void stage_rc(int b, int& R, int& C) { const int st = b / 1024, sb = b % 1024, swz = sb ^ (((sb >> 9) & 1) << 5); R = (st >> 1) * 16 + swz / 64; C = (st & 1) * 32 + (swz % 64) / 2; }
struct Unit { int pm, pn; };
struct Gemm { const bf16_t* A; const bf16_t* Bt; int M, N, K, lda, ldb; };
struct StaticOrder {
    int nM, nN, nwg, G, c;
    __device__ void init(int M, int N, int G_, int c_) { nM = M / BM; nN = N / BM; nwg = nM * nN; G = G_; c = c_; }
    __device__ bool next(int i, Unit& u) const {
        if (c < 0) return false;
        const long L = (long)i * G + c; if (L >= nwg) return false;
        int wgid = (int)L; { const int q = nwg / NXCD, r = nwg % NXCD, xcd = wgid % NXCD, off = wgid / NXCD; wgid = (xcd < r ? xcd * (q + 1) : r * (q + 1) + (xcd - r) * q) + off; }
        const int nig = WGM * nN, gid = wgid / nig, fm = gid * WGM, gsz = (nM - fm) < WGM ? (nM - fm) : WGM;
        u.pm = fm + ((wgid % nig) % gsz); u.pn = (wgid % nig) / gsz; return true;
    }
    __device__ __forceinline__ void a_ready(const Unit&) const {}
    __device__ __forceinline__ void done(const Unit&) const {}
};

template <class Epi, class Sched>
__device__ __forceinline__ void gemm_phase(LAS unsigned char* lds, Gemm g, const Sched& S, const Epi& E) {
    asm volatile("" : "+s"(g.A), "+s"(g.Bt), "+s"(g.K), "+s"(g.lda), "+s"(g.ldb));
    int tid = threadIdx.x; asm volatile("" : "+v"(tid));
    const int wid = __builtin_amdgcn_readfirstlane(tid >> 6), lane = tid & 63, wr = wid >> 2, wc = wid & 3, fr = lane & 15, fq = lane >> 4;
    const int K = g.K, nt = K / BK;
    unsigned voffA[2], voffB[2];
#pragma unroll
    for (int i = 0; i < 2; ++i) { int R, C; stage_rc(tid * 16 + i * 8192, R, C);
        voffA[i] = (unsigned)(R * g.lda + C) * 2u; voffB[i] = (unsigned)(R * g.ldb + C) * 2u; }
    const size_t kstep = (size_t)(BK * 2);
    const size_t hstepA = (size_t)HALF * g.lda * 2, hstepB = (size_t)HALF * g.ldb * 2;
    const size_t tstepA = 2 * hstepA, tstepB = 2 * hstepB;
    const unsigned ldsw = (unsigned)wid * 1024u;
    const int aoff = lds_byte(wr * 64 + fr, fq * 8), boff = lds_byte(wc * 32 + fr, fq * 8);
#define PG8_SA(b, h) (((b) * 2 + (h)) * HTB)
#define PG8_SB(b, h) ((4 + (b) * 2 + (h)) * HTB)
#define PG8_STAGE(bufoff, gbase, voff) do { _Pragma("unroll") for (int _i = 0; _i < 2; ++_i) \
        __builtin_amdgcn_global_load_lds((const unsigned*)((const char*)(gbase) + (voff)[_i]), (LAS unsigned*)(lds + (bufoff) + ldsw + _i * 8192), 16, 0, 0); } while (0)
#define PG8_LDA(dst, b, h) do { _Pragma("unroll") for (int m = 0; m < 4; ++m) _Pragma("unroll") for (int k = 0; k < 2; ++k) dst[m][k] = *(const LAS bf16x8*)(lds + PG8_SA(b, h) + aoff + m * 2048 + k * 1024); } while (0)
#define PG8_LDB(dst, b, h) do { _Pragma("unroll") for (int n = 0; n < 2; ++n) _Pragma("unroll") for (int k = 0; k < 2; ++k) dst[n][k] = *(const LAS bf16x8*)(lds + PG8_SB(b, h) + boff + n * 2048 + k * 1024); } while (0)
#define PG8_MMA(ai, bj, At, Bt) do { __builtin_amdgcn_s_setprio(1); _Pragma("unroll") for (int m = 0; m < 4; ++m) _Pragma("unroll") for (int n = 0; n < 2; ++n) _Pragma("unroll") for (int k = 0; k < 2; ++k) \
        acc[ai][bj][m][n] = __builtin_amdgcn_mfma_f32_16x16x32_bf16(Bt[n][k], At[m][k], acc[ai][bj][m][n], 0, 0, 0); __builtin_amdgcn_s_setprio(0); } while (0)
#define PG8_WAIT_V(n) asm volatile("s_waitcnt vmcnt(" #n ")" ::: "memory")
#define PG8_WAIT_L(n) asm volatile("s_waitcnt lgkmcnt(" #n ")" ::: "memory")
#define PG8_BAR __builtin_amdgcn_s_barrier()
#define PG8_SCHED __builtin_amdgcn_sched_barrier(0)
    Unit cur, nxt; int ui = 0;
    if (!S.next(0, cur)) return;
    f32x4 acc[2][2][4][2];
#pragma unroll
    for (int a = 0; a < 2; ++a)
#pragma unroll
        for (int b = 0; b < 2; ++b)
#pragma unroll
            for (int m = 0; m < 4; ++m)
#pragma unroll
                for (int n = 0; n < 2; ++n) acc[a][b][m][n] = (f32x4){0.f, 0.f, 0.f, 0.f};
    bf16x8 At[4][2], B0[2][2], B1[2][2];
    const char* cA = (const char*)g.A + (size_t)cur.pm * tstepA; const char* cB = (const char*)g.Bt + (size_t)cur.pn * tstepB;
    S.a_ready(cur);
    PG8_STAGE(PG8_SB(0, 0), cB, voffB); PG8_STAGE(PG8_SA(0, 0), cA, voffA); PG8_STAGE(PG8_SB(0, 1), cB + hstepB, voffB); PG8_STAGE(PG8_SA(0, 1), cA + hstepA, voffA);
    if (wr == 1) PG8_BAR;
    PG8_WAIT_V(4); PG8_BAR;
    PG8_STAGE(PG8_SB(1, 0), cB + kstep, voffB); PG8_STAGE(PG8_SA(1, 0), cA + kstep, voffA); PG8_STAGE(PG8_SB(1, 1), cB + hstepB + kstep, voffB);
    PG8_WAIT_V(6); PG8_BAR;
    for (;;) {
        const bool has_next = S.next(ui + 1, nxt);
        const char* nA = has_next ? (const char*)g.A + (size_t)nxt.pm * tstepA : cA; const char* nB = has_next ? (const char*)g.Bt + (size_t)nxt.pn * tstepB : cB;
        for (int t = 0; t < nt; t += 2) {
            const bool last = (t == nt - 2);
            const char* a1 = cA + (size_t)(t + 1) * kstep;
            const char* a2 = last ? nA : cA + (size_t)(t + 2) * kstep; const char* b2 = last ? nB : cB + (size_t)(t + 2) * kstep;
            const char* a3 = a2 + kstep; const char* b3 = b2 + kstep;
            if (last && has_next) S.a_ready(nxt);
            PG8_LDB(B0, 0, 0); PG8_SCHED; PG8_LDA(At, 0, 0); PG8_STAGE(PG8_SA(1, 1), a1 + hstepA, voffA);
            PG8_WAIT_L(8); PG8_BAR; PG8_WAIT_L(0); PG8_MMA(0, 0, At, B0); PG8_BAR; PG8_SCHED;
            PG8_LDB(B1, 0, 1); PG8_STAGE(PG8_SB(0, 0), b2, voffB);
            PG8_BAR; PG8_WAIT_L(0); PG8_MMA(0, 1, At, B1); PG8_BAR;
            PG8_LDA(At, 0, 1); PG8_STAGE(PG8_SA(0, 0), a2, voffA);
            PG8_BAR; PG8_WAIT_L(0); PG8_MMA(1, 0, At, B0); PG8_BAR; PG8_SCHED;
            PG8_STAGE(PG8_SB(0, 1), b2 + hstepB, voffB);
            PG8_WAIT_V(6); PG8_BAR; PG8_MMA(1, 1, At, B1); PG8_BAR;
            PG8_LDB(B0, 1, 0); PG8_SCHED; PG8_LDA(At, 1, 0); PG8_STAGE(PG8_SA(0, 1), a2 + hstepA, voffA);
            PG8_WAIT_L(8); PG8_BAR; PG8_WAIT_L(0); PG8_MMA(0, 0, At, B0); PG8_BAR; PG8_SCHED;
            PG8_LDB(B1, 1, 1); PG8_STAGE(PG8_SB(1, 0), b3, voffB);
            PG8_BAR; PG8_WAIT_L(0); PG8_MMA(0, 1, At, B1); PG8_BAR;
            PG8_LDA(At, 1, 1); PG8_STAGE(PG8_SA(1, 0), a3, voffA);
            PG8_BAR; PG8_WAIT_L(0); PG8_MMA(1, 0, At, B0); PG8_BAR; PG8_SCHED;
            PG8_STAGE(PG8_SB(1, 1), b3 + hstepB, voffB);
            PG8_WAIT_V(6); PG8_BAR; PG8_MMA(1, 1, At, B1); PG8_BAR;
        }
        { int fr2 = fr, fq2 = fq, wr2 = wr, wc2 = wc; asm volatile("" : "+v"(fr2), "+v"(fq2), "+s"(wr2), "+s"(wc2));
            E(acc, cur, wr2, wc2, fr2, fq2); } S.done(cur);
        if (!has_next) break;
#pragma unroll
        for (int a = 0; a < 2; ++a)
#pragma unroll
            for (int b = 0; b < 2; ++b)
#pragma unroll
                for (int m = 0; m < 4; ++m)
#pragma unroll
                    for (int n = 0; n < 2; ++n) acc[a][b][m][n] = (f32x4){0.f, 0.f, 0.f, 0.f};
        cur = nxt; cA = nA; cB = nB; ++ui;
    }
    PG8_WAIT_V(0);
    if (wr == 0) PG8_BAR;
    PG8_BAR;
#undef PG8_SA
#undef PG8_SB
#undef PG8_STAGE
#undef PG8_LDA
#undef PG8_LDB
#undef PG8_MMA
#undef PG8_WAIT_V
#undef PG8_WAIT_L
#undef PG8_BAR
#undef PG8_SCHED
}
}

struct EpiSwiglu {
    bf16_t* O;
    __device__ __forceinline__ void operator()(const f32x4 (&acc)[2][2][4][2], const pg8::Unit& u, int wr, int wc, int fr, int fq) const {
        const int row0 = u.pm * 256 + wr * 64 + fr, col0 = u.pn * 128 + wc * 32 + 8 * fq;
#pragma unroll
        for (int ai = 0; ai < 2; ++ai)
#pragma unroll
            for (int m = 0; m < 4; ++m) {
                bf16_t* rowp = O + (size_t)(row0 + ai * 128 + m * 16) * DFF + col0;
                const f32x4 g0 = acc[ai][0][m][0], g1 = acc[ai][0][m][1], u0 = acc[ai][1][m][0], u1 = acc[ai][1][m][1];
                u32x4 w;
                w.x = cvt_pk_bf16(silu_f(g0[0]) * u0[0], silu_f(g0[1]) * u0[1]); w.y = cvt_pk_bf16(silu_f(g0[2]) * u0[2], silu_f(g0[3]) * u0[3]);
                w.z = cvt_pk_bf16(silu_f(g1[0]) * u1[0], silu_f(g1[1]) * u1[1]); w.w = cvt_pk_bf16(silu_f(g1[2]) * u1[2], silu_f(g1[3]) * u1[3]);
                *(u32x4*)rowp = w;
            }
    }
};
struct EpiYssq {
    bf16_t* Y; float* ssq;
    __device__ __forceinline__ void operator()(const f32x4 (&acc)[2][2][4][2], const pg8::Unit& u, int wr, int wc, int fr, int fq) const {
        const int row0 = u.pm * 256 + wr * 64 + fr, col0 = u.pn * 256 + wc * 32 + 8 * fq;
#pragma unroll
        for (int ai = 0; ai < 2; ++ai)
#pragma unroll
            for (int m = 0; m < 4; ++m) {
                const int row = row0 + ai * 128 + m * 16;
                bf16_t* rowp = Y + (size_t)row * D + col0;
                float s = 0.f;
#pragma unroll
                for (int bj = 0; bj < 2; ++bj) {
                    const f32x4 v0 = acc[ai][bj][m][0], v1 = acc[ai][bj][m][1];
                    s += v0[0] * v0[0] + v0[1] * v0[1] + v0[2] * v0[2] + v0[3] * v0[3] + v1[0] * v1[0] + v1[1] * v1[1] + v1[2] * v1[2] + v1[3] * v1[3];
                    u32x4 w; w.x = cvt_pk_bf16(v0[0], v0[1]); w.y = cvt_pk_bf16(v0[2], v0[3]); w.z = cvt_pk_bf16(v1[0], v1[1]); w.w = cvt_pk_bf16(v1[2], v1[3]);
                    *(u32x4*)(rowp + bj * 128) = w;
                }
                s += __shfl_xor(s, 16); s += __shfl_xor(s, 32);
                if (fq == 0) ssq[(size_t)row * 16 + u.pn * 4 + wc] = s;
            }
    }
};
struct EpiWin {
    bf16_t* ZT; bf16_t* HT; bf16_t* QB; bf16_t* KB; bf16_t* VB; const float* rope; float* newk; float* newv; int layer;
    __device__ __forceinline__ void operator()(const f32x4 (&acc)[2][2][4][2], const pg8::Unit& u, int wr, int wc, int fr, int fq) const {
        const int r0 = u.pm * 256 + wr * 64 + fr;
        const bool lat = u.pm >= 32;
        const int pn = u.pn;
        if (pn < 5) {
            bf16_t* base; int t0; size_t sch;
            if (pn < 2) {
                if (!lat) { const int b = u.pm; base = ZT + ((size_t)b * 256 * 2 + pn) * 256; sch = 512; t0 = r0 - u.pm * 256; }
                else { const int b = (u.pm - 32) >> 2; base = ZT + ZT_LAT + ((size_t)b * 256 * 2 + pn) * 1024; sch = 2048; t0 = r0 - NCTX - b * 1024; }
            } else {
                const int c0 = (pn - 2) * 256;
                if (!lat) { const int b = u.pm; base = HT + ((size_t)b * 768 + c0) * 256; sch = 256; t0 = r0 - u.pm * 256; }
                else { const int b = (u.pm - 32) >> 2; base = HT + HT_LAT + ((size_t)b * 768 + c0) * 1024; sch = 1024; t0 = r0 - NCTX - b * 1024; }
            }
#pragma unroll
            for (int ai = 0; ai < 2; ++ai)
#pragma unroll
                for (int m = 0; m < 4; ++m) {
                    const int t = t0 + ai * 128 + m * 16;
#pragma unroll
                    for (int bj = 0; bj < 2; ++bj)
#pragma unroll
                        for (int n = 0; n < 2; ++n) {
                            const int ch = bj * 128 + wc * 32 + n * 16 + 4 * fq;
                            const f32x4 v = acc[ai][bj][m][n];
#pragma unroll
                            for (int e = 0; e < 4; ++e) base[(size_t)(ch + e) * sch + t] = f2bf(v[e]);
                        }
                }
        } else {
            const int blk = wc & 1;
#pragma unroll
            for (int ai = 0; ai < 2; ++ai)
#pragma unroll
                for (int m = 0; m < 4; ++m) {
                    const int row = r0 + ai * 128 + m * 16;
                    f32x4 cs0 = {1.f, 0.f, 1.f, 0.f}, cs1 = {1.f, 0.f, 1.f, 0.f};
                    if (lat) { const int t = row & 1023; const int pos = blk ? (t & 63) : (t >> 6);
                        const f32x4* rp = (const f32x4*)(rope + (size_t)(pos * 16 + 4 * fq) * 2); cs0 = rp[0]; cs1 = rp[1]; }
#pragma unroll
                    for (int bj = 0; bj < 2; ++bj) {
                        f32x4 x1 = acc[ai][bj][m][0], x2 = acc[ai][bj][m][1];
                        const bool isv = (pn == 7 && bj == 1);
                        const bool isk = (pn == 7 && bj == 0);
                        const int cc = bj * 128 + wc * 32 + 4 * fq;
                        if ((isk || isv) && !lat) {
                            const int b = row >> 8, t = row & 255;
                            float* dst = (isk ? newk : newv) + (((size_t)b * 2 + layer) * 256 + t) * 128 + (cc & 127);
                            *(f32x4*)dst = x1; *(f32x4*)(dst + 16) = x2;
                        }
                        if (!isv) {
                            f32x4 o1, o2;
                            o1[0] = x1[0] * cs0[0] - x2[0] * cs0[1]; o2[0] = x2[0] * cs0[0] + x1[0] * cs0[1];
                            o1[1] = x1[1] * cs0[2] - x2[1] * cs0[3]; o2[1] = x2[1] * cs0[2] + x1[1] * cs0[3];
                            o1[2] = x1[2] * cs1[0] - x2[2] * cs1[1]; o2[2] = x2[2] * cs1[0] + x1[2] * cs1[1];
                            o1[3] = x1[3] * cs1[2] - x2[3] * cs1[3]; o2[3] = x2[3] * cs1[2] + x1[3] * cs1[3];
                            x1 = o1; x2 = o2;
                        }
                        bf16_t* dst;
                        if (pn < 7) { x1 *= 0.125f; x2 *= 0.125f; dst = QB + (size_t)row * 512 + (pn - 5) * 256 + cc; }
                        else if (isk) dst = KB + (size_t)row * 128 + cc;
                        else {
                            bf16_t* vb; size_t n_;
                            if (!lat) { vb = VB + (size_t)(row >> 8) * 128 * 256 + (row & 255); n_ = 256; } else { vb = VB + VT_LAT + (size_t)((row - NCTX) >> 10) * 128 * 1024 + (row & 1023); n_ = 1024; }
                            const int c0 = cc - 128;
#pragma unroll
                            for (int e = 0; e < 4; ++e) { vb[(size_t)(c0 + e) * n_] = f2bf(x1[e]); vb[(size_t)(c0 + 16 + e) * n_] = f2bf(x2[e]); }
                            continue;
                        }
                        u32x2 w1, w2; w1.x = cvt_pk_bf16(x1[0], x1[1]); w1.y = cvt_pk_bf16(x1[2], x1[3]); w2.x = cvt_pk_bf16(x2[0], x2[1]); w2.y = cvt_pk_bf16(x2[2], x2[3]);
                        *(u32x2*)dst = w1; *(u32x2*)(dst + 16) = w2;
                    }
                }
        }
    }
};
struct EpiFourier {
    bf16_t* YC; int rowbase, n;
    __device__ __forceinline__ void operator()(const f32x4 (&acc)[2][2][4][2], const pg8::Unit& u, int wr, int wc, int fr, int fq) const {
        const int kp0 = u.pm * 256 + wr * 64 + fr; const int b = u.pn;
#pragma unroll
        for (int ai = 0; ai < 2; ++ai)
#pragma unroll
            for (int m = 0; m < 4; ++m) {
                bf16_t* rowp = YC + (size_t)(rowbase + b * n + kp0 + ai * 128 + m * 16) * 1024 + wc * 32 + 4 * fq;
#pragma unroll
                for (int bj = 0; bj < 2; ++bj)
#pragma unroll
                    for (int nn = 0; nn < 2; ++nn) { const f32x4 v = acc[ai][bj][m][nn]; u32x2 w; w.x = cvt_pk_bf16(v[0], v[1]); w.y = cvt_pk_bf16(v[2], v[3]);
                        *(u32x2*)(rowp + bj * 128 + nn * 16) = w; }
            }
    }
};

struct TrUnit { const float* src; bf16_t* dst; int ld, k0, cbase, Kd, r0, perm; };
__device__ __forceinline__ TrUnit tr_unit_g(const Params& p, int kind, int idx, int w) {
    TrUnit t; unsigned char* ws = p.ws;
    if (kind == 0) { const int rg = w / 16, kb = w % 16; const int pn = rg >> 1, half = rg & 1;
        t.src = (half ? p.in[10] : p.in[9]) + (size_t)idx * 1024 * DFF; t.ld = DFF; t.k0 = kb * 64; t.cbase = pn * 128; t.dst = (bf16_t*)(ws + OFF_WGU + idx * SZ_WGU); t.Kd = 1024; t.r0 = rg * 128; t.perm = 1; }
    else if (kind == 1) { const int rg = w / 44, kb = w % 44;
        t.src = p.in[11] + (size_t)idx * DFF * 1024; t.ld = 1024; t.k0 = kb * 64; t.cbase = rg * 128; t.dst = (bf16_t*)(ws + OFF_WD + idx * SZ_WD); t.Kd = DFF; t.r0 = rg * 128; t.perm = 1; }
    else if (kind == 2) { const int rg = w / 16, kb = w % 16;
        t.src = p.in[13] + (size_t)idx * 1024 * 1024; t.ld = 1024; t.k0 = kb * 64; t.cbase = rg * 128; t.dst = (bf16_t*)(ws + OFF_WOUT + idx * SZ_WOUT); t.Kd = 1024; t.r0 = rg * 128; t.perm = 1; }
    else { const int rg = w / 16, kb = w % 16;
        t.src = p.in[12] + (size_t)idx * 1024 * INW; t.ld = INW; t.k0 = kb * 64; t.cbase = 256 + rg * 128; t.dst = (bf16_t*)(ws + OFF_WIN + idx * SZ_WIN); t.Kd = 1024; t.r0 = 512 + rg * 128; t.perm = 0; }
    return t;
}
__device__ __forceinline__ int tr_slot_count(int slot) { return slot == 0 ? 704 : slot == 1 ? 1376 : slot == 2 ? 1248 : slot == 3 ? 1184 : 352; }
__device__ __forceinline__ TrUnit tr_unit(const Params& p, int slot, int v) {
    if (slot == 0) return tr_unit_g(p, 0, 0, v);
    if (slot == 1) { if (v < 352) return tr_unit_g(p, 1, 0, v); v -= 352; if (v < 192) return tr_unit_g(p, 3, 0, v); v -= 192; if (v < 128) return tr_unit_g(p, 2, 0, v); return tr_unit_g(p, 0, 1, v - 128); }
    if (slot == 2) { if (v < 352) return tr_unit_g(p, 1, 1, v); v -= 352; if (v < 704) return tr_unit_g(p, 0, 2, v); return tr_unit_g(p, 3, 1, v - 704); }
    if (slot == 3) { if (v < 352) return tr_unit_g(p, 1, 2, v); v -= 352; if (v < 128) return tr_unit_g(p, 2, 1, v); return tr_unit_g(p, 0, 3, v - 128); }
    return tr_unit_g(p, 1, 3, v);
}
__device__ __forceinline__ void tr_load(const TrUnit& t, int tid, f32x4 (&v)[4]) {
#pragma unroll
    for (int i = 0; i < 4; ++i) { const int idx = tid + 512 * i, kk = idx >> 5, c4 = idx & 31;
        v[i] = *(const f32x4*)(t.src + (size_t)(t.k0 + kk) * t.ld + t.cbase + c4 * 4); }
}
__device__ __forceinline__ void tr_slot(const Params& p, float* lds, int slot, int blk, int nblk, int tid) {
    const int NU = tr_slot_count(slot);
    constexpr int TS = 132;
    f32x4 v[4];
    int u = blk;
    TrUnit cur; if (u < NU) { cur = tr_unit(p, slot, u); tr_load(cur, tid, v); }
    while (u < NU) {
#pragma unroll
        for (int i = 0; i < 4; ++i) { const int idx = tid + 512 * i, kk = idx >> 5, c4 = idx & 31; *(f32x4*)(lds + kk * TS + c4 * 4) = v[i]; }
        __syncthreads();
        const int un = u + nblk; TrUnit nxt = cur;
        if (un < NU) { nxt = tr_unit(p, slot, un); tr_load(nxt, tid, v); }
        { const int rr = tid >> 2, kc = tid & 3; const int cc = cur.perm ? ((rr & ~31) + perm32(rr & 31)) : rr;
            float x[16];
#pragma unroll
            for (int j = 0; j < 16; ++j) x[j] = lds[(kc * 16 + j) * TS + cc];
            u32x4 w0, w1; w0.x = pk_bf16(x[0], x[1]); w0.y = pk_bf16(x[2], x[3]); w0.z = pk_bf16(x[4], x[5]); w0.w = pk_bf16(x[6], x[7]);
            w1.x = pk_bf16(x[8], x[9]); w1.y = pk_bf16(x[10], x[11]); w1.z = pk_bf16(x[12], x[13]); w1.w = pk_bf16(x[14], x[15]);
            bf16_t* d = cur.dst + (size_t)(cur.r0 + rr) * cur.Kd + cur.k0 + kc * 16;
            *(u32x4*)d = w0; *(u32x4*)(d + 8) = w1; }
        __syncthreads();
        cur = nxt; u = un;
    }
}
__device__ void phase_prep(const Params& p, float* lds) {
    const int tid = opaque_tid(), nb = gridDim.x, bid = blockIdx.x;
    unsigned char* ws = p.ws;
    tr_slot(p, lds, 0, bid, nb, tid);
    __syncthreads();
    {
        float* tab = lds;
        if (tid < 64) { float sv, cv; sincosf(PI2 * (float)tid / 64.f, &sv, &cv); tab[tid] = cv; tab[64 + tid] = sv; }
        __syncthreads();
        const int lane = tid & 63, wv = tid >> 6;
        for (int u = bid * 8 + wv; u < 8192; u += nb * 8) {
            const int l = u >> 12, k = (u >> 2) & 1023, g = u & 3;
            const float* wrow = p.in[12] + ((size_t)l * 1024 + k) * INW + g * 64;
            const float wv_ = wrow[lane];
            float ac = 0.f, as = 0.f;
#pragma unroll 16
            for (int c = 0; c < 64; ++c) { const float w = __shfl(wv_, c); const int idx = (c * lane) & 63; ac += w * tab[idx]; as += w * tab[64 + idx]; }
            bf16_t* bt = (bf16_t*)(ws + OFF_WIN + l * SZ_WIN);
            bt[(size_t)(g * 64 + lane) * 1024 + k] = f2bf(ac);
            bt[(size_t)(256 + g * 64 + lane) * 1024 + k] = f2bf(as);
        }
        __syncthreads();
    }
    {
        float* sc = lds;
        float* part = lds + 12 * 1024;
        for (int i = tid; i < 9 * 1024; i += NTHREADS) { const int bc = i >> 10, k = i & 1023; const float cv = bc == 0 ? p.in[5][k] : p.in[4][(bc - 1) * 1024 + k]; sc[k * 12 + bc] = cv / (1.0f + expf(-cv)); }
        __syncthreads();
        for (int cb = bid; cb < 256; cb += nb) {
            const int gc0 = cb * 72, l = gc0 / 9216, j0 = gc0 % 9216;
            const int cg = tid % 18, kg = tid / 18;
            if (kg < 28) {
                f32x4 a[9];
#pragma unroll
                for (int i = 0; i < 9; ++i) a[i] = (f32x4){0.f, 0.f, 0.f, 0.f};
                const float* wp = p.in[6] + (size_t)l * 1024 * 9216 + j0 + cg * 4;
#pragma unroll 4
                for (int k = kg; k < 1024; k += 28) { const f32x4 w = *(const f32x4*)(wp + (size_t)k * 9216);
                    const f32x4 s0 = *(const f32x4*)(sc + k * 12), s1 = *(const f32x4*)(sc + k * 12 + 4); const float s8 = sc[k * 12 + 8];
                    a[0] += w * s0[0]; a[1] += w * s0[1]; a[2] += w * s0[2]; a[3] += w * s0[3]; a[4] += w * s1[0]; a[5] += w * s1[1]; a[6] += w * s1[2]; a[7] += w * s1[3]; a[8] += w * s8; }
#pragma unroll
                for (int i = 0; i < 9; ++i)
#pragma unroll
                    for (int e = 0; e < 4; ++e) part[(kg * 72 + cg * 4 + e) * 9 + i] = a[i][e];
            }
            __syncthreads();
            for (int i = tid; i < 72 * 9; i += NTHREADS) { const int c2 = i / 9, bc = i % 9; float s = 0.f;
#pragma unroll
                for (int g = 0; g < 28; ++g) s += part[(g * 72 + c2) * 9 + bc];
                ((float*)(ws + OFF_MOD))[((size_t)l * 9 + bc) * 9216 + j0 + c2] = s + p.in[7][l * 9216 + j0 + c2]; }
            __syncthreads();
        }
    }
    __syncthreads();
    {
        const int lane = tid & 63, wv = tid >> 6;
        float* h2s = lds;
        const int u0 = bid * 10; const int l = u0 / 1280;
        if (u0 < 2560) {
            const float* w1 = p.in[15] + l * 33 * 64; const float* b1 = p.in[16] + l * 64; const float* w2 = p.in[17] + l * 64 * 64; const float* b2 = p.in[18] + l * 64;
            const float* w3 = p.in[19] + (size_t)l * 64 * 1024; const float fr = p.in[20][l * 64 + lane];
            for (int q = wv; q < 10; q += 8) {
                const int rem = (u0 + q) % 1280; const int pass = rem >= 256; const int n = pass ? 1024 : 256; const int d = pass ? rem - 256 : rem;
                const float tt = (float)d / (float)(n - 1);
                float feat = 0.f;
                if (lane == 0) feat = tt;
                else if (lane < 33) { const int j = (lane - 1) & 15; const float fj = 1e-4f + (float)j * ((15.0f - 1e-4f) / 15.0f); const float ang = (PI2 / (float)n) * (float)d * fj;
                    feat = lane < 17 ? cosf(ang) : -sinf(ang); }
                float a1 = b1[lane];
#pragma unroll
                for (int i = 0; i < 33; ++i) a1 += __shfl(feat, i) * w1[i * 64 + lane];
                const float h1 = sinf(fr * a1);
                float a2 = b2[lane];
#pragma unroll
                for (int i = 0; i < 64; ++i) a2 += __shfl(h1, i) * w2[i * 64 + lane];
                h2s[lane * 12 + q] = sinf(fr * a2);
            }
            __syncthreads();
            float acc[2][10];
#pragma unroll
            for (int q = 0; q < 10; ++q) { acc[0][q] = 0.f; acc[1][q] = 0.f; }
#pragma unroll 8
            for (int i = 0; i < 64; ++i) {
                const float wa = w3[i * 1024 + tid], wb = w3[i * 1024 + 512 + tid];
                const f32x4 ha = *(const f32x4*)(h2s + i * 12), hb = *(const f32x4*)(h2s + i * 12 + 4); const float h8 = h2s[i * 12 + 8], h9 = h2s[i * 12 + 9];
                acc[0][0] += ha[0] * wa; acc[0][1] += ha[1] * wa; acc[0][2] += ha[2] * wa; acc[0][3] += ha[3] * wa; acc[0][4] += hb[0] * wa; acc[0][5] += hb[1] * wa; acc[0][6] += hb[2] * wa; acc[0][7] += hb[3] * wa; acc[0][8] += h8 * wa; acc[0][9] += h9 * wa;
                acc[1][0] += ha[0] * wb; acc[1][1] += ha[1] * wb; acc[1][2] += ha[2] * wb; acc[1][3] += ha[3] * wb; acc[1][4] += hb[0] * wb; acc[1][5] += hb[1] * wb; acc[1][6] += hb[2] * wb; acc[1][7] += hb[3] * wb; acc[1][8] += h8 * wb; acc[1][9] += h9 * wb;
            }
            const int ord = (tid >> 8) & 1, c = tid & 255;
            const float dec = fabsf(p.in[21][(l * 2 + ord) * 256 + c]);
            bf16_t* gl = (bf16_t*)(ws + OFF_FILT) + (size_t)l * G_L;
#pragma unroll
            for (int q = 0; q < 10; ++q) {
                const int rem = (u0 + q) % 1280; const int pass = rem >= 256; const int n = pass ? 1024 : 256; const int d = pass ? rem - 256 : rem;
                const float tt = (float)d / (float)(n - 1); const float win = expf(-tt * dec) / (float)(2 * n);
                bf16_t* g = gl + (pass ? G_CTX : 0) + ((size_t)ord * 256 + c) * (2 * n);
                g[n - 1 - d] = f2bf(acc[0][q] * win);
                g[d == 0 ? 2 * n - 1 : n - 1 + d] = d == 0 ? (bf16_t)0 : f2bf(acc[1][q] * win);
            }
        }
        __syncthreads();
    }
    __syncthreads();
    {
        bf16_t* FC = (bf16_t*)(ws + OFF_FC); bf16_t* FL = (bf16_t*)(ws + OFF_FL);
        const int gt = bid * NTHREADS + tid, gn = nb * NTHREADS;
        for (int i = gt; i < 256 * 512 + 1024 * 2048; i += gn) {
            int n, k, col; bf16_t* dst;
            if (i < 256 * 512) { n = 256; k = i >> 9; col = i & 511; dst = FC + i; } else { const int j = i - 256 * 512; n = 1024; k = j >> 11; col = j & 2047; dst = FL + j; }
            const int s = col >= n, t = col - s * n; const int ph = (k * t) & (n - 1);
            float sv, cv; sincosf(PI2 * (float)ph / (float)n, &sv, &cv);
            const float sc = rsqrtf(64.0f * (float)n);
            *dst = f2bf((s ? -sv : cv) * sc);
        }
        { bf16_t* CK = (bf16_t*)(ws + OFF_CKB); bf16_t* CV = (bf16_t*)(ws + OFF_CVT);
            for (int i = gt; i < 2 * 8 * 256 * 128; i += gn) {
                { const int c = i & 127, key = (i >> 7) & 255, b = (i >> 15) & 7, l = i >> 18;
                    CK[i] = f2bf(p.in[2][(((size_t)b * 2 + l) * 256 + key) * 128 + c]); }
                { const int key = i & 255, c = (i >> 8) & 127, b = (i >> 15) & 7, l = i >> 18;
                    CV[i] = f2bf(p.in[3][(((size_t)b * 2 + l) * 256 + key) * 128 + c]); }
            } }
        if (bid == 0) for (int i = tid; i < 64 * 16; i += NTHREADS) { const int pos = i >> 4, j = i & 15; const float inv = powf(10000.0f, -(float)(2 * j) / 32.0f);
            float sv, cv; sincosf((float)pos * inv, &sv, &cv); float* rp = (float*)(ws + OFF_ROPE); rp[2 * i] = cv; rp[2 * i + 1] = sv; }
    }
    __syncthreads();
}

template <int MODE>
__device__ void phase_row(const Params& p, int lpost, int spost, int lpre, int spre) {
    const int tid_ = opaque_tid(); const int lane = tid_ & 63, wv = tid_ >> 6;
    const float* mod = (const float*)(p.ws + OFF_MOD);
    const bf16_t* Y = (const bf16_t*)(p.ws + OFF_Y); const float* ssq = (const float*)(p.ws + OFF_SSQ);
    bf16_t* H = (bf16_t*)(p.ws + OFF_H);
    const float factor = (spost == 1) ? 1.0f : 0.5f;
    const int stride = gridDim.x * 8;
    for (int row0 = blockIdx.x * 8 + wv; row0 < NTOK; row0 += 2 * stride) {
        f32x4 x[2][4]; u32x2 yv[2][4]; f32x4 sq[2][4]; int bc[2]; bool ok[2];
#pragma unroll
        for (int q = 0; q < 2; ++q) {
            const int row = row0 + q * stride; ok[q] = row < NTOK; const int rw = ok[q] ? row : row0;
            bc[q] = rw < NCTX ? 0 : 1 + ((rw - NCTX) >> 10);
            if (MODE == 0) { const float* src = rw < NCTX ? p.in[0] + (size_t)rw * D : p.in[1] + (size_t)(rw - NCTX) * D;
#pragma unroll
                for (int j = 0; j < 4; ++j) x[q][j] = *(const f32x4*)(src + j * 256 + lane * 4); }
            else {
                const float* xsrc = (lpost == 0 && spost == 0) ? (rw < NCTX ? p.in[0] + (size_t)rw * D : p.in[1] + (size_t)(rw - NCTX) * D) : p.out + (size_t)rw * D;
#pragma unroll
                for (int j = 0; j < 4; ++j) { x[q][j] = *(const f32x4*)(xsrc + j * 256 + lane * 4); yv[q][j] = *(const u32x2*)(Y + (size_t)rw * D + j * 256 + lane * 4); }
                const f32x4* sp = (const f32x4*)(ssq + (size_t)rw * 16);
#pragma unroll
                for (int j = 0; j < 4; ++j) sq[q][j] = sp[j];
            }
        }
#pragma unroll
        for (int q = 0; q < 2; ++q) {
            const int row = row0 + q * stride;
            if (!ok[q]) continue;
            float* xr = p.out + (size_t)row * D;
            if (MODE != 0) {
                float tot = 0.f;
#pragma unroll
                for (int j = 0; j < 4; ++j) tot += (sq[q][j][0] + sq[q][j][1]) + (sq[q][j][2] + sq[q][j][3]);
                const float rstd = rsqrtf(tot * (1.0f / 1024.0f) + EPS) * factor;
                const float* gate = mod + ((size_t)lpost * 9 + bc[q]) * 9216 + spost * 3072 + 2048;
                const float* gp = p.in[8] + (lpost * 6 + 2 * spost + 1) * 1024;
#pragma unroll
                for (int j = 0; j < 4; ++j) { const int c = j * 256 + lane * 4;
                    const f32x4 gt = *(const f32x4*)(gate + c), gg = *(const f32x4*)(gp + c);
                    x[q][j][0] += gt[0] * gg[0] * rstd * __uint_as_float(yv[q][j].x << 16);
                    x[q][j][1] += gt[1] * gg[1] * rstd * __uint_as_float(yv[q][j].x & 0xFFFF0000u);
                    x[q][j][2] += gt[2] * gg[2] * rstd * __uint_as_float(yv[q][j].y << 16);
                    x[q][j][3] += gt[3] * gg[3] * rstd * __uint_as_float(yv[q][j].y & 0xFFFF0000u); }
            }
            if (MODE != 0) {
#pragma unroll
                for (int j = 0; j < 4; ++j) *(f32x4*)(xr + j * 256 + lane * 4) = x[q][j]; }
            if (MODE != 2) {
                float s = 0.f;
#pragma unroll
                for (int j = 0; j < 4; ++j) s += x[q][j][0] * x[q][j][0] + x[q][j][1] * x[q][j][1] + x[q][j][2] * x[q][j][2] + x[q][j][3] * x[q][j][3];
#pragma unroll
                for (int o = 32; o >= 1; o >>= 1) s += __shfl_xor(s, o);
                const float rs = rsqrtf(s * (1.0f / 1024.0f) + EPS);
                const float* mb = mod + ((size_t)lpre * 9 + bc[q]) * 9216 + spre * 3072;
                const float* gp = p.in[8] + (lpre * 6 + 2 * spre) * 1024;
#pragma unroll
                for (int j = 0; j < 4; ++j) { const int c = j * 256 + lane * 4;
                    const f32x4 sh = *(const f32x4*)(mb + c), scl = *(const f32x4*)(mb + 1024 + c), gg = *(const f32x4*)(gp + c);
                    f32x4 hh;
#pragma unroll
                    for (int e = 0; e < 4; ++e) hh[e] = x[q][j][e] * rs * gg[e] * (1.0f + scl[e]) + sh[e];
                    u32x2 w; w.x = pk_bf16(hh[0], hh[1]); w.y = pk_bf16(hh[2], hh[3]);
                    *(u32x2*)(H + (size_t)row * D + c) = w; }
            }
        }
    }
}

constexpr int AT_KROWB = 144;
constexpr int AT_VROWB_A = 784, AT_VROWB_B = 528;
constexpr int AT_OFF_V = 320 * AT_KROWB;
struct AttnState { f32x16 O0, O1; float m, lsum; };
template <bool MASK>
__device__ __forceinline__ void attn_tiles(AttnState& st, const bf16x8 (&qf)[4], const LAS unsigned char* Kl, const LAS unsigned char* Vl, int vrowb, int t0, int t1, int dk0, int r, int h) {
    for (int t = t0; t < t1; ++t) {
        const LAS unsigned char* kp = Kl + (t * 32 + r) * AT_KROWB + h * 16;
        bf16x8 kf[4];
#pragma unroll
        for (int kk = 0; kk < 4; ++kk) kf[kk] = *(const LAS bf16x8*)(kp + kk * 32);
        const LAS unsigned char* vp = Vl + r * vrowb + (t * 32 + 4 * h) * 2;
        u32x2 vraw[2][2][2];
#pragma unroll
        for (int dt = 0; dt < 2; ++dt)
#pragma unroll
            for (int s = 0; s < 2; ++s)
#pragma unroll
                for (int q = 0; q < 2; ++q) vraw[dt][s][q] = *(const LAS u32x2*)(vp + dt * 32 * vrowb + (16 * s + 8 * q) * 2);
        f32x16 S;
#pragma unroll
        for (int i = 0; i < 16; ++i) S[i] = 0.f;
#pragma unroll
        for (int kk = 0; kk < 4; ++kk) S = __builtin_amdgcn_mfma_f32_32x32x16_bf16(kf[kk], qf[kk], S, 0, 0, 0);
        if (MASK) {
            const int dk = dk0 + t * 32;
            if (dk <= -128 || dk >= 128) {
#pragma unroll
                for (int i = 0; i < 16; ++i) { const int j = (i & 3) + 8 * (i >> 2) + 4 * h; int dd = dk + j - r; if (dd < 0) dd = -dd; if (dd > 128) S[i] = -1e30f; }
            }
        }
        float mx = S[0];
#pragma unroll
        for (int i = 1; i < 16; ++i) mx = fmaxf(mx, S[i]);
        mx = fmaxf(mx, __shfl_xor(mx, 32));
        const float mn = fmaxf(st.m, mx), corr = __expf(st.m - mn);
        st.m = mn;
        float rs = 0.f;
#pragma unroll
        for (int i = 0; i < 16; ++i) { S[i] = __expf(S[i] - mn); rs += S[i]; }
        rs += __shfl_xor(rs, 32);
        st.lsum = st.lsum * corr + rs;
#pragma unroll
        for (int i = 0; i < 16; ++i) { st.O0[i] *= corr; st.O1[i] *= corr; }
        bf16x8 pf[2];
#pragma unroll
        for (int s = 0; s < 2; ++s) { u32x4 w; w.x = pk_bf16(S[8 * s], S[8 * s + 1]); w.y = pk_bf16(S[8 * s + 2], S[8 * s + 3]); w.z = pk_bf16(S[8 * s + 4], S[8 * s + 5]); w.w = pk_bf16(S[8 * s + 6], S[8 * s + 7]);
            pf[s] = __builtin_bit_cast(bf16x8, w); }
#pragma unroll
        for (int s = 0; s < 2; ++s) {
            u32x4 a0; a0.x = vraw[0][s][0].x; a0.y = vraw[0][s][0].y; a0.z = vraw[0][s][1].x; a0.w = vraw[0][s][1].y;
            u32x4 a1; a1.x = vraw[1][s][0].x; a1.y = vraw[1][s][0].y; a1.z = vraw[1][s][1].x; a1.w = vraw[1][s][1].y;
            st.O0 = __builtin_amdgcn_mfma_f32_32x32x16_bf16(__builtin_bit_cast(bf16x8, a0), pf[s], st.O0, 0, 0, 0);
            st.O1 = __builtin_amdgcn_mfma_f32_32x32x16_bf16(__builtin_bit_cast(bf16x8, a1), pf[s], st.O1, 0, 0, 0);
        }
    }
}
__device__ __forceinline__ void attn_unit(const Params& p, int l, int u, LAS unsigned char* lds, int tid) {
    const int lane = tid & 63, wv = tid >> 6, r = lane & 31, h = lane >> 5;
    const bf16_t* QB = (const bf16_t*)(p.ws + OFF_QB); const bf16_t* KB = (const bf16_t*)(p.ws + OFF_KB); const bf16_t* VT = (const bf16_t*)(p.ws + OFF_VB);
    const bf16_t* CK = (const bf16_t*)(p.ws + OFF_CKB); const bf16_t* CV = (const bf16_t*)(p.ws + OFF_CVT);
    bf16_t* YC = (bf16_t*)(p.ws + OFF_YCAT);
    const int g = wv & 3, qh = wv >> 2;
    const int pass = u < 256; const int v = u & 255;
    int b, kvh, qb, n, rowbase;
    if (!pass) { b = v >> 3; kvh = (v >> 2) & 1; qb = v & 3; n = 256; rowbase = b * 256; }
    else { b = v >> 5; kvh = (v >> 4) & 1; qb = v & 15; n = 1024; rowbase = NCTX + b * 1024; }
    const int head = kvh * 4 + g, q0w = qb * 64 + qh * 32;
    int kloU = 0, khiU = 256;
    if (pass) { kloU = qb * 64 - 128; if (kloU < 0) kloU = 0; khiU = qb * 64 + 192; if (khiU > n) khiU = n; }
    const int nkA = khiU - kloU, npc = nkA * 8, vpr = nkA >> 3;
    const bf16_t* kA = KB + (size_t)(rowbase + kloU) * 128 + kvh * 64;
    const bf16_t* vA = VT + (pass ? VT_LAT + (size_t)b * 128 * 1024 : (size_t)b * 128 * 256) + (size_t)kvh * 64 * n + kloU;
    {
        u32x4 kr[5], vr[5];
#pragma unroll
        for (int it = 0; it < 5; ++it) { const int idx = tid + it * NTHREADS;
            if (idx < npc) { kr[it] = *(const u32x4*)(kA + (size_t)(idx >> 3) * 128 + (idx & 7) * 8);
                const int d = idx / vpr, j = idx - d * vpr; vr[it] = *(const u32x4*)(vA + (size_t)d * n + j * 8); } }
#pragma unroll
        for (int it = 0; it < 5; ++it) { const int idx = tid + it * NTHREADS;
            if (idx < npc) { *(LAS u32x4*)(lds + (idx >> 3) * AT_KROWB + (idx & 7) * 16) = kr[it];
                const int d = idx / vpr, j = idx - d * vpr; *(LAS u32x4*)(lds + AT_OFF_V + d * AT_VROWB_A + j * 16) = vr[it]; } }
    }
    bf16x8 qf[4];
    { const bf16_t* qp = QB + (size_t)(rowbase + q0w + r) * 512 + head * 64 + 8 * h;
#pragma unroll
        for (int kk = 0; kk < 4; ++kk) qf[kk] = *(const bf16x8*)(qp + 16 * kk); }
    AttnState st; st.m = p.in[23][l * 8 + head]; st.lsum = 1.0f;
#pragma unroll
    for (int i = 0; i < 16; ++i) { st.O0[i] = 0.f; st.O1[i] = 0.f; }
    __syncthreads();
    u32x4 kb[4], vb[4];
    if (pass) {
        const bf16_t* kB = CK + ((size_t)(l * 8 + b) * 256) * 128 + kvh * 64;
        const bf16_t* vB = CV + ((size_t)(l * 8 + b) * 128 + kvh * 64) * 256;
#pragma unroll
        for (int it = 0; it < 4; ++it) { const int idx = tid + it * NTHREADS;
            kb[it] = *(const u32x4*)(kB + (size_t)(idx >> 3) * 128 + (idx & 7) * 8);
            vb[it] = *(const u32x4*)(vB + (size_t)(idx >> 5) * 256 + (idx & 31) * 8); }
    }
    {
        int klo = 0, khi = 256;
        if (pass) { klo = q0w - 128; if (klo < 0) klo = 0; khi = q0w + 160; if (khi > n) khi = n; }
        const int t0 = (klo - kloU) >> 5, t1 = (khi - kloU) >> 5;
        if (pass) attn_tiles<true>(st, qf, lds, lds + AT_OFF_V, AT_VROWB_A, t0, t1, kloU - q0w, r, h);
        else attn_tiles<false>(st, qf, lds, lds + AT_OFF_V, AT_VROWB_A, t0, t1, 0, r, h);
    }
    if (pass) {
        __syncthreads();
#pragma unroll
        for (int it = 0; it < 4; ++it) { const int idx = tid + it * NTHREADS;
            *(LAS u32x4*)(lds + (idx >> 3) * AT_KROWB + (idx & 7) * 16) = kb[it];
            *(LAS u32x4*)(lds + AT_OFF_V + (idx >> 5) * AT_VROWB_B + (idx & 31) * 16) = vb[it]; }
        __syncthreads();
        attn_tiles<false>(st, qf, lds, lds + AT_OFF_V, AT_VROWB_B, 0, 8, 0, r, h);
    }
    const float inv = 1.0f / st.lsum;
    bf16_t* op = YC + (size_t)(rowbase + q0w + r) * 1024 + 512 + head * 64 + 4 * h;
#pragma unroll
    for (int gq = 0; gq < 4; ++gq) {
        u32x2 w0; w0.x = pk_bf16(st.O0[4 * gq] * inv, st.O0[4 * gq + 1] * inv); w0.y = pk_bf16(st.O0[4 * gq + 2] * inv, st.O0[4 * gq + 3] * inv);
        u32x2 w1; w1.x = pk_bf16(st.O1[4 * gq] * inv, st.O1[4 * gq + 1] * inv); w1.y = pk_bf16(st.O1[4 * gq + 2] * inv, st.O1[4 * gq + 3] * inv);
        *(u32x2*)(op + 8 * gq) = w0; *(u32x2*)(op + 32 + 8 * gq) = w1;
    }
    __syncthreads();
}
__device__ void attn_mfma(const Params& p, int l, LAS unsigned char* lds) {
    const int tid = opaque_tid();
    for (int u = blockIdx.x; u < 512; u += gridDim.x) attn_unit(p, l, u, lds, tid);
}

template <int NB  , int NBLK  >
__device__ __forceinline__ void hyena_unit(const Params& p, int l, int c, const bf16_t* __restrict__ HTp, int rowbase, const bf16_t* __restrict__ gb, LAS unsigned char* lds, int tid) {
    constexpr int n = 32 * NBLK, NI = 32 / NB, PAD = 32 * (NI - 1);
    constexpr int LENB = (2 * n * 2 - 64 + 255) / 256 * 256 + 64;
    constexpr int UROWB = ((n + 2 * PAD) * 2 + 255) / 256 * 256 + 16;
    constexpr int GSB = (2 * n + 8) * 2;
    constexpr int OFF_F0 = 0, OFF_F1 = 8 * LENB, OFF_U = 16 * LENB, OFF_U2 = OFF_U + NB * UROWB, OFF_G1 = OFF_U2 + NB * UROWB, OFF_G2 = OFF_G1 + NB * n * 2, OFF_GS = OFF_G2 + NB * n * 2;
    static_assert(OFF_GS + 2 * GSB <= 149 * 1024, "hyena LDS");
    const int lane = tid & 63, wv = tid >> 6, r = lane & 31, h = lane >> 5;
    const float* cw = p.in[14] + l * 3 * 768;
    if (tid < 2 * (2 * n / 8)) { const int o = tid / (2 * n / 8), k = tid % (2 * n / 8);
        *(LAS u32x4*)(lds + OFF_GS + o * GSB + k * 16) = *(const u32x4*)(gb + ((size_t)o * 256 + c) * (2 * n) + k * 8); }
    if (tid < 2) *(LAS u32x4*)(lds + OFF_GS + tid * GSB + 2 * n * 2) = (u32x4){0u, 0u, 0u, 0u};
    constexpr int NQ = 3 * NB * (n / 8) / NTHREADS;
#pragma unroll
    for (int it = 0; it < NQ; ++it) {
        const int q = tid + it * NTHREADS;
        const int w = q / (NB * (n / 8)), rem = q % (NB * (n / 8)), b = rem / (n / 8), t0 = (rem % (n / 8)) * 8;
        const int ch = w * 256 + c; const bf16_t* row = HTp + ((size_t)b * 768 + ch) * n;
        const float w0 = cw[ch], w1 = cw[768 + ch], w2 = cw[1536 + ch];
        const u32x4 raw = *(const u32x4*)(row + t0);
        float x[10];
        x[0] = t0 > 0 ? bf2f(row[t0 - 1]) : 0.f; x[9] = t0 + 8 < n ? bf2f(row[t0 + 8]) : 0.f;
        x[1] = __uint_as_float(raw.x << 16); x[2] = __uint_as_float(raw.x & 0xFFFF0000u); x[3] = __uint_as_float(raw.y << 16); x[4] = __uint_as_float(raw.y & 0xFFFF0000u);
        x[5] = __uint_as_float(raw.z << 16); x[6] = __uint_as_float(raw.z & 0xFFFF0000u); x[7] = __uint_as_float(raw.w << 16); x[8] = __uint_as_float(raw.w & 0xFFFF0000u);
        float z[8];
#pragma unroll
        for (int e = 0; e < 8; ++e) z[e] = x[e] * w0 + x[e + 1] * w1 + x[e + 2] * w2;
        u32x4 o; o.x = pk_bf16(z[0], z[1]); o.y = pk_bf16(z[2], z[3]); o.z = pk_bf16(z[4], z[5]); o.w = pk_bf16(z[6], z[7]);
        LAS unsigned char* dst = w == 0 ? lds + OFF_U + b * UROWB + (PAD + t0) * 2 : lds + (w == 1 ? OFF_G1 : OFF_G2) + (b * n + t0) * 2;
        *(LAS u32x4*)dst = o;
    }
    if (PAD > 0) {
        constexpr int FR = PAD / 8, BK_ = (UROWB / 2 - PAD - n) / 8;
        for (int q = tid; q < 2 * NB * (FR + BK_); q += NTHREADS) {
            const int buf = q / (NB * (FR + BK_)), rem = q % (NB * (FR + BK_)), b = rem / (FR + BK_), k = rem % (FR + BK_);
            const int e0 = k < FR ? k * 8 : PAD + n + (k - FR) * 8;
            *(LAS u32x4*)(lds + (buf ? OFF_U2 : OFF_U) + b * UROWB + e0 * 2) = (u32x4){0u, 0u, 0u, 0u};
        }
    }
    __syncthreads();
    if (tid < 2 * (2 * n / 8)) { const int o = tid / (2 * n / 8), k = tid % (2 * n / 8);
        const u32x4 lo = *(const LAS u32x4*)(lds + OFF_GS + o * GSB + k * 16), hi = *(const LAS u32x4*)(lds + OFF_GS + o * GSB + k * 16 + 16);
        const unsigned d[8] = {lo.x, lo.y, lo.z, lo.w, hi.x, hi.y, hi.z, hi.w};
        LAS unsigned char* fdst = lds + (o ? OFF_F1 : OFF_F0) + k * 16;
#pragma unroll
        for (int s = 0; s < 8; ++s) { u32x4 w;
            if ((s & 1) == 0) { w.x = d[s / 2]; w.y = d[s / 2 + 1]; w.z = d[s / 2 + 2]; w.w = d[s / 2 + 3]; }
            else { w.x = __builtin_amdgcn_alignbyte(d[s / 2 + 1], d[s / 2], 2); w.y = __builtin_amdgcn_alignbyte(d[s / 2 + 2], d[s / 2 + 1], 2);
                   w.z = __builtin_amdgcn_alignbyte(d[s / 2 + 3], d[s / 2 + 2], 2); w.w = __builtin_amdgcn_alignbyte(d[s / 2 + 4], d[s / 2 + 3], 2); }
            *(LAS u32x4*)(fdst + s * LENB) = w; }
    }
    __syncthreads();
    const int bcol = NB == 8 ? (r >> 2) : r, ioff = NB == 8 ? (r & 3) : 0, I0 = wv * NI, Icol = I0 + ioff;
    const int si = (7 - r) & 7;
    const int Dlo = I0 + NI - 1 - (NBLK - 1) - (NI - 1), Dhi = I0 + NI - 1;
    bf16_t* YC = (bf16_t*)(p.ws + OFF_YCAT);
#pragma unroll
    for (int o = 0; o < 2; ++o) {
        const LAS unsigned char* ap = lds + (o ? OFF_F1 : OFF_F0) + si * LENB + (n - 1 - r + 8 * h - si) * 2 - 64 * Dlo;
        const LAS unsigned char* bp = lds + (o ? OFF_U2 : OFF_U) + bcol * UROWB + (PAD + 32 * Icol + 8 * h) * 2 - 64 * Dlo;
        f32x16 acc;
#pragma unroll
        for (int i = 0; i < 16; ++i) acc[i] = 0.f;
#pragma unroll 4
        for (int D = Dlo; D <= Dhi; ++D) {
            const bf16x8 a0 = *(const LAS bf16x8*)ap, a1 = *(const LAS bf16x8*)(ap + 32);
            const bf16x8 b0 = *(const LAS bf16x8*)bp, b1 = *(const LAS bf16x8*)(bp + 32);
            acc = __builtin_amdgcn_mfma_f32_32x32x16_bf16(a0, b0, acc, 0, 0, 0);
            acc = __builtin_amdgcn_mfma_f32_32x32x16_bf16(a1, b1, acc, 0, 0, 0);
            ap -= 64; bp -= 64;
        }
        const float bias = p.in[22][(l * 2 + o) * 256 + c];
#pragma unroll
        for (int g = 0; g < 4; ++g) {
            const int t0 = 32 * Icol + 8 * g + 4 * h;
            const u32x2 uin = *(const LAS u32x2*)(lds + (o ? OFF_U2 : OFF_U) + bcol * UROWB + (PAD + t0) * 2);
            const u32x2 gin = *(const LAS u32x2*)(lds + (o ? OFF_G2 : OFF_G1) + (bcol * n + t0) * 2);
            float y[4];
            y[0] = __uint_as_float(gin.x << 16) * (acc[4 * g] + bias * __uint_as_float(uin.x << 16));
            y[1] = __uint_as_float(gin.x & 0xFFFF0000u) * (acc[4 * g + 1] + bias * __uint_as_float(uin.x & 0xFFFF0000u));
            y[2] = __uint_as_float(gin.y << 16) * (acc[4 * g + 2] + bias * __uint_as_float(uin.y << 16));
            y[3] = __uint_as_float(gin.y & 0xFFFF0000u) * (acc[4 * g + 3] + bias * __uint_as_float(uin.y & 0xFFFF0000u));
            if (o == 0) { u32x2 w; w.x = pk_bf16(y[0], y[1]); w.y = pk_bf16(y[2], y[3]);
                *(LAS u32x2*)(lds + OFF_U2 + bcol * UROWB + (PAD + t0) * 2) = w; }
            else { bf16_t* dst = YC + (size_t)(rowbase + bcol * n + t0) * 1024 + 256 + c;
#pragma unroll
                for (int e = 0; e < 4; ++e) dst[(size_t)e * 1024] = f2bf(y[e]); }
        }
        __syncthreads();
    }
}
__device__ void hyena_mfma(const Params& p, int l, LAS unsigned char* lds) {
    const int tid = opaque_tid();
    const bf16_t* HT = (const bf16_t*)(p.ws + OFF_HT);
    const bf16_t* gl = (const bf16_t*)(p.ws + OFF_FILT) + (size_t)l * G_L;
    for (int u = blockIdx.x; u < 512; u += gridDim.x) {
        if (u < 256) hyena_unit<8, 32>(p, l, u, HT + HT_LAT, NCTX, gl + G_CTX, lds, tid);
        else hyena_unit<32, 8>(p, l, u - 256, HT, 0, gl, lds, tid);
    }
}


struct OneUnit { int pm, pn;
    __device__ __forceinline__ bool next(int i, pg8::Unit& u) const { if (i) return false; u.pm = pm; u.pn = pn; return true; }
    __device__ __forceinline__ void a_ready(const pg8::Unit&) const {}
    __device__ __forceinline__ void done(const pg8::Unit&) const {} };
__device__ void mixer_phase(const Params& p, int l, LAS unsigned char* lds) {
    constexpr int NU = 32 + 256 + 256 + 32 + 256 + 256;
    unsigned char* ws = p.ws; asm volatile("" : "+s"(ws));
    unsigned* ctr = (unsigned*)(ws + OFF_BAR) + 64 * l;
    volatile LAS unsigned* slot = (volatile LAS unsigned*)(lds + 149 * 1024 + 8);
    const bf16_t* HT = (const bf16_t*)(ws + OFF_HT);
    const bf16_t* gl = (const bf16_t*)(ws + OFF_FILT) + (size_t)l * G_L;
    int u = blockIdx.x;
    while (u < NU) {
        unsigned ticket = 0;
        if (threadIdx.x == 0) ticket = __hip_atomic_fetch_add(ctr, 1u, __ATOMIC_RELAXED, __HIP_MEMORY_SCOPE_AGENT);
        const int tid = opaque_tid();
        if (u < 32) {
            pg8::Gemm g{(const bf16_t*)(ws + OFF_FL), (const bf16_t*)(ws + OFF_ZT) + ZT_LAT, 1024, 2048, 2048, 2048, 2048};
            OneUnit S{u & 3, u >> 2}; EpiFourier E{(bf16_t*)(ws + OFF_YCAT), NCTX, 1024};
            pg8::gemm_phase(lds, g, S, E);
        } else if (u < 288) attn_unit(p, l, u - 32, lds, tid);
        else if (u < 544) hyena_unit<8, 32>(p, l, u - 288, HT + HT_LAT, NCTX, gl + G_CTX, lds, tid);
        else if (u < 576) {
            pg8::Gemm g{(const bf16_t*)(ws + OFF_FC), (const bf16_t*)(ws + OFF_ZT), 256, 8192, 512, 512, 512};
            OneUnit S{0, u - 544}; EpiFourier E{(bf16_t*)(ws + OFF_YCAT), 0, 256};
            pg8::gemm_phase(lds, g, S, E);
        } else if (u < 832) attn_unit(p, l, 256 + (u - 576), lds, tid);
        else hyena_unit<32, 8>(p, l, u - 832, HT, 0, gl, lds, tid);
        if (threadIdx.x == 0) *slot = ticket + 256u;
        __syncthreads();
        u = (int)*slot;
        __syncthreads();
    }
}

__global__ void __launch_bounds__(NTHREADS, 2) fwd_megakernel(Params p) {
    extern __shared__ __attribute__((aligned(16))) unsigned char shm[];
    cg::grid_group grid = cg::this_grid();
    LAS unsigned char* lds = (LAS unsigned char*)shm;
    float* ldsf = (float*)shm;
    unsigned char* ws = p.ws;
    const int G = gridDim.x, c = blockIdx.x;

    volatile LAS unsigned* xst = (volatile LAS unsigned*)(lds + 149 * 1024);
    if (threadIdx.x < 4) xst[threadIdx.x] = 0u;
    __syncthreads();
    const XcdBarrier xb = xcd_barrier_post((unsigned*)(ws + OFF_BAR), xst);
    for (int _d = 0; _d < DUP_PREP; ++_d) { phase_prep(p, ldsf); __syncthreads(); }
    if (p.ws == nullptr) grid.sync();
    GSYNC();
    phase_row<0>(p, 0, 0, 0, 0);
    GSYNC();
    for (int l = 0; l < 2; ++l) {
        for (int s = 0; s < 3; ++s) {
            unsigned char* ws = p.ws; asm volatile("" : "+s"(ws));
            if (s != 1) {
                const int fs = s >> 1;
                { pg8::Gemm g{(const bf16_t*)(ws + OFF_H), (const bf16_t*)(ws + OFF_WGU + (l * 2 + fs) * SZ_WGU), NTOK, 5632, 1024, 1024, 1024};
                    pg8::StaticOrder S; S.init(g.M, g.N, G, c); EpiSwiglu E{(bf16_t*)(ws + OFF_ACT)};
                    for (int _d = 0; _d < DUP_GEMM; ++_d) pg8::gemm_phase(lds, g, S, E); }
                { int cc = c, gg = G; asm volatile("" : "+s"(cc), "+s"(gg));
                    if (cc >= 1408 - 5 * gg) { __syncthreads(); tr_slot(p, ldsf, 1 + l * 2 + fs, cc - (1408 - 5 * gg), gg - (1408 - 5 * gg), opaque_tid()); } }
                GSYNC();
                { pg8::Gemm g{(const bf16_t*)(ws + OFF_ACT), (const bf16_t*)(ws + OFF_WD + (l * 2 + fs) * SZ_WD), NTOK, 1024, DFF, DFF, DFF};
                    pg8::StaticOrder S; S.init(g.M, g.N, G, c); EpiYssq E{(bf16_t*)(ws + OFF_Y), (float*)(ws + OFF_SSQ)};
                    for (int _d = 0; _d < DUP_GEMM; ++_d) pg8::gemm_phase(lds, g, S, E); }
                GSYNC();
            } else {
                { pg8::Gemm g{(const bf16_t*)(ws + OFF_H), (const bf16_t*)(ws + OFF_WIN + l * SZ_WIN), NTOK, 2048, 1024, 1024, 1024};
                    pg8::StaticOrder S; S.init(g.M, g.N, G, c);
                    EpiWin E{(bf16_t*)(ws + OFF_ZT), (bf16_t*)(ws + OFF_HT), (bf16_t*)(ws + OFF_QB), (bf16_t*)(ws + OFF_KB), (bf16_t*)(ws + OFF_VB), (const float*)(ws + OFF_ROPE),
                             p.out + (size_t)NTOK * D, p.out + (size_t)NTOK * D + (size_t)32 * 2 * 256 * 128, l};
                    for (int _d = 0; _d < DUP_GEMM; ++_d) pg8::gemm_phase(lds, g, S, E); }
                GSYNC();
                mixer_phase(p, l, lds);
                GSYNC();
                { pg8::Gemm g{(const bf16_t*)(ws + OFF_YCAT), (const bf16_t*)(ws + OFF_WOUT + l * SZ_WOUT), NTOK, 1024, 1024, 1024, 1024};
                    pg8::StaticOrder S; S.init(g.M, g.N, G, c); EpiYssq E{(bf16_t*)(ws + OFF_Y), (float*)(ws + OFF_SSQ)};
                    for (int _d = 0; _d < DUP_GEMM; ++_d) pg8::gemm_phase(lds, g, S, E); }
                GSYNC();
            }
            if (l == 1 && s == 2) phase_row<2>(p, l, s, 0, 0);
            else { const int ln = s == 2 ? l + 1 : l, sn = s == 2 ? 0 : s + 1; phase_row<1>(p, l, s, ln, sn); }
            if (!(l == 1 && s == 2)) GSYNC();
        }
    }
}

extern "C" void kernel_launch(void* const* d_in, const int* in_sizes, int n_in, void* d_out, int out_size, void* d_ws, size_t ws_size, hipStream_t stream) {
    constexpr int LDS_BYTES = 149 * 1024 + 256;
    static int grid_blocks = 0;
    if (!grid_blocks) {
        if (n_in != 24 || ws_size < WS_END) { fprintf(stderr, "kernel_launch: bad inputs (n_in %d) or workspace too small (%zu < %zu)\n", n_in, ws_size, (size_t)WS_END); grid_blocks = -1; return; }
        int dev = 0, cus = 0, per_cu = 0;
        hipGetDevice(&dev);
        hipDeviceGetAttribute(&cus, hipDeviceAttributeMultiprocessorCount, dev);
        if (hipFuncSetAttribute((const void*)fwd_megakernel, hipFuncAttributeMaxDynamicSharedMemorySize, LDS_BYTES) != hipSuccess) fprintf(stderr, "kernel_launch: hipFuncSetAttribute failed\n");
        hipOccupancyMaxActiveBlocksPerMultiprocessor(&per_cu, (const void*)fwd_megakernel, NTHREADS, LDS_BYTES);
        if (per_cu < 1) { fprintf(stderr, "kernel_launch: occupancy query says %d blocks per CU\n", per_cu); per_cu = 1; }
        (void)hipGetLastError();
        grid_blocks = cus * per_cu;
        if (grid_blocks > 256) grid_blocks = 256;
    }
    if (grid_blocks < 0) return;
    Params p{};
    for (int i = 0; i < 24; ++i) p.in[i] = (const float*)d_in[i];
    p.out = (float*)d_out; p.ws = (unsigned char*)d_ws;
    (void)hipMemsetAsync((unsigned char*)d_ws + OFF_BAR, 0, 16384, stream);
    void* args[] = {&p};
    hipError_t e = hipLaunchCooperativeKernel((const void*)fwd_megakernel, dim3(grid_blocks), dim3(NTHREADS), args, LDS_BYTES, stream);
    if (e != hipSuccess) fprintf(stderr, "cooperative launch failed: %s (grid %d)\n", hipGetErrorString(e), grid_blocks);
}
```

```cpp
#include <hip/hip_runtime.h>
#include <hip/hip_cooperative_groups.h>
#include <cstdio>
namespace cg = cooperative_groups;

#define LAS __attribute__((address_space(3)))
#define GAS __attribute__((address_space(1)))
#ifndef DUP_PA
#define DUP_PA 1
#endif
#ifndef DUP_PB
#define DUP_PB 1
#endif
#ifndef DUP_PC
#define DUP_PC 1
#endif
#ifndef DUP_PD
#define DUP_PD 1
#endif
#ifndef DUP_HY
#define DUP_HY 1
#endif
#ifndef DUP_AT
#define DUP_AT 1
#endif
#ifndef DUP_GEMM
#define DUP_GEMM 1
#endif
#ifndef DUP_MIX
#define DUP_MIX 1
#endif
#ifndef DUP_PREP
#define DUP_PREP 1
#endif
#ifndef DUP_SYNC
#define DUP_SYNC 1
#endif
#define GSYNC() do { for (int _s = 0; _s < DUP_SYNC; ++_s) xcd_barrier(xb); } while (0)
typedef unsigned short bf16_t;
typedef short bf16x8 __attribute__((ext_vector_type(8)));
typedef float f32x4 __attribute__((ext_vector_type(4)));
typedef unsigned u32x4 __attribute__((ext_vector_type(4)));
typedef unsigned u32x2 __attribute__((ext_vector_type(2)));

constexpr int D = 1024, NTOK = 16384, NCTX = 8192, DFF = 2816, INW = 1792;
constexpr int NTHREADS = 512;
constexpr float EPS = 1e-6f;
constexpr float PI2 = 6.283185307179586f;

constexpr size_t AL(size_t x) { return (x + 255) & ~(size_t)255; }
constexpr size_t SZ_WGU = (size_t)5632 * 1024 * 2, SZ_WD = (size_t)1024 * 2816 * 2, SZ_WIN = (size_t)2048 * 1024 * 2, SZ_WOUT = (size_t)1024 * 1024 * 2;
constexpr size_t OFF_WGU = 0;
constexpr size_t OFF_WD = OFF_WGU + 4 * SZ_WGU;
constexpr size_t OFF_WIN = OFF_WD + 4 * SZ_WD;
constexpr size_t OFF_WOUT = OFF_WIN + 2 * SZ_WIN;
constexpr size_t OFF_H = OFF_WOUT + 2 * SZ_WOUT;
constexpr size_t OFF_Y = OFF_H + (size_t)NTOK * D * 2;
constexpr size_t OFF_SSQ = OFF_Y + (size_t)NTOK * D * 2;
constexpr size_t OFF_MOD = OFF_SSQ + (size_t)NTOK * 16 * 4;
constexpr size_t OFF_FILT = AL(OFF_MOD + (size_t)2 * 9 * 9216 * 4);
constexpr size_t FILT_CTX = (size_t)4 * 256 * 256, FILT_LAT = (size_t)4 * 256 * 1024, FILT_L = FILT_CTX + FILT_LAT;
constexpr size_t G_CTX = (size_t)2 * 256 * 512, G_LAT = (size_t)2 * 256 * 2048, G_L = G_CTX + G_LAT;
constexpr size_t OFF_FC = AL(OFF_FILT + 2 * FILT_L * 4);
constexpr size_t OFF_FL = OFF_FC + (size_t)256 * 512 * 2;
constexpr size_t OFF_ROPE = OFF_FL + (size_t)1024 * 2048 * 2;
constexpr size_t OFF_BAR = AL(OFF_ROPE + 64 * 16 * 8);
constexpr size_t OFF_CKB = OFF_BAR + 16384;
constexpr size_t OFF_CVT = OFF_CKB + (size_t)2 * 8 * 256 * 128 * 2;
constexpr size_t OFF_UNION = AL(OFF_CVT + (size_t)2 * 8 * 256 * 128 * 2);
constexpr size_t OFF_ACT = OFF_UNION;
constexpr size_t OFF_ZT = OFF_UNION;
constexpr size_t ZT_LAT = (size_t)NCTX * 512;
constexpr size_t OFF_HT = OFF_ZT + (size_t)NTOK * 512 * 2;
constexpr size_t HT_LAT = (size_t)NCTX * 768;
constexpr size_t OFF_QB = OFF_HT + (size_t)NTOK * 768 * 2;
constexpr size_t OFF_KB = OFF_QB + (size_t)NTOK * 512 * 2;
constexpr size_t OFF_VB = OFF_KB + (size_t)NTOK * 128 * 2;
constexpr size_t VT_LAT = (size_t)NCTX * 128;
constexpr size_t OFF_YCAT = OFF_VB + (size_t)NTOK * 128 * 2;
constexpr size_t UNION_END = OFF_YCAT + (size_t)NTOK * 1024 * 2;
constexpr size_t ACT_END = OFF_ACT + (size_t)NTOK * DFF * 2;
constexpr size_t WS_END = (UNION_END > ACT_END ? UNION_END : ACT_END);

struct Params {
    const float* in[24];
    float* out;
    unsigned char* ws;
};

__device__ __forceinline__ unsigned short f2bf(float f) { unsigned u = __float_as_uint(f); u += 0x7FFFu + ((u >> 16) & 1u); return (unsigned short)(u >> 16); }
__device__ __forceinline__ float bf2f(unsigned short b) { return __uint_as_float(((unsigned)b) << 16); }
__device__ __forceinline__ unsigned cvt_pk_bf16(float lo, float hi) { unsigned r; asm volatile("v_cvt_pk_bf16_f32 %0, %1, %2" : "=v"(r) : "v"(lo), "v"(hi)); return r; }
typedef __bf16 bf16x2_t __attribute__((ext_vector_type(2)));
typedef float f32x2_t __attribute__((ext_vector_type(2)));
typedef float f32x16 __attribute__((ext_vector_type(16)));
__device__ __forceinline__ unsigned pk_bf16(float lo, float hi) { f32x2_t v = {lo, hi}; return __builtin_bit_cast(unsigned, __builtin_convertvector(v, bf16x2_t)); }
__device__ __forceinline__ float silu_f(float x) { return x * __builtin_amdgcn_rcpf(1.0f + __expf(-x)); }
__device__ __forceinline__ int perm32(int rho) { const int n = rho >> 4, i = rho & 15; return 8 * (i >> 2) + 4 * n + (i & 3); }

__device__ __forceinline__ int opaque_tid() { int t = threadIdx.x; asm volatile("" : "+v"(t)); return t; }


#define XB_TMO      128
#define XB_XCNT(j)  (256  + 64 * (j))
#define XB_XSUB(j)  (1280 + 64 * (j))
#define XB_XGEN(j)  (2304 + 64 * (j))
#define XB_TOP      3328
#define XB_TOPGEN   3392
#define XCD_BAR_WORDS 3456
#define XB_SPIN_CAP (1u << 22)
__device__ __forceinline__ unsigned xb_ld(unsigned* p)              { return __hip_atomic_load(p, __ATOMIC_RELAXED, __HIP_MEMORY_SCOPE_AGENT); }
__device__ __forceinline__ unsigned xb_add(unsigned* p, unsigned v) { return __hip_atomic_fetch_add(p, v, __ATOMIC_RELAXED, __HIP_MEMORY_SCOPE_AGENT); }
__device__ __forceinline__ unsigned xb_xcc_id() { return (unsigned)__builtin_amdgcn_s_getreg((3 << 11) | 20) & 0xFu; }
#define XB_SPIN(cond, bar) do { unsigned _sp = 0; while (cond) { __builtin_amdgcn_s_sleep(1); \
    if ((++_sp & 255u) == 0u) { if (xb_ld(&(bar)[XB_TMO])) break; if (_sp > XB_SPIN_CAP) { atomicAdd(&(bar)[XB_TMO], 1u); break; } } } } while (0)
struct XcdBarrier { unsigned* bar; unsigned x; volatile LAS unsigned* st; };
__device__ __forceinline__ XcdBarrier xcd_barrier_post(unsigned* bar, volatile LAS unsigned* st) {
    XcdBarrier b; b.bar = bar; b.x = xb_xcc_id(); b.st = st;
    if (threadIdx.x == 0) (void)xb_add(&bar[XB_XCNT(b.x)], 1u);
    return b;
}
__device__ __forceinline__ void xcd_barrier_complete(unsigned* bar, unsigned x, unsigned& nloc, unsigned& nx) {
    const unsigned G = gridDim.x * gridDim.y * gridDim.z;
    unsigned sum, cnt, mine, sp = 0u;
    for (;;) {
        sum = 0u; cnt = 0u; mine = 0u;
#pragma unroll
        for (unsigned j = 0; j < 16; ++j) { const unsigned c = xb_ld(&bar[XB_XCNT(j)]); sum += c; cnt += (c > 0u) ? 1u : 0u; mine = (j == x) ? c : mine; }
        if (sum == G) break;
        __builtin_amdgcn_s_sleep(1);
        if ((++sp & 255u) == 0u) { if (xb_ld(&bar[XB_TMO])) break; if (sp > XB_SPIN_CAP) { atomicAdd(&bar[XB_TMO], 1u); break; } }
    }
    nloc = mine > 0u ? mine : 1u; nx = cnt > 0u ? cnt : 1u;
}
__device__ __forceinline__ void xcd_barrier(const XcdBarrier& b) {
    asm volatile("s_waitcnt vmcnt(0)" ::: "memory");
    __syncthreads();
    if (threadIdx.x == 0) {
        unsigned* bar = b.bar;
        __builtin_amdgcn_s_waitcnt(0);
        unsigned nloc = b.st[0], nx = b.st[1];
        if (nloc == 0u) { xcd_barrier_complete(bar, b.x, nloc, nx); b.st[0] = nloc; b.st[1] = nx; }
        const unsigned old = xb_add(&bar[XB_XSUB(b.x)], 1u);
        const unsigned gen = old / nloc;
        if (old + 1u == (gen + 1u) * nloc) {
            __builtin_amdgcn_fence(__ATOMIC_RELEASE, "agent");
            asm volatile("s_waitcnt vmcnt(0)" ::: "memory");
            const unsigned og = xb_add(&bar[XB_TOP], 1u);
            const unsigned tg = og / nx;
            if (og + 1u == (tg + 1u) * nx) xb_add(&bar[XB_TOPGEN], 1u);
            else XB_SPIN(xb_ld(&bar[XB_TOPGEN]) == tg, bar);
            __builtin_amdgcn_fence(__ATOMIC_ACQUIRE, "agent");
            xb_add(&bar[XB_XGEN(b.x)], 1u);
            asm volatile("s_waitcnt vmcnt(0)" ::: "memory");
        } else {
            XB_SPIN(xb_ld(&bar[XB_XGEN(b.x)]) == gen, bar);
            __builtin_amdgcn_fence(__ATOMIC_ACQUIRE, "agent");
            asm volatile("s_waitcnt vmcnt(0)" ::: "memory");
        }
    }
    __syncthreads();
}

namespace pg8 {
constexpr int BM = 256, BK = 64, HALF = 128, HTB = HALF * BK * 2, STAGE_BYTES = 8 * HTB, NXCD = 8, WGM = 8;
__device__ __forceinline__ int lds_byte(int r, int c) { const int st = (r >> 4) * 2 + (c >> 5), rr = r & 15, cc = c & 31, ob = rr * 64 + cc * 2; return st * 1024 + (ob ^ (((ob >> 9) & 1) << 5)); }
__device__ __forceinline__ void stage_rc(int b, int& R, int& C) { const int st = b / 1024, sb = b % 1024, swz = sb ^ (((sb >> 9) & 1) << 5); R = (st >> 1) * 16 + swz / 64; C = (st & 1) * 32 + (swz % 64) / 2; }
struct Unit { int pm, pn; };
struct Gemm { const bf16_t* A; const bf16_t* Bt; int M, N, K, lda, ldb; };
struct StaticOrder {
    int nM, nN, nwg, G, c;
    __device__ void init(int M, int N, int G_, int c_) { nM = M / BM; nN = N / BM; nwg = nM * nN; G = G_; c = c_; }
    __device__ bool next(int i, Unit& u) const {
        if (c < 0) return false;
        const long L = (long)i * G + c; if (L >= nwg) return false;
        int wgid = (int)L; { const int q = nwg / NXCD, r = nwg % NXCD, xcd = wgid % NXCD, off = wgid / NXCD; wgid = (xcd < r ? xcd * (q + 1) : r * (q + 1) + (xcd - r) * q) + off; }
        const int nig = WGM * nN, gid = wgid / nig, fm = gid * WGM, gsz = (nM - fm) < WGM ? (nM - fm) : WGM;
        u.pm = fm + ((wgid % nig) % gsz); u.pn = (wgid % nig) / gsz; return true;
    }
    __device__ __forceinline__ void a_ready(const Unit&) const {}
    __device__ __forceinline__ void done(const Unit&) const {}
};

template <class Epi, class Sched>
__device__ __forceinline__ void gemm_phase(LAS unsigned char* lds, Gemm g, const Sched& S, const Epi& E) {
    asm volatile("" : "+s"(g.A), "+s"(g.Bt), "+s"(g.K), "+s"(g.lda), "+s"(g.ldb));
    int tid = threadIdx.x; asm volatile("" : "+v"(tid));
    const int wid = __builtin_amdgcn_readfirstlane(tid >> 6), lane = tid & 63, wr = wid >> 2, wc = wid & 3, fr = lane & 15, fq = lane >> 4;
    const int K = g.K, nt = K / BK;
    unsigned voffA[2], voffB[2];
#pragma unroll
    for (int i = 0; i < 2; ++i) { int R, C; stage_rc(tid * 16 + i * 8192, R, C);
        voffA[i] = (unsigned)(R * g.lda + C) * 2u; voffB[i] = (unsigned)(R * g.ldb + C) * 2u; }
    const size_t kstep = (size_t)(BK * 2);
    const size_t hstepA = (size_t)HALF * g.lda * 2, hstepB = (size_t)HALF * g.ldb * 2;
    const size_t tstepA = 2 * hstepA, tstepB = 2 * hstepB;
    const unsigned ldsw = (unsigned)wid * 1024u;
    const int aoff = lds_byte(wr * 64 + fr, fq * 8), boff = lds_byte(wc * 32 + fr, fq * 8);
#define PG8_SA(b, h) (((b) * 2 + (h)) * HTB)
#define PG8_SB(b, h) ((4 + (b) * 2 + (h)) * HTB)
#define PG8_STAGE(bufoff, gbase, voff) do { _Pragma("unroll") for (int _i = 0; _i < 2; ++_i) \
        __builtin_amdgcn_global_load_lds((const unsigned*)((const char*)(gbase) + (voff)[_i]), (LAS unsigned*)(lds + (bufoff) + ldsw + _i * 8192), 16, 0, 0); } while (0)
#define PG8_LDA(dst, b, h) do { _Pragma("unroll") for (int m = 0; m < 4; ++m) _Pragma("unroll") for (int k = 0; k < 2; ++k) dst[m][k] = *(const LAS bf16x8*)(lds + PG8_SA(b, h) + aoff + m * 2048 + k * 1024); } while (0)
#define PG8_LDB(dst, b, h) do { _Pragma("unroll") for (int n = 0; n < 2; ++n) _Pragma("unroll") for (int k = 0; k < 2; ++k) dst[n][k] = *(const LAS bf16x8*)(lds + PG8_SB(b, h) + boff + n * 2048 + k * 1024); } while (0)
#define PG8_MMA(ai, bj, At, Bt) do { __builtin_amdgcn_s_setprio(1); _Pragma("unroll") for (int m = 0; m < 4; ++m) _Pragma("unroll") for (int n = 0; n < 2; ++n) _Pragma("unroll") for (int k = 0; k < 2; ++k) \
        acc[ai][bj][m][n] = __builtin_amdgcn_mfma_f32_16x16x32_bf16(Bt[n][k], At[m][k], acc[ai][bj][m][n], 0, 0, 0); __builtin_amdgcn_s_setprio(0); } while (0)
#define PG8_WAIT_V(n) asm volatile("s_waitcnt vmcnt(" #n ")" ::: "memory")
#define PG8_WAIT_L(n) asm volatile("s_waitcnt lgkmcnt(" #n ")" ::: "memory")
#define PG8_BAR __builtin_amdgcn_s_barrier()
#define PG8_SCHED __builtin_amdgcn_sched_barrier(0)
    Unit cur, nxt; int ui = 0;
    if (!S.next(0, cur)) return;
    f32x4 acc[2][2][4][2];
#pragma unroll
    for (int a = 0; a < 2; ++a)
#pragma unroll
        for (int b = 0; b < 2; ++b)
#pragma unroll
            for (int m = 0; m < 4; ++m)
#pragma unroll
                for (int n = 0; n < 2; ++n) acc[a][b][m][n] = (f32x4){0.f, 0.f, 0.f, 0.f};
    bf16x8 At[4][2], B0[2][2], B1[2][2];
    const char* cA = (const char*)g.A + (size_t)cur.pm * tstepA; const char* cB = (const char*)g.Bt + (size_t)cur.pn * tstepB;
    S.a_ready(cur);
    PG8_STAGE(PG8_SB(0, 0), cB, voffB); PG8_STAGE(PG8_SA(0, 0), cA, voffA); PG8_STAGE(PG8_SB(0, 1), cB + hstepB, voffB); PG8_STAGE(PG8_SA(0, 1), cA + hstepA, voffA);
    if (wr == 1) PG8_BAR;
    PG8_WAIT_V(4); PG8_BAR;
    PG8_STAGE(PG8_SB(1, 0), cB + kstep, voffB); PG8_STAGE(PG8_SA(1, 0), cA + kstep, voffA); PG8_STAGE(PG8_SB(1, 1), cB + hstepB + kstep, voffB);
    PG8_WAIT_V(6); PG8_BAR;
    for (;;) {
        const bool has_next = S.next(ui + 1, nxt);
        const char* nA = has_next ? (const char*)g.A + (size_t)nxt.pm * tstepA : cA; const char* nB = has_next ? (const char*)g.Bt + (size_t)nxt.pn * tstepB : cB;
        for (int t = 0; t < nt; t += 2) {
            const bool last = (t == nt - 2);
            const char* a1 = cA + (size_t)(t + 1) * kstep;
            const char* a2 = last ? nA : cA + (size_t)(t + 2) * kstep; const char* b2 = last ? nB : cB + (size_t)(t + 2) * kstep;
            const char* a3 = a2 + kstep; const char* b3 = b2 + kstep;
            if (last && has_next) S.a_ready(nxt);
            PG8_LDB(B0, 0, 0); PG8_SCHED; PG8_LDA(At, 0, 0); PG8_STAGE(PG8_SA(1, 1), a1 + hstepA, voffA);
            PG8_WAIT_L(8); PG8_BAR; PG8_WAIT_L(0); PG8_MMA(0, 0, At, B0); PG8_BAR; PG8_SCHED;
            PG8_LDB(B1, 0, 1); PG8_STAGE(PG8_SB(0, 0), b2, voffB);
            PG8_BAR; PG8_WAIT_L(0); PG8_MMA(0, 1, At, B1); PG8_BAR;
            PG8_LDA(At, 0, 1); PG8_STAGE(PG8_SA(0, 0), a2, voffA);
            PG8_BAR; PG8_WAIT_L(0); PG8_MMA(1, 0, At, B0); PG8_BAR; PG8_SCHED;
            PG8_STAGE(PG8_SB(0, 1), b2 + hstepB, voffB);
            PG8_WAIT_V(6); PG8_BAR; PG8_MMA(1, 1, At, B1); PG8_BAR;
            PG8_LDB(B0, 1, 0); PG8_SCHED; PG8_LDA(At, 1, 0); PG8_STAGE(PG8_SA(0, 1), a2 + hstepA, voffA);
            PG8_WAIT_L(8); PG8_BAR; PG8_WAIT_L(0); PG8_MMA(0, 0, At, B0); PG8_BAR; PG8_SCHED;
            PG8_LDB(B1, 1, 1); PG8_STAGE(PG8_SB(1, 0), b3, voffB);
            PG8_BAR; PG8_WAIT_L(0); PG8_MMA(0, 1, At, B1); PG8_BAR;
            PG8_LDA(At, 1, 1); PG8_STAGE(PG8_SA(1, 0), a3, voffA);
            PG8_BAR; PG8_WAIT_L(0); PG8_MMA(1, 0, At, B0); PG8_BAR; PG8_SCHED;
            PG8_STAGE(PG8_SB(1, 1), b3 + hstepB, voffB);
            PG8_WAIT_V(6); PG8_BAR; PG8_MMA(1, 1, At, B1); PG8_BAR;
        }
        { int fr2 = fr, fq2 = fq, wr2 = wr, wc2 = wc; asm volatile("" : "+v"(fr2), "+v"(fq2), "+s"(wr2), "+s"(wc2));
            E(acc, cur, wr2, wc2, fr2, fq2); } S.done(cur);
        if (!has_next) break;
#pragma unroll
        for (int a = 0; a < 2; ++a)
#pragma unroll
            for (int b = 0; b < 2; ++b)
#pragma unroll
                for (int m = 0; m < 4; ++m)
#pragma unroll
                    for (int n = 0; n < 2; ++n) acc[a][b][m][n] = (f32x4){0.f, 0.f, 0.f, 0.f};
        cur = nxt; cA = nA; cB = nB; ++ui;
    }
    PG8_WAIT_V(0);
    if (wr == 0) PG8_BAR;
    PG8_BAR;
#undef PG8_SA
#undef PG8_SB
#undef PG8_STAGE
#undef PG8_LDA
#undef PG8_LDB
#undef PG8_MMA
#undef PG8_WAIT_V
#undef PG8_WAIT_L
#undef PG8_BAR
#undef PG8_SCHED
}
}

struct EpiSwiglu {
    bf16_t* O;
    __device__ __forceinline__ void operator()(const f32x4 (&acc)[2][2][4][2], const pg8::Unit& u, int wr, int wc, int fr, int fq) const {
        const int row0 = u.pm * 256 + wr * 64 + fr, col0 = u.pn * 128 + wc * 32 + 8 * fq;
#pragma unroll
        for (int ai = 0; ai < 2; ++ai)
#pragma unroll
            for (int m = 0; m < 4; ++m) {
                bf16_t* rowp = O + (size_t)(row0 + ai * 128 + m * 16) * DFF + col0;
                const f32x4 g0 = acc[ai][0][m][0], g1 = acc[ai][0][m][1], u0 = acc[ai][1][m][0], u1 = acc[ai][1][m][1];
                f32x4 r0, r1;
#pragma unroll
                for (int e = 0; e < 4; ++e) { r0[e] = __builtin_amdgcn_rcpf(1.0f + __builtin_amdgcn_exp2f(-g0[e])); r1[e] = __builtin_amdgcn_rcpf(1.0f + __builtin_amdgcn_exp2f(-g1[e])); }
                const f32x4 o0 = (g0 * u0) * r0, o1 = (g1 * u1) * r1;
                u32x4 w;
                w.x = pk_bf16(o0[0], o0[1]); w.y = pk_bf16(o0[2], o0[3]); w.z = pk_bf16(o1[0], o1[1]); w.w = pk_bf16(o1[2], o1[3]);
                *(u32x4*)rowp = w;
            }
    }
};
struct EpiYssq {
    bf16_t* Y; float* ssq;
    __device__ __forceinline__ void operator()(const f32x4 (&acc)[2][2][4][2], const pg8::Unit& u, int wr, int wc, int fr, int fq) const {
        const int row0 = u.pm * 256 + wr * 64 + fr, col0 = u.pn * 256 + wc * 32 + 8 * fq;
#pragma unroll
        for (int ai = 0; ai < 2; ++ai)
#pragma unroll
            for (int m = 0; m < 4; ++m) {
                const int row = row0 + ai * 128 + m * 16;
                bf16_t* rowp = Y + (size_t)row * D + col0;
                float s = 0.f;
#pragma unroll
                for (int bj = 0; bj < 2; ++bj) {
                    const f32x4 v0 = acc[ai][bj][m][0], v1 = acc[ai][bj][m][1];
                    s += v0[0] * v0[0] + v0[1] * v0[1] + v0[2] * v0[2] + v0[3] * v0[3] + v1[0] * v1[0] + v1[1] * v1[1] + v1[2] * v1[2] + v1[3] * v1[3];
                    u32x4 w; w.x = cvt_pk_bf16(v0[0], v0[1]); w.y = cvt_pk_bf16(v0[2], v0[3]); w.z = cvt_pk_bf16(v1[0], v1[1]); w.w = cvt_pk_bf16(v1[2], v1[3]);
                    *(u32x4*)(rowp + bj * 128) = w;
                }
                s += __shfl_xor(s, 16); s += __shfl_xor(s, 32);
                if (fq == 0) ssq[(size_t)row * 16 + u.pn * 4 + wc] = s;
            }
    }
};
struct EpiWin {
    bf16_t* ZT; bf16_t* HT; bf16_t* QB; bf16_t* KB; bf16_t* VB; const float* rope; float* newk; float* newv; int layer;
    __device__ __forceinline__ void operator()(const f32x4 (&acc)[2][2][4][2], const pg8::Unit& u, int wr, int wc, int fr, int fq) const {
        const int r0 = u.pm * 256 + wr * 64 + fr;
        const bool lat = u.pm >= 32;
        const int pn = u.pn;
        if (pn < 5) {
            bf16_t* base; int t0; size_t sch;
            if (pn < 2) {
                if (!lat) { const int b = u.pm; base = ZT + ((size_t)b * 256 * 2 + pn) * 256; sch = 512; t0 = r0 - u.pm * 256; }
                else { const int b = (u.pm - 32) >> 2; base = ZT + ZT_LAT + ((size_t)b * 256 * 2 + pn) * 1024; sch = 2048; t0 = r0 - NCTX - b * 1024; }
            } else {
                const int c0 = (pn - 2) * 256;
                if (!lat) { const int b = u.pm; base = HT + ((size_t)b * 768 + c0) * 256; sch = 256; t0 = r0 - u.pm * 256; }
                else { const int b = (u.pm - 32) >> 2; base = HT + HT_LAT + ((size_t)b * 768 + c0) * 1024; sch = 1024; t0 = r0 - NCTX - b * 1024; }
            }
#pragma unroll
            for (int ai = 0; ai < 2; ++ai)
#pragma unroll
                for (int m = 0; m < 4; ++m) {
                    const int t = t0 + ai * 128 + m * 16;
#pragma unroll
                    for (int bj = 0; bj < 2; ++bj)
#pragma unroll
                        for (int n = 0; n < 2; ++n) {
                            const int ch = bj * 128 + wc * 32 + n * 16 + 4 * fq;
                            const f32x4 v = acc[ai][bj][m][n];
#pragma unroll
                            for (int e = 0; e < 4; ++e) base[(size_t)(ch + e) * sch + t] = f2bf(v[e]);
                        }
                }
        } else {
            const int blk = wc & 1;
#pragma unroll
            for (int ai = 0; ai < 2; ++ai)
#pragma unroll
                for (int m = 0; m < 4; ++m) {
                    const int row = r0 + ai * 128 + m * 16;
                    f32x4 cs0 = {1.f, 0.f, 1.f, 0.f}, cs1 = {1.f, 0.f, 1.f, 0.f};
                    if (lat) { const int t = row & 1023; const int pos = blk ? (t & 63) : (t >> 6);
                        const f32x4* rp = (const f32x4*)(rope + (size_t)(pos * 16 + 4 * fq) * 2); cs0 = rp[0]; cs1 = rp[1]; }
#pragma unroll
                    for (int bj = 0; bj < 2; ++bj) {
                        f32x4 x1 = acc[ai][bj][m][0], x2 = acc[ai][bj][m][1];
                        const bool isv = (pn == 7 && bj == 1);
                        const bool isk = (pn == 7 && bj == 0);
                        const int cc = bj * 128 + wc * 32 + 4 * fq;
                        if ((isk || isv) && !lat) {
                            const int b = row >> 8, t = row & 255;
                            float* dst = (isk ? newk : newv) + (((size_t)b * 2 + layer) * 256 + t) * 128 + (cc & 127);
                            *(f32x4*)dst = x1; *(f32x4*)(dst + 16) = x2;
                        }
                        if (!isv) {
                            f32x4 o1, o2;
                            o1[0] = x1[0] * cs0[0] - x2[0] * cs0[1]; o2[0] = x2[0] * cs0[0] + x1[0] * cs0[1];
                            o1[1] = x1[1] * cs0[2] - x2[1] * cs0[3]; o2[1] = x2[1] * cs0[2] + x1[1] * cs0[3];
                            o1[2] = x1[2] * cs1[0] - x2[2] * cs1[1]; o2[2] = x2[2] * cs1[0] + x1[2] * cs1[1];
                            o1[3] = x1[3] * cs1[2] - x2[3] * cs1[3]; o2[3] = x2[3] * cs1[2] + x1[3] * cs1[3];
                            x1 = o1; x2 = o2;
                        }
                        bf16_t* dst;
                        if (pn < 7) { x1 *= 0.125f; x2 *= 0.125f; dst = QB + (size_t)row * 512 + (pn - 5) * 256 + cc; }
                        else if (isk) dst = KB + (size_t)row * 128 + cc;
                        else {
                            bf16_t* vb; size_t n_;
                            if (!lat) { vb = VB + (size_t)(row >> 8) * 128 * 256 + (row & 255); n_ = 256; } else { vb = VB + VT_LAT + (size_t)((row - NCTX) >> 10) * 128 * 1024 + (row & 1023); n_ = 1024; }
                            const int c0 = cc - 128;
#pragma unroll
                            for (int e = 0; e < 4; ++e) { vb[(size_t)(c0 + e) * n_] = f2bf(x1[e]); vb[(size_t)(c0 + 16 + e) * n_] = f2bf(x2[e]); }
                            continue;
                        }
                        u32x2 w1, w2; w1.x = cvt_pk_bf16(x1[0], x1[1]); w1.y = cvt_pk_bf16(x1[2], x1[3]); w2.x = cvt_pk_bf16(x2[0], x2[1]); w2.y = cvt_pk_bf16(x2[2], x2[3]);
                        *(u32x2*)dst = w1; *(u32x2*)(dst + 16) = w2;
                    }
                }
        }
    }
};
struct EpiFourier {
    bf16_t* YC; int rowbase, n;
    __device__ __forceinline__ void operator()(const f32x4 (&acc)[2][2][4][2], const pg8::Unit& u, int wr, int wc, int fr, int fq) const {
        const int kp0 = u.pm * 256 + wr * 64 + fr; const int b = u.pn;
#pragma unroll
        for (int ai = 0; ai < 2; ++ai)
#pragma unroll
            for (int m = 0; m < 4; ++m) {
                bf16_t* rowp = YC + (size_t)(rowbase + b * n + kp0 + ai * 128 + m * 16) * 1024 + wc * 32 + 4 * fq;
#pragma unroll
                for (int bj = 0; bj < 2; ++bj)
#pragma unroll
                    for (int nn = 0; nn < 2; ++nn) { const f32x4 v = acc[ai][bj][m][nn]; u32x2 w; w.x = cvt_pk_bf16(v[0], v[1]); w.y = cvt_pk_bf16(v[2], v[3]);
                        *(u32x2*)(rowp + bj * 128 + nn * 16) = w; }
            }
    }
};

struct TrUnit { const float* src; bf16_t* dst; int ld, k0, cbase, Kd, r0, perm; float scale; };
__device__ __forceinline__ TrUnit tr_unit_g(const Params& p, int kind, int idx, int w) {
    TrUnit t; unsigned char* ws = p.ws; t.scale = 1.0f;
    if (kind == 0) { const int rg = w / 16, kb = w % 16; const int pn = rg >> 1, half = rg & 1; t.scale = half ? 0.6931471805599453f : 1.4426950408889634f;
        t.src = (half ? p.in[10] : p.in[9]) + (size_t)idx * 1024 * DFF; t.ld = DFF; t.k0 = kb * 64; t.cbase = pn * 128; t.dst = (bf16_t*)(ws + OFF_WGU + idx * SZ_WGU); t.Kd = 1024; t.r0 = rg * 128; t.perm = 1; }
    else if (kind == 1) { const int rg = w / 44, kb = w % 44;
        t.src = p.in[11] + (size_t)idx * DFF * 1024; t.ld = 1024; t.k0 = kb * 64; t.cbase = rg * 128; t.dst = (bf16_t*)(ws + OFF_WD + idx * SZ_WD); t.Kd = DFF; t.r0 = rg * 128; t.perm = 1; }
    else if (kind == 2) { const int rg = w / 16, kb = w % 16;
        t.src = p.in[13] + (size_t)idx * 1024 * 1024; t.ld = 1024; t.k0 = kb * 64; t.cbase = rg * 128; t.dst = (bf16_t*)(ws + OFF_WOUT + idx * SZ_WOUT); t.Kd = 1024; t.r0 = rg * 128; t.perm = 1; }
    else { const int rg = w / 16, kb = w % 16;
        t.src = p.in[12] + (size_t)idx * 1024 * INW; t.ld = INW; t.k0 = kb * 64; t.cbase = 256 + rg * 128; t.dst = (bf16_t*)(ws + OFF_WIN + idx * SZ_WIN); t.Kd = 1024; t.r0 = 512 + rg * 128; t.perm = 0; }
    return t;
}
__device__ __forceinline__ int tr_slot_count(int slot) { return slot == 0 ? 704 : slot == 1 ? 1376 : slot == 2 ? 1248 : slot == 3 ? 1184 : 352; }
__device__ __forceinline__ TrUnit tr_unit(const Params& p, int slot, int v) {
    if (slot == 0) return tr_unit_g(p, 0, 0, v);
    if (slot == 1) { if (v < 352) return tr_unit_g(p, 1, 0, v); v -= 352; if (v < 192) return tr_unit_g(p, 3, 0, v); v -= 192; if (v < 128) return tr_unit_g(p, 2, 0, v); return tr_unit_g(p, 0, 1, v - 128); }
    if (slot == 2) { if (v < 352) return tr_unit_g(p, 1, 1, v); v -= 352; if (v < 704) return tr_unit_g(p, 0, 2, v); return tr_unit_g(p, 3, 1, v - 704); }
    if (slot == 3) { if (v < 352) return tr_unit_g(p, 1, 2, v); v -= 352; if (v < 128) return tr_unit_g(p, 2, 1, v); return tr_unit_g(p, 0, 3, v - 128); }
    return tr_unit_g(p, 1, 3, v);
}
__device__ __forceinline__ void tr_load(const TrUnit& t, int tid, f32x4 (&v)[4]) {
#pragma unroll
    for (int i = 0; i < 4; ++i) { const int idx = tid + 512 * i, kk = idx >> 5, c4 = idx & 31;
        v[i] = *(const f32x4*)(t.src + (size_t)(t.k0 + kk) * t.ld + t.cbase + c4 * 4); }
}
__device__ __forceinline__ void tr_slot(const Params& p, float* lds, int slot, int blk, int nblk, int tid) {
    const int NU = tr_slot_count(slot);
    constexpr int TS = 132;
    f32x4 v[4];
    int u = blk;
    TrUnit cur; if (u < NU) { cur = tr_unit(p, slot, u); tr_load(cur, tid, v); }
    while (u < NU) {
#pragma unroll
        for (int i = 0; i < 4; ++i) { const int idx = tid + 512 * i, kk = idx >> 5, c4 = idx & 31; *(f32x4*)(lds + kk * TS + c4 * 4) = v[i]; }
        __syncthreads();
        const int un = u + nblk; TrUnit nxt = cur;
        if (un < NU) { nxt = tr_unit(p, slot, un); tr_load(nxt, tid, v); }
        { const int rr = tid >> 2, kc = tid & 3; const int cc = cur.perm ? ((rr & ~31) + perm32(rr & 31)) : rr;
            float x[16];
#pragma unroll
            for (int j = 0; j < 16; ++j) x[j] = lds[(kc * 16 + j) * TS + cc] * cur.scale;
            u32x4 w0, w1; w0.x = pk_bf16(x[0], x[1]); w0.y = pk_bf16(x[2], x[3]); w0.z = pk_bf16(x[4], x[5]); w0.w = pk_bf16(x[6], x[7]);
            w1.x = pk_bf16(x[8], x[9]); w1.y = pk_bf16(x[10], x[11]); w1.z = pk_bf16(x[12], x[13]); w1.w = pk_bf16(x[14], x[15]);
            bf16_t* d = cur.dst + (size_t)(cur.r0 + rr) * cur.Kd + cur.k0 + kc * 16;
            *(u32x4*)d = w0; *(u32x4*)(d + 8) = w1; }
        __syncthreads();
        cur = nxt; u = un;
    }
}
__device__ void phase_prep(const Params& p, float* lds) {
    const int tid = opaque_tid(), nb = gridDim.x, bid = blockIdx.x;
    unsigned char* ws = p.ws;
    tr_slot(p, lds, 0, bid, nb, tid);
    __syncthreads();
    {
        float* tab = lds;
        if (tid < 64) { float sv, cv; sincosf(PI2 * (float)tid / 64.f, &sv, &cv); tab[tid] = cv; tab[64 + tid] = sv; }
        __syncthreads();
        const int lane = tid & 63, wv = tid >> 6;
        for (int u = bid * 8 + wv; u < 8192; u += nb * 8) {
            const int l = u >> 12, k = (u >> 2) & 1023, g = u & 3;
            const float* wrow = p.in[12] + ((size_t)l * 1024 + k) * INW + g * 64;
            const float wv_ = wrow[lane];
            float ac = 0.f, as = 0.f;
#pragma unroll 16
            for (int c = 0; c < 64; ++c) { const float w = __shfl(wv_, c); const int idx = (c * lane) & 63; ac += w * tab[idx]; as += w * tab[64 + idx]; }
            bf16_t* bt = (bf16_t*)(ws + OFF_WIN + l * SZ_WIN);
            bt[(size_t)(g * 64 + lane) * 1024 + k] = f2bf(ac);
            bt[(size_t)(256 + g * 64 + lane) * 1024 + k] = f2bf(as);
        }
        __syncthreads();
    }
    {
        float* sc = lds;
        float* part = lds + 12 * 1024;
        for (int i = tid; i < 9 * 1024; i += NTHREADS) { const int bc = i >> 10, k = i & 1023; const float cv = bc == 0 ? p.in[5][k] : p.in[4][(bc - 1) * 1024 + k]; sc[k * 12 + bc] = cv / (1.0f + expf(-cv)); }
        __syncthreads();
        for (int cb = bid; cb < 256; cb += nb) {
            const int gc0 = cb * 72, l = gc0 / 9216, j0 = gc0 % 9216;
            const int cg = tid % 18, kg = tid / 18;
            if (kg < 28) {
                f32x4 a[9];
#pragma unroll
                for (int i = 0; i < 9; ++i) a[i] = (f32x4){0.f, 0.f, 0.f, 0.f};
                const float* wp = p.in[6] + (size_t)l * 1024 * 9216 + j0 + cg * 4;
#pragma unroll 4
                for (int k = kg; k < 1024; k += 28) { const f32x4 w = *(const f32x4*)(wp + (size_t)k * 9216);
                    const f32x4 s0 = *(const f32x4*)(sc + k * 12), s1 = *(const f32x4*)(sc + k * 12 + 4); const float s8 = sc[k * 12 + 8];
                    a[0] += w * s0[0]; a[1] += w * s0[1]; a[2] += w * s0[2]; a[3] += w * s0[3]; a[4] += w * s1[0]; a[5] += w * s1[1]; a[6] += w * s1[2]; a[7] += w * s1[3]; a[8] += w * s8; }
#pragma unroll
                for (int i = 0; i < 9; ++i)
#pragma unroll
                    for (int e = 0; e < 4; ++e) part[(kg * 72 + cg * 4 + e) * 9 + i] = a[i][e];
            }
            __syncthreads();
            for (int i = tid; i < 72 * 9; i += NTHREADS) { const int c2 = i / 9, bc = i % 9; float s = 0.f;
#pragma unroll
                for (int g = 0; g < 28; ++g) s += part[(g * 72 + c2) * 9 + bc];
                ((float*)(ws + OFF_MOD))[((size_t)l * 9 + bc) * 9216 + j0 + c2] = s + p.in[7][l * 9216 + j0 + c2]; }
            __syncthreads();
        }
    }
    __syncthreads();
    {
        const int lane = tid & 63, wv = tid >> 6;
        float* h2s = lds;
        const int u0 = bid * 10; const int l = u0 / 1280;
        if (u0 < 2560) {
            const float* w1 = p.in[15] + l * 33 * 64; const float* b1 = p.in[16] + l * 64; const float* w2 = p.in[17] + l * 64 * 64; const float* b2 = p.in[18] + l * 64;
            const float* w3 = p.in[19] + (size_t)l * 64 * 1024; const float fr = p.in[20][l * 64 + lane];
            for (int q = wv; q < 10; q += 8) {
                const int rem = (u0 + q) % 1280; const int pass = rem >= 256; const int n = pass ? 1024 : 256; const int d = pass ? rem - 256 : rem;
                const float tt = (float)d / (float)(n - 1);
                float feat = 0.f;
                if (lane == 0) feat = tt;
                else if (lane < 33) { const int j = (lane - 1) & 15; const float fj = 1e-4f + (float)j * ((15.0f - 1e-4f) / 15.0f); const float ang = (PI2 / (float)n) * (float)d * fj;
                    feat = lane < 17 ? cosf(ang) : -sinf(ang); }
                float a1 = b1[lane];
#pragma unroll
                for (int i = 0; i < 33; ++i) a1 += __shfl(feat, i) * w1[i * 64 + lane];
                const float h1 = sinf(fr * a1);
                float a2 = b2[lane];
#pragma unroll
                for (int i = 0; i < 64; ++i) a2 += __shfl(h1, i) * w2[i * 64 + lane];
                h2s[lane * 12 + q] = sinf(fr * a2);
            }
            __syncthreads();
            float acc[2][10];
#pragma unroll
            for (int q = 0; q < 10; ++q) { acc[0][q] = 0.f; acc[1][q] = 0.f; }
#pragma unroll 8
            for (int i = 0; i < 64; ++i) {
                const float wa = w3[i * 1024 + tid], wb = w3[i * 1024 + 512 + tid];
                const f32x4 ha = *(const f32x4*)(h2s + i * 12), hb = *(const f32x4*)(h2s + i * 12 + 4); const float h8 = h2s[i * 12 + 8], h9 = h2s[i * 12 + 9];
                acc[0][0] += ha[0] * wa; acc[0][1] += ha[1] * wa; acc[0][2] += ha[2] * wa; acc[0][3] += ha[3] * wa; acc[0][4] += hb[0] * wa; acc[0][5] += hb[1] * wa; acc[0][6] += hb[2] * wa; acc[0][7] += hb[3] * wa; acc[0][8] += h8 * wa; acc[0][9] += h9 * wa;
                acc[1][0] += ha[0] * wb; acc[1][1] += ha[1] * wb; acc[1][2] += ha[2] * wb; acc[1][3] += ha[3] * wb; acc[1][4] += hb[0] * wb; acc[1][5] += hb[1] * wb; acc[1][6] += hb[2] * wb; acc[1][7] += hb[3] * wb; acc[1][8] += h8 * wb; acc[1][9] += h9 * wb;
            }
            const int ord = (tid >> 8) & 1, c = tid & 255;
            const float dec = fabsf(p.in[21][(l * 2 + ord) * 256 + c]);
            bf16_t* gl = (bf16_t*)(ws + OFF_FILT) + (size_t)l * G_L;
#pragma unroll
            for (int q = 0; q < 10; ++q) {
                const int rem = (u0 + q) % 1280; const int pass = rem >= 256; const int n = pass ? 1024 : 256; const int d = pass ? rem - 256 : rem;
                const float tt = (float)d / (float)(n - 1); const float win = expf(-tt * dec) / (float)(2 * n);
                bf16_t* g = gl + (pass ? G_CTX : 0) + ((size_t)ord * 256 + c) * (2 * n);
                g[n - 1 - d] = f2bf(acc[0][q] * win);
                g[d == 0 ? 2 * n - 1 : n - 1 + d] = d == 0 ? (bf16_t)0 : f2bf(acc[1][q] * win);
            }
        }
        __syncthreads();
    }
    __syncthreads();
    {
        bf16_t* FC = (bf16_t*)(ws + OFF_FC); bf16_t* FL = (bf16_t*)(ws + OFF_FL);
        const int gt = bid * NTHREADS + tid, gn = nb * NTHREADS;
        for (int i = gt; i < 256 * 512 + 1024 * 2048; i += gn) {
            int n, k, col; bf16_t* dst;
            if (i < 256 * 512) { n = 256; k = i >> 9; col = i & 511; dst = FC + i; } else { const int j = i - 256 * 512; n = 1024; k = j >> 11; col = j & 2047; dst = FL + j; }
            const int s = col >= n, t = col - s * n; const int ph = (k * t) & (n - 1);
            float sv, cv; sincosf(PI2 * (float)ph / (float)n, &sv, &cv);
            const float sc = rsqrtf(64.0f * (float)n);
            *dst = f2bf((s ? -sv : cv) * sc);
        }
        { bf16_t* CK = (bf16_t*)(ws + OFF_CKB); bf16_t* CV = (bf16_t*)(ws + OFF_CVT);
            for (int i = gt; i < 2 * 8 * 256 * 128; i += gn) {
                { const int c = i & 127, key = (i >> 7) & 255, b = (i >> 15) & 7, l = i >> 18;
                    CK[i] = f2bf(p.in[2][(((size_t)b * 2 + l) * 256 + key) * 128 + c]); }
                { const int key = i & 255, c = (i >> 8) & 127, b = (i >> 15) & 7, l = i >> 18;
                    CV[i] = f2bf(p.in[3][(((size_t)b * 2 + l) * 256 + key) * 128 + c]); }
            } }
        if (bid == 0) for (int i = tid; i < 64 * 16; i += NTHREADS) { const int pos = i >> 4, j = i & 15; const float inv = powf(10000.0f, -(float)(2 * j) / 32.0f);
            float sv, cv; sincosf((float)pos * inv, &sv, &cv); float* rp = (float*)(ws + OFF_ROPE); rp[2 * i] = cv; rp[2 * i + 1] = sv; }
    }
    __syncthreads();
}

template <int MODE>
__device__ void phase_row(const Params& p, int lpost, int spost, int lpre, int spre) {
    const int tid_ = opaque_tid(); const int lane = tid_ & 63, wv = tid_ >> 6;
    GAS unsigned char* wsg = (GAS unsigned char*)p.ws; asm volatile("" : "+s"(wsg));
    const GAS float* mod = (const GAS float*)(wsg + OFF_MOD);
    const GAS bf16_t* Y = (const GAS bf16_t*)(wsg + OFF_Y); const GAS float* ssq = (const GAS float*)(wsg + OFF_SSQ);
    GAS bf16_t* H = (GAS bf16_t*)(wsg + OFF_H);
    const float factor = (spost == 1) ? 1.0f : 0.5f;
    for (int rbase = (blockIdx.x * 8 + wv) * 8; rbase < NTOK; rbase += gridDim.x * 64) {
        const int bc = rbase < NCTX ? 0 : 1 + ((rbase - NCTX) >> 10);
        f32x4 coef[4], gsc[4], sh[4];
        if (MODE != 0) { const GAS float* gate = mod + ((size_t)lpost * 9 + bc) * 9216 + spost * 3072 + 2048; const float* gp = p.in[8] + (lpost * 6 + 2 * spost + 1) * 1024;
#pragma unroll
            for (int j = 0; j < 4; ++j) { const int c = j * 256 + lane * 4; coef[j] = *(const GAS f32x4*)(gate + c) * *(const f32x4*)(gp + c) * factor; } }
        if (MODE != 2) { const GAS float* mb = mod + ((size_t)lpre * 9 + bc) * 9216 + spre * 3072; const float* gp = p.in[8] + (lpre * 6 + 2 * spre) * 1024;
#pragma unroll
            for (int j = 0; j < 4; ++j) { const int c = j * 256 + lane * 4; sh[j] = *(const GAS f32x4*)(mb + c); gsc[j] = *(const f32x4*)(gp + c) * (*(const GAS f32x4*)(mb + 1024 + c) + 1.0f); } }
#pragma unroll 1
        for (int rp = 0; rp < 8; rp += 2) {
            f32x4 x[2][4]; u32x2 yv[2][4]; f32x4 sq[2][4];
#pragma unroll
            for (int q = 0; q < 2; ++q) {
                const int rw = rbase + rp + q;
                if (MODE == 0 || (lpost == 0 && spost == 0)) { const float* src = rw < NCTX ? p.in[0] + (size_t)rw * D : p.in[1] + (size_t)(rw - NCTX) * D;
#pragma unroll
                    for (int j = 0; j < 4; ++j) x[q][j] = *(const f32x4*)(src + j * 256 + lane * 4); }
                else {
#pragma unroll
                    for (int j = 0; j < 4; ++j) x[q][j] = *(const f32x4*)(p.out + (size_t)rw * D + j * 256 + lane * 4); }
                if (MODE != 0) {
#pragma unroll
                    for (int j = 0; j < 4; ++j) yv[q][j] = *(const GAS u32x2*)(Y + (size_t)rw * D + j * 256 + lane * 4);
                    const GAS f32x4* sp = (const GAS f32x4*)(ssq + (size_t)rw * 16);
#pragma unroll
                    for (int j = 0; j < 4; ++j) sq[q][j] = sp[j];
                }
            }
#pragma unroll
            for (int q = 0; q < 2; ++q) {
                const int row = rbase + rp + q;
                if (MODE != 0) {
                    float tot = 0.f;
#pragma unroll
                    for (int j = 0; j < 4; ++j) tot += (sq[q][j][0] + sq[q][j][1]) + (sq[q][j][2] + sq[q][j][3]);
                    const float rstd = rsqrtf(tot * (1.0f / 1024.0f) + EPS);
#pragma unroll
                    for (int j = 0; j < 4; ++j) {
                        x[q][j][0] += coef[j][0] * rstd * __uint_as_float(yv[q][j].x << 16);
                        x[q][j][1] += coef[j][1] * rstd * __uint_as_float(yv[q][j].x & 0xFFFF0000u);
                        x[q][j][2] += coef[j][2] * rstd * __uint_as_float(yv[q][j].y << 16);
                        x[q][j][3] += coef[j][3] * rstd * __uint_as_float(yv[q][j].y & 0xFFFF0000u); }
#pragma unroll
                    for (int j = 0; j < 4; ++j) *(f32x4*)(p.out + (size_t)row * D + j * 256 + lane * 4) = x[q][j];
                }
                if (MODE != 2) {
                    float s = 0.f;
#pragma unroll
                    for (int j = 0; j < 4; ++j) s += x[q][j][0] * x[q][j][0] + x[q][j][1] * x[q][j][1] + x[q][j][2] * x[q][j][2] + x[q][j][3] * x[q][j][3];
#pragma unroll
                    for (int o = 32; o >= 1; o >>= 1) s += __shfl_xor(s, o);
                    const float rs = rsqrtf(s * (1.0f / 1024.0f) + EPS);
#pragma unroll
                    for (int j = 0; j < 4; ++j) { const int c = j * 256 + lane * 4;
                        const f32x4 hh = x[q][j] * rs * gsc[j] + sh[j];
                        u32x2 w; w.x = pk_bf16(hh[0], hh[1]); w.y = pk_bf16(hh[2], hh[3]);
                        *(GAS u32x2*)(H + (size_t)row * D + c) = w; }
                }
            }
        }
    }
}

constexpr int AT_KROWB = 144;
constexpr int AT_VROWB_A = 784, AT_VROWB_B = 528;
constexpr int AT_OFF_V = 320 * AT_KROWB;
struct AttnState { f32x16 O0, O1; float m, lsum; };
template <bool MASK>
__device__ __forceinline__ void attn_tiles(AttnState& st, const bf16x8 (&qf)[4], const LAS unsigned char* Kl, const LAS unsigned char* Vl, int vrowb, int t0, int t1, int dk0, int r, int h) {
    for (int t = t0; t < t1; ++t) {
        const LAS unsigned char* kp = Kl + (t * 32 + r) * AT_KROWB + h * 16;
        bf16x8 kf[4];
#pragma unroll
        for (int kk = 0; kk < 4; ++kk) kf[kk] = *(const LAS bf16x8*)(kp + kk * 32);
        const LAS unsigned char* vp = Vl + r * vrowb + (t * 32 + 4 * h) * 2;
        u32x2 vraw[2][2][2];
#pragma unroll
        for (int dt = 0; dt < 2; ++dt)
#pragma unroll
            for (int s = 0; s < 2; ++s)
#pragma unroll
                for (int q = 0; q < 2; ++q) vraw[dt][s][q] = *(const LAS u32x2*)(vp + dt * 32 * vrowb + (16 * s + 8 * q) * 2);
        f32x16 S;
#pragma unroll
        for (int i = 0; i < 16; ++i) S[i] = 0.f;
#pragma unroll
        for (int kk = 0; kk < 4; ++kk) S = __builtin_amdgcn_mfma_f32_32x32x16_bf16(kf[kk], qf[kk], S, 0, 0, 0);
        if (MASK) {
            const int dk = dk0 + t * 32;
            if (dk <= -128 || dk >= 128) {
#pragma unroll
                for (int i = 0; i < 16; ++i) { const int j = (i & 3) + 8 * (i >> 2) + 4 * h; int dd = dk + j - r; if (dd < 0) dd = -dd; if (dd > 128) S[i] = -1e30f; }
            }
        }
        float mx = S[0];
#pragma unroll
        for (int i = 1; i < 16; ++i) mx = fmaxf(mx, S[i]);
        mx = fmaxf(mx, __shfl_xor(mx, 32));
        const float mn = fmaxf(st.m, mx), corr = __expf(st.m - mn);
        st.m = mn;
        float rs = 0.f;
#pragma unroll
        for (int i = 0; i < 16; ++i) { S[i] = __expf(S[i] - mn); rs += S[i]; }
        rs += __shfl_xor(rs, 32);
        st.lsum = st.lsum * corr + rs;
#pragma unroll
        for (int i = 0; i < 16; ++i) { st.O0[i] *= corr; st.O1[i] *= corr; }
        bf16x8 pf[2];
#pragma unroll
        for (int s = 0; s < 2; ++s) { u32x4 w; w.x = pk_bf16(S[8 * s], S[8 * s + 1]); w.y = pk_bf16(S[8 * s + 2], S[8 * s + 3]); w.z = pk_bf16(S[8 * s + 4], S[8 * s + 5]); w.w = pk_bf16(S[8 * s + 6], S[8 * s + 7]);
            pf[s] = __builtin_bit_cast(bf16x8, w); }
#pragma unroll
        for (int s = 0; s < 2; ++s) {
            u32x4 a0; a0.x = vraw[0][s][0].x; a0.y = vraw[0][s][0].y; a0.z = vraw[0][s][1].x; a0.w = vraw[0][s][1].y;
            u32x4 a1; a1.x = vraw[1][s][0].x; a1.y = vraw[1][s][0].y; a1.z = vraw[1][s][1].x; a1.w = vraw[1][s][1].y;
            st.O0 = __builtin_amdgcn_mfma_f32_32x32x16_bf16(__builtin_bit_cast(bf16x8, a0), pf[s], st.O0, 0, 0, 0);
            st.O1 = __builtin_amdgcn_mfma_f32_32x32x16_bf16(__builtin_bit_cast(bf16x8, a1), pf[s], st.O1, 0, 0, 0);
        }
    }
}
__device__ __forceinline__ void attn_unit(const Params& p, int l, int u, LAS unsigned char* lds, int tid) {
    const int lane = tid & 63, wv = tid >> 6, r = lane & 31, h = lane >> 5;
    const bf16_t* QB = (const bf16_t*)(p.ws + OFF_QB); const bf16_t* KB = (const bf16_t*)(p.ws + OFF_KB); const bf16_t* VT = (const bf16_t*)(p.ws + OFF_VB);
    const bf16_t* CK = (const bf16_t*)(p.ws + OFF_CKB); const bf16_t* CV = (const bf16_t*)(p.ws + OFF_CVT);
    bf16_t* YC = (bf16_t*)(p.ws + OFF_YCAT);
    const int g = wv & 3, qh = wv >> 2;
    const int pass = u < 256; const int v = u & 255;
    int b, kvh, qb, n, rowbase;
    if (!pass) { b = v >> 3; kvh = (v >> 2) & 1; qb = v & 3; n = 256; rowbase = b * 256; }
    else { b = v >> 5; kvh = (v >> 4) & 1; qb = v & 15; n = 1024; rowbase = NCTX + b * 1024; }
    const int head = kvh * 4 + g, q0w = qb * 64 + qh * 32;
    int kloU = 0, khiU = 256;
    if (pass) { kloU = qb * 64 - 128; if (kloU < 0) kloU = 0; khiU = qb * 64 + 192; if (khiU > n) khiU = n; }
    const int nkA = khiU - kloU, npc = nkA * 8, vpr = nkA >> 3;
    const bf16_t* kA = KB + (size_t)(rowbase + kloU) * 128 + kvh * 64;
    const bf16_t* vA = VT + (pass ? VT_LAT + (size_t)b * 128 * 1024 : (size_t)b * 128 * 256) + (size_t)kvh * 64 * n + kloU;
    {
        u32x4 kr[5], vr[5];
#pragma unroll
        for (int it = 0; it < 5; ++it) { const int idx = tid + it * NTHREADS;
            if (idx < npc) { kr[it] = *(const u32x4*)(kA + (size_t)(idx >> 3) * 128 + (idx & 7) * 8);
                const int d = idx / vpr, j = idx - d * vpr; vr[it] = *(const u32x4*)(vA + (size_t)d * n + j * 8); } }
#pragma unroll
        for (int it = 0; it < 5; ++it) { const int idx = tid + it * NTHREADS;
            if (idx < npc) { *(LAS u32x4*)(lds + (idx >> 3) * AT_KROWB + (idx & 7) * 16) = kr[it];
                const int d = idx / vpr, j = idx - d * vpr; *(LAS u32x4*)(lds + AT_OFF_V + d * AT_VROWB_A + j * 16) = vr[it]; } }
    }
    bf16x8 qf[4];
    { const bf16_t* qp = QB + (size_t)(rowbase + q0w + r) * 512 + head * 64 + 8 * h;
#pragma unroll
        for (int kk = 0; kk < 4; ++kk) qf[kk] = *(const bf16x8*)(qp + 16 * kk); }
    AttnState st; st.m = p.in[23][l * 8 + head]; st.lsum = 1.0f;
#pragma unroll
    for (int i = 0; i < 16; ++i) { st.O0[i] = 0.f; st.O1[i] = 0.f; }
    __syncthreads();
    u32x4 kb[4], vb[4];
    if (pass) {
        const bf16_t* kB = CK + ((size_t)(l * 8 + b) * 256) * 128 + kvh * 64;
        const bf16_t* vB = CV + ((size_t)(l * 8 + b) * 128 + kvh * 64) * 256;
#pragma unroll
        for (int it = 0; it < 4; ++it) { const int idx = tid + it * NTHREADS;
            kb[it] = *(const u32x4*)(kB + (size_t)(idx >> 3) * 128 + (idx & 7) * 8);
            vb[it] = *(const u32x4*)(vB + (size_t)(idx >> 5) * 256 + (idx & 31) * 8); }
    }
    {
        int klo = 0, khi = 256;
        if (pass) { klo = q0w - 128; if (klo < 0) klo = 0; khi = q0w + 160; if (khi > n) khi = n; }
        const int t0 = (klo - kloU) >> 5, t1 = (khi - kloU) >> 5;
        if (pass) attn_tiles<true>(st, qf, lds, lds + AT_OFF_V, AT_VROWB_A, t0, t1, kloU - q0w, r, h);
        else attn_tiles<false>(st, qf, lds, lds + AT_OFF_V, AT_VROWB_A, t0, t1, 0, r, h);
    }
    if (pass) {
        __syncthreads();
#pragma unroll
        for (int it = 0; it < 4; ++it) { const int idx = tid + it * NTHREADS;
            *(LAS u32x4*)(lds + (idx >> 3) * AT_KROWB + (idx & 7) * 16) = kb[it];
            *(LAS u32x4*)(lds + AT_OFF_V + (idx >> 5) * AT_VROWB_B + (idx & 31) * 16) = vb[it]; }
        __syncthreads();
        attn_tiles<false>(st, qf, lds, lds + AT_OFF_V, AT_VROWB_B, 0, 8, 0, r, h);
    }
    const float inv = 1.0f / st.lsum;
    bf16_t* op = YC + (size_t)(rowbase + q0w + r) * 1024 + 512 + head * 64 + 4 * h;
#pragma unroll
    for (int gq = 0; gq < 4; ++gq) {
        u32x2 w0; w0.x = pk_bf16(st.O0[4 * gq] * inv, st.O0[4 * gq + 1] * inv); w0.y = pk_bf16(st.O0[4 * gq + 2] * inv, st.O0[4 * gq + 3] * inv);
        u32x2 w1; w1.x = pk_bf16(st.O1[4 * gq] * inv, st.O1[4 * gq + 1] * inv); w1.y = pk_bf16(st.O1[4 * gq + 2] * inv, st.O1[4 * gq + 3] * inv);
        *(u32x2*)(op + 8 * gq) = w0; *(u32x2*)(op + 32 + 8 * gq) = w1;
    }
    __syncthreads();
}
__device__ void attn_mfma(const Params& p, int l, LAS unsigned char* lds) {
    const int tid = opaque_tid();
    for (int u = blockIdx.x; u < 512; u += gridDim.x) attn_unit(p, l, u, lds, tid);
}

template <int NB  , int NBLK  >
__device__ __forceinline__ void hyena_unit(const Params& p, int l, int c, const bf16_t* __restrict__ HTp, int rowbase, const bf16_t* __restrict__ gb, LAS unsigned char* lds, int tid) {
    constexpr int n = 32 * NBLK, NI = 32 / NB, PAD = 32 * (NI - 1);
    constexpr int LENB = (2 * n * 2 - 64 + 255) / 256 * 256 + 64;
    constexpr int UROWB = ((n + 2 * PAD) * 2 + 255) / 256 * 256 + 16;
    constexpr int GSB = (2 * n + 8) * 2;
    constexpr int OFF_F0 = 0, OFF_F1 = 8 * LENB, OFF_U = 16 * LENB, OFF_U2 = OFF_U + NB * UROWB, OFF_G1 = OFF_U2 + NB * UROWB, OFF_G2 = OFF_G1 + NB * n * 2, OFF_GS = OFF_G2 + NB * n * 2;
    static_assert(OFF_GS + 2 * GSB <= 149 * 1024, "hyena LDS");
    const int lane = tid & 63, wv = tid >> 6, r = lane & 31, h = lane >> 5;
    const float* cw = p.in[14] + l * 3 * 768;
    if (tid < 2 * (2 * n / 8)) { const int o = tid / (2 * n / 8), k = tid % (2 * n / 8);
        *(LAS u32x4*)(lds + OFF_GS + o * GSB + k * 16) = *(const u32x4*)(gb + ((size_t)o * 256 + c) * (2 * n) + k * 8); }
    if (tid < 2) *(LAS u32x4*)(lds + OFF_GS + tid * GSB + 2 * n * 2) = (u32x4){0u, 0u, 0u, 0u};
    constexpr int NQ = 3 * NB * (n / 8) / NTHREADS;
#pragma unroll
    for (int it = 0; it < NQ; ++it) {
        const int q = tid + it * NTHREADS;
        const int w = q / (NB * (n / 8)), rem = q % (NB * (n / 8)), b = rem / (n / 8), t0 = (rem % (n / 8)) * 8;
        const int ch = w * 256 + c; const bf16_t* row = HTp + ((size_t)b * 768 + ch) * n;
        const float w0 = cw[ch], w1 = cw[768 + ch], w2 = cw[1536 + ch];
        const u32x4 raw = *(const u32x4*)(row + t0);
        float x[10];
        x[0] = t0 > 0 ? bf2f(row[t0 - 1]) : 0.f; x[9] = t0 + 8 < n ? bf2f(row[t0 + 8]) : 0.f;
        x[1] = __uint_as_float(raw.x << 16); x[2] = __uint_as_float(raw.x & 0xFFFF0000u); x[3] = __uint_as_float(raw.y << 16); x[4] = __uint_as_float(raw.y & 0xFFFF0000u);
        x[5] = __uint_as_float(raw.z << 16); x[6] = __uint_as_float(raw.z & 0xFFFF0000u); x[7] = __uint_as_float(raw.w << 16); x[8] = __uint_as_float(raw.w & 0xFFFF0000u);
        float z[8];
#pragma unroll
        for (int e = 0; e < 8; ++e) z[e] = x[e] * w0 + x[e + 1] * w1 + x[e + 2] * w2;
        u32x4 o; o.x = pk_bf16(z[0], z[1]); o.y = pk_bf16(z[2], z[3]); o.z = pk_bf16(z[4], z[5]); o.w = pk_bf16(z[6], z[7]);
        LAS unsigned char* dst = w == 0 ? lds + OFF_U + b * UROWB + (PAD + t0) * 2 : lds + (w == 1 ? OFF_G1 : OFF_G2) + (b * n + t0) * 2;
        *(LAS u32x4*)dst = o;
    }
    if (PAD > 0) {
        constexpr int FR = PAD / 8, BK_ = (UROWB / 2 - PAD - n) / 8;
        for (int q = tid; q < 2 * NB * (FR + BK_); q += NTHREADS) {
            const int buf = q / (NB * (FR + BK_)), rem = q % (NB * (FR + BK_)), b = rem / (FR + BK_), k = rem % (FR + BK_);
            const int e0 = k < FR ? k * 8 : PAD + n + (k - FR) * 8;
            *(LAS u32x4*)(lds + (buf ? OFF_U2 : OFF_U) + b * UROWB + e0 * 2) = (u32x4){0u, 0u, 0u, 0u};
        }
    }
    __syncthreads();
    if (tid < 2 * (2 * n / 8)) { const int o = tid / (2 * n / 8), k = tid % (2 * n / 8);
        const u32x4 lo = *(const LAS u32x4*)(lds + OFF_GS + o * GSB + k * 16), hi = *(const LAS u32x4*)(lds + OFF_GS + o * GSB + k * 16 + 16);
        const unsigned d[8] = {lo.x, lo.y, lo.z, lo.w, hi.x, hi.y, hi.z, hi.w};
        LAS unsigned char* fdst = lds + (o ? OFF_F1 : OFF_F0) + k * 16;
#pragma unroll
        for (int s = 0; s < 8; ++s) { u32x4 w;
            if ((s & 1) == 0) { w.x = d[s / 2]; w.y = d[s / 2 + 1]; w.z = d[s / 2 + 2]; w.w = d[s / 2 + 3]; }
            else { w.x = __builtin_amdgcn_alignbyte(d[s / 2 + 1], d[s / 2], 2); w.y = __builtin_amdgcn_alignbyte(d[s / 2 + 2], d[s / 2 + 1], 2);
                   w.z = __builtin_amdgcn_alignbyte(d[s / 2 + 3], d[s / 2 + 2], 2); w.w = __builtin_amdgcn_alignbyte(d[s / 2 + 4], d[s / 2 + 3], 2); }
            *(LAS u32x4*)(fdst + s * LENB) = w; }
    }
    __syncthreads();
    const int bcol = NB == 8 ? (r >> 2) : r, ioff = NB == 8 ? (r & 3) : 0, I0 = wv * NI, Icol = I0 + ioff;
    const int si = (7 - r) & 7;
    const int Dlo = I0 + NI - 1 - (NBLK - 1) - (NI - 1), Dhi = I0 + NI - 1;
    bf16_t* YC = (bf16_t*)(p.ws + OFF_YCAT);
#pragma unroll
    for (int o = 0; o < 2; ++o) {
        const LAS unsigned char* ap = lds + (o ? OFF_F1 : OFF_F0) + si * LENB + (n - 1 - r + 8 * h - si) * 2 - 64 * Dlo;
        const LAS unsigned char* bp = lds + (o ? OFF_U2 : OFF_U) + bcol * UROWB + (PAD + 32 * Icol + 8 * h) * 2 - 64 * Dlo;
        f32x16 acc;
#pragma unroll
        for (int i = 0; i < 16; ++i) acc[i] = 0.f;
#pragma unroll 4
        for (int D = Dlo; D <= Dhi; ++D) {
            const bf16x8 a0 = *(const LAS bf16x8*)ap, a1 = *(const LAS bf16x8*)(ap + 32);
            const bf16x8 b0 = *(const LAS bf16x8*)bp, b1 = *(const LAS bf16x8*)(bp + 32);
            acc = __builtin_amdgcn_mfma_f32_32x32x16_bf16(a0, b0, acc, 0, 0, 0);
            acc = __builtin_amdgcn_mfma_f32_32x32x16_bf16(a1, b1, acc, 0, 0, 0);
            ap -= 64; bp -= 64;
        }
        const float bias = p.in[22][(l * 2 + o) * 256 + c];
#pragma unroll
        for (int g = 0; g < 4; ++g) {
            const int t0 = 32 * Icol + 8 * g + 4 * h;
            const u32x2 uin = *(const LAS u32x2*)(lds + (o ? OFF_U2 : OFF_U) + bcol * UROWB + (PAD + t0) * 2);
            const u32x2 gin = *(const LAS u32x2*)(lds + (o ? OFF_G2 : OFF_G1) + (bcol * n + t0) * 2);
            float y[4];
            y[0] = __uint_as_float(gin.x << 16) * (acc[4 * g] + bias * __uint_as_float(uin.x << 16));
            y[1] = __uint_as_float(gin.x & 0xFFFF0000u) * (acc[4 * g + 1] + bias * __uint_as_float(uin.x & 0xFFFF0000u));
            y[2] = __uint_as_float(gin.y << 16) * (acc[4 * g + 2] + bias * __uint_as_float(uin.y << 16));
            y[3] = __uint_as_float(gin.y & 0xFFFF0000u) * (acc[4 * g + 3] + bias * __uint_as_float(uin.y & 0xFFFF0000u));
            if (o == 0) { u32x2 w; w.x = pk_bf16(y[0], y[1]); w.y = pk_bf16(y[2], y[3]);
                *(LAS u32x2*)(lds + OFF_U2 + bcol * UROWB + (PAD + t0) * 2) = w; }
            else { bf16_t* dst = YC + (size_t)(rowbase + bcol * n + t0) * 1024 + 256 + c;
#pragma unroll
                for (int e = 0; e < 4; ++e) dst[(size_t)e * 1024] = f2bf(y[e]); }
        }
        __syncthreads();
    }
}
__device__ void hyena_mfma(const Params& p, int l, LAS unsigned char* lds) {
    const int tid = opaque_tid();
    const bf16_t* HT = (const bf16_t*)(p.ws + OFF_HT);
    const bf16_t* gl = (const bf16_t*)(p.ws + OFF_FILT) + (size_t)l * G_L;
    for (int u = blockIdx.x; u < 512; u += gridDim.x) {
        if (u < 256) hyena_unit<8, 32>(p, l, u, HT + HT_LAT, NCTX, gl + G_CTX, lds, tid);
        else hyena_unit<32, 8>(p, l, u - 256, HT, 0, gl, lds, tid);
    }
}


struct OneUnit { int pm, pn;
    __device__ __forceinline__ bool next(int i, pg8::Unit& u) const { if (i) return false; u.pm = pm; u.pn = pn; return true; }
    __device__ __forceinline__ void a_ready(const pg8::Unit&) const {}
    __device__ __forceinline__ void done(const pg8::Unit&) const {} };
__device__ void mixer_phase(const Params& p, int l, LAS unsigned char* lds) {
    constexpr int NU = 32 + 256 + 256 + 32 + 256 + 256;
    GAS unsigned char* wsg = (GAS unsigned char*)p.ws; asm volatile("" : "+s"(wsg)); unsigned char* ws = (unsigned char*)wsg;
    unsigned* ctr = (unsigned*)(ws + OFF_BAR) + 64 * l;
    volatile LAS unsigned* slot = (volatile LAS unsigned*)(lds + 149 * 1024 + 8);
    const bf16_t* HT = (const bf16_t*)(ws + OFF_HT);
    const bf16_t* gl = (const bf16_t*)(ws + OFF_FILT) + (size_t)l * G_L;
    int u = blockIdx.x;
    while (u < NU) {
        unsigned ticket = 0;
        if (threadIdx.x == 0) ticket = __hip_atomic_fetch_add(ctr, 1u, __ATOMIC_RELAXED, __HIP_MEMORY_SCOPE_AGENT);
        const int tid = opaque_tid();
        if (u < 32) {
            pg8::Gemm g{(const bf16_t*)(ws + OFF_FL), (const bf16_t*)(ws + OFF_ZT) + ZT_LAT, 1024, 2048, 2048, 2048, 2048};
            OneUnit S{u & 3, u >> 2}; EpiFourier E{(bf16_t*)(ws + OFF_YCAT), NCTX, 1024};
            pg8::gemm_phase(lds, g, S, E);
        } else if (u < 288) attn_unit(p, l, u - 32, lds, tid);
        else if (u < 544) hyena_unit<8, 32>(p, l, u - 288, HT + HT_LAT, NCTX, gl + G_CTX, lds, tid);
        else if (u < 576) {
            pg8::Gemm g{(const bf16_t*)(ws + OFF_FC), (const bf16_t*)(ws + OFF_ZT), 256, 8192, 512, 512, 512};
            OneUnit S{0, u - 544}; EpiFourier E{(bf16_t*)(ws + OFF_YCAT), 0, 256};
            pg8::gemm_phase(lds, g, S, E);
        } else if (u < 832) attn_unit(p, l, 256 + (u - 576), lds, tid);
        else hyena_unit<32, 8>(p, l, u - 832, HT, 0, gl, lds, tid);
        if (threadIdx.x == 0) *slot = ticket + 256u;
        __syncthreads();
        u = (int)*slot;
        __syncthreads();
    }
}

__global__ void __launch_bounds__(NTHREADS, 2) fwd_megakernel(Params p) {
    extern __shared__ __attribute__((aligned(16))) unsigned char shm[];
    cg::grid_group grid = cg::this_grid();
    LAS unsigned char* lds = (LAS unsigned char*)shm;
    float* ldsf = (float*)shm;
    unsigned char* ws = p.ws;
    const int G = gridDim.x, c = blockIdx.x;

    volatile LAS unsigned* xst = (volatile LAS unsigned*)(lds + 149 * 1024);
    if (threadIdx.x < 4) xst[threadIdx.x] = 0u;
    __syncthreads();
    const XcdBarrier xb = xcd_barrier_post((unsigned*)(ws + OFF_BAR), xst);
    for (int _d = 0; _d < DUP_PREP; ++_d) { phase_prep(p, ldsf); __syncthreads(); }
    if (p.ws == nullptr) grid.sync();
    GSYNC();
    phase_row<0>(p, 0, 0, 0, 0);
    GSYNC();
    for (int l = 0; l < 2; ++l) {
        for (int s = 0; s < 3; ++s) {
            GAS unsigned char* wsg = (GAS unsigned char*)p.ws; asm volatile("" : "+s"(wsg)); unsigned char* ws = (unsigned char*)wsg;
            if (s != 1) {
                const int fs = s >> 1;
                { pg8::Gemm g{(const bf16_t*)(ws + OFF_H), (const bf16_t*)(ws + OFF_WGU + (l * 2 + fs) * SZ_WGU), NTOK, 5632, 1024, 1024, 1024};
                    pg8::StaticOrder S; S.init(g.M, g.N, G, c); EpiSwiglu E{(bf16_t*)(ws + OFF_ACT)};
                    for (int _d = 0; _d < DUP_GEMM; ++_d) pg8::gemm_phase(lds, g, S, E); }
                { int cc = c, gg = G; asm volatile("" : "+s"(cc), "+s"(gg));
                    if (cc >= 1408 - 5 * gg) { __syncthreads(); tr_slot(p, ldsf, 1 + l * 2 + fs, cc - (1408 - 5 * gg), gg - (1408 - 5 * gg), opaque_tid()); } }
                GSYNC();
                { pg8::Gemm g{(const bf16_t*)(ws + OFF_ACT), (const bf16_t*)(ws + OFF_WD + (l * 2 + fs) * SZ_WD), NTOK, 1024, DFF, DFF, DFF};
                    pg8::StaticOrder S; S.init(g.M, g.N, G, c); EpiYssq E{(bf16_t*)(ws + OFF_Y), (float*)(ws + OFF_SSQ)};
                    for (int _d = 0; _d < DUP_GEMM; ++_d) pg8::gemm_phase(lds, g, S, E); }
                GSYNC();
            } else {
                { pg8::Gemm g{(const bf16_t*)(ws + OFF_H), (const bf16_t*)(ws + OFF_WIN + l * SZ_WIN), NTOK, 2048, 1024, 1024, 1024};
                    pg8::StaticOrder S; S.init(g.M, g.N, G, c);
                    EpiWin E{(bf16_t*)(ws + OFF_ZT), (bf16_t*)(ws + OFF_HT), (bf16_t*)(ws + OFF_QB), (bf16_t*)(ws + OFF_KB), (bf16_t*)(ws + OFF_VB), (const float*)(ws + OFF_ROPE),
                             p.out + (size_t)NTOK * D, p.out + (size_t)NTOK * D + (size_t)32 * 2 * 256 * 128, l};
                    for (int _d = 0; _d < DUP_GEMM; ++_d) pg8::gemm_phase(lds, g, S, E); }
                GSYNC();
                mixer_phase(p, l, lds);
                GSYNC();
                { pg8::Gemm g{(const bf16_t*)(ws + OFF_YCAT), (const bf16_t*)(ws + OFF_WOUT + l * SZ_WOUT), NTOK, 1024, 1024, 1024, 1024};
                    pg8::StaticOrder S; S.init(g.M, g.N, G, c); EpiYssq E{(bf16_t*)(ws + OFF_Y), (float*)(ws + OFF_SSQ)};
                    for (int _d = 0; _d < DUP_GEMM; ++_d) pg8::gemm_phase(lds, g, S, E); }
                GSYNC();
            }
            if (l == 1 && s == 2) phase_row<2>(p, l, s, 0, 0);
            else { const int ln = s == 2 ? l + 1 : l, sn = s == 2 ? 0 : s + 1; phase_row<1>(p, l, s, ln, sn); }
            if (!(l == 1 && s == 2)) GSYNC();
        }
    }
}

extern "C" void kernel_launch(void* const* d_in, const int* in_sizes, int n_in, void* d_out, int out_size, void* d_ws, size_t ws_size, hipStream_t stream) {
    constexpr int LDS_BYTES = 149 * 1024 + 256;
    static int grid_blocks = 0;
    if (!grid_blocks) {
        if (n_in != 24 || ws_size < WS_END) { fprintf(stderr, "kernel_launch: bad inputs (n_in %d) or workspace too small (%zu < %zu)\n", n_in, ws_size, (size_t)WS_END); grid_blocks = -1; return; }
        int dev = 0, cus = 0, per_cu = 0;
        hipGetDevice(&dev);
        hipDeviceGetAttribute(&cus, hipDeviceAttributeMultiprocessorCount, dev);
        if (hipFuncSetAttribute((const void*)fwd_megakernel, hipFuncAttributeMaxDynamicSharedMemorySize, LDS_BYTES) != hipSuccess) fprintf(stderr, "kernel_launch: hipFuncSetAttribute failed\n");
        hipOccupancyMaxActiveBlocksPerMultiprocessor(&per_cu, (const void*)fwd_megakernel, NTHREADS, LDS_BYTES);
        if (per_cu < 1) { fprintf(stderr, "kernel_launch: occupancy query says %d blocks per CU\n", per_cu); per_cu = 1; }
        (void)hipGetLastError();
        grid_blocks = cus * per_cu;
        if (grid_blocks > 256) grid_blocks = 256;
    }
    if (grid_blocks < 0) return;
    Params p{};
    for (int i = 0; i < 24; ++i) p.in[i] = (const float*)d_in[i];
    p.out = (float*)d_out; p.ws = (unsigned char*)d_ws;
    (void)hipMemsetAsync((unsigned char*)d_ws + OFF_BAR, 0, 16384, stream);
    void* args[] = {&p};
    hipError_t e = hipLaunchCooperativeKernel((const void*)fwd_megakernel, dim3(grid_blocks), dim3(NTHREADS), args, LDS_BYTES, stream);
    if (e != hipSuccess) fprintf(stderr, "cooperative launch failed: %s (grid %d)\n", hipGetErrorString(e), grid_blocks);
}
```

```cpp
#include <hip/hip_runtime.h>
#include <hip/hip_cooperative_groups.h>
#include <cstdio>
namespace cg = cooperative_groups;

#define LAS __attribute__((address_space(3)))
#define GAS __attribute__((address_space(1)))
#ifndef DUP_PA
#define DUP_PA 1
#endif
#ifndef DUP_PB
#define DUP_PB 1
#endif
#ifndef DUP_PC
#define DUP_PC 1
#endif
#ifndef DUP_PD
#define DUP_PD 1
#endif
#ifndef DUP_HY
#define DUP_HY 1
#endif
#ifndef DUP_AT
#define DUP_AT 1
#endif
#ifndef DUP_GEMM
#define DUP_GEMM 1
#endif
#ifndef DUP_MIX
#define DUP_MIX 1
#endif
#ifndef DUP_PREP
#define DUP_PREP 1
#endif
#ifndef DUP_SYNC
#define DUP_SYNC 1
#endif
#define GSYNC() do { for (int _s = 0; _s < DUP_SYNC; ++_s) xcd_barrier(xb); } while (0)
typedef unsigned short bf16_t;
typedef short bf16x8 __attribute__((ext_vector_type(8)));
typedef float f32x4 __attribute__((ext_vector_type(4)));
typedef unsigned u32x4 __attribute__((ext_vector_type(4)));
typedef unsigned u32x2 __attribute__((ext_vector_type(2)));

constexpr int D = 1024, NTOK = 16384, NCTX = 8192, DFF = 2816, INW = 1792;
constexpr int NTHREADS = 512;
constexpr float EPS = 1e-6f;
constexpr float PI2 = 6.283185307179586f;

constexpr size_t AL(size_t x) { return (x + 255) & ~(size_t)255; }
constexpr size_t SZ_WGU = (size_t)5632 * 1024 * 2, SZ_WD = (size_t)1024 * 2816 * 2, SZ_WIN = (size_t)2048 * 1024 * 2, SZ_WOUT = (size_t)1024 * 1024 * 2;
constexpr size_t OFF_WGU = 0;
constexpr size_t OFF_WD = OFF_WGU + 4 * SZ_WGU;
constexpr size_t OFF_WIN = OFF_WD + 4 * SZ_WD;
constexpr size_t OFF_WOUT = OFF_WIN + 2 * SZ_WIN;
constexpr size_t OFF_H = OFF_WOUT + 2 * SZ_WOUT;
constexpr size_t OFF_Y = OFF_H + (size_t)NTOK * D * 2;
constexpr size_t OFF_SSQ = OFF_Y + (size_t)NTOK * D * 2;
constexpr size_t OFF_MOD = OFF_SSQ + (size_t)NTOK * 16 * 4;
constexpr size_t OFF_FILT = AL(OFF_MOD + (size_t)2 * 9 * 9216 * 4);
constexpr size_t FILT_CTX = (size_t)4 * 256 * 256, FILT_LAT = (size_t)4 * 256 * 1024, FILT_L = FILT_CTX + FILT_LAT;
constexpr size_t G_CTX = (size_t)2 * 256 * 512, G_LAT = (size_t)2 * 256 * 2048, G_L = G_CTX + G_LAT;
constexpr size_t OFF_FC = AL(OFF_FILT + 2 * FILT_L * 4);
constexpr size_t OFF_FL = OFF_FC + (size_t)256 * 512 * 2;
constexpr size_t OFF_ROPE = OFF_FL + (size_t)1024 * 2048 * 2;
constexpr size_t OFF_BAR = AL(OFF_ROPE + 64 * 16 * 8);
constexpr size_t OFF_CKB = OFF_BAR + 16384;
constexpr size_t OFF_CVT = OFF_CKB + (size_t)2 * 8 * 256 * 128 * 2;
constexpr size_t OFF_UNION = AL(OFF_CVT + (size_t)2 * 8 * 256 * 128 * 2);
constexpr size_t OFF_ACT = OFF_UNION;
constexpr size_t OFF_ZT = OFF_UNION;
constexpr size_t ZT_LAT = (size_t)NCTX * 512;
constexpr size_t OFF_HT = OFF_ZT + (size_t)NTOK * 512 * 2;
constexpr size_t HT_LAT = (size_t)NCTX * 768;
constexpr size_t OFF_QB = OFF_HT + (size_t)NTOK * 768 * 2;
constexpr size_t OFF_KB = OFF_QB + (size_t)NTOK * 512 * 2;
constexpr size_t OFF_VB = OFF_KB + (size_t)NTOK * 128 * 2;
constexpr size_t VT_LAT = (size_t)NCTX * 128;
constexpr size_t OFF_YCAT = OFF_VB + (size_t)NTOK * 128 * 2;
constexpr size_t UNION_END = OFF_YCAT + (size_t)NTOK * 1024 * 2;
constexpr size_t ACT_END = OFF_ACT + (size_t)NTOK * DFF * 2;
constexpr size_t OFF_X16 = AL(UNION_END > ACT_END ? UNION_END : ACT_END);
constexpr size_t WS_END = OFF_X16 + (size_t)NTOK * D * 2;

struct Params {
    const float* in[24];
    float* out;
    unsigned char* ws;
};

__device__ __forceinline__ unsigned short f2bf(float f) { unsigned u = __float_as_uint(f); u += 0x7FFFu + ((u >> 16) & 1u); return (unsigned short)(u >> 16); }
__device__ __forceinline__ float bf2f(unsigned short b) { return __uint_as_float(((unsigned)b) << 16); }
__device__ __forceinline__ unsigned cvt_pk_bf16(float lo, float hi) { unsigned r; asm volatile("v_cvt_pk_bf16_f32 %0, %1, %2" : "=v"(r) : "v"(lo), "v"(hi)); return r; }
typedef __bf16 bf16x2_t __attribute__((ext_vector_type(2)));
typedef float f32x2_t __attribute__((ext_vector_type(2)));
typedef float f32x16 __attribute__((ext_vector_type(16)));
__device__ __forceinline__ unsigned pk_bf16(float lo, float hi) { f32x2_t v = {lo, hi}; return __builtin_bit_cast(unsigned, __builtin_convertvector(v, bf16x2_t)); }
__device__ __forceinline__ float silu_f(float x) { return x * __builtin_amdgcn_rcpf(1.0f + __expf(-x)); }
__device__ __forceinline__ int perm32(int rho) { const int n = rho >> 4, i = rho & 15; return 8 * (i >> 2) + 4 * n + (i & 3); }

__device__ __forceinline__ int opaque_tid() { int t = threadIdx.x; asm volatile("" : "+v"(t)); return t; }


#define XB_TMO      128
#define XB_XCNT(j)  (256  + 64 * (j))
#define XB_XSUB(j)  (1280 + 64 * (j))
#define XB_XGEN(j)  (2304 + 64 * (j))
#define XB_TOP      3328
#define XB_TOPGEN   3392
#define XCD_BAR_WORDS 3456
#define XB_SPIN_CAP (1u << 22)
__device__ __forceinline__ unsigned xb_ld(unsigned* p)              { return __hip_atomic_load(p, __ATOMIC_RELAXED, __HIP_MEMORY_SCOPE_AGENT); }
__device__ __forceinline__ unsigned xb_add(unsigned* p, unsigned v) { return __hip_atomic_fetch_add(p, v, __ATOMIC_RELAXED, __HIP_MEMORY_SCOPE_AGENT); }
__device__ __forceinline__ unsigned xb_xcc_id() { return (unsigned)__builtin_amdgcn_s_getreg((3 << 11) | 20) & 0xFu; }
#define XB_SPIN(cond, bar) do { unsigned _sp = 0; while (cond) { __builtin_amdgcn_s_sleep(1); \
    if ((++_sp & 255u) == 0u) { if (xb_ld(&(bar)[XB_TMO])) break; if (_sp > XB_SPIN_CAP) { atomicAdd(&(bar)[XB_TMO], 1u); break; } } } } while (0)
struct XcdBarrier { unsigned* bar; unsigned x; volatile LAS unsigned* st; };
__device__ __forceinline__ XcdBarrier xcd_barrier_post(unsigned* bar, volatile LAS unsigned* st) {
    XcdBarrier b; b.bar = bar; b.x = xb_xcc_id(); b.st = st;
    if (threadIdx.x == 0) (void)xb_add(&bar[XB_XCNT(b.x)], 1u);
    return b;
}
__device__ __forceinline__ void xcd_barrier_complete(unsigned* bar, unsigned x, unsigned& nloc, unsigned& nx) {
    const unsigned G = gridDim.x * gridDim.y * gridDim.z;
    unsigned sum, cnt, mine, sp = 0u;
    for (;;) {
        sum = 0u; cnt = 0u; mine = 0u;
#pragma unroll
        for (unsigned j = 0; j < 16; ++j) { const unsigned c = xb_ld(&bar[XB_XCNT(j)]); sum += c; cnt += (c > 0u) ? 1u : 0u; mine = (j == x) ? c : mine; }
        if (sum == G) break;
        __builtin_amdgcn_s_sleep(1);
        if ((++sp & 255u) == 0u) { if (xb_ld(&bar[XB_TMO])) break; if (sp > XB_SPIN_CAP) { atomicAdd(&bar[XB_TMO], 1u); break; } }
    }
    nloc = mine > 0u ? mine : 1u; nx = cnt > 0u ? cnt : 1u;
}
__device__ __forceinline__ void xcd_barrier(const XcdBarrier& b) {
    asm volatile("s_waitcnt vmcnt(0)" ::: "memory");
    __syncthreads();
    if (threadIdx.x == 0) {
        unsigned* bar = b.bar;
        __builtin_amdgcn_s_waitcnt(0);
        unsigned nloc = b.st[0], nx = b.st[1];
        if (nloc == 0u) { xcd_barrier_complete(bar, b.x, nloc, nx); b.st[0] = nloc; b.st[1] = nx; }
        const unsigned old = xb_add(&bar[XB_XSUB(b.x)], 1u);
        const unsigned gen = old / nloc;
        if (old + 1u == (gen + 1u) * nloc) {
            __builtin_amdgcn_fence(__ATOMIC_RELEASE, "agent");
            asm volatile("s_waitcnt vmcnt(0)" ::: "memory");
            const unsigned og = xb_add(&bar[XB_TOP], 1u);
            const unsigned tg = og / nx;
            if (og + 1u == (tg + 1u) * nx) xb_add(&bar[XB_TOPGEN], 1u);
            else XB_SPIN(xb_ld(&bar[XB_TOPGEN]) == tg, bar);
            __builtin_amdgcn_fence(__ATOMIC_ACQUIRE, "agent");
            xb_add(&bar[XB_XGEN(b.x)], 1u);
            asm volatile("s_waitcnt vmcnt(0)" ::: "memory");
        } else {
            XB_SPIN(xb_ld(&bar[XB_XGEN(b.x)]) == gen, bar);
            __builtin_amdgcn_fence(__ATOMIC_ACQUIRE, "agent");
            asm volatile("s_waitcnt vmcnt(0)" ::: "memory");
        }
    }
    __syncthreads();
}

namespace pg8 {
constexpr int BM = 256, BK = 64, HALF = 128, HTB = HALF * BK * 2, STAGE_BYTES = 8 * HTB, NXCD = 8, WGM = 8;
__device__ __forceinline__ int lds_byte(int r, int c) { const int st = (r >> 4) * 2 + (c >> 5), rr = r & 15, cc = c & 31, ob = rr * 64 + cc * 2; return st * 1024 + (ob ^ (((ob >> 9) & 1) << 5)); }
__device__ __forceinline__ void stage_rc(int b, int& R, int& C) { const int st = b / 1024, sb = b % 1024, swz = sb ^ (((sb >> 9) & 1) << 5); R = (st >> 1) * 16 + swz / 64; C = (st & 1) * 32 + (swz % 64) / 2; }
struct Unit { int pm, pn; };
struct Gemm { const bf16_t* A; const bf16_t* Bt; int M, N, K, lda, ldb; };
struct StaticOrder {
    int nM, nN, nwg, G, c;
    __device__ void init(int M, int N, int G_, int c_) { nM = M / BM; nN = N / BM; nwg = nM * nN; G = G_; c = c_; }
    __device__ bool next(int i, Unit& u) const {
        if (c < 0) return false;
        const long L = (long)i * G + c; if (L >= nwg) return false;
        int wgid = (int)L; { const int q = nwg / NXCD, r = nwg % NXCD, xcd = wgid % NXCD, off = wgid / NXCD; wgid = (xcd < r ? xcd * (q + 1) : r * (q + 1) + (xcd - r) * q) + off; }
        const int nig = WGM * nN, gid = wgid / nig, fm = gid * WGM, gsz = (nM - fm) < WGM ? (nM - fm) : WGM;
        u.pm = fm + ((wgid % nig) % gsz); u.pn = (wgid % nig) / gsz; return true;
    }
    __device__ __forceinline__ void a_ready(const Unit&) const {}
    __device__ __forceinline__ void done(const Unit&) const {}
};

template <class Epi, class Sched>
__device__ __forceinline__ void gemm_phase(LAS unsigned char* lds, Gemm g, const Sched& S, const Epi& E) {
    asm volatile("" : "+s"(g.A), "+s"(g.Bt), "+s"(g.K), "+s"(g.lda), "+s"(g.ldb));
    int tid = threadIdx.x; asm volatile("" : "+v"(tid));
    const int wid = __builtin_amdgcn_readfirstlane(tid >> 6), lane = tid & 63, wr = wid >> 2, wc = wid & 3, fr = lane & 15, fq = lane >> 4;
    const int K = g.K, nt = K / BK;
    unsigned voffA[2], voffB[2];
#pragma unroll
    for (int i = 0; i < 2; ++i) { int R, C; stage_rc(tid * 16 + i * 8192, R, C);
        voffA[i] = (unsigned)(R * g.lda + C) * 2u; voffB[i] = (unsigned)(R * g.ldb + C) * 2u; }
    const size_t kstep = (size_t)(BK * 2);
    const size_t hstepA = (size_t)HALF * g.lda * 2, hstepB = (size_t)HALF * g.ldb * 2;
    const size_t tstepA = 2 * hstepA, tstepB = 2 * hstepB;
    const unsigned ldsw = (unsigned)wid * 1024u;
    const int aoff = lds_byte(wr * 64 + fr, fq * 8), boff = lds_byte(wc * 32 + fr, fq * 8);
#define PG8_SA(b, h) (((b) * 2 + (h)) * HTB)
#define PG8_SB(b, h) ((4 + (b) * 2 + (h)) * HTB)
#define PG8_STAGE(bufoff, gbase, voff) do { _Pragma("unroll") for (int _i = 0; _i < 2; ++_i) \
        __builtin_amdgcn_global_load_lds((const unsigned*)((const char*)(gbase) + (voff)[_i]), (LAS unsigned*)(lds + (bufoff) + ldsw + _i * 8192), 16, 0, 0); } while (0)
#define PG8_LDA(dst, b, h) do { _Pragma("unroll") for (int m = 0; m < 4; ++m) _Pragma("unroll") for (int k = 0; k < 2; ++k) dst[m][k] = *(const LAS bf16x8*)(lds + PG8_SA(b, h) + aoff + m * 2048 + k * 1024); } while (0)
#define PG8_LDB(dst, b, h) do { _Pragma("unroll") for (int n = 0; n < 2; ++n) _Pragma("unroll") for (int k = 0; k < 2; ++k) dst[n][k] = *(const LAS bf16x8*)(lds + PG8_SB(b, h) + boff + n * 2048 + k * 1024); } while (0)
#define PG8_MMA(ai, bj, At, Bt) do { __builtin_amdgcn_s_setprio(1); _Pragma("unroll") for (int m = 0; m < 4; ++m) _Pragma("unroll") for (int n = 0; n < 2; ++n) _Pragma("unroll") for (int k = 0; k < 2; ++k) \
        acc[ai][bj][m][n] = __builtin_amdgcn_mfma_f32_16x16x32_bf16(Bt[n][k], At[m][k], acc[ai][bj][m][n], 0, 0, 0); __builtin_amdgcn_s_setprio(0); } while (0)
#define PG8_WAIT_V(n) asm volatile("s_waitcnt vmcnt(" #n ")" ::: "memory")
#define PG8_WAIT_L(n) asm volatile("s_waitcnt lgkmcnt(" #n ")" ::: "memory")
#define PG8_BAR __builtin_amdgcn_s_barrier()
#define PG8_SCHED __builtin_amdgcn_sched_barrier(0)
    Unit cur, nxt; int ui = 0;
    if (!S.next(0, cur)) return;
    f32x4 acc[2][2][4][2];
#pragma unroll
    for (int a = 0; a < 2; ++a)
#pragma unroll
        for (int b = 0; b < 2; ++b)
#pragma unroll
            for (int m = 0; m < 4; ++m)
#pragma unroll
                for (int n = 0; n < 2; ++n) acc[a][b][m][n] = (f32x4){0.f, 0.f, 0.f, 0.f};
    bf16x8 At[4][2], B0[2][2], B1[2][2];
    const char* cA = (const char*)g.A + (size_t)cur.pm * tstepA; const char* cB = (const char*)g.Bt + (size_t)cur.pn * tstepB;
    S.a_ready(cur);
    PG8_STAGE(PG8_SB(0, 0), cB, voffB); PG8_STAGE(PG8_SA(0, 0), cA, voffA); PG8_STAGE(PG8_SB(0, 1), cB + hstepB, voffB); PG8_STAGE(PG8_SA(0, 1), cA + hstepA, voffA);
    if (wr == 1) PG8_BAR;
    PG8_WAIT_V(4); PG8_BAR;
    PG8_STAGE(PG8_SB(1, 0), cB + kstep, voffB); PG8_STAGE(PG8_SA(1, 0), cA + kstep, voffA); PG8_STAGE(PG8_SB(1, 1), cB + hstepB + kstep, voffB);
    PG8_WAIT_V(6); PG8_BAR;
    for (;;) {
        const bool has_next = S.next(ui + 1, nxt);
        const char* nA = has_next ? (const char*)g.A + (size_t)nxt.pm * tstepA : cA; const char* nB = has_next ? (const char*)g.Bt + (size_t)nxt.pn * tstepB : cB;
        for (int t = 0; t < nt; t += 2) {
            const bool last = (t == nt - 2);
            const char* a1 = cA + (size_t)(t + 1) * kstep;
            const char* a2 = last ? nA : cA + (size_t)(t + 2) * kstep; const char* b2 = last ? nB : cB + (size_t)(t + 2) * kstep;
            const char* a3 = a2 + kstep; const char* b3 = b2 + kstep;
            if (last && has_next) S.a_ready(nxt);
            PG8_LDB(B0, 0, 0); PG8_SCHED; PG8_LDA(At, 0, 0); PG8_STAGE(PG8_SA(1, 1), a1 + hstepA, voffA);
            PG8_WAIT_L(8); PG8_BAR; PG8_WAIT_L(0); PG8_MMA(0, 0, At, B0); PG8_BAR; PG8_SCHED;
            PG8_LDB(B1, 0, 1); PG8_STAGE(PG8_SB(0, 0), b2, voffB);
            PG8_BAR; PG8_WAIT_L(0); PG8_MMA(0, 1, At, B1); PG8_BAR;
            PG8_LDA(At, 0, 1); PG8_STAGE(PG8_SA(0, 0), a2, voffA);
            PG8_BAR; PG8_WAIT_L(0); PG8_MMA(1, 0, At, B0); PG8_BAR; PG8_SCHED;
            PG8_STAGE(PG8_SB(0, 1), b2 + hstepB, voffB);
            PG8_WAIT_V(6); PG8_BAR; PG8_MMA(1, 1, At, B1); PG8_BAR;
            PG8_LDB(B0, 1, 0); PG8_SCHED; PG8_LDA(At, 1, 0); PG8_STAGE(PG8_SA(0, 1), a2 + hstepA, voffA);
            PG8_WAIT_L(8); PG8_BAR; PG8_WAIT_L(0); PG8_MMA(0, 0, At, B0); PG8_BAR; PG8_SCHED;
            PG8_LDB(B1, 1, 1); PG8_STAGE(PG8_SB(1, 0), b3, voffB);
            PG8_BAR; PG8_WAIT_L(0); PG8_MMA(0, 1, At, B1); PG8_BAR;
            PG8_LDA(At, 1, 1); PG8_STAGE(PG8_SA(1, 0), a3, voffA);
            PG8_BAR; PG8_WAIT_L(0); PG8_MMA(1, 0, At, B0); PG8_BAR; PG8_SCHED;
            PG8_STAGE(PG8_SB(1, 1), b3 + hstepB, voffB);
            PG8_WAIT_V(6); PG8_BAR; PG8_MMA(1, 1, At, B1); PG8_BAR;
        }
        { int fr2 = fr, fq2 = fq, wr2 = wr, wc2 = wc; asm volatile("" : "+v"(fr2), "+v"(fq2), "+s"(wr2), "+s"(wc2));
            E(acc, cur, wr2, wc2, fr2, fq2); } S.done(cur);
        if (!has_next) break;
#pragma unroll
        for (int a = 0; a < 2; ++a)
#pragma unroll
            for (int b = 0; b < 2; ++b)
#pragma unroll
                for (int m = 0; m < 4; ++m)
#pragma unroll
                    for (int n = 0; n < 2; ++n) acc[a][b][m][n] = (f32x4){0.f, 0.f, 0.f, 0.f};
        cur = nxt; cA = nA; cB = nB; ++ui;
    }
    PG8_WAIT_V(0);
    if (wr == 0) PG8_BAR;
    PG8_BAR;
#undef PG8_SA
#undef PG8_SB
#undef PG8_STAGE
#undef PG8_LDA
#undef PG8_LDB
#undef PG8_MMA
#undef PG8_WAIT_V
#undef PG8_WAIT_L
#undef PG8_BAR
#undef PG8_SCHED
}
}

struct EpiSwiglu {
    bf16_t* O;
    __device__ __forceinline__ void operator()(const f32x4 (&acc)[2][2][4][2], const pg8::Unit& u, int wr, int wc, int fr, int fq) const {
        const int row0 = u.pm * 256 + wr * 64 + fr, col0 = u.pn * 128 + wc * 32 + 8 * fq;
#pragma unroll
        for (int ai = 0; ai < 2; ++ai)
#pragma unroll
            for (int m = 0; m < 4; ++m) {
                bf16_t* rowp = O + (size_t)(row0 + ai * 128 + m * 16) * DFF + col0;
                const f32x4 g0 = acc[ai][0][m][0], g1 = acc[ai][0][m][1], u0 = acc[ai][1][m][0], u1 = acc[ai][1][m][1];
                f32x4 r0, r1;
#pragma unroll
                for (int e = 0; e < 4; ++e) { r0[e] = __builtin_amdgcn_rcpf(1.0f + __builtin_amdgcn_exp2f(-g0[e])); r1[e] = __builtin_amdgcn_rcpf(1.0f + __builtin_amdgcn_exp2f(-g1[e])); }
                const f32x4 o0 = (g0 * u0) * r0, o1 = (g1 * u1) * r1;
                u32x4 w;
                w.x = pk_bf16(o0[0], o0[1]); w.y = pk_bf16(o0[2], o0[3]); w.z = pk_bf16(o1[0], o1[1]); w.w = pk_bf16(o1[2], o1[3]);
                *(u32x4*)rowp = w;
            }
    }
};
struct EpiYssq {
    bf16_t* Y; float* ssq;
    __device__ __forceinline__ void operator()(const f32x4 (&acc)[2][2][4][2], const pg8::Unit& u, int wr, int wc, int fr, int fq) const {
        const int row0 = u.pm * 256 + wr * 64 + fr, col0 = u.pn * 256 + wc * 32 + 8 * fq;
#pragma unroll
        for (int ai = 0; ai < 2; ++ai)
#pragma unroll
            for (int m = 0; m < 4; ++m) {
                const int row = row0 + ai * 128 + m * 16;
                bf16_t* rowp = Y + (size_t)row * D + col0;
                float s = 0.f;
#pragma unroll
                for (int bj = 0; bj < 2; ++bj) {
                    const f32x4 v0 = acc[ai][bj][m][0], v1 = acc[ai][bj][m][1];
                    s += v0[0] * v0[0] + v0[1] * v0[1] + v0[2] * v0[2] + v0[3] * v0[3] + v1[0] * v1[0] + v1[1] * v1[1] + v1[2] * v1[2] + v1[3] * v1[3];
                    u32x4 w; w.x = cvt_pk_bf16(v0[0], v0[1]); w.y = cvt_pk_bf16(v0[2], v0[3]); w.z = cvt_pk_bf16(v1[0], v1[1]); w.w = cvt_pk_bf16(v1[2], v1[3]);
                    *(u32x4*)(rowp + bj * 128) = w;
                }
                s += __shfl_xor(s, 16); s += __shfl_xor(s, 32);
                if (fq == 0) ssq[(size_t)row * 16 + u.pn * 4 + wc] = s;
            }
    }
};
struct EpiWin {
    bf16_t* ZT; bf16_t* HT; bf16_t* QB; bf16_t* KB; bf16_t* VB; const float* rope; float* newk; float* newv; int layer;
    __device__ __forceinline__ void operator()(const f32x4 (&acc)[2][2][4][2], const pg8::Unit& u, int wr, int wc, int fr, int fq) const {
        const int r0 = u.pm * 256 + wr * 64 + fr;
        const bool lat = u.pm >= 32;
        const int pn = u.pn;
        if (pn < 5) {
            bf16_t* base; int t0; size_t sch;
            if (pn < 2) {
                if (!lat) { const int b = u.pm; base = ZT + ((size_t)b * 256 * 2 + pn) * 256; sch = 512; t0 = r0 - u.pm * 256; }
                else { const int b = (u.pm - 32) >> 2; base = ZT + ZT_LAT + ((size_t)b * 256 * 2 + pn) * 1024; sch = 2048; t0 = r0 - NCTX - b * 1024; }
            } else {
                const int c0 = (pn - 2) * 256;
                if (!lat) { const int b = u.pm; base = HT + ((size_t)b * 768 + c0) * 256; sch = 256; t0 = r0 - u.pm * 256; }
                else { const int b = (u.pm - 32) >> 2; base = HT + HT_LAT + ((size_t)b * 768 + c0) * 1024; sch = 1024; t0 = r0 - NCTX - b * 1024; }
            }
#pragma unroll
            for (int ai = 0; ai < 2; ++ai)
#pragma unroll
                for (int m = 0; m < 4; ++m) {
                    const int t = t0 + ai * 128 + m * 16;
#pragma unroll
                    for (int bj = 0; bj < 2; ++bj)
#pragma unroll
                        for (int n = 0; n < 2; ++n) {
                            const int ch = bj * 128 + wc * 32 + n * 16 + 4 * fq;
                            const f32x4 v = acc[ai][bj][m][n];
#pragma unroll
                            for (int e = 0; e < 4; ++e) base[(size_t)(ch + e) * sch + t] = f2bf(v[e]);
                        }
                }
        } else {
            const int blk = wc & 1;
#pragma unroll
            for (int ai = 0; ai < 2; ++ai)
#pragma unroll
                for (int m = 0; m < 4; ++m) {
                    const int row = r0 + ai * 128 + m * 16;
                    f32x4 cs0 = {1.f, 0.f, 1.f, 0.f}, cs1 = {1.f, 0.f, 1.f, 0.f};
                    if (lat) { const int t = row & 1023; const int pos = blk ? (t & 63) : (t >> 6);
                        const f32x4* rp = (const f32x4*)(rope + (size_t)(pos * 16 + 4 * fq) * 2); cs0 = rp[0]; cs1 = rp[1]; }
#pragma unroll
                    for (int bj = 0; bj < 2; ++bj) {
                        f32x4 x1 = acc[ai][bj][m][0], x2 = acc[ai][bj][m][1];
                        const bool isv = (pn == 7 && bj == 1);
                        const bool isk = (pn == 7 && bj == 0);
                        const int cc = bj * 128 + wc * 32 + 4 * fq;
                        if ((isk || isv) && !lat) {
                            const int b = row >> 8, t = row & 255;
                            float* dst = (isk ? newk : newv) + (((size_t)b * 2 + layer) * 256 + t) * 128 + (cc & 127);
                            *(f32x4*)dst = x1; *(f32x4*)(dst + 16) = x2;
                        }
                        if (!isv) {
                            f32x4 o1, o2;
                            o1[0] = x1[0] * cs0[0] - x2[0] * cs0[1]; o2[0] = x2[0] * cs0[0] + x1[0] * cs0[1];
                            o1[1] = x1[1] * cs0[2] - x2[1] * cs0[3]; o2[1] = x2[1] * cs0[2] + x1[1] * cs0[3];
                            o1[2] = x1[2] * cs1[0] - x2[2] * cs1[1]; o2[2] = x2[2] * cs1[0] + x1[2] * cs1[1];
                            o1[3] = x1[3] * cs1[2] - x2[3] * cs1[3]; o2[3] = x2[3] * cs1[2] + x1[3] * cs1[3];
                            x1 = o1; x2 = o2;
                        }
                        bf16_t* dst;
                        if (pn < 7) { x1 *= 0.125f; x2 *= 0.125f; dst = QB + (size_t)row * 512 + (pn - 5) * 256 + cc; }
                        else if (isk) dst = KB + (size_t)row * 128 + cc;
                        else {
                            bf16_t* vb; size_t n_;
                            if (!lat) { vb = VB + (size_t)(row >> 8) * 128 * 256 + (row & 255); n_ = 256; } else { vb = VB + VT_LAT + (size_t)((row - NCTX) >> 10) * 128 * 1024 + (row & 1023); n_ = 1024; }
                            const int c0 = cc - 128;
#pragma unroll
                            for (int e = 0; e < 4; ++e) { vb[(size_t)(c0 + e) * n_] = f2bf(x1[e]); vb[(size_t)(c0 + 16 + e) * n_] = f2bf(x2[e]); }
                            continue;
                        }
                        u32x2 w1, w2; w1.x = cvt_pk_bf16(x1[0], x1[1]); w1.y = cvt_pk_bf16(x1[2], x1[3]); w2.x = cvt_pk_bf16(x2[0], x2[1]); w2.y = cvt_pk_bf16(x2[2], x2[3]);
                        *(u32x2*)dst = w1; *(u32x2*)(dst + 16) = w2;
                    }
                }
        }
    }
};
struct EpiFourier {
    bf16_t* YC; int rowbase, n;
    __device__ __forceinline__ void operator()(const f32x4 (&acc)[2][2][4][2], const pg8::Unit& u, int wr, int wc, int fr, int fq) const {
        const int kp0 = u.pm * 256 + wr * 64 + fr; const int b = u.pn;
#pragma unroll
        for (int ai = 0; ai < 2; ++ai)
#pragma unroll
            for (int m = 0; m < 4; ++m) {
                bf16_t* rowp = YC + (size_t)(rowbase + b * n + kp0 + ai * 128 + m * 16) * 1024 + wc * 32 + 4 * fq;
#pragma unroll
                for (int bj = 0; bj < 2; ++bj)
#pragma unroll
                    for (int nn = 0; nn < 2; ++nn) { const f32x4 v = acc[ai][bj][m][nn]; u32x2 w; w.x = cvt_pk_bf16(v[0], v[1]); w.y = cvt_pk_bf16(v[2], v[3]);
                        *(u32x2*)(rowp + bj * 128 + nn * 16) = w; }
            }
    }
};

struct TrUnit { const float* src; bf16_t* dst; int ld, k0, cbase, Kd, r0, perm; float scale; };
__device__ __forceinline__ TrUnit tr_unit_g(const Params& p, int kind, int idx, int w) {
    TrUnit t; unsigned char* ws = p.ws; t.scale = 1.0f;
    if (kind == 0) { const int rg = w / 16, kb = w % 16; const int pn = rg >> 1, half = rg & 1; t.scale = half ? 0.6931471805599453f : 1.4426950408889634f;
        t.src = (half ? p.in[10] : p.in[9]) + (size_t)idx * 1024 * DFF; t.ld = DFF; t.k0 = kb * 64; t.cbase = pn * 128; t.dst = (bf16_t*)(ws + OFF_WGU + idx * SZ_WGU); t.Kd = 1024; t.r0 = rg * 128; t.perm = 1; }
    else if (kind == 1) { const int rg = w / 44, kb = w % 44;
        t.src = p.in[11] + (size_t)idx * DFF * 1024; t.ld = 1024; t.k0 = kb * 64; t.cbase = rg * 128; t.dst = (bf16_t*)(ws + OFF_WD + idx * SZ_WD); t.Kd = DFF; t.r0 = rg * 128; t.perm = 1; }
    else if (kind == 2) { const int rg = w / 16, kb = w % 16;
        t.src = p.in[13] + (size_t)idx * 1024 * 1024; t.ld = 1024; t.k0 = kb * 64; t.cbase = rg * 128; t.dst = (bf16_t*)(ws + OFF_WOUT + idx * SZ_WOUT); t.Kd = 1024; t.r0 = rg * 128; t.perm = 1; }
    else { const int rg = w / 16, kb = w % 16;
        t.src = p.in[12] + (size_t)idx * 1024 * INW; t.ld = INW; t.k0 = kb * 64; t.cbase = 256 + rg * 128; t.dst = (bf16_t*)(ws + OFF_WIN + idx * SZ_WIN); t.Kd = 1024; t.r0 = 512 + rg * 128; t.perm = 0; }
    return t;
}
__device__ __forceinline__ int tr_slot_count(int slot) { return slot == 0 ? 704 : slot == 1 ? 1376 : slot == 2 ? 1248 : slot == 3 ? 1184 : 352; }
__device__ __forceinline__ TrUnit tr_unit(const Params& p, int slot, int v) {
    if (slot == 0) return tr_unit_g(p, 0, 0, v);
    if (slot == 1) { if (v < 352) return tr_unit_g(p, 1, 0, v); v -= 352; if (v < 192) return tr_unit_g(p, 3, 0, v); v -= 192; if (v < 128) return tr_unit_g(p, 2, 0, v); return tr_unit_g(p, 0, 1, v - 128); }
    if (slot == 2) { if (v < 352) return tr_unit_g(p, 1, 1, v); v -= 352; if (v < 704) return tr_unit_g(p, 0, 2, v); return tr_unit_g(p, 3, 1, v - 704); }
    if (slot == 3) { if (v < 352) return tr_unit_g(p, 1, 2, v); v -= 352; if (v < 128) return tr_unit_g(p, 2, 1, v); return tr_unit_g(p, 0, 3, v - 128); }
    return tr_unit_g(p, 1, 3, v);
}
__device__ __forceinline__ void tr_load(const TrUnit& t, int tid, f32x4 (&v)[4]) {
#pragma unroll
    for (int i = 0; i < 4; ++i) { const int idx = tid + 512 * i, kk = idx >> 5, c4 = idx & 31;
        v[i] = *(const f32x4*)(t.src + (size_t)(t.k0 + kk) * t.ld + t.cbase + c4 * 4); }
}
__device__ __forceinline__ void tr_slot(const Params& p, float* lds, int slot, int blk, int nblk, int tid) {
    const int NU = tr_slot_count(slot);
    constexpr int TS = 132;
    f32x4 v[4];
    int u = blk;
    TrUnit cur; if (u < NU) { cur = tr_unit(p, slot, u); tr_load(cur, tid, v); }
    while (u < NU) {
#pragma unroll
        for (int i = 0; i < 4; ++i) { const int idx = tid + 512 * i, kk = idx >> 5, c4 = idx & 31; *(f32x4*)(lds + kk * TS + c4 * 4) = v[i]; }
        __syncthreads();
        const int un = u + nblk; TrUnit nxt = cur;
        if (un < NU) { nxt = tr_unit(p, slot, un); tr_load(nxt, tid, v); }
        { const int rr = tid >> 2, kc = tid & 3; const int cc = cur.perm ? ((rr & ~31) + perm32(rr & 31)) : rr;
            float x[16];
#pragma unroll
            for (int j = 0; j < 16; ++j) x[j] = lds[(kc * 16 + j) * TS + cc] * cur.scale;
            u32x4 w0, w1; w0.x = pk_bf16(x[0], x[1]); w0.y = pk_bf16(x[2], x[3]); w0.z = pk_bf16(x[4], x[5]); w0.w = pk_bf16(x[6], x[7]);
            w1.x = pk_bf16(x[8], x[9]); w1.y = pk_bf16(x[10], x[11]); w1.z = pk_bf16(x[12], x[13]); w1.w = pk_bf16(x[14], x[15]);
            bf16_t* d = cur.dst + (size_t)(cur.r0 + rr) * cur.Kd + cur.k0 + kc * 16;
            *(u32x4*)d = w0; *(u32x4*)(d + 8) = w1; }
        __syncthreads();
        cur = nxt; u = un;
    }
}
__device__ void phase_prep(const Params& p, float* lds) {
    const int tid = opaque_tid(), nb = gridDim.x, bid = blockIdx.x;
    unsigned char* ws = p.ws;
    tr_slot(p, lds, 0, bid, nb, tid);
    __syncthreads();
    {
        float* tab = lds;
        if (tid < 64) { float sv, cv; sincosf(PI2 * (float)tid / 64.f, &sv, &cv); tab[tid] = cv; tab[64 + tid] = sv; }
        __syncthreads();
        const int lane = tid & 63, wv = tid >> 6;
        for (int u = bid * 8 + wv; u < 8192; u += nb * 8) {
            const int l = u >> 12, k = (u >> 2) & 1023, g = u & 3;
            const float* wrow = p.in[12] + ((size_t)l * 1024 + k) * INW + g * 64;
            const float wv_ = wrow[lane];
            float ac = 0.f, as = 0.f;
#pragma unroll 16
            for (int c = 0; c < 64; ++c) { const float w = __shfl(wv_, c); const int idx = (c * lane) & 63; ac += w * tab[idx]; as += w * tab[64 + idx]; }
            bf16_t* bt = (bf16_t*)(ws + OFF_WIN + l * SZ_WIN);
            bt[(size_t)(g * 64 + lane) * 1024 + k] = f2bf(ac);
            bt[(size_t)(256 + g * 64 + lane) * 1024 + k] = f2bf(as);
        }
        __syncthreads();
    }
    {
        float* sc = lds;
        float* part = lds + 12 * 1024;
        for (int i = tid; i < 9 * 1024; i += NTHREADS) { const int bc = i >> 10, k = i & 1023; const float cv = bc == 0 ? p.in[5][k] : p.in[4][(bc - 1) * 1024 + k]; sc[k * 12 + bc] = cv / (1.0f + expf(-cv)); }
        __syncthreads();
        for (int cb = bid; cb < 256; cb += nb) {
            const int gc0 = cb * 72, l = gc0 / 9216, j0 = gc0 % 9216;
            const int cg = tid % 18, kg = tid / 18;
            if (kg < 28) {
                f32x4 a[9];
#pragma unroll
                for (int i = 0; i < 9; ++i) a[i] = (f32x4){0.f, 0.f, 0.f, 0.f};
                const float* wp = p.in[6] + (size_t)l * 1024 * 9216 + j0 + cg * 4;
#pragma unroll 4
                for (int k = kg; k < 1024; k += 28) { const f32x4 w = *(const f32x4*)(wp + (size_t)k * 9216);
                    const f32x4 s0 = *(const f32x4*)(sc + k * 12), s1 = *(const f32x4*)(sc + k * 12 + 4); const float s8 = sc[k * 12 + 8];
                    a[0] += w * s0[0]; a[1] += w * s0[1]; a[2] += w * s0[2]; a[3] += w * s0[3]; a[4] += w * s1[0]; a[5] += w * s1[1]; a[6] += w * s1[2]; a[7] += w * s1[3]; a[8] += w * s8; }
#pragma unroll
                for (int i = 0; i < 9; ++i)
#pragma unroll
                    for (int e = 0; e < 4; ++e) part[(kg * 72 + cg * 4 + e) * 9 + i] = a[i][e];
            }
            __syncthreads();
            for (int i = tid; i < 72 * 9; i += NTHREADS) { const int c2 = i / 9, bc = i % 9; float s = 0.f;
#pragma unroll
                for (int g = 0; g < 28; ++g) s += part[(g * 72 + c2) * 9 + bc];
                ((float*)(ws + OFF_MOD))[((size_t)l * 9 + bc) * 9216 + j0 + c2] = s + p.in[7][l * 9216 + j0 + c2]; }
            __syncthreads();
        }
    }
    __syncthreads();
    {
        const int lane = tid & 63, wv = tid >> 6;
        float* h2s = lds;
        const int u0 = bid * 10; const int l = u0 / 1280;
        if (u0 < 2560) {
            const float* w1 = p.in[15] + l * 33 * 64; const float* b1 = p.in[16] + l * 64; const float* w2 = p.in[17] + l * 64 * 64; const float* b2 = p.in[18] + l * 64;
            const float* w3 = p.in[19] + (size_t)l * 64 * 1024; const float fr = p.in[20][l * 64 + lane];
            for (int q = wv; q < 10; q += 8) {
                const int rem = (u0 + q) % 1280; const int pass = rem >= 256; const int n = pass ? 1024 : 256; const int d = pass ? rem - 256 : rem;
                const float tt = (float)d / (float)(n - 1);
                float feat = 0.f;
                if (lane == 0) feat = tt;
                else if (lane < 33) { const int j = (lane - 1) & 15; const float fj = 1e-4f + (float)j * ((15.0f - 1e-4f) / 15.0f); const float ang = (PI2 / (float)n) * (float)d * fj;
                    feat = lane < 17 ? cosf(ang) : -sinf(ang); }
                float a1 = b1[lane];
#pragma unroll
                for (int i = 0; i < 33; ++i) a1 += __shfl(feat, i) * w1[i * 64 + lane];
                const float h1 = sinf(fr * a1);
                float a2 = b2[lane];
#pragma unroll
                for (int i = 0; i < 64; ++i) a2 += __shfl(h1, i) * w2[i * 64 + lane];
                h2s[lane * 12 + q] = sinf(fr * a2);
            }
            __syncthreads();
            float acc[2][10];
#pragma unroll
            for (int q = 0; q < 10; ++q) { acc[0][q] = 0.f; acc[1][q] = 0.f; }
#pragma unroll 8
            for (int i = 0; i < 64; ++i) {
                const float wa = w3[i * 1024 + tid], wb = w3[i * 1024 + 512 + tid];
                const f32x4 ha = *(const f32x4*)(h2s + i * 12), hb = *(const f32x4*)(h2s + i * 12 + 4); const float h8 = h2s[i * 12 + 8], h9 = h2s[i * 12 + 9];
                acc[0][0] += ha[0] * wa; acc[0][1] += ha[1] * wa; acc[0][2] += ha[2] * wa; acc[0][3] += ha[3] * wa; acc[0][4] += hb[0] * wa; acc[0][5] += hb[1] * wa; acc[0][6] += hb[2] * wa; acc[0][7] += hb[3] * wa; acc[0][8] += h8 * wa; acc[0][9] += h9 * wa;
                acc[1][0] += ha[0] * wb; acc[1][1] += ha[1] * wb; acc[1][2] += ha[2] * wb; acc[1][3] += ha[3] * wb; acc[1][4] += hb[0] * wb; acc[1][5] += hb[1] * wb; acc[1][6] += hb[2] * wb; acc[1][7] += hb[3] * wb; acc[1][8] += h8 * wb; acc[1][9] += h9 * wb;
            }
            const int ord = (tid >> 8) & 1, c = tid & 255;
            const float dec = fabsf(p.in[21][(l * 2 + ord) * 256 + c]);
            bf16_t* gl = (bf16_t*)(ws + OFF_FILT) + (size_t)l * G_L;
#pragma unroll
            for (int q = 0; q < 10; ++q) {
                const int rem = (u0 + q) % 1280; const int pass = rem >= 256; const int n = pass ? 1024 : 256; const int d = pass ? rem - 256 : rem;
                const float tt = (float)d / (float)(n - 1); const float win = expf(-tt * dec) / (float)(2 * n);
                bf16_t* g = gl + (pass ? G_CTX : 0) + ((size_t)ord * 256 + c) * (2 * n);
                g[n - 1 - d] = f2bf(acc[0][q] * win);
                g[d == 0 ? 2 * n - 1 : n - 1 + d] = d == 0 ? (bf16_t)0 : f2bf(acc[1][q] * win);
            }
        }
        __syncthreads();
    }
    __syncthreads();
    {
        bf16_t* FC = (bf16_t*)(ws + OFF_FC); bf16_t* FL = (bf16_t*)(ws + OFF_FL);
        const int gt = bid * NTHREADS + tid, gn = nb * NTHREADS;
        for (int i = gt; i < 256 * 512 + 1024 * 2048; i += gn) {
            int n, k, col; bf16_t* dst;
            if (i < 256 * 512) { n = 256; k = i >> 9; col = i & 511; dst = FC + i; } else { const int j = i - 256 * 512; n = 1024; k = j >> 11; col = j & 2047; dst = FL + j; }
            const int s = col >= n, t = col - s * n; const int ph = (k * t) & (n - 1);
            float sv, cv; sincosf(PI2 * (float)ph / (float)n, &sv, &cv);
            const float sc = rsqrtf(64.0f * (float)n);
            *dst = f2bf((s ? -sv : cv) * sc);
        }
        { bf16_t* CK = (bf16_t*)(ws + OFF_CKB); bf16_t* CV = (bf16_t*)(ws + OFF_CVT);
            for (int i = gt; i < 2 * 8 * 256 * 128; i += gn) {
                { const int c = i & 127, key = (i >> 7) & 255, b = (i >> 15) & 7, l = i >> 18;
                    CK[i] = f2bf(p.in[2][(((size_t)b * 2 + l) * 256 + key) * 128 + c]); }
                { const int key = i & 255, c = (i >> 8) & 127, b = (i >> 15) & 7, l = i >> 18;
                    CV[i] = f2bf(p.in[3][(((size_t)b * 2 + l) * 256 + key) * 128 + c]); }
            } }
        if (bid == 0) for (int i = tid; i < 64 * 16; i += NTHREADS) { const int pos = i >> 4, j = i & 15; const float inv = powf(10000.0f, -(float)(2 * j) / 32.0f);
            float sv, cv; sincosf((float)pos * inv, &sv, &cv); float* rp = (float*)(ws + OFF_ROPE); rp[2 * i] = cv; rp[2 * i + 1] = sv; }
    }
    __syncthreads();
}

template <int MODE>
__device__ void phase_row(const Params& p, int lpost, int spost, int lpre, int spre) {
    const int tid_ = opaque_tid(); const int lane = tid_ & 63, wv = tid_ >> 6;
    GAS unsigned char* wsg = (GAS unsigned char*)p.ws; asm volatile("" : "+s"(wsg));
    const GAS float* mod = (const GAS float*)(wsg + OFF_MOD);
    const GAS bf16_t* Y = (const GAS bf16_t*)(wsg + OFF_Y); const GAS float* ssq = (const GAS float*)(wsg + OFF_SSQ);
    GAS bf16_t* H = (GAS bf16_t*)(wsg + OFF_H); GAS bf16_t* X16 = (GAS bf16_t*)(wsg + OFF_X16);
    const float factor = (spost == 1) ? 1.0f : 0.5f;
    for (int rbase = (blockIdx.x * 8 + wv) * 8; rbase < NTOK; rbase += gridDim.x * 64) {
        const int bc = rbase < NCTX ? 0 : 1 + ((rbase - NCTX) >> 10);
        f32x4 coef[4], gsc[4], sh[4];
        if (MODE != 0) { const GAS float* gate = mod + ((size_t)lpost * 9 + bc) * 9216 + spost * 3072 + 2048; const float* gp = p.in[8] + (lpost * 6 + 2 * spost + 1) * 1024;
#pragma unroll
            for (int j = 0; j < 4; ++j) { const int c = j * 256 + lane * 4; coef[j] = *(const GAS f32x4*)(gate + c) * *(const f32x4*)(gp + c) * factor; } }
        if (MODE != 2) { const GAS float* mb = mod + ((size_t)lpre * 9 + bc) * 9216 + spre * 3072; const float* gp = p.in[8] + (lpre * 6 + 2 * spre) * 1024;
#pragma unroll
            for (int j = 0; j < 4; ++j) { const int c = j * 256 + lane * 4; sh[j] = *(const GAS f32x4*)(mb + c); gsc[j] = *(const f32x4*)(gp + c) * (*(const GAS f32x4*)(mb + 1024 + c) + 1.0f); } }
#pragma unroll 1
        for (int rp = 0; rp < 8; rp += 2) {
            f32x4 x[2][4]; u32x2 yv[2][4]; f32x4 sq[2][4];
#pragma unroll
            for (int q = 0; q < 2; ++q) {
                const int rw = rbase + rp + q;
                if (MODE == 0 || (lpost == 0 && spost == 0)) { const float* src = rw < NCTX ? p.in[0] + (size_t)rw * D : p.in[1] + (size_t)(rw - NCTX) * D;
#pragma unroll
                    for (int j = 0; j < 4; ++j) x[q][j] = *(const f32x4*)(src + j * 256 + lane * 4); }
                else {
#pragma unroll
                    for (int j = 0; j < 4; ++j) { const u32x2 xb = *(const GAS u32x2*)(X16 + (size_t)rw * D + j * 256 + lane * 4);
                        x[q][j][0] = __uint_as_float(xb.x << 16); x[q][j][1] = __uint_as_float(xb.x & 0xFFFF0000u); x[q][j][2] = __uint_as_float(xb.y << 16); x[q][j][3] = __uint_as_float(xb.y & 0xFFFF0000u); } }
                if (MODE != 0) {
#pragma unroll
                    for (int j = 0; j < 4; ++j) yv[q][j] = *(const GAS u32x2*)(Y + (size_t)rw * D + j * 256 + lane * 4);
                    const GAS f32x4* sp = (const GAS f32x4*)(ssq + (size_t)rw * 16);
#pragma unroll
                    for (int j = 0; j < 4; ++j) sq[q][j] = sp[j];
                }
            }
#pragma unroll
            for (int q = 0; q < 2; ++q) {
                const int row = rbase + rp + q;
                if (MODE != 0) {
                    float tot = 0.f;
#pragma unroll
                    for (int j = 0; j < 4; ++j) tot += (sq[q][j][0] + sq[q][j][1]) + (sq[q][j][2] + sq[q][j][3]);
                    const float rstd = rsqrtf(tot * (1.0f / 1024.0f) + EPS);
#pragma unroll
                    for (int j = 0; j < 4; ++j) {
                        x[q][j][0] += coef[j][0] * rstd * __uint_as_float(yv[q][j].x << 16);
                        x[q][j][1] += coef[j][1] * rstd * __uint_as_float(yv[q][j].x & 0xFFFF0000u);
                        x[q][j][2] += coef[j][2] * rstd * __uint_as_float(yv[q][j].y << 16);
                        x[q][j][3] += coef[j][3] * rstd * __uint_as_float(yv[q][j].y & 0xFFFF0000u); }
                    if (MODE == 2) {
#pragma unroll
                        for (int j = 0; j < 4; ++j) *(f32x4*)(p.out + (size_t)row * D + j * 256 + lane * 4) = x[q][j];
                    } else {
#pragma unroll
                        for (int j = 0; j < 4; ++j) { u32x2 w; w.x = pk_bf16(x[q][j][0], x[q][j][1]); w.y = pk_bf16(x[q][j][2], x[q][j][3]); *(GAS u32x2*)(X16 + (size_t)row * D + j * 256 + lane * 4) = w; }
                    }
                }
                if (MODE != 2) {
                    float s = 0.f;
#pragma unroll
                    for (int j = 0; j < 4; ++j) s += x[q][j][0] * x[q][j][0] + x[q][j][1] * x[q][j][1] + x[q][j][2] * x[q][j][2] + x[q][j][3] * x[q][j][3];
#pragma unroll
                    for (int o = 32; o >= 1; o >>= 1) s += __shfl_xor(s, o);
                    const float rs = rsqrtf(s * (1.0f / 1024.0f) + EPS);
#pragma unroll
                    for (int j = 0; j < 4; ++j) { const int c = j * 256 + lane * 4;
                        const f32x4 hh = x[q][j] * rs * gsc[j] + sh[j];
                        u32x2 w; w.x = pk_bf16(hh[0], hh[1]); w.y = pk_bf16(hh[2], hh[3]);
                        *(GAS u32x2*)(H + (size_t)row * D + c) = w; }
                }
            }
        }
    }
}

constexpr int AT_KROWB = 144;
constexpr int AT_VROWB_A = 784, AT_VROWB_B = 528;
constexpr int AT_OFF_V = 320 * AT_KROWB;
struct AttnState { f32x16 O0, O1; float m, lsum; };
template <bool MASK>
__device__ __forceinline__ void attn_tiles(AttnState& st, const bf16x8 (&qf)[4], const LAS unsigned char* Kl, const LAS unsigned char* Vl, int vrowb, int t0, int t1, int dk0, int r, int h) {
    for (int t = t0; t < t1; ++t) {
        const LAS unsigned char* kp = Kl + (t * 32 + r) * AT_KROWB + h * 16;
        bf16x8 kf[4];
#pragma unroll
        for (int kk = 0; kk < 4; ++kk) kf[kk] = *(const LAS bf16x8*)(kp + kk * 32);
        const LAS unsigned char* vp = Vl + r * vrowb + (t * 32 + 4 * h) * 2;
        u32x2 vraw[2][2][2];
#pragma unroll
        for (int dt = 0; dt < 2; ++dt)
#pragma unroll
            for (int s = 0; s < 2; ++s)
#pragma unroll
                for (int q = 0; q < 2; ++q) vraw[dt][s][q] = *(const LAS u32x2*)(vp + dt * 32 * vrowb + (16 * s + 8 * q) * 2);
        f32x16 S;
#pragma unroll
        for (int i = 0; i < 16; ++i) S[i] = 0.f;
#pragma unroll
        for (int kk = 0; kk < 4; ++kk) S = __builtin_amdgcn_mfma_f32_32x32x16_bf16(kf[kk], qf[kk], S, 0, 0, 0);
        if (MASK) {
            const int dk = dk0 + t * 32;
            if (dk <= -128 || dk >= 128) {
#pragma unroll
                for (int i = 0; i < 16; ++i) { const int j = (i & 3) + 8 * (i >> 2) + 4 * h; int dd = dk + j - r; if (dd < 0) dd = -dd; if (dd > 128) S[i] = -1e30f; }
            }
        }
        float mx = S[0];
#pragma unroll
        for (int i = 1; i < 16; ++i) mx = fmaxf(mx, S[i]);
        mx = fmaxf(mx, __shfl_xor(mx, 32));
        const float mn = fmaxf(st.m, mx), corr = __expf(st.m - mn);
        st.m = mn;
        float rs = 0.f;
#pragma unroll
        for (int i = 0; i < 16; ++i) { S[i] = __expf(S[i] - mn); rs += S[i]; }
        rs += __shfl_xor(rs, 32);
        st.lsum = st.lsum * corr + rs;
#pragma unroll
        for (int i = 0; i < 16; ++i) { st.O0[i] *= corr; st.O1[i] *= corr; }
        bf16x8 pf[2];
#pragma unroll
        for (int s = 0; s < 2; ++s) { u32x4 w; w.x = pk_bf16(S[8 * s], S[8 * s + 1]); w.y = pk_bf16(S[8 * s + 2], S[8 * s + 3]); w.z = pk_bf16(S[8 * s + 4], S[8 * s + 5]); w.w = pk_bf16(S[8 * s + 6], S[8 * s + 7]);
            pf[s] = __builtin_bit_cast(bf16x8, w); }
#pragma unroll
        for (int s = 0; s < 2; ++s) {
            u32x4 a0; a0.x = vraw[0][s][0].x; a0.y = vraw[0][s][0].y; a0.z = vraw[0][s][1].x; a0.w = vraw[0][s][1].y;
            u32x4 a1; a1.x = vraw[1][s][0].x; a1.y = vraw[1][s][0].y; a1.z = vraw[1][s][1].x; a1.w = vraw[1][s][1].y;
            st.O0 = __builtin_amdgcn_mfma_f32_32x32x16_bf16(__builtin_bit_cast(bf16x8, a0), pf[s], st.O0, 0, 0, 0);
            st.O1 = __builtin_amdgcn_mfma_f32_32x32x16_bf16(__builtin_bit_cast(bf16x8, a1), pf[s], st.O1, 0, 0, 0);
        }
    }
}
__device__ __forceinline__ void attn_unit(const Params& p, int l, int u, LAS unsigned char* lds, int tid) {
    const int lane = tid & 63, wv = tid >> 6, r = lane & 31, h = lane >> 5;
    const bf16_t* QB = (const bf16_t*)(p.ws + OFF_QB); const bf16_t* KB = (const bf16_t*)(p.ws + OFF_KB); const bf16_t* VT = (const bf16_t*)(p.ws + OFF_VB);
    const bf16_t* CK = (const bf16_t*)(p.ws + OFF_CKB); const bf16_t* CV = (const bf16_t*)(p.ws + OFF_CVT);
    bf16_t* YC = (bf16_t*)(p.ws + OFF_YCAT);
    const int g = wv & 3, qh = wv >> 2;
    const int pass = u < 256; const int v = u & 255;
    int b, kvh, qb, n, rowbase;
    if (!pass) { b = v >> 3; kvh = (v >> 2) & 1; qb = v & 3; n = 256; rowbase = b * 256; }
    else { b = v >> 5; kvh = (v >> 4) & 1; qb = v & 15; n = 1024; rowbase = NCTX + b * 1024; }
    const int head = kvh * 4 + g, q0w = qb * 64 + qh * 32;
    int kloU = 0, khiU = 256;
    if (pass) { kloU = qb * 64 - 128; if (kloU < 0) kloU = 0; khiU = qb * 64 + 192; if (khiU > n) khiU = n; }
    const int nkA = khiU - kloU, npc = nkA * 8, vpr = nkA >> 3;
    const bf16_t* kA = KB + (size_t)(rowbase + kloU) * 128 + kvh * 64;
    const bf16_t* vA = VT + (pass ? VT_LAT + (size_t)b * 128 * 1024 : (size_t)b * 128 * 256) + (size_t)kvh * 64 * n + kloU;
    {
        u32x4 kr[5], vr[5];
#pragma unroll
        for (int it = 0; it < 5; ++it) { const int idx = tid + it * NTHREADS;
            if (idx < npc) { kr[it] = *(const u32x4*)(kA + (size_t)(idx >> 3) * 128 + (idx & 7) * 8);
                const int d = idx / vpr, j = idx - d * vpr; vr[it] = *(const u32x4*)(vA + (size_t)d * n + j * 8); } }
#pragma unroll
        for (int it = 0; it < 5; ++it) { const int idx = tid + it * NTHREADS;
            if (idx < npc) { *(LAS u32x4*)(lds + (idx >> 3) * AT_KROWB + (idx & 7) * 16) = kr[it];
                const int d = idx / vpr, j = idx - d * vpr; *(LAS u32x4*)(lds + AT_OFF_V + d * AT_VROWB_A + j * 16) = vr[it]; } }
    }
    bf16x8 qf[4];
    { const bf16_t* qp = QB + (size_t)(rowbase + q0w + r) * 512 + head * 64 + 8 * h;
#pragma unroll
        for (int kk = 0; kk < 4; ++kk) qf[kk] = *(const bf16x8*)(qp + 16 * kk); }
    AttnState st; st.m = p.in[23][l * 8 + head]; st.lsum = 1.0f;
#pragma unroll
    for (int i = 0; i < 16; ++i) { st.O0[i] = 0.f; st.O1[i] = 0.f; }
    __syncthreads();
    u32x4 kb[4], vb[4];
    if (pass) {
        const bf16_t* kB = CK + ((size_t)(l * 8 + b) * 256) * 128 + kvh * 64;
        const bf16_t* vB = CV + ((size_t)(l * 8 + b) * 128 + kvh * 64) * 256;
#pragma unroll
        for (int it = 0; it < 4; ++it) { const int idx = tid + it * NTHREADS;
            kb[it] = *(const u32x4*)(kB + (size_t)(idx >> 3) * 128 + (idx & 7) * 8);
            vb[it] = *(const u32x4*)(vB + (size_t)(idx >> 5) * 256 + (idx & 31) * 8); }
    }
    {
        int klo = 0, khi = 256;
        if (pass) { klo = q0w - 128; if (klo < 0) klo = 0; khi = q0w + 160; if (khi > n) khi = n; }
        const int t0 = (klo - kloU) >> 5, t1 = (khi - kloU) >> 5;
        if (pass) attn_tiles<true>(st, qf, lds, lds + AT_OFF_V, AT_VROWB_A, t0, t1, kloU - q0w, r, h);
        else attn_tiles<false>(st, qf, lds, lds + AT_OFF_V, AT_VROWB_A, t0, t1, 0, r, h);
    }
    if (pass) {
        __syncthreads();
#pragma unroll
        for (int it = 0; it < 4; ++it) { const int idx = tid + it * NTHREADS;
            *(LAS u32x4*)(lds + (idx >> 3) * AT_KROWB + (idx & 7) * 16) = kb[it];
            *(LAS u32x4*)(lds + AT_OFF_V + (idx >> 5) * AT_VROWB_B + (idx & 31) * 16) = vb[it]; }
        __syncthreads();
        attn_tiles<false>(st, qf, lds, lds + AT_OFF_V, AT_VROWB_B, 0, 8, 0, r, h);
    }
    const float inv = 1.0f / st.lsum;
    bf16_t* op = YC + (size_t)(rowbase + q0w + r) * 1024 + 512 + head * 64 + 4 * h;
#pragma unroll
    for (int gq = 0; gq < 4; ++gq) {
        u32x2 w0; w0.x = pk_bf16(st.O0[4 * gq] * inv, st.O0[4 * gq + 1] * inv); w0.y = pk_bf16(st.O0[4 * gq + 2] * inv, st.O0[4 * gq + 3] * inv);
        u32x2 w1; w1.x = pk_bf16(st.O1[4 * gq] * inv, st.O1[4 * gq + 1] * inv); w1.y = pk_bf16(st.O1[4 * gq + 2] * inv, st.O1[4 * gq + 3] * inv);
        *(u32x2*)(op + 8 * gq) = w0; *(u32x2*)(op + 32 + 8 * gq) = w1;
    }
    __syncthreads();
}
__device__ void attn_mfma(const Params& p, int l, LAS unsigned char* lds) {
    const int tid = opaque_tid();
    for (int u = blockIdx.x; u < 512; u += gridDim.x) attn_unit(p, l, u, lds, tid);
}

template <int NB  , int NBLK  >
__device__ __forceinline__ void hyena_unit(const Params& p, int l, int c, const bf16_t* __restrict__ HTp, int rowbase, const bf16_t* __restrict__ gb, LAS unsigned char* lds, int tid) {
    constexpr int n = 32 * NBLK, NI = 32 / NB, PAD = 32 * (NI - 1);
    constexpr int LENB = (2 * n * 2 - 64 + 255) / 256 * 256 + 64;
    constexpr int UROWB = ((n + 2 * PAD) * 2 + 255) / 256 * 256 + 16;
    constexpr int GSB = (2 * n + 8) * 2;
    constexpr int OFF_F0 = 0, OFF_F1 = 8 * LENB, OFF_U = 16 * LENB, OFF_U2 = OFF_U + NB * UROWB, OFF_G1 = OFF_U2 + NB * UROWB, OFF_G2 = OFF_G1 + NB * n * 2, OFF_GS = OFF_G2 + NB * n * 2;
    static_assert(OFF_GS + 2 * GSB <= 149 * 1024, "hyena LDS");
    const int lane = tid & 63, wv = tid >> 6, r = lane & 31, h = lane >> 5;
    const float* cw = p.in[14] + l * 3 * 768;
    if (tid < 2 * (2 * n / 8)) { const int o = tid / (2 * n / 8), k = tid % (2 * n / 8);
        *(LAS u32x4*)(lds + OFF_GS + o * GSB + k * 16) = *(const u32x4*)(gb + ((size_t)o * 256 + c) * (2 * n) + k * 8); }
    if (tid < 2) *(LAS u32x4*)(lds + OFF_GS + tid * GSB + 2 * n * 2) = (u32x4){0u, 0u, 0u, 0u};
    constexpr int NQ = 3 * NB * (n / 8) / NTHREADS;
#pragma unroll
    for (int it = 0; it < NQ; ++it) {
        const int q = tid + it * NTHREADS;
        const int w = q / (NB * (n / 8)), rem = q % (NB * (n / 8)), b = rem / (n / 8), t0 = (rem % (n / 8)) * 8;
        const int ch = w * 256 + c; const bf16_t* row = HTp + ((size_t)b * 768 + ch) * n;
        const float w0 = cw[ch], w1 = cw[768 + ch], w2 = cw[1536 + ch];
        const u32x4 raw = *(const u32x4*)(row + t0);
        float x[10];
        x[0] = t0 > 0 ? bf2f(row[t0 - 1]) : 0.f; x[9] = t0 + 8 < n ? bf2f(row[t0 + 8]) : 0.f;
        x[1] = __uint_as_float(raw.x << 16); x[2] = __uint_as_float(raw.x & 0xFFFF0000u); x[3] = __uint_as_float(raw.y << 16); x[4] = __uint_as_float(raw.y & 0xFFFF0000u);
        x[5] = __uint_as_float(raw.z << 16); x[6] = __uint_as_float(raw.z & 0xFFFF0000u); x[7] = __uint_as_float(raw.w << 16); x[8] = __uint_as_float(raw.w & 0xFFFF0000u);
        float z[8];
#pragma unroll
        for (int e = 0; e < 8; ++e) z[e] = x[e] * w0 + x[e + 1] * w1 + x[e + 2] * w2;
        u32x4 o; o.x = pk_bf16(z[0], z[1]); o.y = pk_bf16(z[2], z[3]); o.z = pk_bf16(z[4], z[5]); o.w = pk_bf16(z[6], z[7]);
        LAS unsigned char* dst = w == 0 ? lds + OFF_U + b * UROWB + (PAD + t0) * 2 : lds + (w == 1 ? OFF_G1 : OFF_G2) + (b * n + t0) * 2;
        *(LAS u32x4*)dst = o;
    }
    if (PAD > 0) {
        constexpr int FR = PAD / 8, BK_ = (UROWB / 2 - PAD - n) / 8;
        for (int q = tid; q < 2 * NB * (FR + BK_); q += NTHREADS) {
            const int buf = q / (NB * (FR + BK_)), rem = q % (NB * (FR + BK_)), b = rem / (FR + BK_), k = rem % (FR + BK_);
            const int e0 = k < FR ? k * 8 : PAD + n + (k - FR) * 8;
            *(LAS u32x4*)(lds + (buf ? OFF_U2 : OFF_U) + b * UROWB + e0 * 2) = (u32x4){0u, 0u, 0u, 0u};
        }
    }
    __syncthreads();
    if (tid < 2 * (2 * n / 8)) { const int o = tid / (2 * n / 8), k = tid % (2 * n / 8);
        const u32x4 lo = *(const LAS u32x4*)(lds + OFF_GS + o * GSB + k * 16), hi = *(const LAS u32x4*)(lds + OFF_GS + o * GSB + k * 16 + 16);
        const unsigned d[8] = {lo.x, lo.y, lo.z, lo.w, hi.x, hi.y, hi.z, hi.w};
        LAS unsigned char* fdst = lds + (o ? OFF_F1 : OFF_F0) + k * 16;
#pragma unroll
        for (int s = 0; s < 8; ++s) { u32x4 w;
            if ((s & 1) == 0) { w.x = d[s / 2]; w.y = d[s / 2 + 1]; w.z = d[s / 2 + 2]; w.w = d[s / 2 + 3]; }
            else { w.x = __builtin_amdgcn_alignbyte(d[s / 2 + 1], d[s / 2], 2); w.y = __builtin_amdgcn_alignbyte(d[s / 2 + 2], d[s / 2 + 1], 2);
                   w.z = __builtin_amdgcn_alignbyte(d[s / 2 + 3], d[s / 2 + 2], 2); w.w = __builtin_amdgcn_alignbyte(d[s / 2 + 4], d[s / 2 + 3], 2); }
            *(LAS u32x4*)(fdst + s * LENB) = w; }
    }
    __syncthreads();
    const int bcol = NB == 8 ? (r >> 2) : r, ioff = NB == 8 ? (r & 3) : 0, I0 = wv * NI, Icol = I0 + ioff;
    const int si = (7 - r) & 7;
    const int Dlo = I0 + NI - 1 - (NBLK - 1) - (NI - 1), Dhi = I0 + NI - 1;
    bf16_t* YC = (bf16_t*)(p.ws + OFF_YCAT);
#pragma unroll
    for (int o = 0; o < 2; ++o) {
        const LAS unsigned char* ap = lds + (o ? OFF_F1 : OFF_F0) + si * LENB + (n - 1 - r + 8 * h - si) * 2 - 64 * Dlo;
        const LAS unsigned char* bp = lds + (o ? OFF_U2 : OFF_U) + bcol * UROWB + (PAD + 32 * Icol + 8 * h) * 2 - 64 * Dlo;
        f32x16 acc;
#pragma unroll
        for (int i = 0; i < 16; ++i) acc[i] = 0.f;
#pragma unroll 4
        for (int D = Dlo; D <= Dhi; ++D) {
            const bf16x8 a0 = *(const LAS bf16x8*)ap, a1 = *(const LAS bf16x8*)(ap + 32);
            const bf16x8 b0 = *(const LAS bf16x8*)bp, b1 = *(const LAS bf16x8*)(bp + 32);
            acc = __builtin_amdgcn_mfma_f32_32x32x16_bf16(a0, b0, acc, 0, 0, 0);
            acc = __builtin_amdgcn_mfma_f32_32x32x16_bf16(a1, b1, acc, 0, 0, 0);
            ap -= 64; bp -= 64;
        }
        const float bias = p.in[22][(l * 2 + o) * 256 + c];
#pragma unroll
        for (int g = 0; g < 4; ++g) {
            const int t0 = 32 * Icol + 8 * g + 4 * h;
            const u32x2 uin = *(const LAS u32x2*)(lds + (o ? OFF_U2 : OFF_U) + bcol * UROWB + (PAD + t0) * 2);
            const u32x2 gin = *(const LAS u32x2*)(lds + (o ? OFF_G2 : OFF_G1) + (bcol * n + t0) * 2);
            float y[4];
            y[0] = __uint_as_float(gin.x << 16) * (acc[4 * g] + bias * __uint_as_float(uin.x << 16));
            y[1] = __uint_as_float(gin.x & 0xFFFF0000u) * (acc[4 * g + 1] + bias * __uint_as_float(uin.x & 0xFFFF0000u));
            y[2] = __uint_as_float(gin.y << 16) * (acc[4 * g + 2] + bias * __uint_as_float(uin.y << 16));
            y[3] = __uint_as_float(gin.y & 0xFFFF0000u) * (acc[4 * g + 3] + bias * __uint_as_float(uin.y & 0xFFFF0000u));
            if (o == 0) { u32x2 w; w.x = pk_bf16(y[0], y[1]); w.y = pk_bf16(y[2], y[3]);
                *(LAS u32x2*)(lds + OFF_U2 + bcol * UROWB + (PAD + t0) * 2) = w; }
            else { bf16_t* dst = YC + (size_t)(rowbase + bcol * n + t0) * 1024 + 256 + c;
#pragma unroll
                for (int e = 0; e < 4; ++e) dst[(size_t)e * 1024] = f2bf(y[e]); }
        }
        __syncthreads();
    }
}
__device__ void hyena_mfma(const Params& p, int l, LAS unsigned char* lds) {
    const int tid = opaque_tid();
    const bf16_t* HT = (const bf16_t*)(p.ws + OFF_HT);
    const bf16_t* gl = (const bf16_t*)(p.ws + OFF_FILT) + (size_t)l * G_L;
    for (int u = blockIdx.x; u < 512; u += gridDim.x) {
        if (u < 256) hyena_unit<8, 32>(p, l, u, HT + HT_LAT, NCTX, gl + G_CTX, lds, tid);
        else hyena_unit<32, 8>(p, l, u - 256, HT, 0, gl, lds, tid);
    }
}


struct OneUnit { int pm, pn;
    __device__ __forceinline__ bool next(int i, pg8::Unit& u) const { if (i) return false; u.pm = pm; u.pn = pn; return true; }
    __device__ __forceinline__ void a_ready(const pg8::Unit&) const {}
    __device__ __forceinline__ void done(const pg8::Unit&) const {} };
__device__ void mixer_phase(const Params& p, int l, LAS unsigned char* lds) {
    constexpr int NU = 32 + 256 + 256 + 32 + 256 + 256;
    GAS unsigned char* wsg = (GAS unsigned char*)p.ws; asm volatile("" : "+s"(wsg)); unsigned char* ws = (unsigned char*)wsg;
    unsigned* ctr = (unsigned*)(ws + OFF_BAR) + 64 * l;
    volatile LAS unsigned* slot = (volatile LAS unsigned*)(lds + 149 * 1024 + 8);
    const bf16_t* HT = (const bf16_t*)(ws + OFF_HT);
    const bf16_t* gl = (const bf16_t*)(ws + OFF_FILT) + (size_t)l * G_L;
    int u = blockIdx.x;
    while (u < NU) {
        unsigned ticket = 0;
        if (threadIdx.x == 0) ticket = __hip_atomic_fetch_add(ctr, 1u, __ATOMIC_RELAXED, __HIP_MEMORY_SCOPE_AGENT);
        const int tid = opaque_tid();
        if (u < 32) {
            pg8::Gemm g{(const bf16_t*)(ws + OFF_FL), (const bf16_t*)(ws + OFF_ZT) + ZT_LAT, 1024, 2048, 2048, 2048, 2048};
            OneUnit S{u & 3, u >> 2}; EpiFourier E{(bf16_t*)(ws + OFF_YCAT), NCTX, 1024};
            pg8::gemm_phase(lds, g, S, E);
        } else if (u < 288) attn_unit(p, l, u - 32, lds, tid);
        else if (u < 544) hyena_unit<8, 32>(p, l, u - 288, HT + HT_LAT, NCTX, gl + G_CTX, lds, tid);
        else if (u < 576) {
            pg8::Gemm g{(const bf16_t*)(ws + OFF_FC), (const bf16_t*)(ws + OFF_ZT), 256, 8192, 512, 512, 512};
            OneUnit S{0, u - 544}; EpiFourier E{(bf16_t*)(ws + OFF_YCAT), 0, 256};
            pg8::gemm_phase(lds, g, S, E);
        } else if (u < 832) attn_unit(p, l, 256 + (u - 576), lds, tid);
        else hyena_unit<32, 8>(p, l, u - 832, HT, 0, gl, lds, tid);
        if (threadIdx.x == 0) *slot = ticket + 256u;
        __syncthreads();
        u = (int)*slot;
        __syncthreads();
    }
}

__global__ void __launch_bounds__(NTHREADS, 2) fwd_megakernel(Params p) {
    extern __shared__ __attribute__((aligned(16))) unsigned char shm[];
    cg::grid_group grid = cg::this_grid();
    LAS unsigned char* lds = (LAS unsigned char*)shm;
    float* ldsf = (float*)shm;
    unsigned char* ws = p.ws;
    const int G = gridDim.x, c = blockIdx.x;

    volatile LAS unsigned* xst = (volatile LAS unsigned*)(lds + 149 * 1024);
    if (threadIdx.x < 4) xst[threadIdx.x] = 0u;
    __syncthreads();
    const XcdBarrier xb = xcd_barrier_post((unsigned*)(ws + OFF_BAR), xst);
    for (int _d = 0; _d < DUP_PREP; ++_d) { phase_prep(p, ldsf); __syncthreads(); }
    if (p.ws == nullptr) grid.sync();
    GSYNC();
    phase_row<0>(p, 0, 0, 0, 0);
    GSYNC();
    for (int l = 0; l < 2; ++l) {
        for (int s = 0; s < 3; ++s) {
            GAS unsigned char* wsg = (GAS unsigned char*)p.ws; asm volatile("" : "+s"(wsg)); unsigned char* ws = (unsigned char*)wsg;
            if (s != 1) {
                const int fs = s >> 1;
                { pg8::Gemm g{(const bf16_t*)(ws + OFF_H), (const bf16_t*)(ws + OFF_WGU + (l * 2 + fs) * SZ_WGU), NTOK, 5632, 1024, 1024, 1024};
                    pg8::StaticOrder S; S.init(g.M, g.N, G, c); EpiSwiglu E{(bf16_t*)(ws + OFF_ACT)};
                    for (int _d = 0; _d < DUP_GEMM; ++_d) pg8::gemm_phase(lds, g, S, E); }
                { int cc = c, gg = G; asm volatile("" : "+s"(cc), "+s"(gg));
                    if (cc >= 1408 - 5 * gg) { __syncthreads(); tr_slot(p, ldsf, 1 + l * 2 + fs, cc - (1408 - 5 * gg), gg - (1408 - 5 * gg), opaque_tid()); } }
                GSYNC();
                { pg8::Gemm g{(const bf16_t*)(ws + OFF_ACT), (const bf16_t*)(ws + OFF_WD + (l * 2 + fs) * SZ_WD), NTOK, 1024, DFF, DFF, DFF};
                    pg8::StaticOrder S; S.init(g.M, g.N, G, c); EpiYssq E{(bf16_t*)(ws + OFF_Y), (float*)(ws + OFF_SSQ)};
                    for (int _d = 0; _d < DUP_GEMM; ++_d) pg8::gemm_phase(lds, g, S, E); }
                GSYNC();
            } else {
                { pg8::Gemm g{(const bf16_t*)(ws + OFF_H), (const bf16_t*)(ws + OFF_WIN + l * SZ_WIN), NTOK, 2048, 1024, 1024, 1024};
                    pg8::StaticOrder S; S.init(g.M, g.N, G, c);
                    EpiWin E{(bf16_t*)(ws + OFF_ZT), (bf16_t*)(ws + OFF_HT), (bf16_t*)(ws + OFF_QB), (bf16_t*)(ws + OFF_KB), (bf16_t*)(ws + OFF_VB), (const float*)(ws + OFF_ROPE),
                             p.out + (size_t)NTOK * D, p.out + (size_t)NTOK * D + (size_t)32 * 2 * 256 * 128, l};
                    for (int _d = 0; _d < DUP_GEMM; ++_d) pg8::gemm_phase(lds, g, S, E); }
                GSYNC();
                mixer_phase(p, l, lds);
                GSYNC();
                { pg8::Gemm g{(const bf16_t*)(ws + OFF_YCAT), (const bf16_t*)(ws + OFF_WOUT + l * SZ_WOUT), NTOK, 1024, 1024, 1024, 1024};
                    pg8::StaticOrder S; S.init(g.M, g.N, G, c); EpiYssq E{(bf16_t*)(ws + OFF_Y), (float*)(ws + OFF_SSQ)};
                    for (int _d = 0; _d < DUP_GEMM; ++_d) pg8::gemm_phase(lds, g, S, E); }
                GSYNC();
            }
            if (l == 1 && s == 2) phase_row<2>(p, l, s, 0, 0);
            else { const int ln = s == 2 ? l + 1 : l, sn = s == 2 ? 0 : s + 1; phase_row<1>(p, l, s, ln, sn); }
            if (!(l == 1 && s == 2)) GSYNC();
        }
    }
}

extern "C" void kernel_launch(void* const* d_in, const int* in_sizes, int n_in, void* d_out, int out_size, void* d_ws, size_t ws_size, hipStream_t stream) {
    constexpr int LDS_BYTES = 149 * 1024 + 256;
    static int grid_blocks = 0;
    if (!grid_blocks) {
        if (n_in != 24 || ws_size < WS_END) { fprintf(stderr, "kernel_launch: bad inputs (n_in %d) or workspace too small (%zu < %zu)\n", n_in, ws_size, (size_t)WS_END); grid_blocks = -1; return; }
        int dev = 0, cus = 0, per_cu = 0;
        hipGetDevice(&dev);
        hipDeviceGetAttribute(&cus, hipDeviceAttributeMultiprocessorCount, dev);
        if (hipFuncSetAttribute((const void*)fwd_megakernel, hipFuncAttributeMaxDynamicSharedMemorySize, LDS_BYTES) != hipSuccess) fprintf(stderr, "kernel_launch: hipFuncSetAttribute failed\n");
        hipOccupancyMaxActiveBlocksPerMultiprocessor(&per_cu, (const void*)fwd_megakernel, NTHREADS, LDS_BYTES);
        if (per_cu < 1) { fprintf(stderr, "kernel_launch: occupancy query says %d blocks per CU\n", per_cu); per_cu = 1; }
        (void)hipGetLastError();
        grid_blocks = cus * per_cu;
        if (grid_blocks > 256) grid_blocks = 256;
    }
    if (grid_blocks < 0) return;
    Params p{};
    for (int i = 0; i < 24; ++i) p.in[i] = (const float*)d_in[i];
    p.out = (float*)d_out; p.ws = (unsigned char*)d_ws;
    (void)hipMemsetAsync((unsigned char*)d_ws + OFF_BAR, 0, 16384, stream);
    void* args[] = {&p};
    hipError_t e = hipLaunchCooperativeKernel((const void*)fwd_megakernel, dim3(grid_blocks), dim3(NTHREADS), args, LDS_BYTES, stream);
    if (e != hipSuccess) fprintf(stderr, "cooperative launch failed: %s (grid %d)\n", hipGetErrorString(e), grid_blocks);
}
```

```cpp
#include <hip/hip_runtime.h>
#include <hip/hip_cooperative_groups.h>
#include <cstdio>
namespace cg = cooperative_groups;

#define LAS __attribute__((address_space(3)))
#define GAS __attribute__((address_space(1)))
#ifndef DUP_PA
#define DUP_PA 1
#endif
#ifndef DUP_PB
#define DUP_PB 1
#endif
#ifndef DUP_PC
#define DUP_PC 1
#endif
#ifndef DUP_PD
#define DUP_PD 1
#endif
#ifndef DUP_HY
#define DUP_HY 1
#endif
#ifndef DUP_AT
#define DUP_AT 1
#endif
#ifndef DUP_GEMM
#define DUP_GEMM 1
#endif
#ifndef DUP_MIX
#define DUP_MIX 1
#endif
#ifndef DUP_PREP
#define DUP_PREP 1
#endif
#ifndef DUP_SYNC
#define DUP_SYNC 1
#endif
#define GSYNC() do { for (int _s = 0; _s < DUP_SYNC; ++_s) xcd_barrier(xb); } while (0)
typedef unsigned short bf16_t;
typedef short bf16x8 __attribute__((ext_vector_type(8)));
typedef float f32x4 __attribute__((ext_vector_type(4)));
typedef unsigned u32x4 __attribute__((ext_vector_type(4)));
typedef unsigned u32x2 __attribute__((ext_vector_type(2)));

constexpr int D = 1024, NTOK = 16384, NCTX = 8192, DFF = 2816, INW = 1792;
constexpr int NTHREADS = 512;
constexpr float EPS = 1e-6f;
constexpr float PI2 = 6.283185307179586f;

constexpr size_t AL(size_t x) { return (x + 255) & ~(size_t)255; }
constexpr size_t SZ_WGU = (size_t)5632 * 1024 * 2, SZ_WD = (size_t)1024 * 2816 * 2, SZ_WIN = (size_t)2048 * 1024 * 2, SZ_WOUT = (size_t)1024 * 1024 * 2;
constexpr size_t OFF_WGU = 0;
constexpr size_t OFF_WD = OFF_WGU + 4 * SZ_WGU;
constexpr size_t OFF_WIN = OFF_WD + 4 * SZ_WD;
constexpr size_t OFF_WOUT = OFF_WIN + 2 * SZ_WIN;
constexpr size_t OFF_H = OFF_WOUT + 2 * SZ_WOUT;
constexpr size_t OFF_Y = OFF_H + (size_t)NTOK * D * 2;
constexpr size_t OFF_SSQ = OFF_Y + (size_t)NTOK * D * 2;
constexpr size_t OFF_MOD = OFF_SSQ + (size_t)NTOK * 16 * 4;
constexpr size_t OFF_FILT = AL(OFF_MOD + (size_t)2 * 9 * 9216 * 4);
constexpr size_t FILT_CTX = (size_t)4 * 256 * 256, FILT_LAT = (size_t)4 * 256 * 1024, FILT_L = FILT_CTX + FILT_LAT;
constexpr size_t G_CTX = (size_t)2 * 256 * 512, G_LAT = (size_t)2 * 256 * 2048, G_L = G_CTX + G_LAT;
constexpr size_t OFF_FC = AL(OFF_FILT + 2 * FILT_L * 4);
constexpr size_t OFF_FL = OFF_FC + (size_t)256 * 512 * 2;
constexpr size_t OFF_ROPE = OFF_FL + (size_t)1024 * 2048 * 2;
constexpr size_t OFF_BAR = AL(OFF_ROPE + 64 * 16 * 8);
constexpr size_t OFF_CKB = OFF_BAR + 16384;
constexpr size_t OFF_CVT = OFF_CKB + (size_t)2 * 8 * 256 * 128 * 2;
constexpr size_t OFF_UNION = AL(OFF_CVT + (size_t)2 * 8 * 256 * 128 * 2);
constexpr size_t OFF_ACT = OFF_UNION;
constexpr size_t OFF_ZT = OFF_UNION;
constexpr size_t ZT_LAT = (size_t)NCTX * 512;
constexpr size_t OFF_HT = OFF_ZT + (size_t)NTOK * 512 * 2;
constexpr size_t HT_LAT = (size_t)NCTX * 768;
constexpr size_t OFF_QB = OFF_HT + (size_t)NTOK * 768 * 2;
constexpr size_t OFF_KB = OFF_QB + (size_t)NTOK * 512 * 2;
constexpr size_t OFF_VB = OFF_KB + (size_t)NTOK * 128 * 2;
constexpr size_t VT_LAT = (size_t)NCTX * 128;
constexpr size_t OFF_YCAT = OFF_VB + (size_t)NTOK * 128 * 2;
constexpr size_t UNION_END = OFF_YCAT + (size_t)NTOK * 1024 * 2;
constexpr size_t ACT_END = OFF_ACT + (size_t)NTOK * DFF * 2;
constexpr size_t OFF_X16 = AL(UNION_END > ACT_END ? UNION_END : ACT_END);
constexpr size_t WS_END = OFF_X16 + (size_t)NTOK * D * 2;

struct Params {
    const float* in[24];
    float* out;
    unsigned char* ws;
};

__device__ __forceinline__ unsigned short f2bf(float f) { unsigned u = __float_as_uint(f); u += 0x7FFFu + ((u >> 16) & 1u); return (unsigned short)(u >> 16); }
__device__ __forceinline__ float bf2f(unsigned short b) { return __uint_as_float(((unsigned)b) << 16); }
__device__ __forceinline__ unsigned cvt_pk_bf16(float lo, float hi) { unsigned r; asm volatile("v_cvt_pk_bf16_f32 %0, %1, %2" : "=v"(r) : "v"(lo), "v"(hi)); return r; }
typedef __bf16 bf16x2_t __attribute__((ext_vector_type(2)));
typedef float f32x2_t __attribute__((ext_vector_type(2)));
typedef float f32x16 __attribute__((ext_vector_type(16)));
__device__ __forceinline__ unsigned pk_bf16(float lo, float hi) { f32x2_t v = {lo, hi}; return __builtin_bit_cast(unsigned, __builtin_convertvector(v, bf16x2_t)); }
__device__ __forceinline__ float silu_f(float x) { return x * __builtin_amdgcn_rcpf(1.0f + __expf(-x)); }
__device__ __forceinline__ int perm32(int rho) { const int n = rho >> 4, i = rho & 15; return 8 * (i >> 2) + 4 * n + (i & 3); }

__device__ __forceinline__ int opaque_tid() { int t = threadIdx.x; asm volatile("" : "+v"(t)); return t; }


#define XB_TMO      128
#define XB_XCNT(j)  (256  + 64 * (j))
#define XB_XSUB(j)  (1280 + 64 * (j))
#define XB_XGEN(j)  (2304 + 64 * (j))
#define XB_TOP      3328
#define XB_TOPGEN   3392
#define XCD_BAR_WORDS 3456
#define XB_SPIN_CAP (1u << 22)
__device__ __forceinline__ unsigned xb_ld(unsigned* p)              { return __hip_atomic_load(p, __ATOMIC_RELAXED, __HIP_MEMORY_SCOPE_AGENT); }
__device__ __forceinline__ unsigned xb_add(unsigned* p, unsigned v) { return __hip_atomic_fetch_add(p, v, __ATOMIC_RELAXED, __HIP_MEMORY_SCOPE_AGENT); }
__device__ __forceinline__ unsigned xb_xcc_id() { return (unsigned)__builtin_amdgcn_s_getreg((3 << 11) | 20) & 0xFu; }
#define XB_SPIN(cond, bar) do { unsigned _sp = 0; while (cond) { __builtin_amdgcn_s_sleep(1); \
    if ((++_sp & 255u) == 0u) { if (xb_ld(&(bar)[XB_TMO])) break; if (_sp > XB_SPIN_CAP) { atomicAdd(&(bar)[XB_TMO], 1u); break; } } } } while (0)
struct XcdBarrier { unsigned* bar; unsigned x; volatile LAS unsigned* st; };
__device__ __forceinline__ XcdBarrier xcd_barrier_post(unsigned* bar, volatile LAS unsigned* st) {
    XcdBarrier b; b.bar = bar; b.x = xb_xcc_id(); b.st = st;
    if (threadIdx.x == 0) (void)xb_add(&bar[XB_XCNT(b.x)], 1u);
    return b;
}
__device__ __forceinline__ void xcd_barrier_complete(unsigned* bar, unsigned x, unsigned& nloc, unsigned& nx) {
    const unsigned G = gridDim.x * gridDim.y * gridDim.z;
    unsigned sum, cnt, mine, sp = 0u;
    for (;;) {
        sum = 0u; cnt = 0u; mine = 0u;
#pragma unroll
        for (unsigned j = 0; j < 16; ++j) { const unsigned c = xb_ld(&bar[XB_XCNT(j)]); sum += c; cnt += (c > 0u) ? 1u : 0u; mine = (j == x) ? c : mine; }
        if (sum == G) break;
        __builtin_amdgcn_s_sleep(1);
        if ((++sp & 255u) == 0u) { if (xb_ld(&bar[XB_TMO])) break; if (sp > XB_SPIN_CAP) { atomicAdd(&bar[XB_TMO], 1u); break; } }
    }
    nloc = mine > 0u ? mine : 1u; nx = cnt > 0u ? cnt : 1u;
}
__device__ __forceinline__ void xcd_barrier(const XcdBarrier& b) {
    asm volatile("s_waitcnt vmcnt(0)" ::: "memory");
    __syncthreads();
    if (threadIdx.x == 0) {
        unsigned* bar = b.bar;
        __builtin_amdgcn_s_waitcnt(0);
        unsigned nloc = b.st[0], nx = b.st[1];
        if (nloc == 0u) { xcd_barrier_complete(bar, b.x, nloc, nx); b.st[0] = nloc; b.st[1] = nx; }
        const unsigned old = xb_add(&bar[XB_XSUB(b.x)], 1u);
        const unsigned gen = old / nloc;
        if (old + 1u == (gen + 1u) * nloc) {
            __builtin_amdgcn_fence(__ATOMIC_RELEASE, "agent");
            asm volatile("s_waitcnt vmcnt(0)" ::: "memory");
            const unsigned og = xb_add(&bar[XB_TOP], 1u);
            const unsigned tg = og / nx;
            if (og + 1u == (tg + 1u) * nx) xb_add(&bar[XB_TOPGEN], 1u);
            else XB_SPIN(xb_ld(&bar[XB_TOPGEN]) == tg, bar);
            __builtin_amdgcn_fence(__ATOMIC_ACQUIRE, "agent");
            xb_add(&bar[XB_XGEN(b.x)], 1u);
            asm volatile("s_waitcnt vmcnt(0)" ::: "memory");
        } else {
            XB_SPIN(xb_ld(&bar[XB_XGEN(b.x)]) == gen, bar);
            __builtin_amdgcn_fence(__ATOMIC_ACQUIRE, "agent");
            asm volatile("s_waitcnt vmcnt(0)" ::: "memory");
        }
    }
    __syncthreads();
}

namespace pg8 {
constexpr int BM = 256, BK = 64, HALF = 128, HTB = HALF * BK * 2, STAGE_BYTES = 8 * HTB, NXCD = 8, WGM = 8;
__device__ __forceinline__ int lds_byte(int r, int c) { const int st = (r >> 4) * 2 + (c >> 5), rr = r & 15, cc = c & 31, ob = rr * 64 + cc * 2; return st * 1024 + (ob ^ (((ob >> 9) & 1) << 5)); }
__device__ __forceinline__ void stage_rc(int b, int& R, int& C) { const int st = b / 1024, sb = b % 1024, swz = sb ^ (((sb >> 9) & 1) << 5); R = (st >> 1) * 16 + swz / 64; C = (st & 1) * 32 + (swz % 64) / 2; }
struct Unit { int pm, pn; };
struct Gemm { const bf16_t* A; const bf16_t* Bt; int M, N, K, lda, ldb; };
struct StaticOrder {
    int nM, nN, nwg, G, c;
    __device__ void init(int M, int N, int G_, int c_) { nM = M / BM; nN = N / BM; nwg = nM * nN; G = G_; c = c_; }
    __device__ bool next(int i, Unit& u) const {
        if (c < 0) return false;
        const long L = (long)i * G + c; if (L >= nwg) return false;
        int wgid = (int)L; { const int q = nwg / NXCD, r = nwg % NXCD, xcd = wgid % NXCD, off = wgid / NXCD; wgid = (xcd < r ? xcd * (q + 1) : r * (q + 1) + (xcd - r) * q) + off; }
        const int nig = WGM * nN, gid = wgid / nig, fm = gid * WGM, gsz = (nM - fm) < WGM ? (nM - fm) : WGM;
        u.pm = fm + ((wgid % nig) % gsz); u.pn = (wgid % nig) / gsz; return true;
    }
    __device__ __forceinline__ void a_ready(const Unit&) const {}
    __device__ __forceinline__ void done(const Unit&) const {}
};

template <class Epi, class Sched>
__device__ __forceinline__ void gemm_phase(LAS unsigned char* lds, Gemm g, const Sched& S, const Epi& E) {
    asm volatile("" : "+s"(g.A), "+s"(g.Bt), "+s"(g.K), "+s"(g.lda), "+s"(g.ldb));
    int tid = threadIdx.x; asm volatile("" : "+v"(tid));
    const int wid = __builtin_amdgcn_readfirstlane(tid >> 6), lane = tid & 63, wr = wid >> 2, wc = wid & 3, fr = lane & 15, fq = lane >> 4;
    const int K = g.K, nt = K / BK;
    unsigned voffA[2], voffB[2];
#pragma unroll
    for (int i = 0; i < 2; ++i) { int R, C; stage_rc(tid * 16 + i * 8192, R, C);
        voffA[i] = (unsigned)(R * g.lda + C) * 2u; voffB[i] = (unsigned)(R * g.ldb + C) * 2u; }
    const size_t kstep = (size_t)(BK * 2);
    const size_t hstepA = (size_t)HALF * g.lda * 2, hstepB = (size_t)HALF * g.ldb * 2;
    const size_t tstepA = 2 * hstepA, tstepB = 2 * hstepB;
    const unsigned ldsw = (unsigned)wid * 1024u;
    const int aoff = lds_byte(wr * 64 + fr, fq * 8), boff = lds_byte(wc * 32 + fr, fq * 8);
#define PG8_SA(b, h) (((b) * 2 + (h)) * HTB)
#define PG8_SB(b, h) ((4 + (b) * 2 + (h)) * HTB)
#define PG8_STAGE(bufoff, gbase, voff) do { _Pragma("unroll") for (int _i = 0; _i < 2; ++_i) \
        __builtin_amdgcn_global_load_lds((const unsigned*)((const char*)(gbase) + (voff)[_i]), (LAS unsigned*)(lds + (bufoff) + ldsw + _i * 8192), 16, 0, 0); } while (0)
#define PG8_LDA(dst, b, h) do { _Pragma("unroll") for (int m = 0; m < 4; ++m) _Pragma("unroll") for (int k = 0; k < 2; ++k) dst[m][k] = *(const LAS bf16x8*)(lds + PG8_SA(b, h) + aoff + m * 2048 + k * 1024); } while (0)
#define PG8_LDB(dst, b, h) do { _Pragma("unroll") for (int n = 0; n < 2; ++n) _Pragma("unroll") for (int k = 0; k < 2; ++k) dst[n][k] = *(const LAS bf16x8*)(lds + PG8_SB(b, h) + boff + n * 2048 + k * 1024); } while (0)
#define PG8_MMA(ai, bj, At, Bt) do { __builtin_amdgcn_s_setprio(1); _Pragma("unroll") for (int m = 0; m < 4; ++m) _Pragma("unroll") for (int n = 0; n < 2; ++n) _Pragma("unroll") for (int k = 0; k < 2; ++k) \
        acc[ai][bj][m][n] = __builtin_amdgcn_mfma_f32_16x16x32_bf16(Bt[n][k], At[m][k], acc[ai][bj][m][n], 0, 0, 0); __builtin_amdgcn_s_setprio(0); } while (0)
#define PG8_WAIT_V(n) asm volatile("s_waitcnt vmcnt(" #n ")" ::: "memory")
#define PG8_WAIT_L(n) asm volatile("s_waitcnt lgkmcnt(" #n ")" ::: "memory")
#define PG8_BAR __builtin_amdgcn_s_barrier()
#define PG8_SCHED __builtin_amdgcn_sched_barrier(0)
    Unit cur, nxt; int ui = 0;
    if (!S.next(0, cur)) return;
    f32x4 acc[2][2][4][2];
#pragma unroll
    for (int a = 0; a < 2; ++a)
#pragma unroll
        for (int b = 0; b < 2; ++b)
#pragma unroll
            for (int m = 0; m < 4; ++m)
#pragma unroll
                for (int n = 0; n < 2; ++n) acc[a][b][m][n] = (f32x4){0.f, 0.f, 0.f, 0.f};
    bf16x8 At[4][2], B0[2][2], B1[2][2];
    const char* cA = (const char*)g.A + (size_t)cur.pm * tstepA; const char* cB = (const char*)g.Bt + (size_t)cur.pn * tstepB;
    S.a_ready(cur);
    PG8_STAGE(PG8_SB(0, 0), cB, voffB); PG8_STAGE(PG8_SA(0, 0), cA, voffA); PG8_STAGE(PG8_SB(0, 1), cB + hstepB, voffB); PG8_STAGE(PG8_SA(0, 1), cA + hstepA, voffA);
    if (wr == 1) PG8_BAR;
    PG8_WAIT_V(4); PG8_BAR;
    PG8_STAGE(PG8_SB(1, 0), cB + kstep, voffB); PG8_STAGE(PG8_SA(1, 0), cA + kstep, voffA); PG8_STAGE(PG8_SB(1, 1), cB + hstepB + kstep, voffB);
    PG8_WAIT_V(6); PG8_BAR;
    for (;;) {
        const bool has_next = S.next(ui + 1, nxt);
        const char* nA = has_next ? (const char*)g.A + (size_t)nxt.pm * tstepA : cA; const char* nB = has_next ? (const char*)g.Bt + (size_t)nxt.pn * tstepB : cB;
        for (int t = 0; t < nt; t += 2) {
            const bool last = (t == nt - 2);
            const char* a1 = cA + (size_t)(t + 1) * kstep;
            const char* a2 = last ? nA : cA + (size_t)(t + 2) * kstep; const char* b2 = last ? nB : cB + (size_t)(t + 2) * kstep;
            const char* a3 = a2 + kstep; const char* b3 = b2 + kstep;
            if (last && has_next) S.a_ready(nxt);
            PG8_LDB(B0, 0, 0); PG8_SCHED; PG8_LDA(At, 0, 0); PG8_STAGE(PG8_SA(1, 1), a1 + hstepA, voffA);
            PG8_WAIT_L(8); PG8_BAR; PG8_WAIT_L(0); PG8_MMA(0, 0, At, B0); PG8_BAR; PG8_SCHED;
            PG8_LDB(B1, 0, 1); PG8_STAGE(PG8_SB(0, 0), b2, voffB);
            PG8_BAR; PG8_WAIT_L(0); PG8_MMA(0, 1, At, B1); PG8_BAR;
            PG8_LDA(At, 0, 1); PG8_STAGE(PG8_SA(0, 0), a2, voffA);
            PG8_BAR; PG8_WAIT_L(0); PG8_MMA(1, 0, At, B0); PG8_BAR; PG8_SCHED;
            PG8_STAGE(PG8_SB(0, 1), b2 + hstepB, voffB);
            PG8_WAIT_V(6); PG8_BAR; PG8_MMA(1, 1, At, B1); PG8_BAR;
            PG8_LDB(B0, 1, 0); PG8_SCHED; PG8_LDA(At, 1, 0); PG8_STAGE(PG8_SA(0, 1), a2 + hstepA, voffA);
            PG8_WAIT_L(8); PG8_BAR; PG8_WAIT_L(0); PG8_MMA(0, 0, At, B0); PG8_BAR; PG8_SCHED;
            PG8_LDB(B1, 1, 1); PG8_STAGE(PG8_SB(1, 0), b3, voffB);
            PG8_BAR; PG8_WAIT_L(0); PG8_MMA(0, 1, At, B1); PG8_BAR;
            PG8_LDA(At, 1, 1); PG8_STAGE(PG8_SA(1, 0), a3, voffA);
            PG8_BAR; PG8_WAIT_L(0); PG8_MMA(1, 0, At, B0); PG8_BAR; PG8_SCHED;
            PG8_STAGE(PG8_SB(1, 1), b3 + hstepB, voffB);
            PG8_WAIT_V(6); PG8_BAR; PG8_MMA(1, 1, At, B1); PG8_BAR;
        }
        { int fr2 = fr, fq2 = fq, wr2 = wr, wc2 = wc; asm volatile("" : "+v"(fr2), "+v"(fq2), "+s"(wr2), "+s"(wc2));
            E(acc, cur, wr2, wc2, fr2, fq2); } S.done(cur);
        if (!has_next) break;
#pragma unroll
        for (int a = 0; a < 2; ++a)
#pragma unroll
            for (int b = 0; b < 2; ++b)
#pragma unroll
                for (int m = 0; m < 4; ++m)
#pragma unroll
                    for (int n = 0; n < 2; ++n) acc[a][b][m][n] = (f32x4){0.f, 0.f, 0.f, 0.f};
        cur = nxt; cA = nA; cB = nB; ++ui;
    }
    PG8_WAIT_V(0);
    if (wr == 0) PG8_BAR;
    PG8_BAR;
#undef PG8_SA
#undef PG8_SB
#undef PG8_STAGE
#undef PG8_LDA
#undef PG8_LDB
#undef PG8_MMA
#undef PG8_WAIT_V
#undef PG8_WAIT_L
#undef PG8_BAR
#undef PG8_SCHED
}
}

struct EpiSwiglu {
    bf16_t* O;
    __device__ __forceinline__ void operator()(const f32x4 (&acc)[2][2][4][2], const pg8::Unit& u, int wr, int wc, int fr, int fq) const {
        const int row0 = u.pm * 256 + wr * 64 + fr, col0 = u.pn * 128 + wc * 32 + 8 * fq;
#pragma unroll
        for (int ai = 0; ai < 2; ++ai)
#pragma unroll
            for (int m = 0; m < 4; ++m) {
                bf16_t* rowp = O + (size_t)(row0 + ai * 128 + m * 16) * DFF + col0;
                const f32x4 g0 = acc[ai][0][m][0], g1 = acc[ai][0][m][1], u0 = acc[ai][1][m][0], u1 = acc[ai][1][m][1];
                f32x4 r0, r1;
#pragma unroll
                for (int e = 0; e < 4; ++e) { r0[e] = __builtin_amdgcn_exp2f(-g0[e]); r1[e] = __builtin_amdgcn_exp2f(-g1[e]); }
                r0 = r0 + 1.0f; r1 = r1 + 1.0f;
#pragma unroll
                for (int e = 0; e < 4; ++e) { r0[e] = __builtin_amdgcn_rcpf(r0[e]); r1[e] = __builtin_amdgcn_rcpf(r1[e]); }
                const f32x4 o0 = (g0 * u0) * r0, o1 = (g1 * u1) * r1;
                u32x4 w;
                w.x = pk_bf16(o0[0], o0[1]); w.y = pk_bf16(o0[2], o0[3]); w.z = pk_bf16(o1[0], o1[1]); w.w = pk_bf16(o1[2], o1[3]);
                *(u32x4*)rowp = w;
            }
    }
};
struct EpiYssq {
    bf16_t* Y; float* ssq;
    __device__ __forceinline__ void operator()(const f32x4 (&acc)[2][2][4][2], const pg8::Unit& u, int wr, int wc, int fr, int fq) const {
        const int row0 = u.pm * 256 + wr * 64 + fr, col0 = u.pn * 256 + wc * 32 + 8 * fq;
#pragma unroll
        for (int ai = 0; ai < 2; ++ai)
#pragma unroll
            for (int m = 0; m < 4; ++m) {
                const int row = row0 + ai * 128 + m * 16;
                bf16_t* rowp = Y + (size_t)row * D + col0;
                float s = 0.f;
#pragma unroll
                for (int bj = 0; bj < 2; ++bj) {
                    const f32x4 v0 = acc[ai][bj][m][0], v1 = acc[ai][bj][m][1];
                    s += v0[0] * v0[0] + v0[1] * v0[1] + v0[2] * v0[2] + v0[3] * v0[3] + v1[0] * v1[0] + v1[1] * v1[1] + v1[2] * v1[2] + v1[3] * v1[3];
                    u32x4 w; w.x = cvt_pk_bf16(v0[0], v0[1]); w.y = cvt_pk_bf16(v0[2], v0[3]); w.z = cvt_pk_bf16(v1[0], v1[1]); w.w = cvt_pk_bf16(v1[2], v1[3]);
                    *(u32x4*)(rowp + bj * 128) = w;
                }
                s += __shfl_xor(s, 16); s += __shfl_xor(s, 32);
                if (fq == 0) ssq[(size_t)row * 16 + u.pn * 4 + wc] = s;
            }
    }
};
struct EpiWin {
    bf16_t* ZT; bf16_t* HT; bf16_t* QB; bf16_t* KB; bf16_t* VB; const float* rope; float* newk; float* newv; int layer;
    __device__ __forceinline__ void operator()(const f32x4 (&acc)[2][2][4][2], const pg8::Unit& u, int wr, int wc, int fr, int fq) const {
        const int r0 = u.pm * 256 + wr * 64 + fr;
        const bool lat = u.pm >= 32;
        const int pn = u.pn;
        if (pn < 5) {
            bf16_t* base; int t0; size_t sch;
            if (pn < 2) {
                if (!lat) { const int b = u.pm; base = ZT + ((size_t)b * 256 * 2 + pn) * 256; sch = 512; t0 = r0 - u.pm * 256; }
                else { const int b = (u.pm - 32) >> 2; base = ZT + ZT_LAT + ((size_t)b * 256 * 2 + pn) * 1024; sch = 2048; t0 = r0 - NCTX - b * 1024; }
            } else {
                const int c0 = (pn - 2) * 256;
                if (!lat) { const int b = u.pm; base = HT + ((size_t)b * 768 + c0) * 256; sch = 256; t0 = r0 - u.pm * 256; }
                else { const int b = (u.pm - 32) >> 2; base = HT + HT_LAT + ((size_t)b * 768 + c0) * 1024; sch = 1024; t0 = r0 - NCTX - b * 1024; }
            }
#pragma unroll
            for (int ai = 0; ai < 2; ++ai)
#pragma unroll
                for (int m = 0; m < 4; ++m) {
                    const int t = t0 + ai * 128 + m * 16;
#pragma unroll
                    for (int bj = 0; bj < 2; ++bj)
#pragma unroll
                        for (int n = 0; n < 2; ++n) {
                            const int ch = bj * 128 + wc * 32 + n * 16 + 4 * fq;
                            const f32x4 v = acc[ai][bj][m][n];
                            const unsigned w01 = pk_bf16(v[0], v[1]), w23 = pk_bf16(v[2], v[3]);
                            bf16_t* bp = base + (size_t)ch * sch + t;
                            bp[0] = (bf16_t)w01; bp[sch] = (bf16_t)(w01 >> 16); bp[2 * sch] = (bf16_t)w23; bp[3 * sch] = (bf16_t)(w23 >> 16);
                        }
                }
        } else {
            const int blk = wc & 1;
#pragma unroll
            for (int ai = 0; ai < 2; ++ai)
#pragma unroll
                for (int m = 0; m < 4; ++m) {
                    const int row = r0 + ai * 128 + m * 16;
                    f32x4 cs0 = {1.f, 0.f, 1.f, 0.f}, cs1 = {1.f, 0.f, 1.f, 0.f};
                    if (lat) { const int t = row & 1023; const int pos = blk ? (t & 63) : (t >> 6);
                        const f32x4* rp = (const f32x4*)(rope + (size_t)(pos * 16 + 4 * fq) * 2); cs0 = rp[0]; cs1 = rp[1]; }
#pragma unroll
                    for (int bj = 0; bj < 2; ++bj) {
                        f32x4 x1 = acc[ai][bj][m][0], x2 = acc[ai][bj][m][1];
                        const bool isv = (pn == 7 && bj == 1);
                        const bool isk = (pn == 7 && bj == 0);
                        const int cc = bj * 128 + wc * 32 + 4 * fq;
                        if ((isk || isv) && !lat) {
                            const int b = row >> 8, t = row & 255;
                            float* dst = (isk ? newk : newv) + (((size_t)b * 2 + layer) * 256 + t) * 128 + (cc & 127);
                            *(f32x4*)dst = x1; *(f32x4*)(dst + 16) = x2;
                        }
                        if (!isv) {
                            f32x4 o1, o2;
                            o1[0] = x1[0] * cs0[0] - x2[0] * cs0[1]; o2[0] = x2[0] * cs0[0] + x1[0] * cs0[1];
                            o1[1] = x1[1] * cs0[2] - x2[1] * cs0[3]; o2[1] = x2[1] * cs0[2] + x1[1] * cs0[3];
                            o1[2] = x1[2] * cs1[0] - x2[2] * cs1[1]; o2[2] = x2[2] * cs1[0] + x1[2] * cs1[1];
                            o1[3] = x1[3] * cs1[2] - x2[3] * cs1[3]; o2[3] = x2[3] * cs1[2] + x1[3] * cs1[3];
                            x1 = o1; x2 = o2;
                        }
                        bf16_t* dst;
                        if (pn < 7) { x1 *= 0.125f; x2 *= 0.125f; dst = QB + (size_t)row * 512 + (pn - 5) * 256 + cc; }
                        else if (isk) dst = KB + (size_t)row * 128 + cc;
                        else {
                            bf16_t* vb; size_t n_;
                            if (!lat) { vb = VB + (size_t)(row >> 8) * 128 * 256 + (row & 255); n_ = 256; } else { vb = VB + VT_LAT + (size_t)((row - NCTX) >> 10) * 128 * 1024 + (row & 1023); n_ = 1024; }
                            const int c0 = cc - 128;
#pragma unroll
                            for (int e = 0; e < 4; e += 2) { const unsigned wa = pk_bf16(x1[e], x1[e + 1]), wb = pk_bf16(x2[e], x2[e + 1]);
                                vb[(size_t)(c0 + e) * n_] = (bf16_t)wa; vb[(size_t)(c0 + e + 1) * n_] = (bf16_t)(wa >> 16); vb[(size_t)(c0 + 16 + e) * n_] = (bf16_t)wb; vb[(size_t)(c0 + 17 + e) * n_] = (bf16_t)(wb >> 16); }
                            continue;
                        }
                        u32x2 w1, w2; w1.x = cvt_pk_bf16(x1[0], x1[1]); w1.y = cvt_pk_bf16(x1[2], x1[3]); w2.x = cvt_pk_bf16(x2[0], x2[1]); w2.y = cvt_pk_bf16(x2[2], x2[3]);
                        *(u32x2*)dst = w1; *(u32x2*)(dst + 16) = w2;
                    }
                }
        }
    }
};
struct EpiFourier {
    bf16_t* YC; int rowbase, n;
    __device__ __forceinline__ void operator()(const f32x4 (&acc)[2][2][4][2], const pg8::Unit& u, int wr, int wc, int fr, int fq) const {
        const int kp0 = u.pm * 256 + wr * 64 + fr; const int b = u.pn;
#pragma unroll
        for (int ai = 0; ai < 2; ++ai)
#pragma unroll
            for (int m = 0; m < 4; ++m) {
                bf16_t* rowp = YC + (size_t)(rowbase + b * n + kp0 + ai * 128 + m * 16) * 1024 + wc * 32 + 4 * fq;
#pragma unroll
                for (int bj = 0; bj < 2; ++bj)
#pragma unroll
                    for (int nn = 0; nn < 2; ++nn) { const f32x4 v = acc[ai][bj][m][nn]; u32x2 w; w.x = cvt_pk_bf16(v[0], v[1]); w.y = cvt_pk_bf16(v[2], v[3]);
                        *(u32x2*)(rowp + bj * 128 + nn * 16) = w; }
            }
    }
};

struct TrUnit { const float* src; bf16_t* dst; int ld, k0, cbase, Kd, r0, perm; float scale; };
__device__ __forceinline__ TrUnit tr_unit_g(const Params& p, int kind, int idx, int w) {
    TrUnit t; unsigned char* ws = p.ws; t.scale = 1.0f;
    if (kind == 0) { const int rg = w / 16, kb = w % 16; const int pn = rg >> 1, half = rg & 1; t.scale = half ? 0.6931471805599453f : 1.4426950408889634f;
        t.src = (half ? p.in[10] : p.in[9]) + (size_t)idx * 1024 * DFF; t.ld = DFF; t.k0 = kb * 64; t.cbase = pn * 128; t.dst = (bf16_t*)(ws + OFF_WGU + idx * SZ_WGU); t.Kd = 1024; t.r0 = rg * 128; t.perm = 1; }
    else if (kind == 1) { const int rg = w / 44, kb = w % 44;
        t.src = p.in[11] + (size_t)idx * DFF * 1024; t.ld = 1024; t.k0 = kb * 64; t.cbase = rg * 128; t.dst = (bf16_t*)(ws + OFF_WD + idx * SZ_WD); t.Kd = DFF; t.r0 = rg * 128; t.perm = 1; }
    else if (kind == 2) { const int rg = w / 16, kb = w % 16;
        t.src = p.in[13] + (size_t)idx * 1024 * 1024; t.ld = 1024; t.k0 = kb * 64; t.cbase = rg * 128; t.dst = (bf16_t*)(ws + OFF_WOUT + idx * SZ_WOUT); t.Kd = 1024; t.r0 = rg * 128; t.perm = 1; }
    else { const int rg = w / 16, kb = w % 16;
        t.src = p.in[12] + (size_t)idx * 1024 * INW; t.ld = INW; t.k0 = kb * 64; t.cbase = 256 + rg * 128; t.dst = (bf16_t*)(ws + OFF_WIN + idx * SZ_WIN); t.Kd = 1024; t.r0 = 512 + rg * 128; t.perm = 0; }
    return t;
}
__device__ __forceinline__ int tr_slot_count(int slot) { return slot == 0 ? 704 : slot == 1 ? 1376 : slot == 2 ? 1248 : slot == 3 ? 1184 : 352; }
__device__ __forceinline__ TrUnit tr_unit(const Params& p, int slot, int v) {
    if (slot == 0) return tr_unit_g(p, 0, 0, v);
    if (slot == 1) { if (v < 352) return tr_unit_g(p, 1, 0, v); v -= 352; if (v < 192) return tr_unit_g(p, 3, 0, v); v -= 192; if (v < 128) return tr_unit_g(p, 2, 0, v); return tr_unit_g(p, 0, 1, v - 128); }
    if (slot == 2) { if (v < 352) return tr_unit_g(p, 1, 1, v); v -= 352; if (v < 704) return tr_unit_g(p, 0, 2, v); return tr_unit_g(p, 3, 1, v - 704); }
    if (slot == 3) { if (v < 352) return tr_unit_g(p, 1, 2, v); v -= 352; if (v < 128) return tr_unit_g(p, 2, 1, v); return tr_unit_g(p, 0, 3, v - 128); }
    return tr_unit_g(p, 1, 3, v);
}
__device__ __forceinline__ void tr_load(const TrUnit& t, int tid, f32x4 (&v)[4]) {
#pragma unroll
    for (int i = 0; i < 4; ++i) { const int idx = tid + 512 * i, kk = idx >> 5, c4 = idx & 31;
        v[i] = *(const f32x4*)(t.src + (size_t)(t.k0 + kk) * t.ld + t.cbase + c4 * 4); }
}
__device__ __forceinline__ void tr_slot(const Params& p, float* lds, int slot, int blk, int nblk, int tid) {
    const int NU = tr_slot_count(slot);
    constexpr int TS = 132;
    f32x4 v[4];
    int u = blk;
    TrUnit cur; if (u < NU) { cur = tr_unit(p, slot, u); tr_load(cur, tid, v); }
    while (u < NU) {
#pragma unroll
        for (int i = 0; i < 4; ++i) { const int idx = tid + 512 * i, kk = idx >> 5, c4 = idx & 31; *(f32x4*)(lds + kk * TS + c4 * 4) = v[i]; }
        __syncthreads();
        const int un = u + nblk; TrUnit nxt = cur;
        if (un < NU) { nxt = tr_unit(p, slot, un); tr_load(nxt, tid, v); }
        { const int rr = tid >> 2, kc = tid & 3; const int cc = cur.perm ? ((rr & ~31) + perm32(rr & 31)) : rr;
            float x[16];
#pragma unroll
            for (int j = 0; j < 16; ++j) x[j] = lds[(kc * 16 + j) * TS + cc] * cur.scale;
            u32x4 w0, w1; w0.x = pk_bf16(x[0], x[1]); w0.y = pk_bf16(x[2], x[3]); w0.z = pk_bf16(x[4], x[5]); w0.w = pk_bf16(x[6], x[7]);
            w1.x = pk_bf16(x[8], x[9]); w1.y = pk_bf16(x[10], x[11]); w1.z = pk_bf16(x[12], x[13]); w1.w = pk_bf16(x[14], x[15]);
            bf16_t* d = cur.dst + (size_t)(cur.r0 + rr) * cur.Kd + cur.k0 + kc * 16;
            *(u32x4*)d = w0; *(u32x4*)(d + 8) = w1; }
        __syncthreads();
        cur = nxt; u = un;
    }
}
__device__ void phase_prep(const Params& p, float* lds) {
    const int tid = opaque_tid(), nb = gridDim.x, bid = blockIdx.x;
    unsigned char* ws = p.ws;
    tr_slot(p, lds, 0, bid, nb, tid);
    __syncthreads();
    {
        float* tab = lds;
        if (tid < 64) { float sv, cv; sincosf(PI2 * (float)tid / 64.f, &sv, &cv); tab[tid] = cv; tab[64 + tid] = sv; }
        __syncthreads();
        const int lane = tid & 63, wv = tid >> 6;
        for (int u = bid * 8 + wv; u < 8192; u += nb * 8) {
            const int l = u >> 12, k = (u >> 2) & 1023, g = u & 3;
            const float* wrow = p.in[12] + ((size_t)l * 1024 + k) * INW + g * 64;
            const float wv_ = wrow[lane];
            float ac = 0.f, as = 0.f;
#pragma unroll 16
            for (int c = 0; c < 64; ++c) { const float w = __shfl(wv_, c); const int idx = (c * lane) & 63; ac += w * tab[idx]; as += w * tab[64 + idx]; }
            bf16_t* bt = (bf16_t*)(ws + OFF_WIN + l * SZ_WIN);
            bt[(size_t)(g * 64 + lane) * 1024 + k] = f2bf(ac);
            bt[(size_t)(256 + g * 64 + lane) * 1024 + k] = f2bf(as);
        }
        __syncthreads();
    }
    {
        float* sc = lds;
        float* part = lds + 12 * 1024;
        for (int i = tid; i < 9 * 1024; i += NTHREADS) { const int bc = i >> 10, k = i & 1023; const float cv = bc == 0 ? p.in[5][k] : p.in[4][(bc - 1) * 1024 + k]; sc[k * 12 + bc] = cv / (1.0f + expf(-cv)); }
        __syncthreads();
        for (int cb = bid; cb < 256; cb += nb) {
            const int gc0 = cb * 72, l = gc0 / 9216, j0 = gc0 % 9216;
            const int cg = tid % 18, kg = tid / 18;
            if (kg < 28) {
                f32x4 a[9];
#pragma unroll
                for (int i = 0; i < 9; ++i) a[i] = (f32x4){0.f, 0.f, 0.f, 0.f};
                const float* wp = p.in[6] + (size_t)l * 1024 * 9216 + j0 + cg * 4;
#pragma unroll 4
                for (int k = kg; k < 1024; k += 28) { const f32x4 w = *(const f32x4*)(wp + (size_t)k * 9216);
                    const f32x4 s0 = *(const f32x4*)(sc + k * 12), s1 = *(const f32x4*)(sc + k * 12 + 4); const float s8 = sc[k * 12 + 8];
                    a[0] += w * s0[0]; a[1] += w * s0[1]; a[2] += w * s0[2]; a[3] += w * s0[3]; a[4] += w * s1[0]; a[5] += w * s1[1]; a[6] += w * s1[2]; a[7] += w * s1[3]; a[8] += w * s8; }
#pragma unroll
                for (int i = 0; i < 9; ++i)
#pragma unroll
                    for (int e = 0; e < 4; ++e) part[(kg * 72 + cg * 4 + e) * 9 + i] = a[i][e];
            }
            __syncthreads();
            for (int i = tid; i < 72 * 9; i += NTHREADS) { const int c2 = i / 9, bc = i % 9; float s = 0.f;
#pragma unroll
                for (int g = 0; g < 28; ++g) s += part[(g * 72 + c2) * 9 + bc];
                ((float*)(ws + OFF_MOD))[((size_t)l * 9 + bc) * 9216 + j0 + c2] = s + p.in[7][l * 9216 + j0 + c2]; }
            __syncthreads();
        }
    }
    __syncthreads();
    {
        const int lane = tid & 63, wv = tid >> 6;
        float* h2s = lds;
        const int u0 = bid * 10; const int l = u0 / 1280;
        if (u0 < 2560) {
            const float* w1 = p.in[15] + l * 33 * 64; const float* b1 = p.in[16] + l * 64; const float* w2 = p.in[17] + l * 64 * 64; const float* b2 = p.in[18] + l * 64;
            const float* w3 = p.in[19] + (size_t)l * 64 * 1024; const float fr = p.in[20][l * 64 + lane];
            for (int q = wv; q < 10; q += 8) {
                const int rem = (u0 + q) % 1280; const int pass = rem >= 256; const int n = pass ? 1024 : 256; const int d = pass ? rem - 256 : rem;
                const float tt = (float)d / (float)(n - 1);
                float feat = 0.f;
                if (lane == 0) feat = tt;
                else if (lane < 33) { const int j = (lane - 1) & 15; const float fj = 1e-4f + (float)j * ((15.0f - 1e-4f) / 15.0f); const float ang = (PI2 / (float)n) * (float)d * fj;
                    feat = lane < 17 ? cosf(ang) : -sinf(ang); }
                float a1 = b1[lane];
#pragma unroll
                for (int i = 0; i < 33; ++i) a1 += __shfl(feat, i) * w1[i * 64 + lane];
                const float h1 = sinf(fr * a1);
                float a2 = b2[lane];
#pragma unroll
                for (int i = 0; i < 64; ++i) a2 += __shfl(h1, i) * w2[i * 64 + lane];
                h2s[lane * 12 + q] = sinf(fr * a2);
            }
            __syncthreads();
            float acc[2][10];
#pragma unroll
            for (int q = 0; q < 10; ++q) { acc[0][q] = 0.f; acc[1][q] = 0.f; }
#pragma unroll 8
            for (int i = 0; i < 64; ++i) {
                const float wa = w3[i * 1024 + tid], wb = w3[i * 1024 + 512 + tid];
                const f32x4 ha = *(const f32x4*)(h2s + i * 12), hb = *(const f32x4*)(h2s + i * 12 + 4); const float h8 = h2s[i * 12 + 8], h9 = h2s[i * 12 + 9];
                acc[0][0] += ha[0] * wa; acc[0][1] += ha[1] * wa; acc[0][2] += ha[2] * wa; acc[0][3] += ha[3] * wa; acc[0][4] += hb[0] * wa; acc[0][5] += hb[1] * wa; acc[0][6] += hb[2] * wa; acc[0][7] += hb[3] * wa; acc[0][8] += h8 * wa; acc[0][9] += h9 * wa;
                acc[1][0] += ha[0] * wb; acc[1][1] += ha[1] * wb; acc[1][2] += ha[2] * wb; acc[1][3] += ha[3] * wb; acc[1][4] += hb[0] * wb; acc[1][5] += hb[1] * wb; acc[1][6] += hb[2] * wb; acc[1][7] += hb[3] * wb; acc[1][8] += h8 * wb; acc[1][9] += h9 * wb;
            }
            const int ord = (tid >> 8) & 1, c = tid & 255;
            const float dec = fabsf(p.in[21][(l * 2 + ord) * 256 + c]);
            bf16_t* gl = (bf16_t*)(ws + OFF_FILT) + (size_t)l * G_L;
#pragma unroll
            for (int q = 0; q < 10; ++q) {
                const int rem = (u0 + q) % 1280; const int pass = rem >= 256; const int n = pass ? 1024 : 256; const int d = pass ? rem - 256 : rem;
                const float tt = (float)d / (float)(n - 1); const float win = expf(-tt * dec) / (float)(2 * n);
                bf16_t* g = gl + (pass ? G_CTX : 0) + ((size_t)ord * 256 + c) * (2 * n);
                g[n - 1 - d] = f2bf(acc[0][q] * win);
                g[d == 0 ? 2 * n - 1 : n - 1 + d] = d == 0 ? (bf16_t)0 : f2bf(acc[1][q] * win);
            }
        }
        __syncthreads();
    }
    __syncthreads();
    {
        bf16_t* FC = (bf16_t*)(ws + OFF_FC); bf16_t* FL = (bf16_t*)(ws + OFF_FL);
        const int gt = bid * NTHREADS + tid, gn = nb * NTHREADS;
        for (int i = gt; i < 256 * 512 + 1024 * 2048; i += gn) {
            int n, k, col; bf16_t* dst;
            if (i < 256 * 512) { n = 256; k = i >> 9; col = i & 511; dst = FC + i; } else { const int j = i - 256 * 512; n = 1024; k = j >> 11; col = j & 2047; dst = FL + j; }
            const int s = col >= n, t = col - s * n; const int ph = (k * t) & (n - 1);
            float sv, cv; sincosf(PI2 * (float)ph / (float)n, &sv, &cv);
            const float sc = rsqrtf(64.0f * (float)n);
            *dst = f2bf((s ? -sv : cv) * sc);
        }
        { bf16_t* CK = (bf16_t*)(ws + OFF_CKB); bf16_t* CV = (bf16_t*)(ws + OFF_CVT);
            for (int i = gt; i < 2 * 8 * 256 * 128; i += gn) {
                { const int c = i & 127, key = (i >> 7) & 255, b = (i >> 15) & 7, l = i >> 18;
                    CK[i] = f2bf(p.in[2][(((size_t)b * 2 + l) * 256 + key) * 128 + c]); }
                { const int key = i & 255, c = (i >> 8) & 127, b = (i >> 15) & 7, l = i >> 18;
                    CV[i] = f2bf(p.in[3][(((size_t)b * 2 + l) * 256 + key) * 128 + c]); }
            } }
        if (bid == 0) for (int i = tid; i < 64 * 16; i += NTHREADS) { const int pos = i >> 4, j = i & 15; const float inv = powf(10000.0f, -(float)(2 * j) / 32.0f);
            float sv, cv; sincosf((float)pos * inv, &sv, &cv); float* rp = (float*)(ws + OFF_ROPE); rp[2 * i] = cv; rp[2 * i + 1] = sv; }
    }
    __syncthreads();
}

template <int MODE>
__device__ void phase_row(const Params& p, int lpost, int spost, int lpre, int spre) {
    const int tid_ = opaque_tid(); const int lane = tid_ & 63, wv = tid_ >> 6;
    GAS unsigned char* wsg = (GAS unsigned char*)p.ws; asm volatile("" : "+s"(wsg));
    const GAS float* mod = (const GAS float*)(wsg + OFF_MOD);
    const GAS bf16_t* Y = (const GAS bf16_t*)(wsg + OFF_Y); const GAS float* ssq = (const GAS float*)(wsg + OFF_SSQ);
    GAS bf16_t* H = (GAS bf16_t*)(wsg + OFF_H); GAS bf16_t* X16 = (GAS bf16_t*)(wsg + OFF_X16);
    const float factor = (spost == 1) ? 1.0f : 0.5f;
    for (int rbase = (blockIdx.x * 8 + wv) * 8; rbase < NTOK; rbase += gridDim.x * 64) {
        const int bc = rbase < NCTX ? 0 : 1 + ((rbase - NCTX) >> 10);
        f32x4 coef[4], gsc[4], sh[4];
        if (MODE != 0) { const GAS float* gate = mod + ((size_t)lpost * 9 + bc) * 9216 + spost * 3072 + 2048; const float* gp = p.in[8] + (lpost * 6 + 2 * spost + 1) * 1024;
#pragma unroll
            for (int j = 0; j < 4; ++j) { const int c = j * 256 + lane * 4; coef[j] = *(const GAS f32x4*)(gate + c) * *(const f32x4*)(gp + c) * factor; } }
        if (MODE != 2) { const GAS float* mb = mod + ((size_t)lpre * 9 + bc) * 9216 + spre * 3072; const float* gp = p.in[8] + (lpre * 6 + 2 * spre) * 1024;
#pragma unroll
            for (int j = 0; j < 4; ++j) { const int c = j * 256 + lane * 4; sh[j] = *(const GAS f32x4*)(mb + c); gsc[j] = *(const f32x4*)(gp + c) * (*(const GAS f32x4*)(mb + 1024 + c) + 1.0f); } }
#pragma unroll 1
        for (int rp = 0; rp < 8; rp += 2) {
            f32x4 x[2][4]; u32x2 yv[2][4]; f32x4 sq[2][4];
#pragma unroll
            for (int q = 0; q < 2; ++q) {
                const int rw = rbase + rp + q;
                if (MODE == 0 || (lpost == 0 && spost == 0)) { const float* src = rw < NCTX ? p.in[0] + (size_t)rw * D : p.in[1] + (size_t)(rw - NCTX) * D;
#pragma unroll
                    for (int j = 0; j < 4; ++j) x[q][j] = *(const f32x4*)(src + j * 256 + lane * 4); }
                else {
#pragma unroll
                    for (int j = 0; j < 4; ++j) { const u32x2 xb = *(const GAS u32x2*)(X16 + (size_t)rw * D + j * 256 + lane * 4);
                        x[q][j][0] = __uint_as_float(xb.x << 16); x[q][j][1] = __uint_as_float(xb.x & 0xFFFF0000u); x[q][j][2] = __uint_as_float(xb.y << 16); x[q][j][3] = __uint_as_float(xb.y & 0xFFFF0000u); } }
                if (MODE != 0) {
#pragma unroll
                    for (int j = 0; j < 4; ++j) yv[q][j] = *(const GAS u32x2*)(Y + (size_t)rw * D + j * 256 + lane * 4);
                    const GAS f32x4* sp = (const GAS f32x4*)(ssq + (size_t)rw * 16);
#pragma unroll
                    for (int j = 0; j < 4; ++j) sq[q][j] = sp[j];
                }
            }
#pragma unroll
            for (int q = 0; q < 2; ++q) {
                const int row = rbase + rp + q;
                if (MODE != 0) {
                    float tot = 0.f;
#pragma unroll
                    for (int j = 0; j < 4; ++j) tot += (sq[q][j][0] + sq[q][j][1]) + (sq[q][j][2] + sq[q][j][3]);
                    const float rstd = rsqrtf(tot * (1.0f / 1024.0f) + EPS);
#pragma unroll
                    for (int j = 0; j < 4; ++j) {
                        x[q][j][0] += coef[j][0] * rstd * __uint_as_float(yv[q][j].x << 16);
                        x[q][j][1] += coef[j][1] * rstd * __uint_as_float(yv[q][j].x & 0xFFFF0000u);
                        x[q][j][2] += coef[j][2] * rstd * __uint_as_float(yv[q][j].y << 16);
                        x[q][j][3] += coef[j][3] * rstd * __uint_as_float(yv[q][j].y & 0xFFFF0000u); }
                    if (MODE == 2) {
#pragma unroll
                        for (int j = 0; j < 4; ++j) *(f32x4*)(p.out + (size_t)row * D + j * 256 + lane * 4) = x[q][j];
                    } else {
#pragma unroll
                        for (int j = 0; j < 4; ++j) { u32x2 w; w.x = pk_bf16(x[q][j][0], x[q][j][1]); w.y = pk_bf16(x[q][j][2], x[q][j][3]); *(GAS u32x2*)(X16 + (size_t)row * D + j * 256 + lane * 4) = w; }
                    }
                }
                if (MODE != 2) {
                    float s = 0.f;
#pragma unroll
                    for (int j = 0; j < 4; ++j) s += x[q][j][0] * x[q][j][0] + x[q][j][1] * x[q][j][1] + x[q][j][2] * x[q][j][2] + x[q][j][3] * x[q][j][3];
#pragma unroll
                    for (int o = 32; o >= 1; o >>= 1) s += __shfl_xor(s, o);
                    const float rs = rsqrtf(s * (1.0f / 1024.0f) + EPS);
#pragma unroll
                    for (int j = 0; j < 4; ++j) { const int c = j * 256 + lane * 4;
                        const f32x4 hh = x[q][j] * rs * gsc[j] + sh[j];
                        u32x2 w; w.x = pk_bf16(hh[0], hh[1]); w.y = pk_bf16(hh[2], hh[3]);
                        *(GAS u32x2*)(H + (size_t)row * D + c) = w; }
                }
            }
        }
    }
}

constexpr int AT_KROWB = 144;
constexpr int AT_VROWB_A = 784, AT_VROWB_B = 528;
constexpr int AT_OFF_V = 320 * AT_KROWB;
struct AttnState { f32x16 O0, O1; float m, lsum; };
template <bool MASK>
__device__ __forceinline__ void attn_tiles(AttnState& st, const bf16x8 (&qf)[4], const LAS unsigned char* Kl, const LAS unsigned char* Vl, int vrowb, int t0, int t1, int dk0, int r, int h) {
    for (int t = t0; t < t1; ++t) {
        const LAS unsigned char* kp = Kl + (t * 32 + r) * AT_KROWB + h * 16;
        bf16x8 kf[4];
#pragma unroll
        for (int kk = 0; kk < 4; ++kk) kf[kk] = *(const LAS bf16x8*)(kp + kk * 32);
        const LAS unsigned char* vp = Vl + r * vrowb + (t * 32 + 4 * h) * 2;
        u32x2 vraw[2][2][2];
#pragma unroll
        for (int dt = 0; dt < 2; ++dt)
#pragma unroll
            for (int s = 0; s < 2; ++s)
#pragma unroll
                for (int q = 0; q < 2; ++q) vraw[dt][s][q] = *(const LAS u32x2*)(vp + dt * 32 * vrowb + (16 * s + 8 * q) * 2);
        f32x16 S;
#pragma unroll
        for (int i = 0; i < 16; ++i) S[i] = 0.f;
#pragma unroll
        for (int kk = 0; kk < 4; ++kk) S = __builtin_amdgcn_mfma_f32_32x32x16_bf16(kf[kk], qf[kk], S, 0, 0, 0);
        if (MASK) {
            const int dk = dk0 + t * 32;
            if (dk <= -128 || dk >= 128) {
#pragma unroll
                for (int i = 0; i < 16; ++i) { const int j = (i & 3) + 8 * (i >> 2) + 4 * h; int dd = dk + j - r; if (dd < 0) dd = -dd; if (dd > 128) S[i] = -1e30f; }
            }
        }
        float mx = S[0];
#pragma unroll
        for (int i = 1; i < 16; ++i) mx = fmaxf(mx, S[i]);
        mx = fmaxf(mx, __shfl_xor(mx, 32));
        const float mn = fmaxf(st.m, mx), corr = __expf(st.m - mn);
        st.m = mn;
        float rs = 0.f;
#pragma unroll
        for (int i = 0; i < 16; ++i) { S[i] = __expf(S[i] - mn); rs += S[i]; }
        rs += __shfl_xor(rs, 32);
        st.lsum = st.lsum * corr + rs;
#pragma unroll
        for (int i = 0; i < 16; ++i) { st.O0[i] *= corr; st.O1[i] *= corr; }
        bf16x8 pf[2];
#pragma unroll
        for (int s = 0; s < 2; ++s) { u32x4 w; w.x = pk_bf16(S[8 * s], S[8 * s + 1]); w.y = pk_bf16(S[8 * s + 2], S[8 * s + 3]); w.z = pk_bf16(S[8 * s + 4], S[8 * s + 5]); w.w = pk_bf16(S[8 * s + 6], S[8 * s + 7]);
            pf[s] = __builtin_bit_cast(bf16x8, w); }
#pragma unroll
        for (int s = 0; s < 2; ++s) {
            u32x4 a0; a0.x = vraw[0][s][0].x; a0.y = vraw[0][s][0].y; a0.z = vraw[0][s][1].x; a0.w = vraw[0][s][1].y;
            u32x4 a1; a1.x = vraw[1][s][0].x; a1.y = vraw[1][s][0].y; a1.z = vraw[1][s][1].x; a1.w = vraw[1][s][1].y;
            st.O0 = __builtin_amdgcn_mfma_f32_32x32x16_bf16(__builtin_bit_cast(bf16x8, a0), pf[s], st.O0, 0, 0, 0);
            st.O1 = __builtin_amdgcn_mfma_f32_32x32x16_bf16(__builtin_bit_cast(bf16x8, a1), pf[s], st.O1, 0, 0, 0);
        }
    }
}
__device__ __forceinline__ void attn_unit(const Params& p, int l, int u, LAS unsigned char* lds, int tid) {
    const int lane = tid & 63, wv = tid >> 6, r = lane & 31, h = lane >> 5;
    const bf16_t* QB = (const bf16_t*)(p.ws + OFF_QB); const bf16_t* KB = (const bf16_t*)(p.ws + OFF_KB); const bf16_t* VT = (const bf16_t*)(p.ws + OFF_VB);
    const bf16_t* CK = (const bf16_t*)(p.ws + OFF_CKB); const bf16_t* CV = (const bf16_t*)(p.ws + OFF_CVT);
    bf16_t* YC = (bf16_t*)(p.ws + OFF_YCAT);
    const int g = wv & 3, qh = wv >> 2;
    const int pass = u < 256; const int v = u & 255;
    int b, kvh, qb, n, rowbase;
    if (!pass) { b = v >> 3; kvh = (v >> 2) & 1; qb = v & 3; n = 256; rowbase = b * 256; }
    else { b = v >> 5; kvh = (v >> 4) & 1; qb = v & 15; n = 1024; rowbase = NCTX + b * 1024; }
    const int head = kvh * 4 + g, q0w = qb * 64 + qh * 32;
    int kloU = 0, khiU = 256;
    if (pass) { kloU = qb * 64 - 128; if (kloU < 0) kloU = 0; khiU = qb * 64 + 192; if (khiU > n) khiU = n; }
    const int nkA = khiU - kloU, npc = nkA * 8, vpr = nkA >> 3;
    const bf16_t* kA = KB + (size_t)(rowbase + kloU) * 128 + kvh * 64;
    const bf16_t* vA = VT + (pass ? VT_LAT + (size_t)b * 128 * 1024 : (size_t)b * 128 * 256) + (size_t)kvh * 64 * n + kloU;
    {
        u32x4 kr[5], vr[5];
#pragma unroll
        for (int it = 0; it < 5; ++it) { const int idx = tid + it * NTHREADS;
            if (idx < npc) { kr[it] = *(const u32x4*)(kA + (size_t)(idx >> 3) * 128 + (idx & 7) * 8);
                const int d = idx / vpr, j = idx - d * vpr; vr[it] = *(const u32x4*)(vA + (size_t)d * n + j * 8); } }
#pragma unroll
        for (int it = 0; it < 5; ++it) { const int idx = tid + it * NTHREADS;
            if (idx < npc) { *(LAS u32x4*)(lds + (idx >> 3) * AT_KROWB + (idx & 7) * 16) = kr[it];
                const int d = idx / vpr, j = idx - d * vpr; *(LAS u32x4*)(lds + AT_OFF_V + d * AT_VROWB_A + j * 16) = vr[it]; } }
    }
    bf16x8 qf[4];
    { const bf16_t* qp = QB + (size_t)(rowbase + q0w + r) * 512 + head * 64 + 8 * h;
#pragma unroll
        for (int kk = 0; kk < 4; ++kk) qf[kk] = *(const bf16x8*)(qp + 16 * kk); }
    AttnState st; st.m = p.in[23][l * 8 + head]; st.lsum = 1.0f;
#pragma unroll
    for (int i = 0; i < 16; ++i) { st.O0[i] = 0.f; st.O1[i] = 0.f; }
    __syncthreads();
    u32x4 kb[4], vb[4];
    if (pass) {
        const bf16_t* kB = CK + ((size_t)(l * 8 + b) * 256) * 128 + kvh * 64;
        const bf16_t* vB = CV + ((size_t)(l * 8 + b) * 128 + kvh * 64) * 256;
#pragma unroll
        for (int it = 0; it < 4; ++it) { const int idx = tid + it * NTHREADS;
            kb[it] = *(const u32x4*)(kB + (size_t)(idx >> 3) * 128 + (idx & 7) * 8);
            vb[it] = *(const u32x4*)(vB + (size_t)(idx >> 5) * 256 + (idx & 31) * 8); }
    }
    {
        int klo = 0, khi = 256;
        if (pass) { klo = q0w - 128; if (klo < 0) klo = 0; khi = q0w + 160; if (khi > n) khi = n; }
        const int t0 = (klo - kloU) >> 5, t1 = (khi - kloU) >> 5;
        if (pass) attn_tiles<true>(st, qf, lds, lds + AT_OFF_V, AT_VROWB_A, t0, t1, kloU - q0w, r, h);
        else attn_tiles<false>(st, qf, lds, lds + AT_OFF_V, AT_VROWB_A, t0, t1, 0, r, h);
    }
    if (pass) {
        __syncthreads();
#pragma unroll
        for (int it = 0; it < 4; ++it) { const int idx = tid + it * NTHREADS;
            *(LAS u32x4*)(lds + (idx >> 3) * AT_KROWB + (idx & 7) * 16) = kb[it];
            *(LAS u32x4*)(lds + AT_OFF_V + (idx >> 5) * AT_VROWB_B + (idx & 31) * 16) = vb[it]; }
        __syncthreads();
        attn_tiles<false>(st, qf, lds, lds + AT_OFF_V, AT_VROWB_B, 0, 8, 0, r, h);
    }
    const float inv = 1.0f / st.lsum;
    bf16_t* op = YC + (size_t)(rowbase + q0w + r) * 1024 + 512 + head * 64 + 4 * h;
#pragma unroll
    for (int gq = 0; gq < 4; ++gq) {
        u32x2 w0; w0.x = pk_bf16(st.O0[4 * gq] * inv, st.O0[4 * gq + 1] * inv); w0.y = pk_bf16(st.O0[4 * gq + 2] * inv, st.O0[4 * gq + 3] * inv);
        u32x2 w1; w1.x = pk_bf16(st.O1[4 * gq] * inv, st.O1[4 * gq + 1] * inv); w1.y = pk_bf16(st.O1[4 * gq + 2] * inv, st.O1[4 * gq + 3] * inv);
        *(u32x2*)(op + 8 * gq) = w0; *(u32x2*)(op + 32 + 8 * gq) = w1;
    }
    __syncthreads();
}
__device__ void attn_mfma(const Params& p, int l, LAS unsigned char* lds) {
    const int tid = opaque_tid();
    for (int u = blockIdx.x; u < 512; u += gridDim.x) attn_unit(p, l, u, lds, tid);
}

template <int NB  , int NBLK  >
__device__ __forceinline__ void hyena_unit(const Params& p, int l, int c, const bf16_t* __restrict__ HTp, int rowbase, const bf16_t* __restrict__ gb, LAS unsigned char* lds, int tid) {
    constexpr int n = 32 * NBLK, NI = 32 / NB, PAD = 32 * (NI - 1);
    constexpr int LENB = (2 * n * 2 - 64 + 255) / 256 * 256 + 64;
    constexpr int UROWB = ((n + 2 * PAD) * 2 + 255) / 256 * 256 + 16;
    constexpr int GSB = (2 * n + 8) * 2;
    constexpr int OFF_F0 = 0, OFF_F1 = 8 * LENB, OFF_U = 16 * LENB, OFF_U2 = OFF_U + NB * UROWB, OFF_G1 = OFF_U2 + NB * UROWB, OFF_G2 = OFF_G1 + NB * n * 2, OFF_GS = OFF_G2 + NB * n * 2;
    static_assert(OFF_GS + 2 * GSB <= 149 * 1024, "hyena LDS");
    const int lane = tid & 63, wv = tid >> 6, r = lane & 31, h = lane >> 5;
    const float* cw = p.in[14] + l * 3 * 768;
    if (tid < 2 * (2 * n / 8)) { const int o = tid / (2 * n / 8), k = tid % (2 * n / 8);
        *(LAS u32x4*)(lds + OFF_GS + o * GSB + k * 16) = *(const u32x4*)(gb + ((size_t)o * 256 + c) * (2 * n) + k * 8); }
    if (tid < 2) *(LAS u32x4*)(lds + OFF_GS + tid * GSB + 2 * n * 2) = (u32x4){0u, 0u, 0u, 0u};
    constexpr int NQ = 3 * NB * (n / 8) / NTHREADS;
#pragma unroll
    for (int it = 0; it < NQ; ++it) {
        const int q = tid + it * NTHREADS;
        const int w = q / (NB * (n / 8)), rem = q % (NB * (n / 8)), b = rem / (n / 8), t0 = (rem % (n / 8)) * 8;
        const int ch = w * 256 + c; const bf16_t* row = HTp + ((size_t)b * 768 + ch) * n;
        const float w0 = cw[ch], w1 = cw[768 + ch], w2 = cw[1536 + ch];
        const u32x4 raw = *(const u32x4*)(row + t0);
        float x[10];
        x[0] = t0 > 0 ? bf2f(row[t0 - 1]) : 0.f; x[9] = t0 + 8 < n ? bf2f(row[t0 + 8]) : 0.f;
        x[1] = __uint_as_float(raw.x << 16); x[2] = __uint_as_float(raw.x & 0xFFFF0000u); x[3] = __uint_as_float(raw.y << 16); x[4] = __uint_as_float(raw.y & 0xFFFF0000u);
        x[5] = __uint_as_float(raw.z << 16); x[6] = __uint_as_float(raw.z & 0xFFFF0000u); x[7] = __uint_as_float(raw.w << 16); x[8] = __uint_as_float(raw.w & 0xFFFF0000u);
        float z[8];
#pragma unroll
        for (int e = 0; e < 8; ++e) z[e] = x[e] * w0 + x[e + 1] * w1 + x[e + 2] * w2;
        u32x4 o; o.x = pk_bf16(z[0], z[1]); o.y = pk_bf16(z[2], z[3]); o.z = pk_bf16(z[4], z[5]); o.w = pk_bf16(z[6], z[7]);
        LAS unsigned char* dst = w == 0 ? lds + OFF_U + b * UROWB + (PAD + t0) * 2 : lds + (w == 1 ? OFF_G1 : OFF_G2) + (b * n + t0) * 2;
        *(LAS u32x4*)dst = o;
    }
    if (PAD > 0) {
        constexpr int FR = PAD / 8, BK_ = (UROWB / 2 - PAD - n) / 8;
        for (int q = tid; q < 2 * NB * (FR + BK_); q += NTHREADS) {
            const int buf = q / (NB * (FR + BK_)), rem = q % (NB * (FR + BK_)), b = rem / (FR + BK_), k = rem % (FR + BK_);
            const int e0 = k < FR ? k * 8 : PAD + n + (k - FR) * 8;
            *(LAS u32x4*)(lds + (buf ? OFF_U2 : OFF_U) + b * UROWB + e0 * 2) = (u32x4){0u, 0u, 0u, 0u};
        }
    }
    __syncthreads();
    if (tid < 2 * (2 * n / 8)) { const int o = tid / (2 * n / 8), k = tid % (2 * n / 8);
        const u32x4 lo = *(const LAS u32x4*)(lds + OFF_GS + o * GSB + k * 16), hi = *(const LAS u32x4*)(lds + OFF_GS + o * GSB + k * 16 + 16);
        const unsigned d[8] = {lo.x, lo.y, lo.z, lo.w, hi.x, hi.y, hi.z, hi.w};
        LAS unsigned char* fdst = lds + (o ? OFF_F1 : OFF_F0) + k * 16;
#pragma unroll
        for (int s = 0; s < 8; ++s) { u32x4 w;
            if ((s & 1) == 0) { w.x = d[s / 2]; w.y = d[s / 2 + 1]; w.z = d[s / 2 + 2]; w.w = d[s / 2 + 3]; }
            else { w.x = __builtin_amdgcn_alignbyte(d[s / 2 + 1], d[s / 2], 2); w.y = __builtin_amdgcn_alignbyte(d[s / 2 + 2], d[s / 2 + 1], 2);
                   w.z = __builtin_amdgcn_alignbyte(d[s / 2 + 3], d[s / 2 + 2], 2); w.w = __builtin_amdgcn_alignbyte(d[s / 2 + 4], d[s / 2 + 3], 2); }
            *(LAS u32x4*)(fdst + s * LENB) = w; }
    }
    __syncthreads();
    const int bcol = NB == 8 ? (r >> 2) : r, ioff = NB == 8 ? (r & 3) : 0, I0 = wv * NI, Icol = I0 + ioff;
    const int si = (7 - r) & 7;
    const int Dlo = I0 + NI - 1 - (NBLK - 1) - (NI - 1), Dhi = I0 + NI - 1;
    bf16_t* YC = (bf16_t*)(p.ws + OFF_YCAT);
#pragma unroll
    for (int o = 0; o < 2; ++o) {
        const LAS unsigned char* ap = lds + (o ? OFF_F1 : OFF_F0) + si * LENB + (n - 1 - r + 8 * h - si) * 2 - 64 * Dlo;
        const LAS unsigned char* bp = lds + (o ? OFF_U2 : OFF_U) + bcol * UROWB + (PAD + 32 * Icol + 8 * h) * 2 - 64 * Dlo;
        f32x16 acc;
#pragma unroll
        for (int i = 0; i < 16; ++i) acc[i] = 0.f;
#pragma unroll 4
        for (int D = Dlo; D <= Dhi; ++D) {
            const bf16x8 a0 = *(const LAS bf16x8*)ap, a1 = *(const LAS bf16x8*)(ap + 32);
            const bf16x8 b0 = *(const LAS bf16x8*)bp, b1 = *(const LAS bf16x8*)(bp + 32);
            acc = __builtin_amdgcn_mfma_f32_32x32x16_bf16(a0, b0, acc, 0, 0, 0);
            acc = __builtin_amdgcn_mfma_f32_32x32x16_bf16(a1, b1, acc, 0, 0, 0);
            ap -= 64; bp -= 64;
        }
        const float bias = p.in[22][(l * 2 + o) * 256 + c];
#pragma unroll
        for (int g = 0; g < 4; ++g) {
            const int t0 = 32 * Icol + 8 * g + 4 * h;
            const u32x2 uin = *(const LAS u32x2*)(lds + (o ? OFF_U2 : OFF_U) + bcol * UROWB + (PAD + t0) * 2);
            const u32x2 gin = *(const LAS u32x2*)(lds + (o ? OFF_G2 : OFF_G1) + (bcol * n + t0) * 2);
            float y[4];
            y[0] = __uint_as_float(gin.x << 16) * (acc[4 * g] + bias * __uint_as_float(uin.x << 16));
            y[1] = __uint_as_float(gin.x & 0xFFFF0000u) * (acc[4 * g + 1] + bias * __uint_as_float(uin.x & 0xFFFF0000u));
            y[2] = __uint_as_float(gin.y << 16) * (acc[4 * g + 2] + bias * __uint_as_float(uin.y << 16));
            y[3] = __uint_as_float(gin.y & 0xFFFF0000u) * (acc[4 * g + 3] + bias * __uint_as_float(uin.y & 0xFFFF0000u));
            if (o == 0) { u32x2 w; w.x = pk_bf16(y[0], y[1]); w.y = pk_bf16(y[2], y[3]);
                *(LAS u32x2*)(lds + OFF_U2 + bcol * UROWB + (PAD + t0) * 2) = w; }
            else { bf16_t* dst = YC + (size_t)(rowbase + bcol * n + t0) * 1024 + 256 + c;
#pragma unroll
                for (int e = 0; e < 4; e += 2) { const unsigned w = pk_bf16(y[e], y[e + 1]); dst[(size_t)e * 1024] = (bf16_t)w; dst[(size_t)(e + 1) * 1024] = (bf16_t)(w >> 16); } }
        }
        __syncthreads();
    }
}
__device__ void hyena_mfma(const Params& p, int l, LAS unsigned char* lds) {
    const int tid = opaque_tid();
    const bf16_t* HT = (const bf16_t*)(p.ws + OFF_HT);
    const bf16_t* gl = (const bf16_t*)(p.ws + OFF_FILT) + (size_t)l * G_L;
    for (int u = blockIdx.x; u < 512; u += gridDim.x) {
        if (u < 256) hyena_unit<8, 32>(p, l, u, HT + HT_LAT, NCTX, gl + G_CTX, lds, tid);
        else hyena_unit<32, 8>(p, l, u - 256, HT, 0, gl, lds, tid);
    }
}


struct OneUnit { int pm, pn;
    __device__ __forceinline__ bool next(int i, pg8::Unit& u) const { if (i) return false; u.pm = pm; u.pn = pn; return true; }
    __device__ __forceinline__ void a_ready(const pg8::Unit&) const {}
    __device__ __forceinline__ void done(const pg8::Unit&) const {} };
__device__ void mixer_phase(const Params& p, int l, LAS unsigned char* lds) {
    constexpr int NU = 32 + 256 + 256 + 32 + 256 + 256;
    GAS unsigned char* wsg = (GAS unsigned char*)p.ws; asm volatile("" : "+s"(wsg)); unsigned char* ws = (unsigned char*)wsg;
    unsigned* ctr = (unsigned*)(ws + OFF_BAR) + 64 * l;
    volatile LAS unsigned* slot = (volatile LAS unsigned*)(lds + 149 * 1024 + 8);
    const bf16_t* HT = (const bf16_t*)(ws + OFF_HT);
    const bf16_t* gl = (const bf16_t*)(ws + OFF_FILT) + (size_t)l * G_L;
    int u = blockIdx.x;
    while (u < NU) {
        unsigned ticket = 0;
        if (threadIdx.x == 0) ticket = __hip_atomic_fetch_add(ctr, 1u, __ATOMIC_RELAXED, __HIP_MEMORY_SCOPE_AGENT);
        const int tid = opaque_tid();
        if (u < 32) {
            pg8::Gemm g{(const bf16_t*)(ws + OFF_FL), (const bf16_t*)(ws + OFF_ZT) + ZT_LAT, 1024, 2048, 2048, 2048, 2048};
            OneUnit S{u & 3, u >> 2}; EpiFourier E{(bf16_t*)(ws + OFF_YCAT), NCTX, 1024};
            pg8::gemm_phase(lds, g, S, E);
        } else if (u < 288) attn_unit(p, l, u - 32, lds, tid);
        else if (u < 544) hyena_unit<8, 32>(p, l, u - 288, HT + HT_LAT, NCTX, gl + G_CTX, lds, tid);
        else if (u < 576) {
            pg8::Gemm g{(const bf16_t*)(ws + OFF_FC), (const bf16_t*)(ws + OFF_ZT), 256, 8192, 512, 512, 512};
            OneUnit S{0, u - 544}; EpiFourier E{(bf16_t*)(ws + OFF_YCAT), 0, 256};
            pg8::gemm_phase(lds, g, S, E);
        } else if (u < 832) attn_unit(p, l, 256 + (u - 576), lds, tid);
        else hyena_unit<32, 8>(p, l, u - 832, HT, 0, gl, lds, tid);
        if (threadIdx.x == 0) *slot = ticket + 256u;
        __syncthreads();
        u = (int)*slot;
        __syncthreads();
    }
}

__global__ void __launch_bounds__(NTHREADS, 2) fwd_megakernel(Params p) {
    extern __shared__ __attribute__((aligned(16))) unsigned char shm[];
    cg::grid_group grid = cg::this_grid();
    LAS unsigned char* lds = (LAS unsigned char*)shm;
    float* ldsf = (float*)shm;
    unsigned char* ws = p.ws;
    const int G = gridDim.x, c = blockIdx.x;

    volatile LAS unsigned* xst = (volatile LAS unsigned*)(lds + 149 * 1024);
    if (threadIdx.x < 4) xst[threadIdx.x] = 0u;
    __syncthreads();
    const XcdBarrier xb = xcd_barrier_post((unsigned*)(ws + OFF_BAR), xst);
    for (int _d = 0; _d < DUP_PREP; ++_d) { phase_prep(p, ldsf); __syncthreads(); }
    if (p.ws == nullptr) grid.sync();
    GSYNC();
    phase_row<0>(p, 0, 0, 0, 0);
    GSYNC();
    for (int l = 0; l < 2; ++l) {
        for (int s = 0; s < 3; ++s) {
            GAS unsigned char* wsg = (GAS unsigned char*)p.ws; asm volatile("" : "+s"(wsg)); unsigned char* ws = (unsigned char*)wsg;
            if (s != 1) {
                const int fs = s >> 1;
                { pg8::Gemm g{(const bf16_t*)(ws + OFF_H), (const bf16_t*)(ws + OFF_WGU + (l * 2 + fs) * SZ_WGU), NTOK, 5632, 1024, 1024, 1024};
                    pg8::StaticOrder S; S.init(g.M, g.N, G, c); EpiSwiglu E{(bf16_t*)(ws + OFF_ACT)};
                    for (int _d = 0; _d < DUP_GEMM; ++_d) pg8::gemm_phase(lds, g, S, E); }
                { int cc = c, gg = G; asm volatile("" : "+s"(cc), "+s"(gg));
                    if (cc >= 1408 - 5 * gg) { __syncthreads(); tr_slot(p, ldsf, 1 + l * 2 + fs, cc - (1408 - 5 * gg), gg - (1408 - 5 * gg), opaque_tid()); } }
                GSYNC();
                { pg8::Gemm g{(const bf16_t*)(ws + OFF_ACT), (const bf16_t*)(ws + OFF_WD + (l * 2 + fs) * SZ_WD), NTOK, 1024, DFF, DFF, DFF};
                    pg8::StaticOrder S; S.init(g.M, g.N, G, c); EpiYssq E{(bf16_t*)(ws + OFF_Y), (float*)(ws + OFF_SSQ)};
                    for (int _d = 0; _d < DUP_GEMM; ++_d) pg8::gemm_phase(lds, g, S, E); }
                GSYNC();
            } else {
                { pg8::Gemm g{(const bf16_t*)(ws + OFF_H), (const bf16_t*)(ws + OFF_WIN + l * SZ_WIN), NTOK, 2048, 1024, 1024, 1024};
                    pg8::StaticOrder S; S.init(g.M, g.N, G, c);
                    EpiWin E{(bf16_t*)(ws + OFF_ZT), (bf16_t*)(ws + OFF_HT), (bf16_t*)(ws + OFF_QB), (bf16_t*)(ws + OFF_KB), (bf16_t*)(ws + OFF_VB), (const float*)(ws + OFF_ROPE),
                             p.out + (size_t)NTOK * D, p.out + (size_t)NTOK * D + (size_t)32 * 2 * 256 * 128, l};
                    for (int _d = 0; _d < DUP_GEMM; ++_d) pg8::gemm_phase(lds, g, S, E); }
                GSYNC();
                mixer_phase(p, l, lds);
                GSYNC();
                { pg8::Gemm g{(const bf16_t*)(ws + OFF_YCAT), (const bf16_t*)(ws + OFF_WOUT + l * SZ_WOUT), NTOK, 1024, 1024, 1024, 1024};
                    pg8::StaticOrder S; S.init(g.M, g.N, G, c); EpiYssq E{(bf16_t*)(ws + OFF_Y), (float*)(ws + OFF_SSQ)};
                    for (int _d = 0; _d < DUP_GEMM; ++_d) pg8::gemm_phase(lds, g, S, E); }
                GSYNC();
            }
            if (l == 1 && s == 2) phase_row<2>(p, l, s, 0, 0);
            else { const int ln = s == 2 ? l + 1 : l, sn = s == 2 ? 0 : s + 1; phase_row<1>(p, l, s, ln, sn); }
            if (!(l == 1 && s == 2)) GSYNC();
        }
    }
}

extern "C" void kernel_launch(void* const* d_in, const int* in_sizes, int n_in, void* d_out, int out_size, void* d_ws, size_t ws_size, hipStream_t stream) {
    constexpr int LDS_BYTES = 149 * 1024 + 256;
    static int grid_blocks = 0;
    if (!grid_blocks) {
        if (n_in != 24 || ws_size < WS_END) { fprintf(stderr, "kernel_launch: bad inputs (n_in %d) or workspace too small (%zu < %zu)\n", n_in, ws_size, (size_t)WS_END); grid_blocks = -1; return; }
        int dev = 0, cus = 0, per_cu = 0;
        hipGetDevice(&dev);
        hipDeviceGetAttribute(&cus, hipDeviceAttributeMultiprocessorCount, dev);
        if (hipFuncSetAttribute((const void*)fwd_megakernel, hipFuncAttributeMaxDynamicSharedMemorySize, LDS_BYTES) != hipSuccess) fprintf(stderr, "kernel_launch: hipFuncSetAttribute failed\n");
        hipOccupancyMaxActiveBlocksPerMultiprocessor(&per_cu, (const void*)fwd_megakernel, NTHREADS, LDS_BYTES);
        if (per_cu < 1) { fprintf(stderr, "kernel_launch: occupancy query says %d blocks per CU\n", per_cu); per_cu = 1; }
        (void)hipGetLastError();
        grid_blocks = cus * per_cu;
        if (grid_blocks > 256) grid_blocks = 256;
    }
    if (grid_blocks < 0) return;
    Params p{};
    for (int i = 0; i < 24; ++i) p.in[i] = (const float*)d_in[i];
    p.out = (float*)d_out; p.ws = (unsigned char*)d_ws;
    (void)hipMemsetAsync((unsigned char*)d_ws + OFF_BAR, 0, 16384, stream);
    void* args[] = {&p};
    hipError_t e = hipLaunchCooperativeKernel((const void*)fwd_megakernel, dim3(grid_blocks), dim3(NTHREADS), args, LDS_BYTES, stream);
    if (e != hipSuccess) fprintf(stderr, "cooperative launch failed: %s (grid %d)\n", hipGetErrorString(e), grid_blocks);
}
```

```cpp
#include <hip/hip_runtime.h>
#include <hip/hip_cooperative_groups.h>
#include <cstdio>
namespace cg = cooperative_groups;

#define LAS __attribute__((address_space(3)))
#define GAS __attribute__((address_space(1)))
#ifndef DUP_PA
#define DUP_PA 1
#endif
#ifndef DUP_PB
#define DUP_PB 1
#endif
#ifndef DUP_PC
#define DUP_PC 1
#endif
#ifndef DUP_PD
#define DUP_PD 1
#endif
#ifndef DUP_HY
#define DUP_HY 1
#endif
#ifndef DUP_AT
#define DUP_AT 1
#endif
#ifndef DUP_GEMM
#define DUP_GEMM 1
#endif
#ifndef DUP_MIX
#define DUP_MIX 1
#endif
#ifndef DUP_PREP
#define DUP_PREP 1
#endif
#ifndef DUP_SYNC
#define DUP_SYNC 1
#endif
#define GSYNC() do { for (int _s = 0; _s < DUP_SYNC; ++_s) xcd_barrier(xb); } while (0)
typedef unsigned short bf16_t;
typedef short bf16x8 __attribute__((ext_vector_type(8)));
typedef float f32x4 __attribute__((ext_vector_type(4)));
typedef unsigned u32x4 __attribute__((ext_vector_type(4)));
typedef unsigned u32x2 __attribute__((ext_vector_type(2)));

constexpr int D = 1024, NTOK = 16384, NCTX = 8192, DFF = 2816, INW = 1792;
constexpr int NTHREADS = 512;
constexpr float EPS = 1e-6f;
constexpr float PI2 = 6.283185307179586f;

constexpr size_t AL(size_t x) { return (x + 255) & ~(size_t)255; }
constexpr size_t SZ_WGU = (size_t)5632 * 1024 * 2, SZ_WD = (size_t)1024 * 2816 * 2, SZ_WIN = (size_t)2048 * 1024 * 2, SZ_WOUT = (size_t)1024 * 1024 * 2;
constexpr size_t OFF_WGU = 0;
constexpr size_t OFF_WD = OFF_WGU + 4 * SZ_WGU;
constexpr size_t OFF_WIN = OFF_WD + 4 * SZ_WD;
constexpr size_t OFF_WOUT = OFF_WIN + 2 * SZ_WIN;
constexpr size_t OFF_H = OFF_WOUT + 2 * SZ_WOUT;
constexpr size_t OFF_Y = OFF_H + (size_t)NTOK * D * 2;
constexpr size_t OFF_SSQ = OFF_Y + (size_t)NTOK * D * 2;
constexpr size_t OFF_MOD = OFF_SSQ + (size_t)NTOK * 16 * 4;
constexpr size_t OFF_FILT = AL(OFF_MOD + (size_t)2 * 9 * 9216 * 4);
constexpr size_t FILT_CTX = (size_t)4 * 256 * 256, FILT_LAT = (size_t)4 * 256 * 1024, FILT_L = FILT_CTX + FILT_LAT;
constexpr size_t G_CTX = (size_t)2 * 256 * 512, G_LAT = (size_t)2 * 256 * 2048, G_L = G_CTX + G_LAT;
constexpr size_t OFF_FC = AL(OFF_FILT + 2 * FILT_L * 4);
constexpr size_t OFF_FL = OFF_FC + (size_t)256 * 512 * 2;
constexpr size_t OFF_ROPE = OFF_FL + (size_t)1024 * 2048 * 2;
constexpr size_t OFF_BAR = AL(OFF_ROPE + 64 * 16 * 8);
constexpr size_t OFF_CKB = OFF_BAR + 16384;
constexpr size_t OFF_CVT = OFF_CKB + (size_t)2 * 8 * 256 * 128 * 2;
constexpr size_t OFF_UNION = AL(OFF_CVT + (size_t)2 * 8 * 256 * 128 * 2);
constexpr size_t OFF_ACT = OFF_UNION;
constexpr size_t OFF_ZT = OFF_UNION;
constexpr size_t ZT_LAT = (size_t)NCTX * 512;
constexpr size_t OFF_HT = OFF_ZT + (size_t)NTOK * 512 * 2;
constexpr size_t HT_LAT = (size_t)NCTX * 768;
constexpr size_t OFF_QB = OFF_HT + (size_t)NTOK * 768 * 2;
constexpr size_t OFF_KB = OFF_QB + (size_t)NTOK * 512 * 2;
constexpr size_t OFF_VB = OFF_KB + (size_t)NTOK * 128 * 2;
constexpr size_t VT_LAT = (size_t)NCTX * 128;
constexpr size_t OFF_YCAT = OFF_VB + (size_t)NTOK * 128 * 2;
constexpr size_t UNION_END = OFF_YCAT + (size_t)NTOK * 1024 * 2;
constexpr size_t ACT_END = OFF_ACT + (size_t)NTOK * DFF * 2;
constexpr size_t OFF_X16 = AL(UNION_END > ACT_END ? UNION_END : ACT_END);
constexpr size_t WS_END = OFF_X16 + (size_t)NTOK * D * 2;

struct Params {
    const float* in[24];
    float* out;
    unsigned char* ws;
};

__device__ __forceinline__ unsigned short f2bf(float f) { unsigned u = __float_as_uint(f); u += 0x7FFFu + ((u >> 16) & 1u); return (unsigned short)(u >> 16); }
__device__ __forceinline__ float bf2f(unsigned short b) { return __uint_as_float(((unsigned)b) << 16); }
__device__ __forceinline__ unsigned cvt_pk_bf16(float lo, float hi) { unsigned r; asm volatile("v_cvt_pk_bf16_f32 %0, %1, %2" : "=v"(r) : "v"(lo), "v"(hi)); return r; }
typedef __bf16 bf16x2_t __attribute__((ext_vector_type(2)));
typedef float f32x2_t __attribute__((ext_vector_type(2)));
typedef float f32x16 __attribute__((ext_vector_type(16)));
__device__ __forceinline__ unsigned pk_bf16(float lo, float hi) { f32x2_t v = {lo, hi}; return __builtin_bit_cast(unsigned, __builtin_convertvector(v, bf16x2_t)); }
__device__ __forceinline__ float silu_f(float x) { return x * __builtin_amdgcn_rcpf(1.0f + __expf(-x)); }
__device__ __forceinline__ int perm32(int rho) { const int n = rho >> 4, i = rho & 15; return 8 * (i >> 2) + 4 * n + (i & 3); }

__device__ __forceinline__ int opaque_tid() { int t = threadIdx.x; asm volatile("" : "+v"(t)); return t; }


#define XB_TMO      128
#define XB_XCNT(j)  (256  + 64 * (j))
#define XB_XSUB(j)  (1280 + 64 * (j))
#define XB_XGEN(j)  (2304 + 64 * (j))
#define XB_TOP      3328
#define XB_TOPGEN   3392
#define XCD_BAR_WORDS 3456
#define XB_SPIN_CAP (1u << 22)
__device__ __forceinline__ unsigned xb_ld(unsigned* p)              { return __hip_atomic_load(p, __ATOMIC_RELAXED, __HIP_MEMORY_SCOPE_AGENT); }
__device__ __forceinline__ unsigned xb_add(unsigned* p, unsigned v) { return __hip_atomic_fetch_add(p, v, __ATOMIC_RELAXED, __HIP_MEMORY_SCOPE_AGENT); }
__device__ __forceinline__ unsigned xb_xcc_id() { return (unsigned)__builtin_amdgcn_s_getreg((3 << 11) | 20) & 0xFu; }
#define XB_SPIN(cond, bar) do { unsigned _sp = 0; while (cond) { __builtin_amdgcn_s_sleep(1); \
    if ((++_sp & 255u) == 0u) { if (xb_ld(&(bar)[XB_TMO])) break; if (_sp > XB_SPIN_CAP) { atomicAdd(&(bar)[XB_TMO], 1u); break; } } } } while (0)
struct XcdBarrier { unsigned* bar; unsigned x; volatile LAS unsigned* st; };
__device__ __forceinline__ XcdBarrier xcd_barrier_post(unsigned* bar, volatile LAS unsigned* st) {
    XcdBarrier b; b.bar = bar; b.x = xb_xcc_id(); b.st = st;
    if (threadIdx.x == 0) (void)xb_add(&bar[XB_XCNT(b.x)], 1u);
    return b;
}
__device__ __forceinline__ void xcd_barrier_complete(unsigned* bar, unsigned x, unsigned& nloc, unsigned& nx) {
    const unsigned G = gridDim.x * gridDim.y * gridDim.z;
    unsigned sum, cnt, mine, sp = 0u;
    for (;;) {
        sum = 0u; cnt = 0u; mine = 0u;
#pragma unroll
        for (unsigned j = 0; j < 16; ++j) { const unsigned c = xb_ld(&bar[XB_XCNT(j)]); sum += c; cnt += (c > 0u) ? 1u : 0u; mine = (j == x) ? c : mine; }
        if (sum == G) break;
        __builtin_amdgcn_s_sleep(1);
        if ((++sp & 255u) == 0u) { if (xb_ld(&bar[XB_TMO])) break; if (sp > XB_SPIN_CAP) { atomicAdd(&bar[XB_TMO], 1u); break; } }
    }
    nloc = mine > 0u ? mine : 1u; nx = cnt > 0u ? cnt : 1u;
}
__device__ __forceinline__ void xcd_barrier(const XcdBarrier& b) {
    asm volatile("s_waitcnt vmcnt(0)" ::: "memory");
    __syncthreads();
    if (threadIdx.x == 0) {
        unsigned* bar = b.bar;
        __builtin_amdgcn_s_waitcnt(0);
        unsigned nloc = b.st[0], nx = b.st[1];
        if (nloc == 0u) { xcd_barrier_complete(bar, b.x, nloc, nx); b.st[0] = nloc; b.st[1] = nx; }
        const unsigned old = xb_add(&bar[XB_XSUB(b.x)], 1u);
        const unsigned gen = old / nloc;
        if (old + 1u == (gen + 1u) * nloc) {
            __builtin_amdgcn_fence(__ATOMIC_RELEASE, "agent");
            asm volatile("s_waitcnt vmcnt(0)" ::: "memory");
            const unsigned og = xb_add(&bar[XB_TOP], 1u);
            const unsigned tg = og / nx;
            if (og + 1u == (tg + 1u) * nx) xb_add(&bar[XB_TOPGEN], 1u);
            else XB_SPIN(xb_ld(&bar[XB_TOPGEN]) == tg, bar);
            __builtin_amdgcn_fence(__ATOMIC_ACQUIRE, "agent");
            xb_add(&bar[XB_XGEN(b.x)], 1u);
            asm volatile("s_waitcnt vmcnt(0)" ::: "memory");
        } else {
            XB_SPIN(xb_ld(&bar[XB_XGEN(b.x)]) == gen, bar);
            __builtin_amdgcn_fence(__ATOMIC_ACQUIRE, "agent");
            asm volatile("s_waitcnt vmcnt(0)" ::: "memory");
        }
    }
    __syncthreads();
}

namespace pg8 {
constexpr int BM = 256, BK = 64, HALF = 128, HTB = HALF * BK * 2, STAGE_BYTES = 8 * HTB, NXCD = 8, WGM = 8;
__device__ __forceinline__ int lds_byte(int r, int c) { const int st = (r >> 4) * 2 + (c >> 5), rr = r & 15, cc = c & 31, ob = rr * 64 + cc * 2; return st * 1024 + (ob ^ (((ob >> 9) & 1) << 5)); }
__device__ __forceinline__ void stage_rc(int b, int& R, int& C) { const int st = b / 1024, sb = b % 1024, swz = sb ^ (((sb >> 9) & 1) << 5); R = (st >> 1) * 16 + swz / 64; C = (st & 1) * 32 + (swz % 64) / 2; }
struct Unit { int pm, pn; };
struct Gemm { const bf16_t* A; const bf16_t* Bt; int M, N, K, lda, ldb; };
struct StaticOrder {
    int nM, nN, nwg, G, c;
    __device__ void init(int M, int N, int G_, int c_) { nM = M / BM; nN = N / BM; nwg = nM * nN; G = G_; c = c_; }
    __device__ bool next(int i, Unit& u) const {
        if (c < 0) return false;
        const long L = (long)i * G + c; if (L >= nwg) return false;
        int wgid = (int)L; { const int q = nwg / NXCD, r = nwg % NXCD, xcd = wgid % NXCD, off = wgid / NXCD; wgid = (xcd < r ? xcd * (q + 1) : r * (q + 1) + (xcd - r) * q) + off; }
        const int nig = WGM * nN, gid = wgid / nig, fm = gid * WGM, gsz = (nM - fm) < WGM ? (nM - fm) : WGM;
        u.pm = fm + ((wgid % nig) % gsz); u.pn = (wgid % nig) / gsz; return true;
    }
    __device__ __forceinline__ void a_ready(const Unit&) const {}
    __device__ __forceinline__ void done(const Unit&) const {}
};

template <class Epi, class Sched>
__device__ __forceinline__ void gemm_phase(LAS unsigned char* lds, Gemm g, const Sched& S, const Epi& E) {
    asm volatile("" : "+s"(g.A), "+s"(g.Bt), "+s"(g.K), "+s"(g.lda), "+s"(g.ldb));
    int tid = threadIdx.x; asm volatile("" : "+v"(tid));
    const int wid = __builtin_amdgcn_readfirstlane(tid >> 6), lane = tid & 63, wr = wid >> 2, wc = wid & 3, fr = lane & 15, fq = lane >> 4;
    const int K = g.K, nt = K / BK;
    unsigned voffA[2], voffB[2];
#pragma unroll
    for (int i = 0; i < 2; ++i) { int R, C; stage_rc(tid * 16 + i * 8192, R, C);
        voffA[i] = (unsigned)(R * g.lda + C) * 2u; voffB[i] = (unsigned)(R * g.ldb + C) * 2u; }
    const size_t kstep = (size_t)(BK * 2);
    const size_t hstepA = (size_t)HALF * g.lda * 2, hstepB = (size_t)HALF * g.ldb * 2;
    const size_t tstepA = 2 * hstepA, tstepB = 2 * hstepB;
    const unsigned ldsw = (unsigned)wid * 1024u;
    const int aoff = lds_byte(wr * 64 + fr, fq * 8), boff = lds_byte(wc * 32 + fr, fq * 8);
#define PG8_SA(b, h) (((b) * 2 + (h)) * HTB)
#define PG8_SB(b, h) ((4 + (b) * 2 + (h)) * HTB)
#define PG8_STAGE(bufoff, gbase, voff) do { _Pragma("unroll") for (int _i = 0; _i < 2; ++_i) \
        __builtin_amdgcn_global_load_lds((const unsigned*)((const char*)(gbase) + (voff)[_i]), (LAS unsigned*)(lds + (bufoff) + ldsw + _i * 8192), 16, 0, 0); } while (0)
#define PG8_LDA(dst, b, h) do { _Pragma("unroll") for (int m = 0; m < 4; ++m) _Pragma("unroll") for (int k = 0; k < 2; ++k) dst[m][k] = *(const LAS bf16x8*)(lds + PG8_SA(b, h) + aoff + m * 2048 + k * 1024); } while (0)
#define PG8_LDB(dst, b, h) do { _Pragma("unroll") for (int n = 0; n < 2; ++n) _Pragma("unroll") for (int k = 0; k < 2; ++k) dst[n][k] = *(const LAS bf16x8*)(lds + PG8_SB(b, h) + boff + n * 2048 + k * 1024); } while (0)
#define PG8_MMA(ai, bj, At, Bt) do { __builtin_amdgcn_s_setprio(1); _Pragma("unroll") for (int m = 0; m < 4; ++m) _Pragma("unroll") for (int n = 0; n < 2; ++n) _Pragma("unroll") for (int k = 0; k < 2; ++k) \
        acc[ai][bj][m][n] = __builtin_amdgcn_mfma_f32_16x16x32_bf16(Bt[n][k], At[m][k], acc[ai][bj][m][n], 0, 0, 0); __builtin_amdgcn_s_setprio(0); } while (0)
#define PG8_WAIT_V(n) asm volatile("s_waitcnt vmcnt(" #n ")" ::: "memory")
#define PG8_WAIT_L(n) asm volatile("s_waitcnt lgkmcnt(" #n ")" ::: "memory")
#define PG8_BAR __builtin_amdgcn_s_barrier()
#define PG8_SCHED __builtin_amdgcn_sched_barrier(0)
    Unit cur, nxt; int ui = 0;
    if (!S.next(0, cur)) return;
    f32x4 acc[2][2][4][2];
#pragma unroll
    for (int a = 0; a < 2; ++a)
#pragma unroll
        for (int b = 0; b < 2; ++b)
#pragma unroll
            for (int m = 0; m < 4; ++m)
#pragma unroll
                for (int n = 0; n < 2; ++n) acc[a][b][m][n] = (f32x4){0.f, 0.f, 0.f, 0.f};
    bf16x8 At[4][2], B0[2][2], B1[2][2];
    const char* cA = (const char*)g.A + (size_t)cur.pm * tstepA; const char* cB = (const char*)g.Bt + (size_t)cur.pn * tstepB;
    S.a_ready(cur);
    PG8_STAGE(PG8_SB(0, 0), cB, voffB); PG8_STAGE(PG8_SA(0, 0), cA, voffA); PG8_STAGE(PG8_SB(0, 1), cB + hstepB, voffB); PG8_STAGE(PG8_SA(0, 1), cA + hstepA, voffA);
    if (wr == 1) PG8_BAR;
    PG8_WAIT_V(4); PG8_BAR;
    PG8_STAGE(PG8_SB(1, 0), cB + kstep, voffB); PG8_STAGE(PG8_SA(1, 0), cA + kstep, voffA); PG8_STAGE(PG8_SB(1, 1), cB + hstepB + kstep, voffB);
    PG8_WAIT_V(6); PG8_BAR;
    for (;;) {
        const bool has_next = S.next(ui + 1, nxt);
        const char* nA = has_next ? (const char*)g.A + (size_t)nxt.pm * tstepA : cA; const char* nB = has_next ? (const char*)g.Bt + (size_t)nxt.pn * tstepB : cB;
        for (int t = 0; t < nt; t += 2) {
            const bool last = (t == nt - 2);
            const char* a1 = cA + (size_t)(t + 1) * kstep;
            const char* a2 = last ? nA : cA + (size_t)(t + 2) * kstep; const char* b2 = last ? nB : cB + (size_t)(t + 2) * kstep;
            const char* a3 = a2 + kstep; const char* b3 = b2 + kstep;
            if (last && has_next) S.a_ready(nxt);
            PG8_LDB(B0, 0, 0); PG8_SCHED; PG8_LDA(At, 0, 0); PG8_STAGE(PG8_SA(1, 1), a1 + hstepA, voffA);
            PG8_WAIT_L(8); PG8_BAR; PG8_WAIT_L(0); PG8_MMA(0, 0, At, B0); PG8_BAR; PG8_SCHED;
            PG8_LDB(B1, 0, 1); PG8_STAGE(PG8_SB(0, 0), b2, voffB);
            PG8_BAR; PG8_WAIT_L(0); PG8_MMA(0, 1, At, B1); PG8_BAR;
            PG8_LDA(At, 0, 1); PG8_STAGE(PG8_SA(0, 0), a2, voffA);
            PG8_BAR; PG8_WAIT_L(0); PG8_MMA(1, 0, At, B0); PG8_BAR; PG8_SCHED;
            PG8_STAGE(PG8_SB(0, 1), b2 + hstepB, voffB);
            PG8_WAIT_V(6); PG8_BAR; PG8_MMA(1, 1, At, B1); PG8_BAR;
            PG8_LDB(B0, 1, 0); PG8_SCHED; PG8_LDA(At, 1, 0); PG8_STAGE(PG8_SA(0, 1), a2 + hstepA, voffA);
            PG8_WAIT_L(8); PG8_BAR; PG8_WAIT_L(0); PG8_MMA(0, 0, At, B0); PG8_BAR; PG8_SCHED;
            PG8_LDB(B1, 1, 1); PG8_STAGE(PG8_SB(1, 0), b3, voffB);
            PG8_BAR; PG8_WAIT_L(0); PG8_MMA(0, 1, At, B1); PG8_BAR;
            PG8_LDA(At, 1, 1); PG8_STAGE(PG8_SA(1, 0), a3, voffA);
            PG8_BAR; PG8_WAIT_L(0); PG8_MMA(1, 0, At, B0); PG8_BAR; PG8_SCHED;
            PG8_STAGE(PG8_SB(1, 1), b3 + hstepB, voffB);
            PG8_WAIT_V(6); PG8_BAR; PG8_MMA(1, 1, At, B1); PG8_BAR;
        }
        { int fr2 = fr, fq2 = fq, wr2 = wr, wc2 = wc; asm volatile("" : "+v"(fr2), "+v"(fq2), "+s"(wr2), "+s"(wc2));
            E(acc, cur, wr2, wc2, fr2, fq2); } S.done(cur);
        if (!has_next) break;
#pragma unroll
        for (int a = 0; a < 2; ++a)
#pragma unroll
            for (int b = 0; b < 2; ++b)
#pragma unroll
                for (int m = 0; m < 4; ++m)
#pragma unroll
                    for (int n = 0; n < 2; ++n) acc[a][b][m][n] = (f32x4){0.f, 0.f, 0.f, 0.f};
        cur = nxt; cA = nA; cB = nB; ++ui;
    }
    PG8_WAIT_V(0);
    if (wr == 0) PG8_BAR;
    PG8_BAR;
#undef PG8_SA
#undef PG8_SB
#undef PG8_STAGE
#undef PG8_LDA
#undef PG8_LDB
#undef PG8_MMA
#undef PG8_WAIT_V
#undef PG8_WAIT_L
#undef PG8_BAR
#undef PG8_SCHED
}
}

struct EpiSwiglu {
    bf16_t* O;
    __device__ __forceinline__ void operator()(const f32x4 (&acc)[2][2][4][2], const pg8::Unit& u, int wr, int wc, int fr, int fq) const {
        const int row0 = u.pm * 256 + wr * 64 + fr, col0 = u.pn * 128 + wc * 32 + 8 * fq;
#pragma unroll
        for (int ai = 0; ai < 2; ++ai)
#pragma unroll
            for (int m = 0; m < 4; ++m) {
                bf16_t* rowp = O + (size_t)(row0 + ai * 128 + m * 16) * DFF + col0;
                const f32x4 g0 = acc[ai][0][m][0], g1 = acc[ai][0][m][1], u0 = acc[ai][1][m][0], u1 = acc[ai][1][m][1];
                f32x4 r0, r1;
#pragma unroll
                for (int e = 0; e < 4; ++e) { r0[e] = __builtin_amdgcn_exp2f(-g0[e]); r1[e] = __builtin_amdgcn_exp2f(-g1[e]); }
                r0 = r0 + 1.0f; r1 = r1 + 1.0f;
#pragma unroll
                for (int e = 0; e < 4; ++e) { r0[e] = __builtin_amdgcn_rcpf(r0[e]); r1[e] = __builtin_amdgcn_rcpf(r1[e]); }
                const f32x4 o0 = (g0 * u0) * r0, o1 = (g1 * u1) * r1;
                u32x4 w;
                w.x = pk_bf16(o0[0], o0[1]); w.y = pk_bf16(o0[2], o0[3]); w.z = pk_bf16(o1[0], o1[1]); w.w = pk_bf16(o1[2], o1[3]);
                *(u32x4*)rowp = w;
            }
    }
};
struct EpiYssq {
    bf16_t* Y; float* ssq;
    __device__ __forceinline__ void operator()(const f32x4 (&acc)[2][2][4][2], const pg8::Unit& u, int wr, int wc, int fr, int fq) const {
        const int row0 = u.pm * 256 + wr * 64 + fr, col0 = u.pn * 256 + wc * 32 + 8 * fq;
#pragma unroll
        for (int ai = 0; ai < 2; ++ai)
#pragma unroll
            for (int m = 0; m < 4; ++m) {
                const int row = row0 + ai * 128 + m * 16;
                bf16_t* rowp = Y + (size_t)row * D + col0;
                float s = 0.f;
#pragma unroll
                for (int bj = 0; bj < 2; ++bj) {
                    const f32x4 v0 = acc[ai][bj][m][0], v1 = acc[ai][bj][m][1];
                    s += v0[0] * v0[0] + v0[1] * v0[1] + v0[2] * v0[2] + v0[3] * v0[3] + v1[0] * v1[0] + v1[1] * v1[1] + v1[2] * v1[2] + v1[3] * v1[3];
                    u32x4 w; w.x = cvt_pk_bf16(v0[0], v0[1]); w.y = cvt_pk_bf16(v0[2], v0[3]); w.z = cvt_pk_bf16(v1[0], v1[1]); w.w = cvt_pk_bf16(v1[2], v1[3]);
                    *(u32x4*)(rowp + bj * 128) = w;
                }
                s += __shfl_xor(s, 16); s += __shfl_xor(s, 32);
                if (fq == 0) ssq[(size_t)row * 16 + u.pn * 4 + wc] = s;
            }
    }
};
struct EpiWin {
    bf16_t* ZT; bf16_t* HT; bf16_t* QB; bf16_t* KB; bf16_t* VB; const float* rope; float* newk; float* newv; int layer;
    __device__ __forceinline__ void operator()(const f32x4 (&acc)[2][2][4][2], const pg8::Unit& u, int wr, int wc, int fr, int fq) const {
        const int r0 = u.pm * 256 + wr * 64 + fr;
        const bool lat = u.pm >= 32;
        const int pn = u.pn;
        if (pn < 5) {
            bf16_t* base; int t0; size_t sch;
            if (pn < 2) {
                if (!lat) { const int b = u.pm; base = ZT + ((size_t)b * 256 * 2 + pn) * 256; sch = 512; t0 = r0 - u.pm * 256; }
                else { const int b = (u.pm - 32) >> 2; base = ZT + ZT_LAT + ((size_t)b * 256 * 2 + pn) * 1024; sch = 2048; t0 = r0 - NCTX - b * 1024; }
            } else {
                const int c0 = (pn - 2) * 256;
                if (!lat) { const int b = u.pm; base = HT + ((size_t)b * 768 + c0) * 256; sch = 256; t0 = r0 - u.pm * 256; }
                else { const int b = (u.pm - 32) >> 2; base = HT + HT_LAT + ((size_t)b * 768 + c0) * 1024; sch = 1024; t0 = r0 - NCTX - b * 1024; }
            }
#pragma unroll
            for (int ai = 0; ai < 2; ++ai)
#pragma unroll
                for (int m = 0; m < 4; ++m) {
                    const int t = t0 + ai * 128 + m * 16;
#pragma unroll
                    for (int bj = 0; bj < 2; ++bj)
#pragma unroll
                        for (int n = 0; n < 2; ++n) {
                            const int ch = bj * 128 + wc * 32 + n * 16 + 4 * fq;
                            const f32x4 v = acc[ai][bj][m][n];
                            const unsigned w01 = pk_bf16(v[0], v[1]), w23 = pk_bf16(v[2], v[3]);
                            bf16_t* bp = base + (size_t)ch * sch + t;
                            bp[0] = (bf16_t)w01; bp[sch] = (bf16_t)(w01 >> 16); bp[2 * sch] = (bf16_t)w23; bp[3 * sch] = (bf16_t)(w23 >> 16);
                        }
                }
        } else {
            const int blk = wc & 1;
#pragma unroll
            for (int ai = 0; ai < 2; ++ai)
#pragma unroll
                for (int m = 0; m < 4; ++m) {
                    const int row = r0 + ai * 128 + m * 16;
                    f32x4 cs0 = {1.f, 0.f, 1.f, 0.f}, cs1 = {1.f, 0.f, 1.f, 0.f};
                    if (lat) { const int t = row & 1023; const int pos = blk ? (t & 63) : (t >> 6);
                        const f32x4* rp = (const f32x4*)(rope + (size_t)(pos * 16 + 4 * fq) * 2); cs0 = rp[0]; cs1 = rp[1]; }
#pragma unroll
                    for (int bj = 0; bj < 2; ++bj) {
                        f32x4 x1 = acc[ai][bj][m][0], x2 = acc[ai][bj][m][1];
                        const bool isv = (pn == 7 && bj == 1);
                        const bool isk = (pn == 7 && bj == 0);
                        const int cc = bj * 128 + wc * 32 + 4 * fq;
                        if ((isk || isv) && !lat) {
                            const int b = row >> 8, t = row & 255;
                            float* dst = (isk ? newk : newv) + (((size_t)b * 2 + layer) * 256 + t) * 128 + (cc & 127);
                            *(f32x4*)dst = x1; *(f32x4*)(dst + 16) = x2;
                        }
                        if (!isv) {
                            f32x4 o1, o2;
                            o1[0] = x1[0] * cs0[0] - x2[0] * cs0[1]; o2[0] = x2[0] * cs0[0] + x1[0] * cs0[1];
                            o1[1] = x1[1] * cs0[2] - x2[1] * cs0[3]; o2[1] = x2[1] * cs0[2] + x1[1] * cs0[3];
                            o1[2] = x1[2] * cs1[0] - x2[2] * cs1[1]; o2[2] = x2[2] * cs1[0] + x1[2] * cs1[1];
                            o1[3] = x1[3] * cs1[2] - x2[3] * cs1[3]; o2[3] = x2[3] * cs1[2] + x1[3] * cs1[3];
                            x1 = o1; x2 = o2;
                        }
                        bf16_t* dst;
                        if (pn < 7) { x1 *= 0.125f; x2 *= 0.125f; dst = QB + (size_t)row * 512 + (pn - 5) * 256 + cc; }
                        else if (isk) dst = KB + (size_t)row * 128 + cc;
                        else {
                            bf16_t* vb; size_t n_;
                            if (!lat) { vb = VB + (size_t)(row >> 8) * 128 * 256 + (row & 255); n_ = 256; } else { vb = VB + VT_LAT + (size_t)((row - NCTX) >> 10) * 128 * 1024 + (row & 1023); n_ = 1024; }
                            const int c0 = cc - 128;
#pragma unroll
                            for (int e = 0; e < 4; e += 2) { const unsigned wa = pk_bf16(x1[e], x1[e + 1]), wb = pk_bf16(x2[e], x2[e + 1]);
                                vb[(size_t)(c0 + e) * n_] = (bf16_t)wa; vb[(size_t)(c0 + e + 1) * n_] = (bf16_t)(wa >> 16); vb[(size_t)(c0 + 16 + e) * n_] = (bf16_t)wb; vb[(size_t)(c0 + 17 + e) * n_] = (bf16_t)(wb >> 16); }
                            continue;
                        }
                        u32x2 w1, w2; w1.x = cvt_pk_bf16(x1[0], x1[1]); w1.y = cvt_pk_bf16(x1[2], x1[3]); w2.x = cvt_pk_bf16(x2[0], x2[1]); w2.y = cvt_pk_bf16(x2[2], x2[3]);
                        *(u32x2*)dst = w1; *(u32x2*)(dst + 16) = w2;
                    }
                }
        }
    }
};
struct EpiFourier {
    bf16_t* YC; int rowbase, n;
    __device__ __forceinline__ void operator()(const f32x4 (&acc)[2][2][4][2], const pg8::Unit& u, int wr, int wc, int fr, int fq) const {
        const int kp0 = u.pm * 256 + wr * 64 + fr; const int b = u.pn;
#pragma unroll
        for (int ai = 0; ai < 2; ++ai)
#pragma unroll
            for (int m = 0; m < 4; ++m) {
                bf16_t* rowp = YC + (size_t)(rowbase + b * n + kp0 + ai * 128 + m * 16) * 1024 + wc * 32 + 4 * fq;
#pragma unroll
                for (int bj = 0; bj < 2; ++bj)
#pragma unroll
                    for (int nn = 0; nn < 2; ++nn) { const f32x4 v = acc[ai][bj][m][nn]; u32x2 w; w.x = cvt_pk_bf16(v[0], v[1]); w.y = cvt_pk_bf16(v[2], v[3]);
                        *(u32x2*)(rowp + bj * 128 + nn * 16) = w; }
            }
    }
};

struct TrUnit { const float* src; bf16_t* dst; int ld, k0, cbase, Kd, r0, perm; float scale; };
__device__ __forceinline__ TrUnit tr_unit_g(const Params& p, int kind, int idx, int w) {
    TrUnit t; unsigned char* ws = p.ws; t.scale = 1.0f;
    if (kind == 0) { const int rg = w / 16, kb = w % 16; const int pn = rg >> 1, half = rg & 1; t.scale = half ? 0.6931471805599453f : 1.4426950408889634f;
        t.src = (half ? p.in[10] : p.in[9]) + (size_t)idx * 1024 * DFF; t.ld = DFF; t.k0 = kb * 64; t.cbase = pn * 128; t.dst = (bf16_t*)(ws + OFF_WGU + idx * SZ_WGU); t.Kd = 1024; t.r0 = rg * 128; t.perm = 1; }
    else if (kind == 1) { const int rg = w / 44, kb = w % 44;
        t.src = p.in[11] + (size_t)idx * DFF * 1024; t.ld = 1024; t.k0 = kb * 64; t.cbase = rg * 128; t.dst = (bf16_t*)(ws + OFF_WD + idx * SZ_WD); t.Kd = DFF; t.r0 = rg * 128; t.perm = 1; }
    else if (kind == 2) { const int rg = w / 16, kb = w % 16;
        t.src = p.in[13] + (size_t)idx * 1024 * 1024; t.ld = 1024; t.k0 = kb * 64; t.cbase = rg * 128; t.dst = (bf16_t*)(ws + OFF_WOUT + idx * SZ_WOUT); t.Kd = 1024; t.r0 = rg * 128; t.perm = 1; }
    else { const int rg = w / 16, kb = w % 16;
        t.src = p.in[12] + (size_t)idx * 1024 * INW; t.ld = INW; t.k0 = kb * 64; t.cbase = 256 + rg * 128; t.dst = (bf16_t*)(ws + OFF_WIN + idx * SZ_WIN); t.Kd = 1024; t.r0 = 512 + rg * 128; t.perm = 0; }
    return t;
}
__device__ __forceinline__ int tr_slot_count(int slot) { return slot == 0 ? 704 : slot == 1 ? 1376 : slot == 2 ? 1248 : slot == 3 ? 1184 : 352; }
__device__ __forceinline__ TrUnit tr_unit(const Params& p, int slot, int v) {
    if (slot == 0) return tr_unit_g(p, 0, 0, v);
    if (slot == 1) { if (v < 352) return tr_unit_g(p, 1, 0, v); v -= 352; if (v < 192) return tr_unit_g(p, 3, 0, v); v -= 192; if (v < 128) return tr_unit_g(p, 2, 0, v); return tr_unit_g(p, 0, 1, v - 128); }
    if (slot == 2) { if (v < 352) return tr_unit_g(p, 1, 1, v); v -= 352; if (v < 704) return tr_unit_g(p, 0, 2, v); return tr_unit_g(p, 3, 1, v - 704); }
    if (slot == 3) { if (v < 352) return tr_unit_g(p, 1, 2, v); v -= 352; if (v < 128) return tr_unit_g(p, 2, 1, v); return tr_unit_g(p, 0, 3, v - 128); }
    return tr_unit_g(p, 1, 3, v);
}
__device__ __forceinline__ void tr_load(const TrUnit& t, int tid, f32x4 (&v)[4]) {
#pragma unroll
    for (int i = 0; i < 4; ++i) { const int idx = tid + 512 * i, kk = idx >> 5, c4 = idx & 31;
        v[i] = *(const f32x4*)(t.src + (size_t)(t.k0 + kk) * t.ld + t.cbase + c4 * 4); }
}
__device__ __forceinline__ void tr_slot(const Params& p, float* lds, int slot, int blk, int nblk, int tid) {
    const int NU = tr_slot_count(slot);
    constexpr int TS = 132;
    f32x4 v[4];
    int u = blk;
    TrUnit cur; if (u < NU) { cur = tr_unit(p, slot, u); tr_load(cur, tid, v); }
    while (u < NU) {
#pragma unroll
        for (int i = 0; i < 4; ++i) { const int idx = tid + 512 * i, kk = idx >> 5, c4 = idx & 31; *(f32x4*)(lds + kk * TS + c4 * 4) = v[i]; }
        __syncthreads();
        const int un = u + nblk; TrUnit nxt = cur;
        if (un < NU) { nxt = tr_unit(p, slot, un); tr_load(nxt, tid, v); }
        { const int rr = tid >> 2, kc = tid & 3; const int cc = cur.perm ? ((rr & ~31) + perm32(rr & 31)) : rr;
            float x[16];
#pragma unroll
            for (int j = 0; j < 16; ++j) x[j] = lds[(kc * 16 + j) * TS + cc] * cur.scale;
            u32x4 w0, w1; w0.x = pk_bf16(x[0], x[1]); w0.y = pk_bf16(x[2], x[3]); w0.z = pk_bf16(x[4], x[5]); w0.w = pk_bf16(x[6], x[7]);
            w1.x = pk_bf16(x[8], x[9]); w1.y = pk_bf16(x[10], x[11]); w1.z = pk_bf16(x[12], x[13]); w1.w = pk_bf16(x[14], x[15]);
            bf16_t* d = cur.dst + (size_t)(cur.r0 + rr) * cur.Kd + cur.k0 + kc * 16;
            *(u32x4*)d = w0; *(u32x4*)(d + 8) = w1; }
        __syncthreads();
        cur = nxt; u = un;
    }
}
__device__ void phase_prep(const Params& p, float* lds) {
    const int tid = opaque_tid(), nb = gridDim.x, bid = blockIdx.x;
    unsigned char* ws = p.ws;
    tr_slot(p, lds, 0, bid, nb, tid);
    __syncthreads();
    {
        float* tab = lds;
        if (tid < 64) { float sv, cv; sincosf(PI2 * (float)tid / 64.f, &sv, &cv); tab[tid] = cv; tab[64 + tid] = sv; }
        __syncthreads();
        const int lane = tid & 63, wv = tid >> 6;
        for (int u = bid * 8 + wv; u < 8192; u += nb * 8) {
            const int l = u >> 12, k = (u >> 2) & 1023, g = u & 3;
            const float* wrow = p.in[12] + ((size_t)l * 1024 + k) * INW + g * 64;
            const float wv_ = wrow[lane];
            float ac = 0.f, as = 0.f;
#pragma unroll 16
            for (int c = 0; c < 64; ++c) { const float w = __shfl(wv_, c); const int idx = (c * lane) & 63; ac += w * tab[idx]; as += w * tab[64 + idx]; }
            bf16_t* bt = (bf16_t*)(ws + OFF_WIN + l * SZ_WIN);
            bt[(size_t)(g * 64 + lane) * 1024 + k] = f2bf(ac);
            bt[(size_t)(256 + g * 64 + lane) * 1024 + k] = f2bf(as);
        }
        __syncthreads();
    }
    {
        float* sc = lds;
        float* part = lds + 12 * 1024;
        for (int i = tid; i < 9 * 1024; i += NTHREADS) { const int bc = i >> 10, k = i & 1023; const float cv = bc == 0 ? p.in[5][k] : p.in[4][(bc - 1) * 1024 + k]; sc[k * 12 + bc] = cv / (1.0f + expf(-cv)); }
        __syncthreads();
        for (int cb = bid; cb < 256; cb += nb) {
            const int gc0 = cb * 72, l = gc0 / 9216, j0 = gc0 % 9216;
            const int cg = tid % 18, kg = tid / 18;
            if (kg < 28) {
                f32x4 a[9];
#pragma unroll
                for (int i = 0; i < 9; ++i) a[i] = (f32x4){0.f, 0.f, 0.f, 0.f};
                const float* wp = p.in[6] + (size_t)l * 1024 * 9216 + j0 + cg * 4;
#pragma unroll 4
                for (int k = kg; k < 1024; k += 28) { const f32x4 w = *(const f32x4*)(wp + (size_t)k * 9216);
                    const f32x4 s0 = *(const f32x4*)(sc + k * 12), s1 = *(const f32x4*)(sc + k * 12 + 4); const float s8 = sc[k * 12 + 8];
                    a[0] += w * s0[0]; a[1] += w * s0[1]; a[2] += w * s0[2]; a[3] += w * s0[3]; a[4] += w * s1[0]; a[5] += w * s1[1]; a[6] += w * s1[2]; a[7] += w * s1[3]; a[8] += w * s8; }
#pragma unroll
                for (int i = 0; i < 9; ++i)
#pragma unroll
                    for (int e = 0; e < 4; ++e) part[(kg * 72 + cg * 4 + e) * 9 + i] = a[i][e];
            }
            __syncthreads();
            for (int i = tid; i < 72 * 9; i += NTHREADS) { const int c2 = i / 9, bc = i % 9; float s = 0.f;
#pragma unroll
                for (int g = 0; g < 28; ++g) s += part[(g * 72 + c2) * 9 + bc];
                ((float*)(ws + OFF_MOD))[((size_t)l * 9 + bc) * 9216 + j0 + c2] = s + p.in[7][l * 9216 + j0 + c2]; }
            __syncthreads();
        }
    }
    __syncthreads();
    {
        const int lane = tid & 63, wv = tid >> 6;
        float* h2s = lds;
        const int u0 = bid * 10; const int l = u0 / 1280;
        if (u0 < 2560) {
            const float* w1 = p.in[15] + l * 33 * 64; const float* b1 = p.in[16] + l * 64; const float* w2 = p.in[17] + l * 64 * 64; const float* b2 = p.in[18] + l * 64;
            const float* w3 = p.in[19] + (size_t)l * 64 * 1024; const float fr = p.in[20][l * 64 + lane];
            for (int q = wv; q < 10; q += 8) {
                const int rem = (u0 + q) % 1280; const int pass = rem >= 256; const int n = pass ? 1024 : 256; const int d = pass ? rem - 256 : rem;
                const float tt = (float)d / (float)(n - 1);
                float feat = 0.f;
                if (lane == 0) feat = tt;
                else if (lane < 33) { const int j = (lane - 1) & 15; const float fj = 1e-4f + (float)j * ((15.0f - 1e-4f) / 15.0f); const float ang = (PI2 / (float)n) * (float)d * fj;
                    feat = lane < 17 ? cosf(ang) : -sinf(ang); }
                float a1 = b1[lane];
#pragma unroll
                for (int i = 0; i < 33; ++i) a1 += __shfl(feat, i) * w1[i * 64 + lane];
                const float h1 = sinf(fr * a1);
                float a2 = b2[lane];
#pragma unroll
                for (int i = 0; i < 64; ++i) a2 += __shfl(h1, i) * w2[i * 64 + lane];
                h2s[lane * 12 + q] = sinf(fr * a2);
            }
            __syncthreads();
            float acc[2][10];
#pragma unroll
            for (int q = 0; q < 10; ++q) { acc[0][q] = 0.f; acc[1][q] = 0.f; }
#pragma unroll 8
            for (int i = 0; i < 64; ++i) {
                const float wa = w3[i * 1024 + tid], wb = w3[i * 1024 + 512 + tid];
                const f32x4 ha = *(const f32x4*)(h2s + i * 12), hb = *(const f32x4*)(h2s + i * 12 + 4); const float h8 = h2s[i * 12 + 8], h9 = h2s[i * 12 + 9];
                acc[0][0] += ha[0] * wa; acc[0][1] += ha[1] * wa; acc[0][2] += ha[2] * wa; acc[0][3] += ha[3] * wa; acc[0][4] += hb[0] * wa; acc[0][5] += hb[1] * wa; acc[0][6] += hb[2] * wa; acc[0][7] += hb[3] * wa; acc[0][8] += h8 * wa; acc[0][9] += h9 * wa;
                acc[1][0] += ha[0] * wb; acc[1][1] += ha[1] * wb; acc[1][2] += ha[2] * wb; acc[1][3] += ha[3] * wb; acc[1][4] += hb[0] * wb; acc[1][5] += hb[1] * wb; acc[1][6] += hb[2] * wb; acc[1][7] += hb[3] * wb; acc[1][8] += h8 * wb; acc[1][9] += h9 * wb;
            }
            const int ord = (tid >> 8) & 1, c = tid & 255;
            const float dec = fabsf(p.in[21][(l * 2 + ord) * 256 + c]);
            bf16_t* gl = (bf16_t*)(ws + OFF_FILT) + (size_t)l * G_L;
#pragma unroll
            for (int q = 0; q < 10; ++q) {
                const int rem = (u0 + q) % 1280; const int pass = rem >= 256; const int n = pass ? 1024 : 256; const int d = pass ? rem - 256 : rem;
                const float tt = (float)d / (float)(n - 1); const float win = expf(-tt * dec) / (float)(2 * n);
                bf16_t* g = gl + (pass ? G_CTX : 0) + ((size_t)ord * 256 + c) * (2 * n);
                g[n - 1 - d] = f2bf(acc[0][q] * win);
                g[d == 0 ? 2 * n - 1 : n - 1 + d] = d == 0 ? (bf16_t)0 : f2bf(acc[1][q] * win);
            }
        }
        __syncthreads();
    }
    __syncthreads();
    {
        bf16_t* FC = (bf16_t*)(ws + OFF_FC); bf16_t* FL = (bf16_t*)(ws + OFF_FL);
        const int gt = bid * NTHREADS + tid, gn = nb * NTHREADS;
        for (int i = gt; i < 256 * 512 + 1024 * 2048; i += gn) {
            int n, k, col; bf16_t* dst;
            if (i < 256 * 512) { n = 256; k = i >> 9; col = i & 511; dst = FC + i; } else { const int j = i - 256 * 512; n = 1024; k = j >> 11; col = j & 2047; dst = FL + j; }
            const int s = col >= n, t = col - s * n; const int ph = (k * t) & (n - 1);
            float sv, cv; sincosf(PI2 * (float)ph / (float)n, &sv, &cv);
            const float sc = rsqrtf(64.0f * (float)n);
            *dst = f2bf((s ? -sv : cv) * sc);
        }
        { bf16_t* CK = (bf16_t*)(ws + OFF_CKB); bf16_t* CV = (bf16_t*)(ws + OFF_CVT);
            for (int i = gt; i < 2 * 8 * 256 * 128; i += gn) {
                { const int c = i & 127, key = (i >> 7) & 255, b = (i >> 15) & 7, l = i >> 18;
                    CK[i] = f2bf(p.in[2][(((size_t)b * 2 + l) * 256 + key) * 128 + c]); }
                { const int key = i & 255, c = (i >> 8) & 127, b = (i >> 15) & 7, l = i >> 18;
                    CV[i] = f2bf(p.in[3][(((size_t)b * 2 + l) * 256 + key) * 128 + c]); }
            } }
        if (bid == 0) for (int i = tid; i < 64 * 16; i += NTHREADS) { const int pos = i >> 4, j = i & 15; const float inv = powf(10000.0f, -(float)(2 * j) / 32.0f);
            float sv, cv; sincosf((float)pos * inv, &sv, &cv); float* rp = (float*)(ws + OFF_ROPE); rp[2 * i] = cv; rp[2 * i + 1] = sv; }
    }
    __syncthreads();
}

template <int MODE>
__device__ void phase_row(const Params& p, int lpost, int spost, int lpre, int spre) {
    const int tid_ = opaque_tid(); const int lane = tid_ & 63, wv = tid_ >> 6;
    GAS unsigned char* wsg = (GAS unsigned char*)p.ws; asm volatile("" : "+s"(wsg));
    const GAS float* mod = (const GAS float*)(wsg + OFF_MOD);
    const GAS bf16_t* Y = (const GAS bf16_t*)(wsg + OFF_Y); const GAS float* ssq = (const GAS float*)(wsg + OFF_SSQ);
    GAS bf16_t* H = (GAS bf16_t*)(wsg + OFF_H); GAS bf16_t* X16 = (GAS bf16_t*)(wsg + OFF_X16);
    const float factor = (spost == 1) ? 1.0f : 0.5f;
    for (int rbase = (blockIdx.x * 8 + wv) * 8; rbase < NTOK; rbase += gridDim.x * 64) {
        const int bc = rbase < NCTX ? 0 : 1 + ((rbase - NCTX) >> 10);
        f32x4 coef[4], gsc[4], sh[4];
        if (MODE != 0) { const GAS float* gate = mod + ((size_t)lpost * 9 + bc) * 9216 + spost * 3072 + 2048; const float* gp = p.in[8] + (lpost * 6 + 2 * spost + 1) * 1024;
#pragma unroll
            for (int j = 0; j < 4; ++j) { const int c = j * 256 + lane * 4; coef[j] = *(const GAS f32x4*)(gate + c) * *(const f32x4*)(gp + c) * factor; } }
        if (MODE != 2) { const GAS float* mb = mod + ((size_t)lpre * 9 + bc) * 9216 + spre * 3072; const float* gp = p.in[8] + (lpre * 6 + 2 * spre) * 1024;
#pragma unroll
            for (int j = 0; j < 4; ++j) { const int c = j * 256 + lane * 4; sh[j] = *(const GAS f32x4*)(mb + c); gsc[j] = *(const f32x4*)(gp + c) * (*(const GAS f32x4*)(mb + 1024 + c) + 1.0f); } }
#pragma unroll 1
        for (int rp = 0; rp < 8; rp += 2) {
            f32x4 x[2][4]; u32x2 yv[2][4]; f32x4 sq[2][4];
#pragma unroll
            for (int q = 0; q < 2; ++q) {
                const int rw = rbase + rp + q;
                if (MODE == 0 || (lpost == 0 && spost == 0)) { const float* src = rw < NCTX ? p.in[0] + (size_t)rw * D : p.in[1] + (size_t)(rw - NCTX) * D;
#pragma unroll
                    for (int j = 0; j < 4; ++j) x[q][j] = *(const f32x4*)(src + j * 256 + lane * 4); }
                else {
#pragma unroll
                    for (int j = 0; j < 4; ++j) { const u32x2 xb = *(const GAS u32x2*)(X16 + (size_t)rw * D + j * 256 + lane * 4);
                        x[q][j][0] = __uint_as_float(xb.x << 16); x[q][j][1] = __uint_as_float(xb.x & 0xFFFF0000u); x[q][j][2] = __uint_as_float(xb.y << 16); x[q][j][3] = __uint_as_float(xb.y & 0xFFFF0000u); } }
                if (MODE != 0) {
#pragma unroll
                    for (int j = 0; j < 4; ++j) yv[q][j] = *(const GAS u32x2*)(Y + (size_t)rw * D + j * 256 + lane * 4);
                    const GAS f32x4* sp = (const GAS f32x4*)(ssq + (size_t)rw * 16);
#pragma unroll
                    for (int j = 0; j < 4; ++j) sq[q][j] = sp[j];
                }
            }
#pragma unroll
            for (int q = 0; q < 2; ++q) {
                const int row = rbase + rp + q;
                if (MODE != 0) {
                    float tot = 0.f;
#pragma unroll
                    for (int j = 0; j < 4; ++j) tot += (sq[q][j][0] + sq[q][j][1]) + (sq[q][j][2] + sq[q][j][3]);
                    const float rstd = rsqrtf(tot * (1.0f / 1024.0f) + EPS);
#pragma unroll
                    for (int j = 0; j < 4; ++j) {
                        x[q][j][0] += coef[j][0] * rstd * __uint_as_float(yv[q][j].x << 16);
                        x[q][j][1] += coef[j][1] * rstd * __uint_as_float(yv[q][j].x & 0xFFFF0000u);
                        x[q][j][2] += coef[j][2] * rstd * __uint_as_float(yv[q][j].y << 16);
                        x[q][j][3] += coef[j][3] * rstd * __uint_as_float(yv[q][j].y & 0xFFFF0000u); }
                    if (MODE == 2) {
#pragma unroll
                        for (int j = 0; j < 4; ++j) *(f32x4*)(p.out + (size_t)row * D + j * 256 + lane * 4) = x[q][j];
                    } else {
#pragma unroll
                        for (int j = 0; j < 4; ++j) { u32x2 w; w.x = pk_bf16(x[q][j][0], x[q][j][1]); w.y = pk_bf16(x[q][j][2], x[q][j][3]); *(GAS u32x2*)(X16 + (size_t)row * D + j * 256 + lane * 4) = w; }
                    }
                }
                if (MODE != 2) {
                    float s = 0.f;
#pragma unroll
                    for (int j = 0; j < 4; ++j) s += x[q][j][0] * x[q][j][0] + x[q][j][1] * x[q][j][1] + x[q][j][2] * x[q][j][2] + x[q][j][3] * x[q][j][3];
#pragma unroll
                    for (int o = 32; o >= 1; o >>= 1) s += __shfl_xor(s, o);
                    const float rs = rsqrtf(s * (1.0f / 1024.0f) + EPS);
#pragma unroll
                    for (int j = 0; j < 4; ++j) { const int c = j * 256 + lane * 4;
                        const f32x4 hh = x[q][j] * rs * gsc[j] + sh[j];
                        u32x2 w; w.x = pk_bf16(hh[0], hh[1]); w.y = pk_bf16(hh[2], hh[3]);
                        *(GAS u32x2*)(H + (size_t)row * D + c) = w; }
                }
            }
        }
    }
}

constexpr int AT_KROWB = 144;
constexpr int AT_VROWB_A = 784, AT_VROWB_B = 528;
constexpr int AT_OFF_V = 320 * AT_KROWB;
struct AttnState { f32x16 O0, O1; float m, lsum; };
template <bool MASK>
__device__ __forceinline__ void attn_tiles(AttnState& st, const bf16x8 (&qf)[4], const LAS unsigned char* Kl, const LAS unsigned char* Vl, int vrowb, int t0, int t1, int dk0, int r, int h) {
    for (int t = t0; t < t1; ++t) {
        const LAS unsigned char* kp = Kl + (t * 32 + r) * AT_KROWB + h * 16;
        bf16x8 kf[4];
#pragma unroll
        for (int kk = 0; kk < 4; ++kk) kf[kk] = *(const LAS bf16x8*)(kp + kk * 32);
        const LAS unsigned char* vp = Vl + r * vrowb + (t * 32 + 4 * h) * 2;
        u32x2 vraw[2][2][2];
#pragma unroll
        for (int dt = 0; dt < 2; ++dt)
#pragma unroll
            for (int s = 0; s < 2; ++s)
#pragma unroll
                for (int q = 0; q < 2; ++q) vraw[dt][s][q] = *(const LAS u32x2*)(vp + dt * 32 * vrowb + (16 * s + 8 * q) * 2);
        f32x16 S;
#pragma unroll
        for (int i = 0; i < 16; ++i) S[i] = 0.f;
#pragma unroll
        for (int kk = 0; kk < 4; ++kk) S = __builtin_amdgcn_mfma_f32_32x32x16_bf16(kf[kk], qf[kk], S, 0, 0, 0);
        if (MASK) {
            const int dk = dk0 + t * 32;
            if (dk <= -128 || dk >= 128) {
#pragma unroll
                for (int i = 0; i < 16; ++i) { const int j = (i & 3) + 8 * (i >> 2) + 4 * h; int dd = dk + j - r; if (dd < 0) dd = -dd; if (dd > 128) S[i] = -1e30f; }
            }
        }
        float mx = S[0];
#pragma unroll
        for (int i = 1; i < 16; ++i) mx = fmaxf(mx, S[i]);
        mx = fmaxf(mx, __shfl_xor(mx, 32));
        const float mn = fmaxf(st.m, mx), corr = __expf(st.m - mn);
        st.m = mn;
        float rs = 0.f;
#pragma unroll
        for (int i = 0; i < 16; ++i) { S[i] = __expf(S[i] - mn); rs += S[i]; }
        rs += __shfl_xor(rs, 32);
        st.lsum = st.lsum * corr + rs;
#pragma unroll
        for (int i = 0; i < 16; ++i) { st.O0[i] *= corr; st.O1[i] *= corr; }
        bf16x8 pf[2];
#pragma unroll
        for (int s = 0; s < 2; ++s) { u32x4 w; w.x = pk_bf16(S[8 * s], S[8 * s + 1]); w.y = pk_bf16(S[8 * s + 2], S[8 * s + 3]); w.z = pk_bf16(S[8 * s + 4], S[8 * s + 5]); w.w = pk_bf16(S[8 * s + 6], S[8 * s + 7]);
            pf[s] = __builtin_bit_cast(bf16x8, w); }
#pragma unroll
        for (int s = 0; s < 2; ++s) {
            u32x4 a0; a0.x = vraw[0][s][0].x; a0.y = vraw[0][s][0].y; a0.z = vraw[0][s][1].x; a0.w = vraw[0][s][1].y;
            u32x4 a1; a1.x = vraw[1][s][0].x; a1.y = vraw[1][s][0].y; a1.z = vraw[1][s][1].x; a1.w = vraw[1][s][1].y;
            st.O0 = __builtin_amdgcn_mfma_f32_32x32x16_bf16(__builtin_bit_cast(bf16x8, a0), pf[s], st.O0, 0, 0, 0);
            st.O1 = __builtin_amdgcn_mfma_f32_32x32x16_bf16(__builtin_bit_cast(bf16x8, a1), pf[s], st.O1, 0, 0, 0);
        }
    }
}
__device__ __forceinline__ void attn_unit(const Params& p, int l, int u, LAS unsigned char* lds, int tid) {
    const int lane = tid & 63, wv = tid >> 6, r = lane & 31, h = lane >> 5;
    const bf16_t* QB = (const bf16_t*)(p.ws + OFF_QB); const bf16_t* KB = (const bf16_t*)(p.ws + OFF_KB); const bf16_t* VT = (const bf16_t*)(p.ws + OFF_VB);
    const bf16_t* CK = (const bf16_t*)(p.ws + OFF_CKB); const bf16_t* CV = (const bf16_t*)(p.ws + OFF_CVT);
    bf16_t* YC = (bf16_t*)(p.ws + OFF_YCAT);
    const int g = wv & 3, qh = wv >> 2;
    const int pass = u < 256; const int v = u & 255;
    int b, kvh, qb, n, rowbase;
    if (!pass) { b = v >> 3; kvh = (v >> 2) & 1; qb = v & 3; n = 256; rowbase = b * 256; }
    else { b = v >> 5; kvh = (v >> 4) & 1; qb = v & 15; n = 1024; rowbase = NCTX + b * 1024; }
    const int head = kvh * 4 + g, q0w = qb * 64 + qh * 32;
    int kloU = 0, khiU = 256;
    if (pass) { kloU = qb * 64 - 128; if (kloU < 0) kloU = 0; khiU = qb * 64 + 192; if (khiU > n) khiU = n; }
    const int nkA = khiU - kloU, npc = nkA * 8, vpr = nkA >> 3;
    const bf16_t* kA = KB + (size_t)(rowbase + kloU) * 128 + kvh * 64;
    const bf16_t* vA = VT + (pass ? VT_LAT + (size_t)b * 128 * 1024 : (size_t)b * 128 * 256) + (size_t)kvh * 64 * n + kloU;
    {
        u32x4 kr[5], vr[5];
#pragma unroll
        for (int it = 0; it < 5; ++it) { const int idx = tid + it * NTHREADS;
            if (idx < npc) { kr[it] = *(const u32x4*)(kA + (size_t)(idx >> 3) * 128 + (idx & 7) * 8);
                const int d = idx / vpr, j = idx - d * vpr; vr[it] = *(const u32x4*)(vA + (size_t)d * n + j * 8); } }
#pragma unroll
        for (int it = 0; it < 5; ++it) { const int idx = tid + it * NTHREADS;
            if (idx < npc) { *(LAS u32x4*)(lds + (idx >> 3) * AT_KROWB + (idx & 7) * 16) = kr[it];
                const int d = idx / vpr, j = idx - d * vpr; *(LAS u32x4*)(lds + AT_OFF_V + d * AT_VROWB_A + j * 16) = vr[it]; } }
    }
    bf16x8 qf[4];
    { const bf16_t* qp = QB + (size_t)(rowbase + q0w + r) * 512 + head * 64 + 8 * h;
#pragma unroll
        for (int kk = 0; kk < 4; ++kk) qf[kk] = *(const bf16x8*)(qp + 16 * kk); }
    AttnState st; st.m = p.in[23][l * 8 + head]; st.lsum = 1.0f;
#pragma unroll
    for (int i = 0; i < 16; ++i) { st.O0[i] = 0.f; st.O1[i] = 0.f; }
    __syncthreads();
    u32x4 kb[4], vb[4];
    if (pass) {
        const bf16_t* kB = CK + ((size_t)(l * 8 + b) * 256) * 128 + kvh * 64;
        const bf16_t* vB = CV + ((size_t)(l * 8 + b) * 128 + kvh * 64) * 256;
#pragma unroll
        for (int it = 0; it < 4; ++it) { const int idx = tid + it * NTHREADS;
            kb[it] = *(const u32x4*)(kB + (size_t)(idx >> 3) * 128 + (idx & 7) * 8);
            vb[it] = *(const u32x4*)(vB + (size_t)(idx >> 5) * 256 + (idx & 31) * 8); }
    }
    {
        int klo = 0, khi = 256;
        if (pass) { klo = q0w - 128; if (klo < 0) klo = 0; khi = q0w + 160; if (khi > n) khi = n; }
        const int t0 = (klo - kloU) >> 5, t1 = (khi - kloU) >> 5;
        if (pass) attn_tiles<true>(st, qf, lds, lds + AT_OFF_V, AT_VROWB_A, t0, t1, kloU - q0w, r, h);
        else attn_tiles<false>(st, qf, lds, lds + AT_OFF_V, AT_VROWB_A, t0, t1, 0, r, h);
    }
    if (pass) {
        __syncthreads();
#pragma unroll
        for (int it = 0; it < 4; ++it) { const int idx = tid + it * NTHREADS;
            *(LAS u32x4*)(lds + (idx >> 3) * AT_KROWB + (idx & 7) * 16) = kb[it];
            *(LAS u32x4*)(lds + AT_OFF_V + (idx >> 5) * AT_VROWB_B + (idx & 31) * 16) = vb[it]; }
        __syncthreads();
        attn_tiles<false>(st, qf, lds, lds + AT_OFF_V, AT_VROWB_B, 0, 8, 0, r, h);
    }
    const float inv = 1.0f / st.lsum;
    bf16_t* op = YC + (size_t)(rowbase + q0w + r) * 1024 + 512 + head * 64 + 4 * h;
#pragma unroll
    for (int gq = 0; gq < 4; ++gq) {
        u32x2 w0; w0.x = pk_bf16(st.O0[4 * gq] * inv, st.O0[4 * gq + 1] * inv); w0.y = pk_bf16(st.O0[4 * gq + 2] * inv, st.O0[4 * gq + 3] * inv);
        u32x2 w1; w1.x = pk_bf16(st.O1[4 * gq] * inv, st.O1[4 * gq + 1] * inv); w1.y = pk_bf16(st.O1[4 * gq + 2] * inv, st.O1[4 * gq + 3] * inv);
        *(u32x2*)(op + 8 * gq) = w0; *(u32x2*)(op + 32 + 8 * gq) = w1;
    }
    __syncthreads();
}
__device__ void attn_mfma(const Params& p, int l, LAS unsigned char* lds) {
    const int tid = opaque_tid();
    for (int u = blockIdx.x; u < 512; u += gridDim.x) attn_unit(p, l, u, lds, tid);
}

template <int NB  , int NBLK  >
__device__ __forceinline__ void hyena_unit(const Params& p, int l, int c, const bf16_t* __restrict__ HTp, int rowbase, const bf16_t* __restrict__ gb, LAS unsigned char* lds, int tid) {
    constexpr int n = 32 * NBLK, NI = 32 / NB, PAD = 32 * (NI - 1);
    constexpr int LENB = (2 * n * 2 - 64 + 255) / 256 * 256 + 64;
    constexpr int UROWB = ((n + 2 * PAD) * 2 + 255) / 256 * 256 + 16;
    constexpr int GSB = (2 * n + 8) * 2;
    constexpr int OFF_F0 = 0, OFF_F1 = 8 * LENB, OFF_U = 16 * LENB, OFF_U2 = OFF_U + NB * UROWB, OFF_G1 = OFF_U2 + NB * UROWB, OFF_G2 = OFF_G1 + NB * n * 2, OFF_GS = OFF_G2 + NB * n * 2;
    static_assert(OFF_GS + 2 * GSB <= 149 * 1024, "hyena LDS");
    const int lane = tid & 63, wv = tid >> 6, r = lane & 31, h = lane >> 5;
    const float* cw = p.in[14] + l * 3 * 768;
    if (tid < 2 * (2 * n / 8)) { const int o = tid / (2 * n / 8), k = tid % (2 * n / 8);
        *(LAS u32x4*)(lds + OFF_GS + o * GSB + k * 16) = *(const u32x4*)(gb + ((size_t)o * 256 + c) * (2 * n) + k * 8); }
    if (tid < 2) *(LAS u32x4*)(lds + OFF_GS + tid * GSB + 2 * n * 2) = (u32x4){0u, 0u, 0u, 0u};
    constexpr int NQ = 3 * NB * (n / 8) / NTHREADS;
#pragma unroll
    for (int it = 0; it < NQ; ++it) {
        const int q = tid + it * NTHREADS;
        const int w = q / (NB * (n / 8)), rem = q % (NB * (n / 8)), b = rem / (n / 8), t0 = (rem % (n / 8)) * 8;
        const int ch = w * 256 + c; const bf16_t* row = HTp + ((size_t)b * 768 + ch) * n;
        const float w0 = cw[ch], w1 = cw[768 + ch], w2 = cw[1536 + ch];
        const u32x4 raw = *(const u32x4*)(row + t0);
        float x[10];
        x[0] = t0 > 0 ? bf2f(row[t0 - 1]) : 0.f; x[9] = t0 + 8 < n ? bf2f(row[t0 + 8]) : 0.f;
        x[1] = __uint_as_float(raw.x << 16); x[2] = __uint_as_float(raw.x & 0xFFFF0000u); x[3] = __uint_as_float(raw.y << 16); x[4] = __uint_as_float(raw.y & 0xFFFF0000u);
        x[5] = __uint_as_float(raw.z << 16); x[6] = __uint_as_float(raw.z & 0xFFFF0000u); x[7] = __uint_as_float(raw.w << 16); x[8] = __uint_as_float(raw.w & 0xFFFF0000u);
        float z[8];
#pragma unroll
        for (int e = 0; e < 8; ++e) z[e] = x[e] * w0 + x[e + 1] * w1 + x[e + 2] * w2;
        u32x4 o; o.x = pk_bf16(z[0], z[1]); o.y = pk_bf16(z[2], z[3]); o.z = pk_bf16(z[4], z[5]); o.w = pk_bf16(z[6], z[7]);
        LAS unsigned char* dst = w == 0 ? lds + OFF_U + b * UROWB + (PAD + t0) * 2 : lds + (w == 1 ? OFF_G1 : OFF_G2) + (b * n + t0) * 2;
        *(LAS u32x4*)dst = o;
    }
    if (PAD > 0) {
        constexpr int FR = PAD / 8, BK_ = (UROWB / 2 - PAD - n) / 8;
        for (int q = tid; q < 2 * NB * (FR + BK_); q += NTHREADS) {
            const int buf = q / (NB * (FR + BK_)), rem = q % (NB * (FR + BK_)), b = rem / (FR + BK_), k = rem % (FR + BK_);
            const int e0 = k < FR ? k * 8 : PAD + n + (k - FR) * 8;
            *(LAS u32x4*)(lds + (buf ? OFF_U2 : OFF_U) + b * UROWB + e0 * 2) = (u32x4){0u, 0u, 0u, 0u};
        }
    }
    __syncthreads();
    if (tid < 2 * (2 * n / 8)) { const int o = tid / (2 * n / 8), k = tid % (2 * n / 8);
        const u32x4 lo = *(const LAS u32x4*)(lds + OFF_GS + o * GSB + k * 16), hi = *(const LAS u32x4*)(lds + OFF_GS + o * GSB + k * 16 + 16);
        const unsigned d[8] = {lo.x, lo.y, lo.z, lo.w, hi.x, hi.y, hi.z, hi.w};
        LAS unsigned char* fdst = lds + (o ? OFF_F1 : OFF_F0) + k * 16;
#pragma unroll
        for (int s = 0; s < 8; ++s) { u32x4 w;
            if ((s & 1) == 0) { w.x = d[s / 2]; w.y = d[s / 2 + 1]; w.z = d[s / 2 + 2]; w.w = d[s / 2 + 3]; }
            else { w.x = __builtin_amdgcn_alignbyte(d[s / 2 + 1], d[s / 2], 2); w.y = __builtin_amdgcn_alignbyte(d[s / 2 + 2], d[s / 2 + 1], 2);
                   w.z = __builtin_amdgcn_alignbyte(d[s / 2 + 3], d[s / 2 + 2], 2); w.w = __builtin_amdgcn_alignbyte(d[s / 2 + 4], d[s / 2 + 3], 2); }
            *(LAS u32x4*)(fdst + s * LENB) = w; }
    }
    __syncthreads();
    const int bcol = NB == 8 ? (r >> 2) : r, ioff = NB == 8 ? (r & 3) : 0, I0 = wv * NI, Icol = I0 + ioff;
    const int si = (7 - r) & 7;
    const int Dlo = I0 + NI - 1 - (NBLK - 1) - (NI - 1), Dhi = I0 + NI - 1;
    bf16_t* YC = (bf16_t*)(p.ws + OFF_YCAT);
#pragma unroll
    for (int o = 0; o < 2; ++o) {
        const LAS unsigned char* ap = lds + (o ? OFF_F1 : OFF_F0) + si * LENB + (n - 1 - r + 8 * h - si) * 2 - 64 * Dlo;
        const LAS unsigned char* bp = lds + (o ? OFF_U2 : OFF_U) + bcol * UROWB + (PAD + 32 * Icol + 8 * h) * 2 - 64 * Dlo;
        f32x16 acc;
#pragma unroll
        for (int i = 0; i < 16; ++i) acc[i] = 0.f;
#pragma unroll 4
        for (int D = Dlo; D <= Dhi; ++D) {
            const bf16x8 a0 = *(const LAS bf16x8*)ap, a1 = *(const LAS bf16x8*)(ap + 32);
            const bf16x8 b0 = *(const LAS bf16x8*)bp, b1 = *(const LAS bf16x8*)(bp + 32);
            acc = __builtin_amdgcn_mfma_f32_32x32x16_bf16(a0, b0, acc, 0, 0, 0);
            acc = __builtin_amdgcn_mfma_f32_32x32x16_bf16(a1, b1, acc, 0, 0, 0);
            ap -= 64; bp -= 64;
        }
        const float bias = p.in[22][(l * 2 + o) * 256 + c];
#pragma unroll
        for (int g = 0; g < 4; ++g) {
            const int t0 = 32 * Icol + 8 * g + 4 * h;
            const u32x2 uin = *(const LAS u32x2*)(lds + (o ? OFF_U2 : OFF_U) + bcol * UROWB + (PAD + t0) * 2);
            const u32x2 gin = *(const LAS u32x2*)(lds + (o ? OFF_G2 : OFF_G1) + (bcol * n + t0) * 2);
            float y[4];
            y[0] = __uint_as_float(gin.x << 16) * (acc[4 * g] + bias * __uint_as_float(uin.x << 16));
            y[1] = __uint_as_float(gin.x & 0xFFFF0000u) * (acc[4 * g + 1] + bias * __uint_as_float(uin.x & 0xFFFF0000u));
            y[2] = __uint_as_float(gin.y << 16) * (acc[4 * g + 2] + bias * __uint_as_float(uin.y << 16));
            y[3] = __uint_as_float(gin.y & 0xFFFF0000u) * (acc[4 * g + 3] + bias * __uint_as_float(uin.y & 0xFFFF0000u));
            if (o == 0) { u32x2 w; w.x = pk_bf16(y[0], y[1]); w.y = pk_bf16(y[2], y[3]);
                *(LAS u32x2*)(lds + OFF_U2 + bcol * UROWB + (PAD + t0) * 2) = w; }
            else { bf16_t* dst = YC + (size_t)(rowbase + bcol * n + t0) * 1024 + 256 + c;
#pragma unroll
                for (int e = 0; e < 4; e += 2) { const unsigned w = pk_bf16(y[e], y[e + 1]); dst[(size_t)e * 1024] = (bf16_t)w; dst[(size_t)(e + 1) * 1024] = (bf16_t)(w >> 16); } }
        }
        __syncthreads();
    }
}
__device__ void hyena_mfma(const Params& p, int l, LAS unsigned char* lds) {
    const int tid = opaque_tid();
    const bf16_t* HT = (const bf16_t*)(p.ws + OFF_HT);
    const bf16_t* gl = (const bf16_t*)(p.ws + OFF_FILT) + (size_t)l * G_L;
    for (int u = blockIdx.x; u < 512; u += gridDim.x) {
        if (u < 256) hyena_unit<8, 32>(p, l, u, HT + HT_LAT, NCTX, gl + G_CTX, lds, tid);
        else hyena_unit<32, 8>(p, l, u - 256, HT, 0, gl, lds, tid);
    }
}


struct OneUnit { int pm, pn;
    __device__ __forceinline__ bool next(int i, pg8::Unit& u) const { if (i) return false; u.pm = pm; u.pn = pn; return true; }
    __device__ __forceinline__ void a_ready(const pg8::Unit&) const {}
    __device__ __forceinline__ void done(const pg8::Unit&) const {} };
__device__ void mixer_phase(const Params& p, int l, LAS unsigned char* lds) {
    constexpr int NU = 32 + 256 + 256 + 32 + 256 + 256;
    GAS unsigned char* wsg = (GAS unsigned char*)p.ws; asm volatile("" : "+s"(wsg)); unsigned char* ws = (unsigned char*)wsg;
    unsigned* ctr = (unsigned*)(ws + OFF_BAR) + 64 * l;
    volatile LAS unsigned* slot = (volatile LAS unsigned*)(lds + 149 * 1024 + 8);
    const bf16_t* HT = (const bf16_t*)(ws + OFF_HT);
    const bf16_t* gl = (const bf16_t*)(ws + OFF_FILT) + (size_t)l * G_L;
    int u = blockIdx.x;
    while (u < NU) {
        unsigned ticket = 0;
        if (threadIdx.x == 0) ticket = __hip_atomic_fetch_add(ctr, 1u, __ATOMIC_RELAXED, __HIP_MEMORY_SCOPE_AGENT);
        const int tid = opaque_tid();
        if (u < 32) {
            pg8::Gemm g{(const bf16_t*)(ws + OFF_FL), (const bf16_t*)(ws + OFF_ZT) + ZT_LAT, 1024, 2048, 2048, 2048, 2048};
            OneUnit S{u & 3, u >> 2}; EpiFourier E{(bf16_t*)(ws + OFF_YCAT), NCTX, 1024};
            pg8::gemm_phase(lds, g, S, E);
        } else if (u < 288) hyena_unit<8, 32>(p, l, u - 32, HT + HT_LAT, NCTX, gl + G_CTX, lds, tid);
        else if (u < 544) attn_unit(p, l, u - 288, lds, tid);
        else if (u < 576) {
            pg8::Gemm g{(const bf16_t*)(ws + OFF_FC), (const bf16_t*)(ws + OFF_ZT), 256, 8192, 512, 512, 512};
            OneUnit S{0, u - 544}; EpiFourier E{(bf16_t*)(ws + OFF_YCAT), 0, 256};
            pg8::gemm_phase(lds, g, S, E);
        } else if (u < 832) attn_unit(p, l, 256 + (u - 576), lds, tid);
        else hyena_unit<32, 8>(p, l, u - 832, HT, 0, gl, lds, tid);
        if (threadIdx.x == 0) *slot = ticket + 256u;
        __syncthreads();
        u = (int)*slot;
        __syncthreads();
    }
}

__global__ void __launch_bounds__(NTHREADS, 2) fwd_megakernel(Params p) {
    extern __shared__ __attribute__((aligned(16))) unsigned char shm[];
    cg::grid_group grid = cg::this_grid();
    LAS unsigned char* lds = (LAS unsigned char*)shm;
    float* ldsf = (float*)shm;
    unsigned char* ws = p.ws;
    const int G = gridDim.x, c = blockIdx.x;

    volatile LAS unsigned* xst = (volatile LAS unsigned*)(lds + 149 * 1024);
    if (threadIdx.x < 4) xst[threadIdx.x] = 0u;
    __syncthreads();
    const XcdBarrier xb = xcd_barrier_post((unsigned*)(ws + OFF_BAR), xst);
    for (int _d = 0; _d < DUP_PREP; ++_d) { phase_prep(p, ldsf); __syncthreads(); }
    if (p.ws == nullptr) grid.sync();
    GSYNC();
    phase_row<0>(p, 0, 0, 0, 0);
    GSYNC();
    for (int l = 0; l < 2; ++l) {
        for (int s = 0; s < 3; ++s) {
            GAS unsigned char* wsg = (GAS unsigned char*)p.ws; asm volatile("" : "+s"(wsg)); unsigned char* ws = (unsigned char*)wsg;
            if (s != 1) {
                const int fs = s >> 1;
                { pg8::Gemm g{(const bf16_t*)(ws + OFF_H), (const bf16_t*)(ws + OFF_WGU + (l * 2 + fs) * SZ_WGU), NTOK, 5632, 1024, 1024, 1024};
                    pg8::StaticOrder S; S.init(g.M, g.N, G, c); EpiSwiglu E{(bf16_t*)(ws + OFF_ACT)};
                    for (int _d = 0; _d < DUP_GEMM; ++_d) pg8::gemm_phase(lds, g, S, E); }
                { int cc = c, gg = G; asm volatile("" : "+s"(cc), "+s"(gg));
                    if (cc >= 1408 - 5 * gg) { __syncthreads(); tr_slot(p, ldsf, 1 + l * 2 + fs, cc - (1408 - 5 * gg), gg - (1408 - 5 * gg), opaque_tid()); } }
                GSYNC();
                { pg8::Gemm g{(const bf16_t*)(ws + OFF_ACT), (const bf16_t*)(ws + OFF_WD + (l * 2 + fs) * SZ_WD), NTOK, 1024, DFF, DFF, DFF};
                    pg8::StaticOrder S; S.init(g.M, g.N, G, c); EpiYssq E{(bf16_t*)(ws + OFF_Y), (float*)(ws + OFF_SSQ)};
                    for (int _d = 0; _d < DUP_GEMM; ++_d) pg8::gemm_phase(lds, g, S, E); }
                GSYNC();
            } else {
                { pg8::Gemm g{(const bf16_t*)(ws + OFF_H), (const bf16_t*)(ws + OFF_WIN + l * SZ_WIN), NTOK, 2048, 1024, 1024, 1024};
                    pg8::StaticOrder S; S.init(g.M, g.N, G, c);
                    EpiWin E{(bf16_t*)(ws + OFF_ZT), (bf16_t*)(ws + OFF_HT), (bf16_t*)(ws + OFF_QB), (bf16_t*)(ws + OFF_KB), (bf16_t*)(ws + OFF_VB), (const float*)(ws + OFF_ROPE),
                             p.out + (size_t)NTOK * D, p.out + (size_t)NTOK * D + (size_t)32 * 2 * 256 * 128, l};
                    for (int _d = 0; _d < DUP_GEMM; ++_d) pg8::gemm_phase(lds, g, S, E); }
                GSYNC();
                mixer_phase(p, l, lds);
                GSYNC();
                { pg8::Gemm g{(const bf16_t*)(ws + OFF_YCAT), (const bf16_t*)(ws + OFF_WOUT + l * SZ_WOUT), NTOK, 1024, 1024, 1024, 1024};
                    pg8::StaticOrder S; S.init(g.M, g.N, G, c); EpiYssq E{(bf16_t*)(ws + OFF_Y), (float*)(ws + OFF_SSQ)};
                    for (int _d = 0; _d < DUP_GEMM; ++_d) pg8::gemm_phase(lds, g, S, E); }
                GSYNC();
            }
            if (l == 1 && s == 2) phase_row<2>(p, l, s, 0, 0);
            else { const int ln = s == 2 ? l + 1 : l, sn = s == 2 ? 0 : s + 1; phase_row<1>(p, l, s, ln, sn); }
            if (!(l == 1 && s == 2)) GSYNC();
        }
    }
}

extern "C" void kernel_launch(void* const* d_in, const int* in_sizes, int n_in, void* d_out, int out_size, void* d_ws, size_t ws_size, hipStream_t stream) {
    constexpr int LDS_BYTES = 149 * 1024 + 256;
    static int grid_blocks = 0;
    if (!grid_blocks) {
        if (n_in != 24 || ws_size < WS_END) { fprintf(stderr, "kernel_launch: bad inputs (n_in %d) or workspace too small (%zu < %zu)\n", n_in, ws_size, (size_t)WS_END); grid_blocks = -1; return; }
        int dev = 0, cus = 0, per_cu = 0;
        hipGetDevice(&dev);
        hipDeviceGetAttribute(&cus, hipDeviceAttributeMultiprocessorCount, dev);
        if (hipFuncSetAttribute((const void*)fwd_megakernel, hipFuncAttributeMaxDynamicSharedMemorySize, LDS_BYTES) != hipSuccess) fprintf(stderr, "kernel_launch: hipFuncSetAttribute failed\n");
        hipOccupancyMaxActiveBlocksPerMultiprocessor(&per_cu, (const void*)fwd_megakernel, NTHREADS, LDS_BYTES);
        if (per_cu < 1) { fprintf(stderr, "kernel_launch: occupancy query says %d blocks per CU\n", per_cu); per_cu = 1; }
        (void)hipGetLastError();
        grid_blocks = cus * per_cu;
        if (grid_blocks > 256) grid_blocks = 256;
    }
    if (grid_blocks < 0) return;
    Params p{};
    for (int i = 0; i < 24; ++i) p.in[i] = (const float*)d_in[i];
    p.out = (float*)d_out; p.ws = (unsigned char*)d_ws;
    (void)hipMemsetAsync((unsigned char*)d_ws + OFF_BAR, 0, 16384, stream);
    void* args[] = {&p};
    hipError_t e = hipLaunchCooperativeKernel((const void*)fwd_megakernel, dim3(grid_blocks), dim3(NTHREADS), args, LDS_BYTES, stream);
    if (e != hipSuccess) fprintf(stderr, "cooperative launch failed: %s (grid %d)\n", hipGetErrorString(e), grid_blocks);
}
```
